# Optimizing an MI355X kernel written in HIP

```python
import math
import jax, jax.numpy as jnp
from jax import lax
import numpy as np

D_MODEL = 1024
BATCH = 4
SEQ = 8192
DEPTH = 1

N_Q_HEADS = 8
N_KV_HEADS = 2
GROUP = N_Q_HEADS // N_KV_HEADS
HEAD_DIM = 64
ROT_DIM = HEAD_DIM // 4
ROPE_THETA = 500000.0
WINDOW = 128
ATTN_BLOCK = 128
ATTN_WIDTH = N_Q_HEADS * HEAD_DIM
KV_WIDTH = N_KV_HEADS * HEAD_DIM

HGRN_HEADS = 4
HGRN_KEY_DIM = 128
HGRN_VAL_DIM = 128
HGRN_KEY_WIDTH = HGRN_HEADS * HGRN_KEY_DIM
HGRN_WIDTH = HGRN_HEADS * HGRN_VAL_DIM
HGRN_CHUNK = 64

IN_SIZES = (ATTN_WIDTH, KV_WIDTH, KV_WIDTH,
            HGRN_KEY_WIDTH, HGRN_KEY_WIDTH, HGRN_WIDTH, HGRN_WIDTH,
            D_MODEL, D_MODEL)
IN_WIDTH = sum(IN_SIZES)

N_GROUPS = 4
EXPERTS_PER_GROUP = 8
N_EXPERTS = N_GROUPS * EXPERTS_PER_GROUP
TOP_K = 2
EXPERT_FF = 512
MOE_BLOCK = 128

NORM_EPS = 1e-6

kernel_name = "hybrid_swa_hgrn2_hmoe_block"


def rms_norm(x, w):
    xf = x.astype(jnp.float32)
    y = xf * lax.rsqrt(jnp.mean(xf * xf, axis=-1, keepdims=True) + NORM_EPS)
    return (y * w.astype(jnp.float32)).astype(x.dtype)


def rope_tables(positions):
    inv_freq = ROPE_THETA ** (-jnp.arange(0, ROT_DIM, 2, dtype=jnp.float32) / ROT_DIM)
    ang = positions.astype(jnp.float32)[..., None] * inv_freq
    return jnp.cos(ang)[:, :, None, :], jnp.sin(ang)[:, :, None, :]


def partial_rope(x, cos, sin):
    half = ROT_DIM // 2
    xf = x.astype(jnp.float32)
    x1, x2 = xf[..., :half], xf[..., half:ROT_DIM]
    out = jnp.concatenate([x1 * cos - x2 * sin, x2 * cos + x1 * sin, xf[..., ROT_DIM:]], axis=-1)
    return out.astype(x.dtype)


def sliding_window_gqa(q, k, v, sinks):
    B, S = q.shape[0], q.shape[1]
    nb = S // ATTN_BLOCK
    qb = q.reshape(B, nb, ATTN_BLOCK, N_KV_HEADS, GROUP, HEAD_DIM).astype(jnp.float32)
    kb = k.reshape(B, nb, ATTN_BLOCK, N_KV_HEADS, HEAD_DIM).astype(jnp.float32)
    vb = v.reshape(B, nb, ATTN_BLOCK, N_KV_HEADS, HEAD_DIM).astype(jnp.float32)
    pad = ((0, 0), (1, 0), (0, 0), (0, 0), (0, 0))
    kk = jnp.concatenate([jnp.pad(kb[:, :-1], pad), kb], axis=2)
    vv = jnp.concatenate([jnp.pad(vb[:, :-1], pad), vb], axis=2)
    s = jnp.einsum('bnqhgd,bnkhd->bnhgqk', qb, kk) * (HEAD_DIM ** -0.5)
    qi = jnp.arange(ATTN_BLOCK)[:, None] + ATTN_BLOCK
    kj = jnp.arange(2 * ATTN_BLOCK)[None, :]
    band = (kj <= qi) & (qi - kj < WINDOW)
    has_prev = (jnp.arange(nb)[:, None, None] > 0) | (kj[None] >= ATTN_BLOCK)
    valid = band[None] & has_prev
    s = jnp.where(valid[None, :, None, None], s, -jnp.inf)
    sink = sinks.astype(jnp.float32).reshape(N_KV_HEADS, GROUP)[None, None, :, :, None, None]
    m = jnp.maximum(jnp.max(s, axis=-1, keepdims=True), sink)
    p = jnp.exp(s - m)
    denom = jnp.sum(p, axis=-1, keepdims=True) + jnp.exp(sink - m)
    o = jnp.einsum('bnhgqk,bnkhd->bnqhgd', p / denom, vv)
    return o.reshape(B, S, ATTN_WIDTH).astype(q.dtype)


def hgrn2_chunkwise(q, k, v, log_f):
    B, S = q.shape[0], q.shape[1]
    nc = S // HGRN_CHUNK

    def to_chunks(t):
        return t.reshape(B, nc, HGRN_CHUNK, HGRN_HEADS, t.shape[-1]).transpose(1, 0, 3, 2, 4)

    causal = jnp.tril(jnp.ones((HGRN_CHUNK, HGRN_CHUNK), dtype=bool))

    def step(state, inp):
        qc, kc, vc, gc = inp
        b = jnp.cumsum(gc, axis=2)
        o_inter = jnp.einsum('bhtk,bhkv->bhtv', qc * jnp.exp(b), state)
        diff = b[:, :, :, None, :] - b[:, :, None, :, :]
        decay = jnp.exp(jnp.where(causal[:, :, None], diff, -jnp.inf))
        a = jnp.einsum('bhtk,bhsk,bhtsk->bhts', qc, kc, decay)
        o_intra = jnp.einsum('bhts,bhsv->bhtv', a, vc)
        b_last = b[:, :, -1:, :]
        state = jnp.exp(b_last[:, :, 0])[..., None] * state + jnp.einsum(
            'bhsk,bhsv->bhkv', kc * jnp.exp(b_last - b), vc)
        return state, o_inter + o_intra

    init = jnp.zeros((B, HGRN_HEADS, HGRN_KEY_DIM, HGRN_VAL_DIM), jnp.float32)
    _, o = lax.scan(step, init, (to_chunks(q), to_chunks(k), to_chunks(v), to_chunks(log_f)))
    return o.transpose(1, 0, 3, 2, 4).reshape(B, S, HGRN_HEADS, HGRN_VAL_DIM)


def hierarchical_moe(xn, w_rg, b_rg, w_re, b_re, w_gate, w_up, w_down):
    T, D = xn.shape
    lg = (xn @ w_rg).astype(jnp.float32) + b_rg.astype(jnp.float32)
    pg = jax.nn.softmax(lg, axis=-1)
    gsel = jnp.argmax(pg, axis=-1)
    pgsel = jnp.take_along_axis(pg, gsel[:, None], axis=1)[:, 0]
    le = ((xn @ w_re).astype(jnp.float32) + b_re.astype(jnp.float32)).reshape(T, N_GROUPS, EXPERTS_PER_GROUP)
    le_sel = jnp.take_along_axis(le, gsel[:, None, None], axis=1)[:, 0]
    pe = jax.nn.softmax(le_sel, axis=-1)
    topv, topi = lax.top_k(pe, TOP_K)
    gate_w = pgsel[:, None] * topv / jnp.sum(topv, axis=-1, keepdims=True)
    eid = gsel[:, None] * EXPERTS_PER_GROUP + topi

    TK = T * TOP_K
    flat_e = eid.reshape(-1).astype(jnp.int32)
    flat_tok = jnp.repeat(jnp.arange(T, dtype=jnp.int32), TOP_K)
    flat_w = gate_w.reshape(-1)
    order = jnp.argsort(flat_e)
    se = flat_e[order]
    counts = jnp.bincount(flat_e, length=N_EXPERTS)
    starts = jnp.cumsum(counts) - counts
    padded = ((counts + MOE_BLOCK - 1) // MOE_BLOCK) * MOE_BLOCK
    pends = jnp.cumsum(padded)
    pstarts = pends - padded
    dest = pstarts[se] + jnp.arange(TK, dtype=jnp.int32) - starts[se]
    P = TK + N_EXPERTS * MOE_BLOCK
    P = ((P + MOE_BLOCK - 1) // MOE_BLOCK) * MOE_BLOCK
    nblk = P // MOE_BLOCK
    row_tok = jnp.full((P,), T, jnp.int32).at[dest].set(flat_tok[order])
    row_w = jnp.zeros((P,), jnp.float32).at[dest].set(flat_w[order])
    blk_e = jnp.minimum(jnp.searchsorted(pends, jnp.arange(nblk, dtype=jnp.int32) * MOE_BLOCK, side='right'),
                        N_EXPERTS - 1)
    x_pad = jnp.concatenate([xn, jnp.zeros((1, D), xn.dtype)], axis=0)
    x_blocks = x_pad[row_tok].reshape(nblk, MOE_BLOCK, D)

    def expert_block(args):
        xb, e = args
        h = jax.nn.silu(xb @ w_gate[e]) * (xb @ w_up[e])
        return h @ w_down[e]

    y_blocks = lax.map(expert_block, (x_blocks, blk_e))
    y_rows = y_blocks.reshape(P, D) * row_w[:, None].astype(y_blocks.dtype)
    return jax.ops.segment_sum(y_rows, row_tok, num_segments=T + 1)[:T]


def setup_inputs(seed: int = 0) -> dict:
    key = jax.random.key(seed)
    ks = jax.random.split(key, 24)
    f32 = jnp.float32
    nrm = lambda k, shape, scale: jax.random.normal(k, shape, f32) * scale
    x = jax.random.normal(ks[0], (BATCH, SEQ, D_MODEL), f32)
    offs = jax.random.randint(ks[1], (BATCH, 1), 0, 4096, dtype=jnp.int32)
    positions = offs + jnp.arange(SEQ, dtype=jnp.int32)[None, :]
    return {
        "x": x,
        "positions": positions,
        "norm1_w": 1.0 + nrm(ks[2], (DEPTH, D_MODEL), 0.02),
        "w_in": nrm(ks[3], (DEPTH, D_MODEL, IN_WIDTH), D_MODEL ** -0.5),
        "q_norm_w": 1.0 + nrm(ks[4], (DEPTH, HEAD_DIM), 0.02),
        "k_norm_w": 1.0 + nrm(ks[5], (DEPTH, HEAD_DIM), 0.02),
        "attn_sinks": nrm(ks[6], (DEPTH, N_Q_HEADS), 0.5),
        "hgrn_lower_bounds": nrm(ks[7], (DEPTH + 1, HGRN_KEY_WIDTH), 0.5),
        "hgrn_norm_w": 1.0 + nrm(ks[8], (DEPTH, HGRN_VAL_DIM), 0.02),
        "w_branch_attn": nrm(ks[9], (DEPTH, ATTN_WIDTH, D_MODEL), ATTN_WIDTH ** -0.5),
        "w_branch_hgrn": nrm(ks[10], (DEPTH, HGRN_WIDTH, D_MODEL), HGRN_WIDTH ** -0.5),
        "w_out": nrm(ks[11], (DEPTH, D_MODEL, D_MODEL), D_MODEL ** -0.5),
        "norm2_w": 1.0 + nrm(ks[12], (DEPTH, D_MODEL), 0.02),
        "w_router_group": nrm(ks[13], (DEPTH, D_MODEL, N_GROUPS), D_MODEL ** -0.5),
        "b_router_group": nrm(ks[14], (DEPTH, N_GROUPS), 0.01),
        "w_router_expert": nrm(ks[15], (DEPTH, D_MODEL, N_EXPERTS), D_MODEL ** -0.5),
        "b_router_expert": nrm(ks[16], (DEPTH, N_EXPERTS), 0.01),
        "w_gate_experts": nrm(ks[17], (DEPTH, N_EXPERTS, D_MODEL, EXPERT_FF), D_MODEL ** -0.5),
        "w_up_experts": nrm(ks[18], (DEPTH, N_EXPERTS, D_MODEL, EXPERT_FF), D_MODEL ** -0.5),
        "w_down_experts": nrm(ks[19], (DEPTH, N_EXPERTS, EXPERT_FF, D_MODEL), EXPERT_FF ** -0.5),
    }


def reference(x, positions, norm1_w, w_in, q_norm_w, k_norm_w, attn_sinks, hgrn_lower_bounds,
              hgrn_norm_w, w_branch_attn, w_branch_hgrn, w_out, norm2_w, w_router_group,
              b_router_group, w_router_expert, b_router_expert, w_gate_experts, w_up_experts,
              w_down_experts):
    B, S, D = x.shape
    cos, sin = rope_tables(positions)
    split_points = [int(v) for v in np.cumsum(IN_SIZES)[:-1]]
    lower_bounds = jnp.cumsum(jax.nn.softmax(hgrn_lower_bounds.astype(jnp.float32), axis=0), axis=0)
    for l in range(DEPTH):
        xn = rms_norm(x, norm1_w[l])
        proj = xn @ w_in[l]
        q_a, k_a, v_a, q_h, f_h, i_h, g_h, z_a, z_b = jnp.split(proj, split_points, axis=-1)

        q_a = partial_rope(rms_norm(q_a.reshape(B, S, N_Q_HEADS, HEAD_DIM), q_norm_w[l]), cos, sin)
        k_a = partial_rope(rms_norm(k_a.reshape(B, S, N_KV_HEADS, HEAD_DIM), k_norm_w[l]), cos, sin)
        v_a = v_a.reshape(B, S, N_KV_HEADS, HEAD_DIM)
        attn = sliding_window_gqa(q_a, k_a, v_a, attn_sinks[l])

        lb = lower_bounds[l]
        fg = lb + (1.0 - lb) * jax.nn.sigmoid(f_h.astype(jnp.float32))
        hq = jax.nn.silu(q_h.astype(jnp.float32)).reshape(B, S, HGRN_HEADS, HGRN_KEY_DIM)
        hk = (1.0 - fg).reshape(B, S, HGRN_HEADS, HGRN_KEY_DIM)
        hlogf = jnp.log(fg).reshape(B, S, HGRN_HEADS, HGRN_KEY_DIM)
        hv = i_h.astype(jnp.float32).reshape(B, S, HGRN_HEADS, HGRN_VAL_DIM)
        ho = rms_norm(hgrn2_chunkwise(hq, hk, hv, hlogf), hgrn_norm_w[l]).reshape(B, S, HGRN_WIDTH)
        hgrn = (ho * jax.nn.silu(g_h.astype(jnp.float32))).astype(x.dtype)

        mixed = (jax.nn.sigmoid(z_a) * (attn @ w_branch_attn[l])
                 + jax.nn.sigmoid(z_b) * (hgrn @ w_branch_hgrn[l]))
        x = x + mixed @ w_out[l]

        hn = rms_norm(x, norm2_w[l]).reshape(B * S, D)
        moe = hierarchical_moe(hn, w_router_group[l], b_router_group[l], w_router_expert[l],
                               b_router_expert[l], w_gate_experts[l], w_up_experts[l], w_down_experts[l])
        x = x + moe.reshape(B, S, D).astype(x.dtype)
    return x
```

```cpp
#include <hip/hip_runtime.h>
#include <cstdio>
#include <cstdint>

#define LAS __attribute__((address_space(3)))
typedef unsigned short bf16;
typedef short bf16x8 __attribute__((ext_vector_type(8)));
typedef float f32x4 __attribute__((ext_vector_type(4)));
typedef unsigned u32x4 __attribute__((ext_vector_type(4)));
typedef unsigned u32x2 __attribute__((ext_vector_type(2)));

constexpr int NTHREADS = 512;
constexpr int LDS_BYTES = 147456;
constexpr int LDS_ST_OFF = LDS_BYTES - 64;

constexpr int BATCH = 4, SEQ = 8192, T = BATCH * SEQ, D = 1024, NPROJ = 4864;
constexpr int C_QA = 0, C_KA = 512, C_VA = 640, C_QH = 768, C_FH = 1280, C_IH = 1792, C_GH = 2304, C_ZA = 2816, C_ZB = 3840;
constexpr int NEXP = 32, FF = 512;
constexpr float EPS = 1e-6f;

constexpr size_t MiB = 1u << 20;
constexpr size_t WS_CTL = 0;
constexpr size_t CTL_CNT = 65536;
constexpr size_t WS_WINT = 1 * MiB;
constexpr size_t WS_WAT = 11 * MiB;
constexpr size_t WS_WBT = 12 * MiB;
constexpr size_t WS_WOT = 13 * MiB;
constexpr size_t WS_WR = 15 * MiB;
constexpr size_t WS_WGU = 16 * MiB;
constexpr size_t WS_WD = 80 * MiB;
constexpr size_t WS_PROJ = 112 * MiB;
constexpr size_t WS_MIXED = 416 * MiB;
constexpr size_t WS_END = 480 * MiB;
constexpr size_t WS_HN = 112 * MiB;
constexpr size_t WS_SSQ = 176 * MiB;
constexpr size_t WS_LIST = 178 * MiB;
constexpr size_t WS_GW = 186 * MiB;
constexpr size_t WS_RSTD = 187 * MiB;
constexpr size_t WS_H = 192 * MiB;
constexpr size_t OUT_U = 0, OUT_SIN = 16 * MiB, OUT_DSC = 32 * MiB, OUT_ATTN = 64 * MiB, OUT_HGRN = 96 * MiB;

__device__ __forceinline__ unsigned f2bf(float f) { unsigned u = __builtin_bit_cast(unsigned, f); return (u + 0x7fffu + ((u >> 16) & 1u)) >> 16; }
__device__ __forceinline__ float bf2f(unsigned h) { return __builtin_bit_cast(float, h << 16); }
__device__ __forceinline__ unsigned pk2(float lo, float hi) { return f2bf(lo) | (f2bf(hi) << 16); }
__device__ __forceinline__ float bflo(unsigned w) { return __builtin_bit_cast(float, w << 16); }
__device__ __forceinline__ float bfhi(unsigned w) { return __builtin_bit_cast(float, w & 0xffff0000u); }
__device__ __forceinline__ float sigmoidf_(float x) { return __builtin_amdgcn_rcpf(1.f + __expf(-x)); }
__device__ __forceinline__ int opaque(int x) { asm volatile("" : "+v"(x)); return x; }
__device__ __forceinline__ float wave_sum(float v) {
#pragma unroll
    for (int o = 1; o < 64; o <<= 1) v += __shfl_xor(v, o);
    return v;
}

#define XB_TMO      128
#define XB_XCNT(j)  (256  + 64 * (j))
#define XB_XSUB(j)  (1280 + 64 * (j))
#define XB_XGEN(j)  (2304 + 64 * (j))
#define XB_TOP      3328
#define XB_TOPGEN   3392
#define XCD_BAR_WORDS 3456
#define XB_SPIN_CAP (1u << 20)
__device__ __forceinline__ unsigned xb_ld(unsigned* p)              { return __hip_atomic_load(p, __ATOMIC_RELAXED, __HIP_MEMORY_SCOPE_AGENT); }
__device__ __forceinline__ unsigned xb_add(unsigned* p, unsigned v) { return __hip_atomic_fetch_add(p, v, __ATOMIC_RELAXED, __HIP_MEMORY_SCOPE_AGENT); }
__device__ __forceinline__ unsigned xb_xcc_id() { return (unsigned)__builtin_amdgcn_s_getreg((3 << 11) | 20) & 0xFu; }
#define XB_SPIN(cond, bar) do { unsigned _sp = 0; while (cond) { __builtin_amdgcn_s_sleep(1); \
    if ((++_sp & 255u) == 0u) { if (xb_ld(&(bar)[XB_TMO])) break; if (_sp > XB_SPIN_CAP) { atomicAdd(&(bar)[XB_TMO], 1u); break; } } } } while (0)
struct XcdBarrier { unsigned* bar; unsigned x; volatile LAS unsigned* st; };
__device__ __forceinline__ XcdBarrier xcd_barrier_post(unsigned* bar, volatile LAS unsigned* st) {
    XcdBarrier b; b.bar = bar; b.x = xb_xcc_id(); b.st = st;
    if (threadIdx.x == 0) (void)xb_add(&bar[XB_XCNT(b.x)], 1u);
    return b;
}
__device__ __forceinline__ void xcd_barrier_complete(unsigned* bar, unsigned x, unsigned& nloc, unsigned& nx) {
    const unsigned G = gridDim.x * gridDim.y * gridDim.z;
    unsigned sum, cnt, mine, sp = 0u;
    for (;;) {
        sum = 0u; cnt = 0u; mine = 0u;
#pragma unroll
        for (unsigned j = 0; j < 16; ++j) { const unsigned c = xb_ld(&bar[XB_XCNT(j)]); sum += c; cnt += (c > 0u) ? 1u : 0u; mine = (j == x) ? c : mine; }
        if (sum == G) break;
        __builtin_amdgcn_s_sleep(1);
        if ((++sp & 255u) == 0u) { if (xb_ld(&bar[XB_TMO])) break; if (sp > XB_SPIN_CAP) { atomicAdd(&bar[XB_TMO], 1u); break; } }
    }
    nloc = mine > 0u ? mine : 1u; nx = cnt > 0u ? cnt : 1u;
}
__device__ __forceinline__ void xcd_barrier(const XcdBarrier& b) {
    asm volatile("s_waitcnt vmcnt(0)" ::: "memory");
    __syncthreads();
    if (threadIdx.x == 0) {
        unsigned* bar = b.bar;
        __builtin_amdgcn_s_waitcnt(0);
        unsigned nloc = b.st[0], nx = b.st[1];
        if (nloc == 0u) { xcd_barrier_complete(bar, b.x, nloc, nx); b.st[0] = nloc; b.st[1] = nx; }
        const unsigned old = xb_add(&bar[XB_XSUB(b.x)], 1u);
        const unsigned gen = old / nloc;
        if (old + 1u == (gen + 1u) * nloc) {
            __builtin_amdgcn_fence(__ATOMIC_RELEASE, "agent");
            asm volatile("s_waitcnt vmcnt(0)" ::: "memory");
            const unsigned og = xb_add(&bar[XB_TOP], 1u);
            const unsigned tg = og / nx;
            if (og + 1u == (tg + 1u) * nx) xb_add(&bar[XB_TOPGEN], 1u);
            else XB_SPIN(xb_ld(&bar[XB_TOPGEN]) == tg, bar);
            __builtin_amdgcn_fence(__ATOMIC_ACQUIRE, "agent");
            xb_add(&bar[XB_XGEN(b.x)], 1u);
            asm volatile("s_waitcnt vmcnt(0)" ::: "memory");
        } else {
            XB_SPIN(xb_ld(&bar[XB_XGEN(b.x)]) == gen, bar);
            __builtin_amdgcn_fence(__ATOMIC_ACQUIRE, "agent");
            asm volatile("s_waitcnt vmcnt(0)" ::: "memory");
        }
    }
    __syncthreads();
}

struct Params {
    const float* x; const int* positions; const float* norm1_w; const float* w_in; const float* q_norm_w; const float* k_norm_w;
    const float* sinks; const float* hlb; const float* hnw; const float* w_ba; const float* w_bh; const float* w_out; const float* norm2_w;
    const float* w_rg; const float* b_rg; const float* w_re; const float* b_re; const float* w_gate; const float* w_up; const float* w_down;
    float* out; unsigned char* ws;
};

__device__ __forceinline__ void stage_rc(int b, int& R, int& C) {
    const int st = b >> 10, sb = b & 1023, swz = sb ^ (((sb >> 9) & 1) << 5);
    R = (st >> 1) * 16 + (swz >> 6);
    C = (st & 1) * 32 + ((swz & 63) >> 1);
}
#define WAIT_V0() asm volatile("s_waitcnt vmcnt(0)" ::: "memory")

__device__ __forceinline__ void gemm_core(LAS unsigned char* lds, const bf16* __restrict__ Ab, const unsigned (&oa)[4], const bf16* __restrict__ Bb, const unsigned (&ob)[4], const int nt,
                                          f32x4 (&acc)[8][4], const int wid, const int lane) {
    const int wr = wid >> 2, wc = wid & 3, fr = lane & 15, fq = lane >> 4;
    const int laneoff = (fr * 64 + fq * 16) ^ (((fr >> 3) & 1) << 5);
    const int aoff = wr * 16384 + laneoff, boff = 32768 + wc * 8192 + laneoff;
    const int ldsw = wid * 1024;
#define GLDS_STAGE(buf, kt) do { _Pragma("unroll") for (int i_ = 0; i_ < 4; ++i_) { \
        __builtin_amdgcn_global_load_lds((const unsigned*)(Ab + (oa[i_] + (unsigned)((kt) * 64))), (LAS unsigned*)(lds + (buf) * 65536 + ldsw + i_ * 8192), 16, 0, 0); \
        __builtin_amdgcn_global_load_lds((const unsigned*)(Bb + (ob[i_] + (unsigned)((kt) * 64))), (LAS unsigned*)(lds + (buf) * 65536 + 32768 + ldsw + i_ * 8192), 16, 0, 0); } } while (0)
#define GEMM_COMPUTE(cur) do { _Pragma("unroll") for (int ks = 0; ks < 2; ++ks) { \
            bf16x8 At[8], Bf[4]; \
            _Pragma("unroll") for (int m = 0; m < 8; ++m) At[m] = *(const LAS bf16x8*)(lds + (cur) * 65536 + aoff + (m * 2 + ks) * 1024); \
            _Pragma("unroll") for (int n = 0; n < 4; ++n) Bf[n] = *(const LAS bf16x8*)(lds + (cur) * 65536 + boff + (n * 2 + ks) * 1024); \
            _Pragma("unroll") for (int m = 0; m < 8; ++m) _Pragma("unroll") for (int n = 0; n < 4; ++n) \
                acc[m][n] = __builtin_amdgcn_mfma_f32_16x16x32_bf16(Bf[n], At[m], acc[m][n], 0, 0, 0); \
            __builtin_amdgcn_sched_barrier(0); } } while (0)
    GLDS_STAGE(0, 0); WAIT_V0(); __syncthreads();
#if 1
#pragma unroll 1
    for (int t = 0; t < nt; ++t) {
        const int cur = t & 1;
        if (t + 1 < nt) GLDS_STAGE(cur ^ 1, t + 1);
        GEMM_COMPUTE(cur);
        WAIT_V0(); __syncthreads();
    }
#else
#pragma unroll 1
    for (int t = 0; t < nt; t += 2) {
        GLDS_STAGE(1, t + 1);
        GEMM_COMPUTE(0);
        WAIT_V0(); __syncthreads();
        if (t + 2 < nt) GLDS_STAGE(0, t + 2);
        GEMM_COMPUTE(1);
        WAIT_V0(); __syncthreads();
    }
#endif
#undef GEMM_COMPUTE
#undef GLDS_STAGE
}
__device__ __forceinline__ void acc_zero(f32x4 (&acc)[8][4]) {
#pragma unroll
    for (int m = 0; m < 8; ++m)
#pragma unroll
        for (int n = 0; n < 4; ++n) acc[m][n] = (f32x4){0.f, 0.f, 0.f, 0.f};
}
__device__ __forceinline__ bool tile_order(int i, int G, int c, int nM, int nN, int& pm, int& pn) {
    const int nwg = nM * nN; const long L = (long)i * G + c; if (L >= nwg) return false;
    int wgid = (int)L; { const int q = nwg / 8, r = nwg % 8, xcd = wgid % 8, off = wgid / 8; wgid = (xcd < r ? xcd * (q + 1) : r * (q + 1) + (xcd - r) * q) + off; }
    const int WGM = 8, nig = WGM * nN, gid = wgid / nig, fm = gid * WGM, gsz = (nM - fm) < WGM ? (nM - fm) : WGM;
    pm = fm + ((wgid % nig) % gsz); pn = (wgid % nig) / gsz; return true;
}

__device__ __forceinline__ void transpose_item(const float* W, int K, int N, bf16* WT, int k0, int n0, int drow0, LAS float* scr, int lane) {
#pragma unroll 8
    for (int i = 0; i < 32; ++i) { const int kk = 2 * i + (lane >> 5); scr[kk * 33 + (lane & 31)] = W[(size_t)(k0 + kk) * N + n0 + (lane & 31)]; }
    asm volatile("s_waitcnt lgkmcnt(0)" ::: "memory");
    const int c = lane & 7;
#pragma unroll
    for (int j = 0; j < 4; ++j) { const int n = (lane >> 3) + 8 * j; const LAS float* s = scr + (8 * c) * 33 + n;
        u32x4 o; o.x = pk2(s[0 * 33], s[1 * 33]); o.y = pk2(s[2 * 33], s[3 * 33]); o.z = pk2(s[4 * 33], s[5 * 33]); o.w = pk2(s[6 * 33], s[7 * 33]);
        *(u32x4*)(WT + (size_t)(drow0 + n) * K + k0 + 8 * c) = o; }
    asm volatile("s_waitcnt lgkmcnt(0)" ::: "memory");
}

__device__ __forceinline__ void phase0(const Params& P, LAS unsigned char* lds, int vcu, int G, int tid, int wid, int lane) {
    unsigned char* ws = P.ws;
    LAS float* scr = (LAS float*)(lds + wid * 16384);
    const int gw = vcu * 8 + wid, NGW = G * 8;
    constexpr int I_IN = 16 * 152, I_BR = 8 * 32, I_OUT = 16 * 32, I_G = 16 * 16, I_D = 8 * 32;
    constexpr int NITEMS = I_IN + 2 * I_BR + I_OUT + NEXP * (2 * I_G + I_D);
    for (int it = gw; it < NITEMS; it += NGW) {
        int r = it;
        if (r < I_IN) { const int kb = r / 152, nb = r % 152; transpose_item(P.w_in, 1024, NPROJ, (bf16*)(ws + WS_WINT), 64 * kb, 32 * nb, 32 * nb, scr, lane); continue; } r -= I_IN;
        if (r < I_BR) { const int kb = r / 32, nb = r % 32; transpose_item(P.w_ba, 512, 1024, (bf16*)(ws + WS_WAT), 64 * kb, 32 * nb, 32 * nb, scr, lane); continue; } r -= I_BR;
        if (r < I_BR) { const int kb = r / 32, nb = r % 32; transpose_item(P.w_bh, 512, 1024, (bf16*)(ws + WS_WBT), 64 * kb, 32 * nb, 32 * nb, scr, lane); continue; } r -= I_BR;
        if (r < I_OUT) { const int kb = r / 32, nb = r % 32; transpose_item(P.w_out, 1024, 1024, (bf16*)(ws + WS_WOT), 64 * kb, 32 * nb, 32 * nb, scr, lane); continue; } r -= I_OUT;
        const int e = r / (2 * I_G + I_D); r -= e * (2 * I_G + I_D);
        if (r < I_G) { const int kb = r / 16, nb = r % 16; transpose_item(P.w_gate + (size_t)e * 1024 * 512, 1024, 512, (bf16*)(ws + WS_WGU) + (size_t)e * 1024 * 1024, 64 * kb, 32 * nb, 64 * nb, scr, lane); continue; } r -= I_G;
        if (r < I_G) { const int kb = r / 16, nb = r % 16; transpose_item(P.w_up + (size_t)e * 1024 * 512, 1024, 512, (bf16*)(ws + WS_WGU) + (size_t)e * 1024 * 1024, 64 * kb, 32 * nb, 64 * nb + 32, scr, lane); continue; } r -= I_G;
        { const int kb = r / 32, nb = r % 32; transpose_item(P.w_down + (size_t)e * 512 * 1024, 512, 1024, (bf16*)(ws + WS_WD) + (size_t)e * 1024 * 512, 64 * kb, 32 * nb, 32 * nb, scr, lane); }
    }
    { float* Wr = (float*)(ws + WS_WR);
      for (int idx = (vcu * NTHREADS + tid); idx < 48 * 1024; idx += G * NTHREADS) { const int j = idx >> 10, k = idx & 1023; float v = 0.f;
          if (j < 4) v = P.w_rg[k * 4 + j] * P.norm2_w[k]; else if (j < 36) v = P.w_re[k * 32 + (j - 4)] * P.norm2_w[k];
          Wr[idx] = v; } }
    { bf16* xn = (bf16*)P.out;
      f32x4 wv[4];
#pragma unroll
      for (int j = 0; j < 4; ++j) wv[j] = *(const f32x4*)(P.norm1_w + 4 * lane + 256 * j);
      for (int m = gw; m < T; m += NGW) {
          const f32x4* xr = (const f32x4*)(P.x + (size_t)m * D) + lane; f32x4 v[4]; float s = 0.f;
#pragma unroll
          for (int j = 0; j < 4; ++j) { v[j] = xr[64 * j]; s += (v[j].x * v[j].x + v[j].y * v[j].y) + (v[j].z * v[j].z + v[j].w * v[j].w); }
          const float rstd = 1.f / sqrtf(wave_sum(s) * (1.f / D) + EPS);
          u32x2* o8 = (u32x2*)(xn + (size_t)m * D) + lane;
#pragma unroll
          for (int j = 0; j < 4; ++j) { u32x2 o; o.x = pk2(v[j].x * rstd * wv[j].x, v[j].y * rstd * wv[j].y); o.y = pk2(v[j].z * rstd * wv[j].z, v[j].w * rstd * wv[j].w); o8[64 * j] = o; }
      } }
}

__device__ __forceinline__ void phase1(const Params& P, LAS unsigned char* lds, int G, int tid, int wid, int lane) {
    const bf16* A = (const bf16*)P.out; const bf16* Bt = (const bf16*)(P.ws + WS_WINT); bf16* proj = (bf16*)(P.ws + WS_PROJ);
    const int wr = wid >> 2, wc = wid & 3, fr = lane & 15, fq = lane >> 4;
    int sR[4], sC; { int C_; for (int i = 0; i < 4; ++i) { stage_rc(wid * 1024 + i * 8192 + lane * 16, sR[i], C_); } sC = C_; }
    for (int it = 0;; ++it) {
        int pm, pn; if (!tile_order(it, G, (int)blockIdx.x, T / 256, NPROJ / 256, pm, pn)) break;
        unsigned oa[4], ob[4];
#pragma unroll
        for (int i = 0; i < 4; ++i) { oa[i] = (unsigned)((pm * 256 + sR[i]) * 1024 + sC); ob[i] = (unsigned)((pn * 256 + sR[i]) * 1024 + sC); }
        f32x4 acc[8][4]; acc_zero(acc);
        gemm_core(lds, A, oa, Bt, ob, 16, acc, wid, lane);
        const int fro = opaque(fr), fqo = opaque(fq);
#pragma unroll
        for (int m = 0; m < 8; ++m) { const size_t row = (size_t)pm * 256 + wr * 128 + m * 16 + fro;
#pragma unroll
            for (int n = 0; n < 4; ++n) { const int col = pn * 256 + wc * 64 + n * 16 + fqo * 4; const f32x4 v = acc[m][n];
                u32x2 o; o.x = pk2(v[0], v[1]); o.y = pk2(v[2], v[3]); *(u32x2*)(proj + row * NPROJ + col) = o; } }
    }
}

__device__ __forceinline__ void phase5(const Params& P, LAS unsigned char* lds, int G, int tid, int wid, int lane) {
    const bf16* A1 = (const bf16*)((unsigned char*)P.out + OUT_ATTN); const bf16* A2 = (const bf16*)((unsigned char*)P.out + OUT_HGRN);
    const bf16* B1 = (const bf16*)(P.ws + WS_WAT); const bf16* B2 = (const bf16*)(P.ws + WS_WBT);
    const bf16* proj = (const bf16*)(P.ws + WS_PROJ); bf16* mixed = (bf16*)(P.ws + WS_MIXED);
    const int wr = wid >> 2, wc = wid & 3, fr = lane & 15, fq = lane >> 4;
    int sR[4], sC; { int C_; for (int i = 0; i < 4; ++i) { stage_rc(wid * 1024 + i * 8192 + lane * 16, sR[i], C_); } sC = C_; }
    for (int it = 0;; ++it) {
        int pm, pn; if (!tile_order(it, G, (int)blockIdx.x, T / 256, 4, pm, pn)) break;
        unsigned oa[4], ob[4];
#pragma unroll
        for (int i = 0; i < 4; ++i) { oa[i] = (unsigned)((pm * 256 + sR[i]) * 512 + sC); ob[i] = (unsigned)((pn * 256 + sR[i]) * 512 + sC); }
        f32x4 acc[8][4]; acc_zero(acc);
        gemm_core(lds, A1, oa, B1, ob, 8, acc, wid, lane);
        int fro = opaque(fr), fqo = opaque(fq);
#pragma unroll
        for (int m = 0; m < 8; ++m) { const size_t row = (size_t)pm * 256 + wr * 128 + m * 16 + fro;
#pragma unroll
            for (int n = 0; n < 4; ++n) { const int col = pn * 256 + wc * 64 + n * 16 + fqo * 4;
                const u32x2 za = *(const u32x2*)(proj + row * NPROJ + C_ZA + col), zb = *(const u32x2*)(proj + row * NPROJ + C_ZB + col);
                f32x4 r;
                r[0] = (1.f + __expf(-bflo(zb.x))) * __builtin_amdgcn_rcpf(1.f + __expf(-bflo(za.x))); r[1] = (1.f + __expf(-bfhi(zb.x))) * __builtin_amdgcn_rcpf(1.f + __expf(-bfhi(za.x)));
                r[2] = (1.f + __expf(-bflo(zb.y))) * __builtin_amdgcn_rcpf(1.f + __expf(-bflo(za.y))); r[3] = (1.f + __expf(-bfhi(zb.y))) * __builtin_amdgcn_rcpf(1.f + __expf(-bfhi(za.y)));
                acc[m][n] = acc[m][n] * r; }
            asm volatile("" ::: "memory"); }
        gemm_core(lds, A2, oa, B2, ob, 8, acc, wid, lane);
        fro = opaque(fr); fqo = opaque(fq);
#pragma unroll
        for (int m = 0; m < 8; ++m) { const size_t row = (size_t)pm * 256 + wr * 128 + m * 16 + fro;
#pragma unroll
            for (int n = 0; n < 4; ++n) { const int col = pn * 256 + wc * 64 + n * 16 + fqo * 4;
                const u32x2 zb = *(const u32x2*)(proj + row * NPROJ + C_ZB + col); const f32x4 v = acc[m][n];
                u32x2 o; o.x = pk2(v[0] * sigmoidf_(bflo(zb.x)), v[1] * sigmoidf_(bfhi(zb.x))); o.y = pk2(v[2] * sigmoidf_(bflo(zb.y)), v[3] * sigmoidf_(bfhi(zb.y)));
                *(u32x2*)(mixed + row * 1024 + col) = o; }
            asm volatile("" ::: "memory"); }
    }
}

__device__ __forceinline__ void phase6(const Params& P, LAS unsigned char* lds, int G, int tid, int wid, int lane) {
    const bf16* A = (const bf16*)(P.ws + WS_MIXED); const bf16* Bt = (const bf16*)(P.ws + WS_WOT);
    bf16* hn = (bf16*)(P.ws + WS_HN); float* ssq = (float*)(P.ws + WS_SSQ);
    const int wr = wid >> 2, wc = wid & 3, fr = lane & 15, fq = lane >> 4;
    int sR[4], sC; { int C_; for (int i = 0; i < 4; ++i) { stage_rc(wid * 1024 + i * 8192 + lane * 16, sR[i], C_); } sC = C_; }
    for (int it = 0;; ++it) {
        int pm, pn; if (!tile_order(it, G, (int)blockIdx.x, T / 256, 4, pm, pn)) break;
        unsigned oa[4], ob[4];
#pragma unroll
        for (int i = 0; i < 4; ++i) { oa[i] = (unsigned)((pm * 256 + sR[i]) * 1024 + sC); ob[i] = (unsigned)((pn * 256 + sR[i]) * 1024 + sC); }
        f32x4 acc[8][4]; acc_zero(acc);
        gemm_core(lds, A, oa, Bt, ob, 16, acc, wid, lane);
        const int fro = opaque(fr), fqo = opaque(fq);
#pragma unroll
        for (int m = 0; m < 8; ++m) { const size_t row = (size_t)pm * 256 + wr * 128 + m * 16 + fro; float s = 0.f;
#pragma unroll
            for (int n = 0; n < 4; ++n) { const int col = pn * 256 + wc * 64 + n * 16 + fqo * 4;
                const f32x4 xv = *(const f32x4*)(P.x + row * 1024 + col); const f32x4 w2 = *(const f32x4*)(P.norm2_w + col);
                const f32x4 v = acc[m][n] + xv;
                *(f32x4*)(P.out + row * 1024 + col) = v;
                s += (v[0] * v[0] + v[1] * v[1]) + (v[2] * v[2] + v[3] * v[3]);
                u32x2 o; o.x = pk2(v[0] * w2[0], v[1] * w2[1]); o.y = pk2(v[2] * w2[2], v[3] * w2[3]); *(u32x2*)(hn + row * 1024 + col) = o; }
            s += __shfl_xor(s, 16); s += __shfl_xor(s, 32);
            if (fq == 0) ssq[row * 16 + pn * 4 + wc] = s;
            asm volatile("" ::: "memory"); }
    }
}

constexpr int H_TOT = 0, H_DV = 2048, H_SSQ = 2560, H_QT = 4608, H_KH = H_QT + 17408, H_KTT = H_KH + 17408, H_VT = H_KTT + 18432, H_ST = H_VT + 18432, H_AM = H_ST + 34816, H_END = H_AM + 9216;
static_assert(H_END <= LDS_ST_OFF, "hgrn LDS");
__device__ __forceinline__ bf16x8 ldfrag(const LAS unsigned char* base, int row, int stride, int kbyte) { return *(const LAS bf16x8*)(base + row * stride + kbyte); }

template <int MODE>
__device__ __forceinline__ void hgrn_unit(const Params& P, LAS unsigned char* lds, int unit, int tid, int wid, int lane) {
    const int b = unit >> 6, h = (unit >> 4) & 3, sc = unit & 15;
    const int fr = opaque(lane & 15), fq = opaque(lane >> 4), c = opaque(tid & 127), qd = tid >> 7;
    const bf16* proj = (const bf16*)(P.ws + WS_PROJ);
    LAS float* TOT = (LAS float*)(lds + H_TOT); LAS float* DV = (LAS float*)(lds + H_DV); LAS float* SSQ = (LAS float*)(lds + H_SSQ);
    LAS bf16* Qt = (LAS bf16*)(lds + H_QT); LAS bf16* Kh = (LAS bf16*)(lds + H_KH); LAS bf16* KtT = (LAS bf16*)(lds + H_KTT); LAS bf16* VT = (LAS bf16*)(lds + H_VT);
    const float lbv = 1.f / (1.f + __expf(P.hlb[512 + h * 128 + c] - P.hlb[h * 128 + c]));
    float* Ug = (float*)((unsigned char*)P.out + OUT_U) + (size_t)unit * 16384;
    const float* Sin = (const float*)((unsigned char*)P.out + OUT_SIN) + (size_t)unit * 16384;
    f32x4 accS[8];
#pragma unroll
    for (int di = 0; di < 8; ++di) {
        if (MODE == 1 && sc > 0) {
#pragma unroll
            for (int r = 0; r < 4; ++r) accS[di][r] = Sin[(16 * di + 4 * fq + r) * 128 + 16 * wid + fr];
        } else accS[di] = (f32x4){0.f, 0.f, 0.f, 0.f};
        if (MODE == 1) { u32x2 o; o.x = pk2(accS[di][0], accS[di][1]); o.y = pk2(accS[di][2], accS[di][3]);
            *(LAS u32x2*)(lds + H_ST + (16 * wid + fr) * 272 + (16 * di + 4 * fq) * 2) = o; }
    }
    float dsum = 0.f;
#pragma unroll 1
    for (int cc = 0; cc < 8; ++cc) {
        const size_t t0 = (size_t)b * SEQ + sc * 512 + cc * 64;
        const bf16* pbase = proj + (t0 + qd * 16) * NPROJ + h * 128 + c;
        float bpart[16], kk[16]; float run = 0.f;
#pragma unroll
        for (int i = 0; i < 16; ++i) { const float f = bf2f(pbase[(size_t)i * NPROJ + C_FH]);
            const float kv = (1.f - lbv) / (1.f + __expf(f));
            kk[i] = kv; run += __logf(1.f - kv); bpart[i] = run; }
        TOT[qd * 128 + c] = run;
        __syncthreads();
        float offs = 0.f, blast = 0.f;
#pragma unroll
        for (int q = 0; q < 4; ++q) { const float tv = TOT[q * 128 + c]; blast += tv; if (q < qd) offs += tv; }
        if (qd == 0) { DV[c] = __expf(blast); dsum += blast; }
#pragma unroll
        for (int i = 0; i < 16; ++i) { const int t = qd * 16 + i; const float bb = bpart[i] + offs;
            if (MODE == 1) { const float q = bf2f(pbase[(size_t)i * NPROJ + C_QH]); const float qs = q / (1.f + __expf(-q));
                Qt[t * 136 + c] = (bf16)f2bf(qs * __expf(bb)); Kh[t * 136 + c] = (bf16)f2bf(kk[i] * __expf(fminf(-bb, 80.f))); }
            KtT[c * 72 + t] = (bf16)f2bf(kk[i] * __expf(blast - bb));
            VT[c * 72 + t] = pbase[(size_t)i * NPROJ + C_IH];
            if ((i & 3) == 3) asm volatile("" ::: "memory"); }
        __syncthreads();
        f32x4 acco[4];
        if (MODE == 1) {
#pragma unroll
            for (int e2 = 0; e2 < 2; ++e2) { const int idx = 2 * wid + e2, mi = idx >> 2, ni = idx & 3; f32x4 a = (f32x4){0.f, 0.f, 0.f, 0.f};
                if (ni <= mi) {
#pragma unroll
                    for (int ks = 0; ks < 4; ++ks) { const bf16x8 kf = ldfrag(lds + H_KH, 16 * ni + fr, 272, (ks * 32 + fq * 8) * 2), qf = ldfrag(lds + H_QT, 16 * mi + fr, 272, (ks * 32 + fq * 8) * 2);
                        a = __builtin_amdgcn_mfma_f32_16x16x32_bf16(kf, qf, a, 0, 0, 0); } }
                const int t = 16 * mi + fr, s0 = 16 * ni + 4 * fq;
#pragma unroll
                for (int r = 0; r < 4; ++r) if (s0 + r > t || ni > mi) a[r] = 0.f;
                u32x2 o; o.x = pk2(a[0], a[1]); o.y = pk2(a[2], a[3]); *(LAS u32x2*)(lds + H_AM + t * 144 + s0 * 2) = o; }
#pragma unroll
            for (int mi = 0; mi < 4; ++mi) { acco[mi] = (f32x4){0.f, 0.f, 0.f, 0.f};
#pragma unroll
                for (int ks = 0; ks < 4; ++ks) { const bf16x8 sf = ldfrag(lds + H_ST, 16 * wid + fr, 272, (ks * 32 + fq * 8) * 2), qf = ldfrag(lds + H_QT, 16 * mi + fr, 272, (ks * 32 + fq * 8) * 2);
                    acco[mi] = __builtin_amdgcn_mfma_f32_16x16x32_bf16(sf, qf, acco[mi], 0, 0, 0); } }
        }
#pragma unroll
        for (int di = 0; di < 8; ++di) { const f32x4 dv4 = *(const LAS f32x4*)(lds + H_DV + (16 * di + 4 * fq) * 4); accS[di] = accS[di] * dv4;
#pragma unroll
            for (int ks = 0; ks < 2; ++ks) { const bf16x8 kf = ldfrag(lds + H_KTT, 16 * di + fr, 144, (ks * 32 + fq * 8) * 2), vf = ldfrag(lds + H_VT, 16 * wid + fr, 144, (ks * 32 + fq * 8) * 2);
                accS[di] = __builtin_amdgcn_mfma_f32_16x16x32_bf16(kf, vf, accS[di], 0, 0, 0); }
            if (MODE == 1) { u32x2 o; o.x = pk2(accS[di][0], accS[di][1]); o.y = pk2(accS[di][2], accS[di][3]);
                *(LAS u32x2*)(lds + H_ST + (16 * wid + fr) * 272 + (16 * di + 4 * fq) * 2) = o; } }
        if (MODE == 1) {
            __syncthreads();
#pragma unroll
            for (int mi = 0; mi < 4; ++mi) {
#pragma unroll
                for (int ks = 0; ks < 2; ++ks) { const bf16x8 vf = ldfrag(lds + H_VT, 16 * wid + fr, 144, (ks * 32 + fq * 8) * 2), af = ldfrag(lds + H_AM, 16 * mi + fr, 144, (ks * 32 + fq * 8) * 2);
                    acco[mi] = __builtin_amdgcn_mfma_f32_16x16x32_bf16(vf, af, acco[mi], 0, 0, 0); }
                float s = (acco[mi][0] * acco[mi][0] + acco[mi][1] * acco[mi][1]) + (acco[mi][2] * acco[mi][2] + acco[mi][3] * acco[mi][3]);
                s += __shfl_xor(s, 16); s += __shfl_xor(s, 32);
                if (fq == 0) SSQ[wid * 64 + 16 * mi + fr] = s; }
            __syncthreads();
            bf16* hg = (bf16*)((unsigned char*)P.out + OUT_HGRN);
            const f32x4 nw = *(const f32x4*)(P.hnw + 16 * wid + 4 * fq);
#pragma unroll
            for (int mi = 0; mi < 4; ++mi) { const int t = 16 * mi + fr; float tot = 0.f;
#pragma unroll
                for (int w = 0; w < 8; ++w) tot += SSQ[w * 64 + t];
                const float rstd = 1.f / sqrtf(tot * (1.f / 128.f) + EPS);
                const u32x2 gg = *(const u32x2*)(proj + (t0 + t) * NPROJ + C_GH + h * 128 + 16 * wid + 4 * fq);
                const float g0 = bflo(gg.x), g1 = bfhi(gg.x), g2 = bflo(gg.y), g3 = bfhi(gg.y);
                u32x2 o; o.x = pk2(acco[mi][0] * rstd * nw[0] * (g0 / (1.f + __expf(-g0))), acco[mi][1] * rstd * nw[1] * (g1 / (1.f + __expf(-g1))));
                o.y = pk2(acco[mi][2] * rstd * nw[2] * (g2 / (1.f + __expf(-g2))), acco[mi][3] * rstd * nw[3] * (g3 / (1.f + __expf(-g3))));
                *(u32x2*)(hg + (t0 + t) * 512 + h * 128 + 16 * wid + 4 * fq) = o; }
        }
    }
    if (MODE == 0) {
#pragma unroll
        for (int di = 0; di < 8; ++di)
#pragma unroll
            for (int r = 0; r < 4; ++r) Ug[(16 * di + 4 * fq + r) * 128 + 16 * wid + fr] = accS[di][r];
        if (qd == 0) ((float*)((unsigned char*)P.out + OUT_DSC))[unit * 128 + c] = __expf(dsum);
    }
    __syncthreads();
}

__device__ __forceinline__ void hgrn_scan(const Params& P, int G, int tid) {
    const float* U = (const float*)((unsigned char*)P.out + OUT_U); float* Sin = (float*)((unsigned char*)P.out + OUT_SIN);
    const float* Dsc = (const float*)((unsigned char*)P.out + OUT_DSC);
    for (int idx = blockIdx.x * NTHREADS + tid; idx < 16 * 16384; idx += G * NTHREADS) {
        const int p = idx >> 14, e = idx & 16383, dk = e >> 7; float S = 0.f;
        for (int sc = 0; sc < 15; ++sc) { const int u = p * 16 + sc; S = Dsc[u * 128 + dk] * S + U[(size_t)u * 16384 + e]; Sin[(size_t)(u + 1) * 16384 + e] = S; }
    }
}

constexpr int A_KT = 0, A_VT = 36864, A_QS = 70656, A_END = A_QS + 73728;
static_assert(A_END <= LDS_ST_OFF, "attn LDS");
__device__ __forceinline__ void rope16(float (&v)[32], float posf) {
    const float invf[8] = {1.0f, 0.1939227432012558f, 0.03760603070259094f, 0.007292664609849453f, 0.0014142135623842478f, 0.00027424818836152554f, 5.318296098266728e-05f, 1.0313386155758053e-05f};
#pragma unroll
    for (int i = 0; i < 8; ++i) { float sn, cs; sincosf(posf * invf[i], &sn, &cs); const float x1 = v[i], x2 = v[i + 8]; v[i] = x1 * cs - x2 * sn; v[i + 8] = x2 * cs + x1 * sn; }
}
__device__ __forceinline__ void attn_unit(const Params& P, LAS unsigned char* lds, int unit, int tid, int wid, int lane) {
    const int hk = unit & 1, nb = (unit >> 1) & 63, b = unit >> 7;
    const int fr = lane & 15, fq = lane >> 4;
    const bf16* proj = (const bf16*)(P.ws + WS_PROJ);
    { const int key = tid >> 1, half = tid & 1; const int srel = nb * 128 - 128 + key;
      const bool ok = srel >= 0; const size_t tok = (size_t)b * SEQ + (ok ? srel : 0);
      float v[32];
      { const u32x4* src = (const u32x4*)(proj + tok * NPROJ + C_KA + hk * 64 + half * 32);
#pragma unroll
        for (int j = 0; j < 4; ++j) { const u32x4 w = src[j]; v[8 * j + 0] = bflo(w.x); v[8 * j + 1] = bfhi(w.x); v[8 * j + 2] = bflo(w.y); v[8 * j + 3] = bfhi(w.y); v[8 * j + 4] = bflo(w.z); v[8 * j + 5] = bfhi(w.z); v[8 * j + 6] = bflo(w.w); v[8 * j + 7] = bfhi(w.w); } }
      float s = 0.f;
#pragma unroll
      for (int j = 0; j < 32; ++j) s += v[j] * v[j];
      s += __shfl_xor(s, 1);
      const float rstd = 1.f / sqrtf(s * (1.f / 64.f) + EPS);
#pragma unroll
      for (int j = 0; j < 32; ++j) v[j] = v[j] * rstd * P.k_norm_w[half * 32 + j];
      if (half == 0) rope16(v, (float)P.positions[tok]);
#pragma unroll
      for (int j = 0; j < 4; ++j) { u32x4 o; o.x = pk2(v[8 * j], v[8 * j + 1]); o.y = pk2(v[8 * j + 2], v[8 * j + 3]); o.z = pk2(v[8 * j + 4], v[8 * j + 5]); o.w = pk2(v[8 * j + 6], v[8 * j + 7]);
          if (!ok) o = (u32x4){0u, 0u, 0u, 0u};
          *(LAS u32x4*)(lds + A_KT + key * 144 + half * 64 + j * 16) = o; }
      const u32x4* vs = (const u32x4*)(proj + tok * NPROJ + C_VA + hk * 64 + half * 32);
#pragma unroll
      for (int j = 0; j < 4; ++j) { u32x4 w = vs[j]; if (!ok) w = (u32x4){0u, 0u, 0u, 0u};
          LAS bf16* dst = (LAS bf16*)(lds + A_VT) + (half * 32 + 8 * j) * 264 + key;
          dst[0 * 264] = (bf16)(w.x & 0xffffu); dst[1 * 264] = (bf16)(w.x >> 16); dst[2 * 264] = (bf16)(w.y & 0xffffu); dst[3 * 264] = (bf16)(w.y >> 16);
          dst[4 * 264] = (bf16)(w.z & 0xffffu); dst[5 * 264] = (bf16)(w.z >> 16); dst[6 * 264] = (bf16)(w.w & 0xffffu); dst[7 * 264] = (bf16)(w.w >> 16); } }
    { const int g = tid >> 7, ql = tid & 127; const size_t tok = (size_t)b * SEQ + nb * 128 + ql;
      const u32x4* src = (const u32x4*)(proj + tok * NPROJ + C_QA + (hk * 4 + g) * 64);
      float s = 0.f;
#pragma unroll
      for (int j = 0; j < 8; ++j) { const u32x4 w = src[j]; const float a0 = bflo(w.x), a1 = bfhi(w.x), a2 = bflo(w.y), a3 = bfhi(w.y), a4 = bflo(w.z), a5 = bfhi(w.z), a6 = bflo(w.w), a7 = bfhi(w.w);
          s += (a0 * a0 + a1 * a1) + (a2 * a2 + a3 * a3) + (a4 * a4 + a5 * a5) + (a6 * a6 + a7 * a7); }
      const float rstd = 0.125f / sqrtf(s * (1.f / 64.f) + EPS);
      const float posf = (float)P.positions[tok];
#pragma unroll
      for (int half = 0; half < 2; ++half) { float v[32];
#pragma unroll
          for (int j = 0; j < 4; ++j) { const u32x4 w = src[half * 4 + j]; v[8 * j + 0] = bflo(w.x); v[8 * j + 1] = bfhi(w.x); v[8 * j + 2] = bflo(w.y); v[8 * j + 3] = bfhi(w.y); v[8 * j + 4] = bflo(w.z); v[8 * j + 5] = bfhi(w.z); v[8 * j + 6] = bflo(w.w); v[8 * j + 7] = bfhi(w.w); }
#pragma unroll
          for (int j = 0; j < 32; ++j) v[j] = v[j] * rstd * P.q_norm_w[half * 32 + j];
          if (half == 0) rope16(v, posf);
#pragma unroll
          for (int j = 0; j < 4; ++j) { u32x4 o; o.x = pk2(v[8 * j], v[8 * j + 1]); o.y = pk2(v[8 * j + 2], v[8 * j + 3]); o.z = pk2(v[8 * j + 4], v[8 * j + 5]); o.w = pk2(v[8 * j + 6], v[8 * j + 7]);
              *(LAS u32x4*)(lds + A_QS + tid * 144 + half * 64 + j * 16) = o; } } }
    __syncthreads();
    { const int g = wid >> 1; const float sink = P.sinks[hk * 4 + g];
      bf16* attn = (bf16*)((unsigned char*)P.out + OUT_ATTN);
#pragma unroll 1
      for (int p = 0; p < 2; ++p) { const int q0 = (wid & 1) * 64 + p * 32;
          f32x4 sT[10][2];
          bf16x8 qf[2][2];
#pragma unroll
          for (int nq = 0; nq < 2; ++nq)
#pragma unroll
              for (int ks = 0; ks < 2; ++ks) qf[nq][ks] = ldfrag(lds + A_QS, g * 128 + q0 + 16 * nq + fr, 144, (ks * 32 + fq * 8) * 2);
#pragma unroll
          for (int kt = 0; kt < 10; ++kt) {
#pragma unroll
              for (int nq = 0; nq < 2; ++nq) sT[kt][nq] = (f32x4){0.f, 0.f, 0.f, 0.f};
#pragma unroll
              for (int ks = 0; ks < 2; ++ks) { const bf16x8 kf = ldfrag(lds + A_KT, q0 + 16 * kt + fr, 144, (ks * 32 + fq * 8) * 2);
#pragma unroll
                  for (int nq = 0; nq < 2; ++nq) sT[kt][nq] = __builtin_amdgcn_mfma_f32_16x16x32_bf16(kf, qf[nq][ks], sT[kt][nq], 0, 0, 0); } }
          float linv[2];
#pragma unroll
          for (int nq = 0; nq < 2; ++nq) { const int ql = q0 + 16 * nq + fr; float mx = sink;
#pragma unroll
              for (int kt = 0; kt < 10; ++kt)
#pragma unroll
                  for (int r = 0; r < 4; ++r) { const int kj = q0 + 16 * kt + 4 * fq + r; const bool valid = (kj > ql) && (kj <= ql + 128) && (nb > 0 || kj >= 128);
                      if (!valid) sT[kt][nq][r] = -1e30f; mx = fmaxf(mx, sT[kt][nq][r]); }
              mx = fmaxf(mx, __shfl_xor(mx, 16)); mx = fmaxf(mx, __shfl_xor(mx, 32));
              float l = 0.f;
#pragma unroll
              for (int kt = 0; kt < 10; ++kt)
#pragma unroll
                  for (int r = 0; r < 4; ++r) { const float pv = (sT[kt][nq][r] > -1e29f) ? __expf(sT[kt][nq][r] - mx) : 0.f; sT[kt][nq][r] = pv; l += pv; }
              l += __shfl_xor(l, 16); l += __shfl_xor(l, 32);
              l += __expf(sink - mx);
              linv[nq] = 1.f / l; }
          f32x4 oT[4][2];
#pragma unroll
          for (int dt = 0; dt < 4; ++dt)
#pragma unroll
              for (int nq = 0; nq < 2; ++nq) oT[dt][nq] = (f32x4){0.f, 0.f, 0.f, 0.f};
#pragma unroll
          for (int j = 0; j < 5; ++j) { bf16x8 pf[2];
#pragma unroll
              for (int nq = 0; nq < 2; ++nq) { u32x4 w; w.x = pk2(sT[2 * j][nq][0], sT[2 * j][nq][1]); w.y = pk2(sT[2 * j][nq][2], sT[2 * j][nq][3]); w.z = pk2(sT[2 * j + 1][nq][0], sT[2 * j + 1][nq][1]); w.w = pk2(sT[2 * j + 1][nq][2], sT[2 * j + 1][nq][3]);
                  pf[nq] = __builtin_bit_cast(bf16x8, w); }
#pragma unroll
              for (int dt = 0; dt < 4; ++dt) { const LAS unsigned char* vrow = lds + A_VT + (16 * dt + fr) * 528 + (q0 + 32 * j + 4 * fq) * 2;
                  const u32x2 lo = *(const LAS u32x2*)vrow, hi = *(const LAS u32x2*)(vrow + 32);
                  u32x4 w; w.x = lo.x; w.y = lo.y; w.z = hi.x; w.w = hi.y; const bf16x8 vf = __builtin_bit_cast(bf16x8, w);
#pragma unroll
                  for (int nq = 0; nq < 2; ++nq) oT[dt][nq] = __builtin_amdgcn_mfma_f32_16x16x32_bf16(vf, pf[nq], oT[dt][nq], 0, 0, 0); } }
#pragma unroll
          for (int nq = 0; nq < 2; ++nq) { const size_t tok = (size_t)b * SEQ + nb * 128 + q0 + 16 * nq + fr;
#pragma unroll
              for (int dt = 0; dt < 4; ++dt) { const f32x4 v = oT[dt][nq] * linv[nq]; u32x2 o; o.x = pk2(v[0], v[1]); o.y = pk2(v[2], v[3]);
                  *(u32x2*)(attn + tok * 512 + (hk * 4 + g) * 64 + 16 * dt + 4 * fq) = o; } }
      } }
    __syncthreads();
}

__device__ __forceinline__ void phase7(const Params& P, LAS unsigned char* lds, int vcu, int G, int tid, int wid, int lane) {
    const float* Wr = (const float*)(P.ws + WS_WR); const float* ssq = (const float*)(P.ws + WS_SSQ);
    unsigned* cnt = (unsigned*)(P.ws + WS_CTL + CTL_CNT); int* list = (int*)(P.ws + WS_LIST); float* gw = (float*)(P.ws + WS_GW); float* rstdv = (float*)(P.ws + WS_RSTD);
    const int fr = lane & 15, fq = lane >> 4;
    LAS float* LG = (LAS float*)(lds + wid * 3072);
    for (int base = vcu * 8; base < T / 16; base += G * 8) {
        const int rg = base + wid; const int R0 = rg * 16;
        f32x4 acc[3];
#pragma unroll
        for (int nt = 0; nt < 3; ++nt) acc[nt] = (f32x4){0.f, 0.f, 0.f, 0.f};
        const float* xr = P.out + (size_t)(R0 + fr) * 1024 + 4 * fq;
        const float* w0 = Wr + (size_t)fr * 1024 + 4 * fq;
#pragma unroll 4
        for (int s = 0; s < 64; ++s) { const f32x4 xa = *(const f32x4*)(xr + 16 * s); f32x4 wb[3];
#pragma unroll
            for (int nt = 0; nt < 3; ++nt) wb[nt] = *(const f32x4*)(w0 + nt * 16384 + 16 * s);
#pragma unroll
            for (int i = 0; i < 4; ++i)
#pragma unroll
                for (int nt = 0; nt < 3; ++nt) acc[nt] = __builtin_amdgcn_mfma_f32_16x16x4f32(xa[i], wb[nt][i], acc[nt], 0, 0, 0); }
#pragma unroll
        for (int r = 0; r < 4; ++r) { const float* sp = ssq + (size_t)(R0 + 4 * fq + r) * 16; float tot = 0.f;
#pragma unroll
            for (int q = 0; q < 4; ++q) { const f32x4 v = *(const f32x4*)(sp + 4 * q); tot += v[0]; tot += v[1]; tot += v[2]; tot += v[3]; }
            const float rstd = 1.f / sqrtf(tot * (1.f / 1024.f) + EPS);
            if (fr == 0) rstdv[R0 + 4 * fq + r] = rstd;
#pragma unroll
            for (int nt = 0; nt < 3; ++nt) { const int j = 16 * nt + fr; float bias = 0.f; if (j < 4) bias = P.b_rg[j]; else if (j < 36) bias = P.b_re[j - 4];
                LG[(4 * fq + r) * 48 + j] = acc[nt][r] * rstd + bias; } }
        __syncthreads();
        if (lane < 16) { const int tok = R0 + lane; const LAS float* lg = LG + lane * 48;
            int gsel = 0; float best = lg[0];
#pragma unroll
            for (int i = 1; i < 4; ++i) { const float v = lg[i]; if (v > best) { best = v; gsel = i; } }
            float Z = 0.f;
#pragma unroll
            for (int i = 0; i < 4; ++i) Z += __expf(lg[i] - best);
            const float pgsel = 1.f / Z;
            const LAS float* le = lg + 4 + gsel * 8;
            float lmax = le[0];
#pragma unroll
            for (int i = 1; i < 8; ++i) lmax = fmaxf(lmax, le[i]);
            float Zp = 0.f;
#pragma unroll
            for (int i = 0; i < 8; ++i) Zp += __expf(le[i] - lmax);
            int i1 = 0; float p1 = -1.f;
#pragma unroll
            for (int i = 0; i < 8; ++i) { const float pe = __expf(le[i] - lmax) / Zp; if (pe > p1) { p1 = pe; i1 = i; } }
            int i2 = 0; float p2 = -1.f;
#pragma unroll
            for (int i = 0; i < 8; ++i) { const float pe = __expf(le[i] - lmax) / Zp; if (i != i1 && pe > p2) { p2 = pe; i2 = i; } }
            const float den = p1 + p2;
            gw[tok * 2 + 0] = pgsel * p1 / den; gw[tok * 2 + 1] = pgsel * p2 / den;
            const int l0 = gsel * 8 + i1, l1 = 32 + gsel * 8 + i2;
            const unsigned pos0 = atomicAdd(&cnt[l0], 1u); list[(size_t)l0 * T + pos0] = tok;
            const unsigned pos1 = atomicAdd(&cnt[l1], 1u); list[(size_t)l1 * T + pos1] = tok; }
        __syncthreads();
    }
}

constexpr int M_TOKS = 131072, M_RS = 132096, M_PB = 133120, M_CN = 133632;
__device__ __forceinline__ void moe_prefix(const Params& P, LAS unsigned char* lds, int tid) {
    const unsigned* cnt = (const unsigned*)(P.ws + WS_CTL + CTL_CNT);
    LAS int* PB = (LAS int*)(lds + M_PB); LAS int* CN = (LAS int*)(lds + M_CN);
    if (tid < 64) CN[tid] = (int)cnt[tid];
    __syncthreads();
    if (tid == 0) { int s = 0; for (int l = 0; l < 64; ++l) { PB[l] = s; s += (CN[l] + 255) >> 8; } PB[64] = s; }
    __syncthreads();
}
template <int MODE>
__device__ __forceinline__ void moe_gemm(const Params& P, LAS unsigned char* lds, int vcu, int G, int lbeg, int lend, int tid, int wid, int lane) {
    LAS int* PB = (LAS int*)(lds + M_PB); LAS int* CN = (LAS int*)(lds + M_CN); LAS int* TOKS = (LAS int*)(lds + M_TOKS); LAS float* RS = (LAS float*)(lds + M_RS);
    const int* list = (const int*)(P.ws + WS_LIST); const float* gw = (const float*)(P.ws + WS_GW); const float* rstdv = (const float*)(P.ws + WS_RSTD);
    const bf16* hn = (const bf16*)(P.ws + WS_HN); bf16* hb = (bf16*)(P.ws + WS_H);
    const int wr = wid >> 2, wc = wid & 3, fr = lane & 15, fq = lane >> 4;
    int sR[4], sC; { int C_; for (int i = 0; i < 4; ++i) { stage_rc(wid * 1024 + i * 8192 + lane * 16, sR[i], C_); } sC = C_; }
    const int rb0 = PB[lbeg], nunits = (PB[lend] - rb0) * 4;
    for (int u = vcu; u < nunits; u += G) {
        const int rb = rb0 + (u >> 2), pn = u & 3;
        int l = lbeg; while (PB[l + 1] <= rb) ++l;
        const int e = l & 31, k = l >> 5, cn = CN[l], i0 = (rb - PB[l]) * 256;
        if (tid < 256) { const int idx = i0 + tid; const bool ok = idx < cn; const int tk = list[(size_t)l * T + (ok ? idx : 0)];
            TOKS[tid] = ok ? tk : (-1 - tk);
            RS[tid] = (MODE == 0) ? rstdv[tk] : gw[tk * 2 + k]; }
        __syncthreads();
        unsigned oa[4], ob[4];
#pragma unroll
        for (int i = 0; i < 4; ++i) {
            if (MODE == 0) { int tk = TOKS[sR[i]]; tk = tk < 0 ? (-1 - tk) : tk; oa[i] = (unsigned)(tk * 1024 + sC); ob[i] = (unsigned)(((e * 1024 + pn * 256 + sR[i]) * 1024) + sC); }
            else { oa[i] = (unsigned)((rb * 256 + sR[i]) * 512 + sC); ob[i] = (unsigned)(((e * 1024 + pn * 256 + sR[i]) * 512) + sC); } }
        f32x4 acc[8][4]; acc_zero(acc);
        gemm_core(lds, MODE == 0 ? hn : (const bf16*)hb, oa, (const bf16*)(P.ws + (MODE == 0 ? WS_WGU : WS_WD)), ob, MODE == 0 ? 16 : 8, acc, wid, lane);
        const int fro = opaque(fr), fqo = opaque(fq);
#pragma unroll
        for (int m = 0; m < 8; ++m) { const int r = wr * 128 + m * 16 + fro; const float rs = RS[r];
            if (MODE == 0) {
#pragma unroll
                for (int n = 0; n < 2; ++n) { const f32x4 gv = acc[m][n] * rs, uv = acc[m][n + 2] * rs; const int hcol = pn * 128 + wc * 32 + n * 16 + 4 * fqo;
                    u32x2 o; o.x = pk2(gv[0] / (1.f + __expf(-gv[0])) * uv[0], gv[1] / (1.f + __expf(-gv[1])) * uv[1]);
                    o.y = pk2(gv[2] / (1.f + __expf(-gv[2])) * uv[2], gv[3] / (1.f + __expf(-gv[3])) * uv[3]);
                    *(u32x2*)(hb + ((size_t)rb * 256 + r) * 512 + hcol) = o; }
            } else { const int tk = TOKS[r];
                if (tk >= 0) {
#pragma unroll
                    for (int n = 0; n < 4; ++n) { const int col = pn * 256 + wc * 64 + n * 16 + 4 * fqo; float* op = P.out + (size_t)tk * 1024 + col;
                        const f32x4 old = *(const f32x4*)op; *(f32x4*)op = old + acc[m][n] * rs; } } }
            asm volatile("" ::: "memory");
        }
        __syncthreads();
    }
}

__global__ void __launch_bounds__(NTHREADS, 2) mega_fwd(Params P) {
    extern __shared__ __attribute__((aligned(16))) unsigned char lds_raw[];
    LAS unsigned char* lds = (LAS unsigned char*)lds_raw;
    const int tid = threadIdx.x, lane = tid & 63, wid = __builtin_amdgcn_readfirstlane(tid >> 6);
    const int G = gridDim.x; const int bx = blockIdx.x; const int vcu = (G % 8 == 0) ? (bx % 8) * (G / 8) + bx / 8 : bx;
    volatile LAS unsigned* st = (volatile LAS unsigned*)(lds + LDS_ST_OFF);
    if (tid < 16) st[tid] = 0u;
    __syncthreads();
    unsigned* bar = (unsigned*)(P.ws + WS_CTL);
    const XcdBarrier xb = xcd_barrier_post(bar, st);

#ifndef PHMASK
#define PHMASK 0xFFF
#endif
#define PH(k) ((PHMASK >> (k)) & 1)
    if (PH(0)) phase0(P, lds, vcu, G, tid, wid, lane);
    xcd_barrier(xb);
    if (PH(1)) phase1(P, lds, G, tid, wid, lane);
    xcd_barrier(xb);
    if (PH(2)) for (int u = bx; u < 256; u += G) if ((u & 15) != 15) hgrn_unit<0>(P, lds, u, tid, wid, lane);
    xcd_barrier(xb);
    if (PH(3)) { hgrn_scan(P, G, tid);
        for (int u = bx; u < 512; u += G) attn_unit(P, lds, u, tid, wid, lane); }
    xcd_barrier(xb);
    if (PH(4)) for (int u = bx; u < 256; u += G) hgrn_unit<1>(P, lds, u, tid, wid, lane);
    xcd_barrier(xb);
    if (PH(5)) phase5(P, lds, G, tid, wid, lane);
    xcd_barrier(xb);
    if (PH(6)) phase6(P, lds, G, tid, wid, lane);
    xcd_barrier(xb);
    if (PH(7)) phase7(P, lds, vcu, G, tid, wid, lane);
    xcd_barrier(xb);
    if (PH(8)) { moe_prefix(P, lds, tid);
        moe_gemm<0>(P, lds, vcu, G, 0, 64, tid, wid, lane); }
    xcd_barrier(xb);
    if (PH(9)) { if (!PH(8)) moe_prefix(P, lds, tid); moe_gemm<1>(P, lds, vcu, G, 0, 32, tid, wid, lane); }
    xcd_barrier(xb);
    if (PH(10)) { if (!PH(8)) moe_prefix(P, lds, tid); moe_gemm<1>(P, lds, vcu, G, 32, 64, tid, wid, lane); }
    if (xb_ld(&bar[XB_TMO]) != 0u && tid == 0) P.out[(size_t)bx * 1024] = __builtin_nanf("");
}

extern "C" void kernel_launch(void* const* d_in, const int* in_sizes, int n_in, void* d_out, int out_size, void* d_ws, size_t ws_size, hipStream_t stream) {
    static int grid = 0;
    if (grid == 0) {
        if (n_in != 20 || out_size != T * D || ws_size < WS_END) { fprintf(stderr, "kernel_launch: unexpected shapes (n_in %d out %d ws %zu, need ws >= %zu)\n", n_in, out_size, ws_size, (size_t)WS_END); grid = -1; return; }
        int dev = 0, cus = 0, per_cu = 0;
        if (hipGetDevice(&dev) != hipSuccess || hipDeviceGetAttribute(&cus, hipDeviceAttributeMultiprocessorCount, dev) != hipSuccess) { grid = -1; return; }
        if (hipFuncSetAttribute((const void*)mega_fwd, hipFuncAttributeMaxDynamicSharedMemorySize, LDS_BYTES) != hipSuccess) { fprintf(stderr, "hipFuncSetAttribute failed\n"); grid = -1; return; }
        if (hipOccupancyMaxActiveBlocksPerMultiprocessor(&per_cu, (const void*)mega_fwd, NTHREADS, LDS_BYTES) != hipSuccess || per_cu < 1) { fprintf(stderr, "occupancy query: %d blocks/CU\n", per_cu); grid = -1; return; }
        grid = cus;
    }
    if (grid < 0) return;
    if (hipMemsetAsync((char*)d_ws + WS_CTL, 0, 1 * MiB, stream) != hipSuccess) return;
    Params p{};
    p.x = (const float*)d_in[0]; p.positions = (const int*)d_in[1]; p.norm1_w = (const float*)d_in[2]; p.w_in = (const float*)d_in[3];
    p.q_norm_w = (const float*)d_in[4]; p.k_norm_w = (const float*)d_in[5]; p.sinks = (const float*)d_in[6]; p.hlb = (const float*)d_in[7];
    p.hnw = (const float*)d_in[8]; p.w_ba = (const float*)d_in[9]; p.w_bh = (const float*)d_in[10]; p.w_out = (const float*)d_in[11];
    p.norm2_w = (const float*)d_in[12]; p.w_rg = (const float*)d_in[13]; p.b_rg = (const float*)d_in[14]; p.w_re = (const float*)d_in[15];
    p.b_re = (const float*)d_in[16]; p.w_gate = (const float*)d_in[17]; p.w_up = (const float*)d_in[18]; p.w_down = (const float*)d_in[19];
    p.out = (float*)d_out; p.ws = (unsigned char*)d_ws;
    void* args[] = {&p};
    const hipError_t e = hipLaunchCooperativeKernel((const void*)mega_fwd, dim3(grid), dim3(NTHREADS), args, LDS_BYTES, stream);
    if (e != hipSuccess) fprintf(stderr, "cooperative launch failed: %s (grid %d)\n", hipGetErrorString(e), grid);
}
```

```cpp
#include <hip/hip_runtime.h>
#include <cstdio>
#include <cstdint>

#define LAS __attribute__((address_space(3)))
typedef unsigned short bf16;
typedef short bf16x8 __attribute__((ext_vector_type(8)));
typedef float f32x4 __attribute__((ext_vector_type(4)));
typedef unsigned u32x4 __attribute__((ext_vector_type(4)));
typedef unsigned u32x2 __attribute__((ext_vector_type(2)));

constexpr int NTHREADS = 512;
constexpr int LDS_BYTES = 147456;
constexpr int LDS_ST_OFF = LDS_BYTES - 64;

constexpr int BATCH = 4, SEQ = 8192, T = BATCH * SEQ, D = 1024, NPROJ = 4864;
constexpr int C_QA = 0, C_KA = 512, C_VA = 640, C_QH = 768, C_FH = 1280, C_IH = 1792, C_GH = 2304, C_ZA = 2816, C_ZB = 3840;
constexpr int NEXP = 32, FF = 512;
constexpr float EPS = 1e-6f;

constexpr size_t MiB = 1u << 20;
constexpr size_t WS_CTL = 0;
constexpr size_t CTL_CNT = 65536;
constexpr size_t WS_WINT = 1 * MiB;
constexpr size_t WS_WAT = 11 * MiB;
constexpr size_t WS_WBT = 12 * MiB;
constexpr size_t WS_WOT = 13 * MiB;
constexpr size_t WS_WR = 15 * MiB;
constexpr size_t WS_WGU = 16 * MiB;
constexpr size_t WS_WD = 80 * MiB;
constexpr size_t WS_PROJ = 112 * MiB;
constexpr size_t WS_MIXED = 416 * MiB;
constexpr size_t WS_END = 480 * MiB;
constexpr size_t WS_HN = 112 * MiB;
constexpr size_t WS_SSQ = 176 * MiB;
constexpr size_t WS_LIST = 178 * MiB;
constexpr size_t WS_GW = 186 * MiB;
constexpr size_t WS_RSTD = 187 * MiB;
constexpr size_t WS_H = 192 * MiB;
constexpr size_t OUT_U = 0, OUT_SIN = 16 * MiB, OUT_DSC = 32 * MiB, OUT_AH = 64 * MiB;

__device__ __forceinline__ unsigned f2bf(float f) { unsigned u = __builtin_bit_cast(unsigned, f); return (u + 0x7fffu + ((u >> 16) & 1u)) >> 16; }
__device__ __forceinline__ float bf2f(unsigned h) { return __builtin_bit_cast(float, h << 16); }
__device__ __forceinline__ unsigned pk2(float lo, float hi) { return f2bf(lo) | (f2bf(hi) << 16); }
__device__ __forceinline__ float bflo(unsigned w) { return __builtin_bit_cast(float, w << 16); }
__device__ __forceinline__ float bfhi(unsigned w) { return __builtin_bit_cast(float, w & 0xffff0000u); }
__device__ __forceinline__ float sigmoidf_(float x) { return __builtin_amdgcn_rcpf(1.f + __expf(-x)); }
__device__ __forceinline__ int opaque(int x) { asm volatile("" : "+v"(x)); return x; }
__device__ __forceinline__ float wave_sum(float v) {
#pragma unroll
    for (int o = 1; o < 64; o <<= 1) v += __shfl_xor(v, o);
    return v;
}

#define XB_TMO      128
#define XB_XCNT(j)  (256  + 64 * (j))
#define XB_XSUB(j)  (1280 + 64 * (j))
#define XB_XGEN(j)  (2304 + 64 * (j))
#define XB_TOP      3328
#define XB_TOPGEN   3392
#define XCD_BAR_WORDS 3456
#define XB_SPIN_CAP (1u << 20)
__device__ __forceinline__ unsigned xb_ld(unsigned* p)              { return __hip_atomic_load(p, __ATOMIC_RELAXED, __HIP_MEMORY_SCOPE_AGENT); }
__device__ __forceinline__ unsigned xb_add(unsigned* p, unsigned v) { return __hip_atomic_fetch_add(p, v, __ATOMIC_RELAXED, __HIP_MEMORY_SCOPE_AGENT); }
__device__ __forceinline__ unsigned xb_xcc_id() { return (unsigned)__builtin_amdgcn_s_getreg((3 << 11) | 20) & 0xFu; }
#define XB_SPIN(cond, bar) do { unsigned _sp = 0; while (cond) { __builtin_amdgcn_s_sleep(1); \
    if ((++_sp & 255u) == 0u) { if (xb_ld(&(bar)[XB_TMO])) break; if (_sp > XB_SPIN_CAP) { atomicAdd(&(bar)[XB_TMO], 1u); break; } } } } while (0)
struct XcdBarrier { unsigned* bar; unsigned x; volatile LAS unsigned* st; };
__device__ __forceinline__ XcdBarrier xcd_barrier_post(unsigned* bar, volatile LAS unsigned* st) {
    XcdBarrier b; b.bar = bar; b.x = xb_xcc_id(); b.st = st;
    if (threadIdx.x == 0) (void)xb_add(&bar[XB_XCNT(b.x)], 1u);
    return b;
}
__device__ __forceinline__ void xcd_barrier_complete(unsigned* bar, unsigned x, unsigned& nloc, unsigned& nx) {
    const unsigned G = gridDim.x * gridDim.y * gridDim.z;
    unsigned sum, cnt, mine, sp = 0u;
    for (;;) {
        sum = 0u; cnt = 0u; mine = 0u;
#pragma unroll
        for (unsigned j = 0; j < 16; ++j) { const unsigned c = xb_ld(&bar[XB_XCNT(j)]); sum += c; cnt += (c > 0u) ? 1u : 0u; mine = (j == x) ? c : mine; }
        if (sum == G) break;
        __builtin_amdgcn_s_sleep(1);
        if ((++sp & 255u) == 0u) { if (xb_ld(&bar[XB_TMO])) break; if (sp > XB_SPIN_CAP) { atomicAdd(&bar[XB_TMO], 1u); break; } }
    }
    nloc = mine > 0u ? mine : 1u; nx = cnt > 0u ? cnt : 1u;
}
__device__ __forceinline__ void xcd_barrier(const XcdBarrier& b) {
    asm volatile("s_waitcnt vmcnt(0)" ::: "memory");
    __syncthreads();
    if (threadIdx.x == 0) {
        unsigned* bar = b.bar;
        __builtin_amdgcn_s_waitcnt(0);
        unsigned nloc = b.st[0], nx = b.st[1];
        if (nloc == 0u) { xcd_barrier_complete(bar, b.x, nloc, nx); b.st[0] = nloc; b.st[1] = nx; }
        const unsigned old = xb_add(&bar[XB_XSUB(b.x)], 1u);
        const unsigned gen = old / nloc;
        if (old + 1u == (gen + 1u) * nloc) {
            __builtin_amdgcn_fence(__ATOMIC_RELEASE, "agent");
            asm volatile("s_waitcnt vmcnt(0)" ::: "memory");
            const unsigned og = xb_add(&bar[XB_TOP], 1u);
            const unsigned tg = og / nx;
            if (og + 1u == (tg + 1u) * nx) xb_add(&bar[XB_TOPGEN], 1u);
            else XB_SPIN(xb_ld(&bar[XB_TOPGEN]) == tg, bar);
            __builtin_amdgcn_fence(__ATOMIC_ACQUIRE, "agent");
            xb_add(&bar[XB_XGEN(b.x)], 1u);
            asm volatile("s_waitcnt vmcnt(0)" ::: "memory");
        } else {
            XB_SPIN(xb_ld(&bar[XB_XGEN(b.x)]) == gen, bar);
            __builtin_amdgcn_fence(__ATOMIC_ACQUIRE, "agent");
            asm volatile("s_waitcnt vmcnt(0)" ::: "memory");
        }
    }
    __syncthreads();
}

struct Params {
    const float* x; const int* positions; const float* norm1_w; const float* w_in; const float* q_norm_w; const float* k_norm_w;
    const float* sinks; const float* hlb; const float* hnw; const float* w_ba; const float* w_bh; const float* w_out; const float* norm2_w;
    const float* w_rg; const float* b_rg; const float* w_re; const float* b_re; const float* w_gate; const float* w_up; const float* w_down;
    float* out; unsigned char* ws;
};

namespace pg8 {
constexpr int BK = 64, HALF = 128, HTB = HALF * BK * 2;
__device__ __forceinline__ int lds_byte(int r, int c) { const int st = (r >> 4) * 2 + (c >> 5), rr = r & 15, cc = c & 31, ob = rr * 64 + cc * 2; return st * 1024 + (ob ^ (((ob >> 9) & 1) << 5)); }
__device__ __forceinline__ void stage_rc(int b, int& R, int& C) { const int st = b / 1024, sb = b % 1024, swz = sb ^ (((sb >> 9) & 1) << 5); R = (st >> 1) * 16 + swz / 64; C = (st & 1) * 32 + (swz % 64) / 2; }
__device__ __forceinline__ int perm32(int rho) { const int n = rho >> 4, i = rho & 15; return 8 * (i >> 2) + 4 * n + (i & 3); }
struct Unit { int pm, pn, l, i0, cn; };

template <class Epi, class Sched>
__device__ __forceinline__ void gemm_phase(LAS unsigned char* lds, const Sched& S, const Epi& E) {
    const int tid = threadIdx.x, wid = __builtin_amdgcn_readfirstlane(tid >> 6), lane = tid & 63, wr = wid >> 2, wc = wid & 3, fr = lane & 15, fq = lane >> 4;
    const int K = S.K, nt = K / BK;
    int sR[2], sC = 0; unsigned voffB[2];
#pragma unroll
    for (int i = 0; i < 2; ++i) { int R, C; stage_rc(tid * 16 + i * 8192, R, C); sR[i] = R; sC = C; const int Rb = Epi::PERM ? ((R & ~31) + perm32(R & 31)) : R; voffB[i] = (unsigned)(Rb * K + C) * 2u; }
    const unsigned kstep = (unsigned)(BK * 2);
    const size_t hstep = (size_t)HALF * K * 2;
    const unsigned ldsw = (unsigned)wid * 1024u;
    const int aoff = lds_byte(wr * 64 + fr, fq * 8), boff = lds_byte(wc * 32 + fr, fq * 8);
#define PG8_SA(b, h) (((b) * 2 + (h)) * HTB)
#define PG8_SB(b, h) ((4 + (b) * 2 + (h)) * HTB)
#define PG8_STAGE_B(bufoff, gbase) do { _Pragma("unroll") for (int _i = 0; _i < 2; ++_i) \
        __builtin_amdgcn_global_load_lds((const unsigned*)((const char*)(gbase) + voffB[_i]), (LAS unsigned*)(lds + (bufoff) + ldsw + _i * 8192), 16, 0, 0); } while (0)
#define PG8_STAGE_A(bufoff, va, kb) do { _Pragma("unroll") for (int _i = 0; _i < 2; ++_i) \
        __builtin_amdgcn_global_load_lds((const unsigned*)(Ab + ((size_t)(va)[_i] + (kb))), (LAS unsigned*)(lds + (bufoff) + ldsw + _i * 8192), 16, 0, 0); } while (0)
#define PG8_LDA(dst, b, h) do { _Pragma("unroll") for (int m = 0; m < 4; ++m) _Pragma("unroll") for (int k = 0; k < 2; ++k) dst[m][k] = *(const LAS bf16x8*)(lds + PG8_SA(b, h) + aoff + m * 2048 + k * 1024); } while (0)
#define PG8_LDB(dst, b, h) do { _Pragma("unroll") for (int n = 0; n < 2; ++n) _Pragma("unroll") for (int k = 0; k < 2; ++k) dst[n][k] = *(const LAS bf16x8*)(lds + PG8_SB(b, h) + boff + n * 2048 + k * 1024); } while (0)
#define PG8_MMA(ai, bj, At, Bt) do { __builtin_amdgcn_s_setprio(1); _Pragma("unroll") for (int m = 0; m < 4; ++m) _Pragma("unroll") for (int n = 0; n < 2; ++n) _Pragma("unroll") for (int k = 0; k < 2; ++k) \
        acc[ai][bj][m][n] = __builtin_amdgcn_mfma_f32_16x16x32_bf16(Bt[n][k], At[m][k], acc[ai][bj][m][n], 0, 0, 0); __builtin_amdgcn_s_setprio(0); } while (0)
#define PG8_WAIT_V(n) asm volatile("s_waitcnt vmcnt(" #n ")" ::: "memory")
#define PG8_WAIT_L(n) asm volatile("s_waitcnt lgkmcnt(" #n ")" ::: "memory")
#define PG8_BAR __builtin_amdgcn_s_barrier()
#define PG8_SCHED __builtin_amdgcn_sched_barrier(0)
    Unit cur, nxt; int ui = 0;
    if (!S.next(0, cur)) return;
    f32x4 acc[2][2][4][2];
#pragma unroll
    for (int a = 0; a < 2; ++a)
#pragma unroll
        for (int b = 0; b < 2; ++b)
#pragma unroll
            for (int m = 0; m < 4; ++m)
#pragma unroll
                for (int n = 0; n < 2; ++n) acc[a][b][m][n] = (f32x4){0.f, 0.f, 0.f, 0.f};
    bf16x8 At[4][2], B0[2][2], B1[2][2];
    const char* const Ab = S.a_base();
    unsigned vA0[2], vA1[2], nA0[2], nA1[2];
#pragma unroll
    for (int i = 0; i < 2; ++i) { vA0[i] = S.a_voff(cur, 0, sR[i], sC); vA1[i] = S.a_voff(cur, 1, sR[i], sC); }
    const char* cB = S.b_base(cur);
    PG8_STAGE_B(PG8_SB(0, 0), cB); PG8_STAGE_B(PG8_SB(0, 1), cB + hstep); PG8_STAGE_A(PG8_SA(0, 0), vA0, 0u); PG8_STAGE_A(PG8_SA(0, 1), vA1, 0u);
    if (wr == 1) PG8_BAR;
    PG8_WAIT_V(2); PG8_BAR;
    PG8_STAGE_B(PG8_SB(1, 0), cB + kstep); PG8_STAGE_A(PG8_SA(1, 0), vA0, kstep); PG8_STAGE_B(PG8_SB(1, 1), cB + hstep + kstep);
    PG8_WAIT_V(6); PG8_BAR;
    for (;;) {
        const bool has_next = S.next(ui + 1, nxt);
        const char* nB = has_next ? S.b_base(nxt) : cB;
#pragma unroll
        for (int i = 0; i < 2; ++i) { nA0[i] = has_next ? S.a_voff(nxt, 0, sR[i], sC) : vA0[i]; nA1[i] = has_next ? S.a_voff(nxt, 1, sR[i], sC) : vA1[i]; }
#pragma unroll 1
        for (int t = 0; t < nt; t += 2) {
            const bool last = (t == nt - 2);
            if constexpr (Epi::MID) { if (t == (nt >> 1)) E.mid(acc, cur, wr, wc, fr, fq); }
            const unsigned k1 = (unsigned)(t + 1) * kstep;
            const unsigned k2 = last ? 0u : (unsigned)(t + 2) * kstep, k3 = k2 + kstep;
            const char* b2 = last ? nB : cB + (size_t)(t + 2) * kstep; const char* b3 = b2 + kstep;
            unsigned uA0[2], uA1[2];
#pragma unroll
            for (int i = 0; i < 2; ++i) { uA0[i] = last ? nA0[i] : vA0[i]; uA1[i] = last ? nA1[i] : vA1[i]; }
            PG8_LDB(B0, 0, 0); PG8_LDB(B1, 0, 1); PG8_SCHED; PG8_LDA(At, 0, 0); PG8_STAGE_A(PG8_SA(1, 1), vA1, k1);
            PG8_WAIT_V(8); PG8_WAIT_L(0); PG8_BAR; PG8_MMA(0, 0, At, B0); PG8_MMA(0, 1, At, B1); PG8_BAR; PG8_SCHED;
            PG8_LDA(At, 0, 1); PG8_STAGE_B(PG8_SB(0, 0), b2); PG8_STAGE_B(PG8_SB(0, 1), b2 + hstep); PG8_STAGE_A(PG8_SA(0, 0), uA0, k2);
            PG8_WAIT_V(8); PG8_WAIT_L(0); PG8_BAR; PG8_MMA(1, 0, At, B0); PG8_MMA(1, 1, At, B1); PG8_BAR; PG8_SCHED;
            PG8_LDB(B0, 1, 0); PG8_LDB(B1, 1, 1); PG8_SCHED; PG8_LDA(At, 1, 0); PG8_STAGE_A(PG8_SA(0, 1), uA1, k2);
            PG8_WAIT_V(8); PG8_WAIT_L(0); PG8_BAR; PG8_MMA(0, 0, At, B0); PG8_MMA(0, 1, At, B1); PG8_BAR; PG8_SCHED;
            PG8_LDA(At, 1, 1); PG8_STAGE_B(PG8_SB(1, 0), b3); PG8_STAGE_B(PG8_SB(1, 1), b3 + hstep); PG8_STAGE_A(PG8_SA(1, 0), uA0, k3);
            PG8_WAIT_V(8); PG8_WAIT_L(0); PG8_BAR; PG8_MMA(1, 0, At, B0); PG8_MMA(1, 1, At, B1); PG8_BAR; PG8_SCHED;
        }
        if (wr == 0) PG8_BAR;
        E(acc, cur, wr, wc, fr, fq);
        if (!has_next) break;
#pragma unroll
        for (int a = 0; a < 2; ++a)
#pragma unroll
            for (int b = 0; b < 2; ++b)
#pragma unroll
                for (int m = 0; m < 4; ++m)
#pragma unroll
                    for (int n = 0; n < 2; ++n) acc[a][b][m][n] = (f32x4){0.f, 0.f, 0.f, 0.f};
        cur = nxt; cB = nB; ++ui;
#pragma unroll
        for (int i = 0; i < 2; ++i) { vA0[i] = nA0[i]; vA1[i] = nA1[i]; }
        if (wr == 1) PG8_BAR;
    }
    PG8_WAIT_V(0);
    PG8_BAR;
#undef PG8_SA
#undef PG8_SB
#undef PG8_STAGE_A
#undef PG8_STAGE_B
#undef PG8_LDA
#undef PG8_LDB
#undef PG8_MMA
#undef PG8_WAIT_V
#undef PG8_WAIT_L
#undef PG8_BAR
#undef PG8_SCHED
}
__device__ __forceinline__ bool tile_order(int i, int G, int c, int nM, int nN, int& pm, int& pn) {
    const int nwg = nM * nN; const long L = (long)i * G + c; if (L >= nwg) return false;
    int wgid = (int)L; { const int q = nwg / 8, r = nwg % 8, xcd = wgid % 8, off = wgid / 8; wgid = (xcd < r ? xcd * (q + 1) : r * (q + 1) + (xcd - r) * q) + off; }
    const int WGM = 8, nig = WGM * nN, gid = wgid / nig, fm = gid * WGM, gsz = (nM - fm) < WGM ? (nM - fm) : WGM;
    pm = fm + ((wgid % nig) % gsz); pn = (wgid % nig) / gsz; return true;
}
struct DenseSched {
    const char* A; const char* Bt; int K, nM, nN, G, c;
    __device__ __forceinline__ bool next(int i, Unit& u) const { u.l = 0; u.i0 = 0; u.cn = 0; return tile_order(i, G, c, nM, nN, u.pm, u.pn); }
    __device__ __forceinline__ const char* a_base() const { return A; }
    __device__ __forceinline__ unsigned a_voff(const Unit& u, int h, int R, int C) const { return (unsigned)((u.pm * 256 + h * 128 + R) * K + C) * 2u; }
    __device__ __forceinline__ const char* b_base(const Unit& u) const { return Bt + (size_t)u.pn * 256 * K * 2; }
};
template <int MODE> struct MoeSched {
    const char* A; const char* Bt; const int* list; const LAS int* PB; const LAS int* CN; int K, rb0, nunits, vcu, G, lbeg;
    __device__ __forceinline__ bool next(int i, Unit& u) const {
        const int idx = vcu + i * G; if (idx >= nunits) return false;
        const int rb = rb0 + (idx >> 2); int l = lbeg; while (PB[l + 1] <= rb) ++l;
        u.pm = rb; u.pn = idx & 3; u.l = l; u.i0 = (rb - PB[l]) * 256; u.cn = CN[l]; return true; }
    __device__ __forceinline__ const char* a_base() const { return A; }
    __device__ __forceinline__ unsigned a_voff(const Unit& u, int h, int R, int C) const {
        if (MODE == 0) { int idx = u.i0 + h * 128 + R; idx = idx < u.cn ? idx : u.cn - 1; const int tok = list[(size_t)u.l * T + idx]; return (unsigned)(tok * 1024 + C) * 2u; }
        return (unsigned)((u.pm * 256 + h * 128 + R) * 512 + C) * 2u; }
    __device__ __forceinline__ const char* b_base(const Unit& u) const { return Bt + ((size_t)(u.l & 31) * 1024 + u.pn * 256) * K * 2; }
};
}

struct EpiProj { static constexpr bool PERM = true, MID = false; bf16* proj;
    __device__ __forceinline__ void operator()(const f32x4 (&acc)[2][2][4][2], const pg8::Unit& u, int wr, int wc, int fr, int fq) const {
        const int fro = opaque(fr), fqo = opaque(fq);
#pragma unroll
        for (int ai = 0; ai < 2; ++ai)
#pragma unroll
            for (int m = 0; m < 4; ++m) { bf16* rowp = proj + (size_t)(u.pm * 256 + ai * 128 + wr * 64 + m * 16 + fro) * NPROJ + u.pn * 256 + wc * 32 + 8 * fqo;
#pragma unroll
                for (int bj = 0; bj < 2; ++bj) { const f32x4 v0 = acc[ai][bj][m][0], v1 = acc[ai][bj][m][1];
                    u32x4 w; w.x = pk2(v0[0], v0[1]); w.y = pk2(v0[2], v0[3]); w.z = pk2(v1[0], v1[1]); w.w = pk2(v1[2], v1[3]); *(u32x4*)(rowp + bj * 128) = w; } }
    } };
struct EpiMixed { static constexpr bool PERM = true, MID = true; const bf16* proj; bf16* mixed;
    __device__ __forceinline__ void mid(f32x4 (&acc)[2][2][4][2], const pg8::Unit& u, int wr, int wc, int fr, int fq) const {
        const int fro = opaque(fr), fqo = opaque(fq);
#pragma unroll
        for (int ai = 0; ai < 2; ++ai)
#pragma unroll
            for (int m = 0; m < 4; ++m) { const bf16* zr = proj + (size_t)(u.pm * 256 + ai * 128 + wr * 64 + m * 16 + fro) * NPROJ + u.pn * 256 + wc * 32 + 8 * fqo;
#pragma unroll
                for (int bj = 0; bj < 2; ++bj) { const u32x4 za = *(const u32x4*)(zr + C_ZA + bj * 128), zb = *(const u32x4*)(zr + C_ZB + bj * 128);
                    f32x4 r0, r1;
                    r0[0] = (1.f + __expf(-bflo(zb.x))) * __builtin_amdgcn_rcpf(1.f + __expf(-bflo(za.x))); r0[1] = (1.f + __expf(-bfhi(zb.x))) * __builtin_amdgcn_rcpf(1.f + __expf(-bfhi(za.x)));
                    r0[2] = (1.f + __expf(-bflo(zb.y))) * __builtin_amdgcn_rcpf(1.f + __expf(-bflo(za.y))); r0[3] = (1.f + __expf(-bfhi(zb.y))) * __builtin_amdgcn_rcpf(1.f + __expf(-bfhi(za.y)));
                    r1[0] = (1.f + __expf(-bflo(zb.z))) * __builtin_amdgcn_rcpf(1.f + __expf(-bflo(za.z))); r1[1] = (1.f + __expf(-bfhi(zb.z))) * __builtin_amdgcn_rcpf(1.f + __expf(-bfhi(za.z)));
                    r1[2] = (1.f + __expf(-bflo(zb.w))) * __builtin_amdgcn_rcpf(1.f + __expf(-bflo(za.w))); r1[3] = (1.f + __expf(-bfhi(zb.w))) * __builtin_amdgcn_rcpf(1.f + __expf(-bfhi(za.w)));
                    acc[ai][bj][m][0] = acc[ai][bj][m][0] * r0; acc[ai][bj][m][1] = acc[ai][bj][m][1] * r1; }
                asm volatile("" ::: "memory"); }
    }
    __device__ __forceinline__ void operator()(const f32x4 (&acc)[2][2][4][2], const pg8::Unit& u, int wr, int wc, int fr, int fq) const {
        const int fro = opaque(fr), fqo = opaque(fq);
#pragma unroll
        for (int ai = 0; ai < 2; ++ai)
#pragma unroll
            for (int m = 0; m < 4; ++m) { const size_t row = (size_t)(u.pm * 256 + ai * 128 + wr * 64 + m * 16 + fro); const int col = u.pn * 256 + wc * 32 + 8 * fqo;
#pragma unroll
                for (int bj = 0; bj < 2; ++bj) { const u32x4 zb = *(const u32x4*)(proj + row * NPROJ + C_ZB + col + bj * 128); const f32x4 v0 = acc[ai][bj][m][0], v1 = acc[ai][bj][m][1];
                    u32x4 w; w.x = pk2(v0[0] * sigmoidf_(bflo(zb.x)), v0[1] * sigmoidf_(bfhi(zb.x))); w.y = pk2(v0[2] * sigmoidf_(bflo(zb.y)), v0[3] * sigmoidf_(bfhi(zb.y)));
                    w.z = pk2(v1[0] * sigmoidf_(bflo(zb.z)), v1[1] * sigmoidf_(bfhi(zb.z))); w.w = pk2(v1[2] * sigmoidf_(bflo(zb.w)), v1[3] * sigmoidf_(bfhi(zb.w)));
                    *(u32x4*)(mixed + row * 1024 + col + bj * 128) = w; }
                asm volatile("" ::: "memory"); }
    } };
struct EpiX1 { static constexpr bool PERM = false, MID = false; const float* x; const float* w2; float* out; bf16* hn; float* ssq;
    __device__ __forceinline__ void operator()(const f32x4 (&acc)[2][2][4][2], const pg8::Unit& u, int wr, int wc, int fr, int fq) const {
        const int fro = opaque(fr), fqo = opaque(fq);
#pragma unroll
        for (int ai = 0; ai < 2; ++ai)
#pragma unroll
            for (int m = 0; m < 4; ++m) { const size_t row = (size_t)(u.pm * 256 + ai * 128 + wr * 64 + m * 16 + fro); float s = 0.f;
#pragma unroll
                for (int bj = 0; bj < 2; ++bj)
#pragma unroll
                    for (int n = 0; n < 2; ++n) { const int col = u.pn * 256 + bj * 128 + wc * 32 + n * 16 + 4 * fqo;
                        const f32x4 xv = *(const f32x4*)(x + row * 1024 + col); const f32x4 wv = *(const f32x4*)(w2 + col);
                        const f32x4 v = acc[ai][bj][m][n] + xv;
                        *(f32x4*)(out + row * 1024 + col) = v;
                        s += (v[0] * v[0] + v[1] * v[1]) + (v[2] * v[2] + v[3] * v[3]);
                        u32x2 o; o.x = pk2(v[0] * wv[0], v[1] * wv[1]); o.y = pk2(v[2] * wv[2], v[3] * wv[3]); *(u32x2*)(hn + row * 1024 + col) = o; }
                s += __shfl_xor(s, 16); s += __shfl_xor(s, 32);
                if (fq == 0) ssq[row * 16 + u.pn * 4 + wc] = s;
                asm volatile("" ::: "memory"); }
    } };
struct EpiGateUp { static constexpr bool PERM = true, MID = false; const int* list; const float* rstdv; bf16* hb;
    __device__ __forceinline__ void operator()(const f32x4 (&acc)[2][2][4][2], const pg8::Unit& u, int wr, int wc, int fr, int fq) const {
        const int fro = opaque(fr), fqo = opaque(fq);
#pragma unroll
        for (int ai = 0; ai < 2; ++ai)
#pragma unroll
            for (int m = 0; m < 4; ++m) { const int r = ai * 128 + wr * 64 + m * 16 + fro; int idx = u.i0 + r; idx = idx < u.cn ? idx : u.cn - 1;
                const float rs = rstdv[list[(size_t)u.l * T + idx]];
                u32x4 w;
                { const f32x4 g = acc[ai][0][m][0] * rs, uu = acc[ai][1][m][0] * rs;
                  w.x = pk2(g[0] * sigmoidf_(g[0]) * uu[0], g[1] * sigmoidf_(g[1]) * uu[1]); w.y = pk2(g[2] * sigmoidf_(g[2]) * uu[2], g[3] * sigmoidf_(g[3]) * uu[3]); }
                { const f32x4 g = acc[ai][0][m][1] * rs, uu = acc[ai][1][m][1] * rs;
                  w.z = pk2(g[0] * sigmoidf_(g[0]) * uu[0], g[1] * sigmoidf_(g[1]) * uu[1]); w.w = pk2(g[2] * sigmoidf_(g[2]) * uu[2], g[3] * sigmoidf_(g[3]) * uu[3]); }
                *(u32x4*)(hb + ((size_t)u.pm * 256 + r) * 512 + u.pn * 128 + wc * 32 + 8 * fqo) = w;
                asm volatile("" ::: "memory"); }
    } };
struct EpiDown { static constexpr bool PERM = false, MID = false; const int* list; const float* gw; float* out; float osc;
    __device__ __forceinline__ void operator()(const f32x4 (&acc)[2][2][4][2], const pg8::Unit& u, int wr, int wc, int fr, int fq) const {
        const int fro = opaque(fr), fqo = opaque(fq); const int slot = u.l >> 5;
#pragma unroll
        for (int ai = 0; ai < 2; ++ai)
#pragma unroll
            for (int m = 0; m < 4; ++m) { const int r = ai * 128 + wr * 64 + m * 16 + fro; const int idx = u.i0 + r;
                if (idx < u.cn) { const int tok = list[(size_t)u.l * T + idx]; const float g = gw[tok * 2 + slot] * osc;
#pragma unroll
                    for (int bj = 0; bj < 2; ++bj)
#pragma unroll
                        for (int n = 0; n < 2; ++n) { float* op = out + (size_t)tok * 1024 + u.pn * 256 + bj * 128 + wc * 32 + n * 16 + 4 * fqo;
                            const f32x4 old = *(const f32x4*)op; *(f32x4*)op = old + acc[ai][bj][m][n] * g; } }
                asm volatile("" ::: "memory"); }
    } };

__device__ __forceinline__ void transpose_item(const float* W, int N, bf16* WT, int ldwt, int kd0, int k0, int n0, int drow0, LAS float* scr, int lane) {
#pragma unroll 8
    for (int i = 0; i < 32; ++i) { const int kk = 2 * i + (lane >> 5); scr[kk * 33 + (lane & 31)] = W[(size_t)(k0 + kk) * N + n0 + (lane & 31)]; }
    asm volatile("s_waitcnt lgkmcnt(0)" ::: "memory");
    const int c = lane & 7;
#pragma unroll
    for (int j = 0; j < 4; ++j) { const int n = (lane >> 3) + 8 * j; const LAS float* s = scr + (8 * c) * 33 + n;
        u32x4 o; o.x = pk2(s[0 * 33], s[1 * 33]); o.y = pk2(s[2 * 33], s[3 * 33]); o.z = pk2(s[4 * 33], s[5 * 33]); o.w = pk2(s[6 * 33], s[7 * 33]);
        *(u32x4*)(WT + (size_t)(drow0 + n) * ldwt + kd0 + k0 + 8 * c) = o; }
    asm volatile("s_waitcnt lgkmcnt(0)" ::: "memory");
}

__device__ __forceinline__ void phase0(const Params& P, LAS unsigned char* lds, int vcu, int G, int tid, int wid, int lane) {
    unsigned char* ws = P.ws;
    LAS float* scr = (LAS float*)(lds + wid * 16384);
    const int gw = vcu * 8 + wid, NGW = G * 8;
    constexpr int I_IN = 16 * 152, I_BR = 8 * 32, I_OUT = 16 * 32, I_G = 16 * 16, I_D = 8 * 32;
    constexpr int NITEMS = I_IN + 2 * I_BR + I_OUT + NEXP * (2 * I_G + I_D);
    for (int it = gw; it < NITEMS; it += NGW) {
        int r = it;
        if (r < I_IN) { const int kb = r / 152, nb = r % 152; transpose_item(P.w_in, NPROJ, (bf16*)(ws + WS_WINT), 1024, 0, 64 * kb, 32 * nb, 32 * nb, scr, lane); continue; } r -= I_IN;
        if (r < I_BR) { const int kb = r / 32, nb = r % 32; transpose_item(P.w_ba, 1024, (bf16*)(ws + WS_WAT), 1024, 0, 64 * kb, 32 * nb, 32 * nb, scr, lane); continue; } r -= I_BR;
        if (r < I_BR) { const int kb = r / 32, nb = r % 32; transpose_item(P.w_bh, 1024, (bf16*)(ws + WS_WAT), 1024, 512, 64 * kb, 32 * nb, 32 * nb, scr, lane); continue; } r -= I_BR;
        if (r < I_OUT) { const int kb = r / 32, nb = r % 32; transpose_item(P.w_out, 1024, (bf16*)(ws + WS_WOT), 1024, 0, 64 * kb, 32 * nb, 32 * nb, scr, lane); continue; } r -= I_OUT;
        const int e = r / (2 * I_G + I_D); r -= e * (2 * I_G + I_D);
        if (r < I_G) { const int kb = r / 16, nb = r % 16; const int n0 = 32 * nb; transpose_item(P.w_gate + (size_t)e * 1024 * 512, 512, (bf16*)(ws + WS_WGU) + (size_t)e * 1024 * 1024, 1024, 0, 64 * kb, n0, (n0 >> 7) * 256 + (n0 & 127), scr, lane); continue; } r -= I_G;
        if (r < I_G) { const int kb = r / 16, nb = r % 16; const int n0 = 32 * nb; transpose_item(P.w_up + (size_t)e * 1024 * 512, 512, (bf16*)(ws + WS_WGU) + (size_t)e * 1024 * 1024, 1024, 0, 64 * kb, n0, (n0 >> 7) * 256 + 128 + (n0 & 127), scr, lane); continue; } r -= I_G;
        { const int kb = r / 32, nb = r % 32; transpose_item(P.w_down + (size_t)e * 512 * 1024, 1024, (bf16*)(ws + WS_WD) + (size_t)e * 1024 * 512, 512, 0, 64 * kb, 32 * nb, 32 * nb, scr, lane); }
    }
    { float* Wr = (float*)(ws + WS_WR);
      for (int idx = (vcu * NTHREADS + tid); idx < 48 * 1024; idx += G * NTHREADS) { const int j = idx >> 10, k = idx & 1023; float v = 0.f;
          if (j < 4) v = P.w_rg[k * 4 + j] * P.norm2_w[k]; else if (j < 36) v = P.w_re[k * 32 + (j - 4)] * P.norm2_w[k];
          Wr[idx] = v; } }
    { bf16* xn = (bf16*)P.out;
      f32x4 wv[4];
#pragma unroll
      for (int j = 0; j < 4; ++j) wv[j] = *(const f32x4*)(P.norm1_w + 4 * lane + 256 * j);
      for (int m = gw; m < T; m += NGW) {
          const f32x4* xr = (const f32x4*)(P.x + (size_t)m * D) + lane; f32x4 v[4]; float s = 0.f;
#pragma unroll
          for (int j = 0; j < 4; ++j) { v[j] = xr[64 * j]; s += (v[j].x * v[j].x + v[j].y * v[j].y) + (v[j].z * v[j].z + v[j].w * v[j].w); }
          const float rstd = 1.f / sqrtf(wave_sum(s) * (1.f / D) + EPS);
          u32x2* o8 = (u32x2*)(xn + (size_t)m * D) + lane;
#pragma unroll
          for (int j = 0; j < 4; ++j) { u32x2 o; o.x = pk2(v[j].x * rstd * wv[j].x, v[j].y * rstd * wv[j].y); o.y = pk2(v[j].z * rstd * wv[j].z, v[j].w * rstd * wv[j].w); o8[64 * j] = o; }
      } }
}

__device__ __forceinline__ void phase1(const Params& P, LAS unsigned char* lds, int G) {
    const pg8::DenseSched S{(const char*)P.out, (const char*)(P.ws + WS_WINT), 1024, T / 256, NPROJ / 256, G, (int)blockIdx.x};
    const EpiProj E{(bf16*)(P.ws + WS_PROJ)};
    pg8::gemm_phase(lds, S, E);
}
__device__ __forceinline__ void phase5(const Params& P, LAS unsigned char* lds, int G) {
    const pg8::DenseSched S{(const char*)P.out + OUT_AH, (const char*)(P.ws + WS_WAT), 1024, T / 256, 4, G, (int)blockIdx.x};
    const EpiMixed E{(const bf16*)(P.ws + WS_PROJ), (bf16*)(P.ws + WS_MIXED)};
    pg8::gemm_phase(lds, S, E);
}
__device__ __forceinline__ void phase6(const Params& P, LAS unsigned char* lds, int G) {
    const pg8::DenseSched S{(const char*)(P.ws + WS_MIXED), (const char*)(P.ws + WS_WOT), 1024, T / 256, 4, G, (int)blockIdx.x};
    const EpiX1 E{P.x, P.norm2_w, P.out, (bf16*)(P.ws + WS_HN), (float*)(P.ws + WS_SSQ)};
    pg8::gemm_phase(lds, S, E);
}

constexpr int H_TOT = 0, H_DV = 2048, H_SSQ = 2560, H_QT = 4608, H_KH = H_QT + 17408, H_KTT = H_KH + 17408, H_VT = H_KTT + 18432, H_ST = H_VT + 18432, H_AM = H_ST + 34816, H_END = H_AM + 9216;
static_assert(H_END <= LDS_ST_OFF, "hgrn LDS");
__device__ __forceinline__ bf16x8 ldfrag(const LAS unsigned char* base, int row, int stride, int kbyte) { return *(const LAS bf16x8*)(base + row * stride + kbyte); }

template <int MODE>
__device__ __forceinline__ void hgrn_unit(const Params& P, LAS unsigned char* lds, int unit, int tid, int wid, int lane) {
    const int b = unit >> 6, h = (unit >> 4) & 3, sc = unit & 15;
    const int fr = opaque(lane & 15), fq = opaque(lane >> 4), c = opaque(tid & 127), qd = tid >> 7;
    const bf16* proj = (const bf16*)(P.ws + WS_PROJ);
    LAS float* TOT = (LAS float*)(lds + H_TOT); LAS float* DV = (LAS float*)(lds + H_DV); LAS float* SSQ = (LAS float*)(lds + H_SSQ);
    LAS bf16* Qt = (LAS bf16*)(lds + H_QT); LAS bf16* Kh = (LAS bf16*)(lds + H_KH); LAS bf16* KtT = (LAS bf16*)(lds + H_KTT); LAS bf16* VT = (LAS bf16*)(lds + H_VT);
    const float lbv = 1.f / (1.f + __expf(P.hlb[512 + h * 128 + c] - P.hlb[h * 128 + c]));
    float* Ug = (float*)((unsigned char*)P.out + OUT_U) + (size_t)unit * 16384;
    const float* Sin = (const float*)((unsigned char*)P.out + OUT_SIN) + (size_t)unit * 16384;
    f32x4 accS[8];
#pragma unroll
    for (int di = 0; di < 8; ++di) {
        if (MODE == 1 && sc > 0) {
#pragma unroll
            for (int r = 0; r < 4; ++r) accS[di][r] = Sin[(16 * di + 4 * fq + r) * 128 + 16 * wid + fr];
        } else accS[di] = (f32x4){0.f, 0.f, 0.f, 0.f};
        if (MODE == 1) { u32x2 o; o.x = pk2(accS[di][0], accS[di][1]); o.y = pk2(accS[di][2], accS[di][3]);
            *(LAS u32x2*)(lds + H_ST + (16 * wid + fr) * 272 + (16 * di + 4 * fq) * 2) = o; }
    }
    float dsum = 0.f;
#pragma unroll 1
    for (int cc = 0; cc < 8; ++cc) {
        const size_t t0 = (size_t)b * SEQ + sc * 512 + cc * 64;
        const bf16* pbase = proj + (t0 + qd * 16) * NPROJ + h * 128 + c;
        float bpart[16], kk[16]; float run = 0.f;
#pragma unroll
        for (int i = 0; i < 16; ++i) { const float f = bf2f(pbase[(size_t)i * NPROJ + C_FH]);
            const float kv = (1.f - lbv) / (1.f + __expf(f));
            kk[i] = kv; run += __logf(1.f - kv); bpart[i] = run; }
        TOT[qd * 128 + c] = run;
        __syncthreads();
        float offs = 0.f, blast = 0.f;
#pragma unroll
        for (int q = 0; q < 4; ++q) { const float tv = TOT[q * 128 + c]; blast += tv; if (q < qd) offs += tv; }
        if (qd == 0) { DV[c] = __expf(blast); dsum += blast; }
#pragma unroll
        for (int i = 0; i < 16; ++i) { const int t = qd * 16 + i; const float bb = bpart[i] + offs;
            if (MODE == 1) { const float q = bf2f(pbase[(size_t)i * NPROJ + C_QH]); const float qs = q / (1.f + __expf(-q));
                Qt[t * 136 + c] = (bf16)f2bf(qs * __expf(bb)); Kh[t * 136 + c] = (bf16)f2bf(kk[i] * __expf(fminf(-bb, 80.f))); }
            KtT[c * 72 + t] = (bf16)f2bf(kk[i] * __expf(blast - bb));
            VT[c * 72 + t] = pbase[(size_t)i * NPROJ + C_IH];
            if ((i & 3) == 3) asm volatile("" ::: "memory"); }
        __syncthreads();
        f32x4 acco[4];
        if (MODE == 1) {
#pragma unroll
            for (int e2 = 0; e2 < 2; ++e2) { const int idx = 2 * wid + e2, mi = idx >> 2, ni = idx & 3; f32x4 a = (f32x4){0.f, 0.f, 0.f, 0.f};
                if (ni <= mi) {
#pragma unroll
                    for (int ks = 0; ks < 4; ++ks) { const bf16x8 kf = ldfrag(lds + H_KH, 16 * ni + fr, 272, (ks * 32 + fq * 8) * 2), qf = ldfrag(lds + H_QT, 16 * mi + fr, 272, (ks * 32 + fq * 8) * 2);
                        a = __builtin_amdgcn_mfma_f32_16x16x32_bf16(kf, qf, a, 0, 0, 0); } }
                const int t = 16 * mi + fr, s0 = 16 * ni + 4 * fq;
#pragma unroll
                for (int r = 0; r < 4; ++r) if (s0 + r > t || ni > mi) a[r] = 0.f;
                u32x2 o; o.x = pk2(a[0], a[1]); o.y = pk2(a[2], a[3]); *(LAS u32x2*)(lds + H_AM + t * 144 + s0 * 2) = o; }
#pragma unroll
            for (int mi = 0; mi < 4; ++mi) { acco[mi] = (f32x4){0.f, 0.f, 0.f, 0.f};
#pragma unroll
                for (int ks = 0; ks < 4; ++ks) { const bf16x8 sf = ldfrag(lds + H_ST, 16 * wid + fr, 272, (ks * 32 + fq * 8) * 2), qf = ldfrag(lds + H_QT, 16 * mi + fr, 272, (ks * 32 + fq * 8) * 2);
                    acco[mi] = __builtin_amdgcn_mfma_f32_16x16x32_bf16(sf, qf, acco[mi], 0, 0, 0); } }
        }
#pragma unroll
        for (int di = 0; di < 8; ++di) { const f32x4 dv4 = *(const LAS f32x4*)(lds + H_DV + (16 * di + 4 * fq) * 4); accS[di] = accS[di] * dv4;
#pragma unroll
            for (int ks = 0; ks < 2; ++ks) { const bf16x8 kf = ldfrag(lds + H_KTT, 16 * di + fr, 144, (ks * 32 + fq * 8) * 2), vf = ldfrag(lds + H_VT, 16 * wid + fr, 144, (ks * 32 + fq * 8) * 2);
                accS[di] = __builtin_amdgcn_mfma_f32_16x16x32_bf16(kf, vf, accS[di], 0, 0, 0); }
            if (MODE == 1) { u32x2 o; o.x = pk2(accS[di][0], accS[di][1]); o.y = pk2(accS[di][2], accS[di][3]);
                *(LAS u32x2*)(lds + H_ST + (16 * wid + fr) * 272 + (16 * di + 4 * fq) * 2) = o; } }
        if (MODE == 1) {
            __syncthreads();
#pragma unroll
            for (int mi = 0; mi < 4; ++mi) {
#pragma unroll
                for (int ks = 0; ks < 2; ++ks) { const bf16x8 vf = ldfrag(lds + H_VT, 16 * wid + fr, 144, (ks * 32 + fq * 8) * 2), af = ldfrag(lds + H_AM, 16 * mi + fr, 144, (ks * 32 + fq * 8) * 2);
                    acco[mi] = __builtin_amdgcn_mfma_f32_16x16x32_bf16(vf, af, acco[mi], 0, 0, 0); }
                float s = (acco[mi][0] * acco[mi][0] + acco[mi][1] * acco[mi][1]) + (acco[mi][2] * acco[mi][2] + acco[mi][3] * acco[mi][3]);
                s += __shfl_xor(s, 16); s += __shfl_xor(s, 32);
                if (fq == 0) SSQ[wid * 64 + 16 * mi + fr] = s; }
            __syncthreads();
            bf16* hg = (bf16*)((unsigned char*)P.out + OUT_AH);
            const f32x4 nw = *(const f32x4*)(P.hnw + 16 * wid + 4 * fq);
#pragma unroll
            for (int mi = 0; mi < 4; ++mi) { const int t = 16 * mi + fr; float tot = 0.f;
#pragma unroll
                for (int w = 0; w < 8; ++w) tot += SSQ[w * 64 + t];
                const float rstd = 1.f / sqrtf(tot * (1.f / 128.f) + EPS);
                const u32x2 gg = *(const u32x2*)(proj + (t0 + t) * NPROJ + C_GH + h * 128 + 16 * wid + 4 * fq);
                const float g0 = bflo(gg.x), g1 = bfhi(gg.x), g2 = bflo(gg.y), g3 = bfhi(gg.y);
                u32x2 o; o.x = pk2(acco[mi][0] * rstd * nw[0] * (g0 / (1.f + __expf(-g0))), acco[mi][1] * rstd * nw[1] * (g1 / (1.f + __expf(-g1))));
                o.y = pk2(acco[mi][2] * rstd * nw[2] * (g2 / (1.f + __expf(-g2))), acco[mi][3] * rstd * nw[3] * (g3 / (1.f + __expf(-g3))));
                *(u32x2*)(hg + (t0 + t) * 1024 + 512 + h * 128 + 16 * wid + 4 * fq) = o; }
        }
    }
    if (MODE == 0) {
#pragma unroll
        for (int di = 0; di < 8; ++di)
#pragma unroll
            for (int r = 0; r < 4; ++r) Ug[(16 * di + 4 * fq + r) * 128 + 16 * wid + fr] = accS[di][r];
        if (qd == 0) ((float*)((unsigned char*)P.out + OUT_DSC))[unit * 128 + c] = __expf(dsum);
    }
    __syncthreads();
}

__device__ __forceinline__ void hgrn_scan(const Params& P, int G, int tid) {
    const float* U = (const float*)((unsigned char*)P.out + OUT_U); float* Sin = (float*)((unsigned char*)P.out + OUT_SIN);
    const float* Dsc = (const float*)((unsigned char*)P.out + OUT_DSC);
    for (int idx = blockIdx.x * NTHREADS + tid; idx < 16 * 16384; idx += G * NTHREADS) {
        const int p = idx >> 14, e = idx & 16383, dk = e >> 7; float S = 0.f;
        for (int sc = 0; sc < 15; ++sc) { const int u = p * 16 + sc; S = Dsc[u * 128 + dk] * S + U[(size_t)u * 16384 + e]; Sin[(size_t)(u + 1) * 16384 + e] = S; }
    }
}

constexpr int A_KT = 0, A_VT = 36864, A_QS = 70656, A_END = A_QS + 73728;
static_assert(A_END <= LDS_ST_OFF, "attn LDS");
__device__ __forceinline__ void rope16(float (&v)[32], float posf) {
    const float invf[8] = {1.0f, 0.1939227432012558f, 0.03760603070259094f, 0.007292664609849453f, 0.0014142135623842478f, 0.00027424818836152554f, 5.318296098266728e-05f, 1.0313386155758053e-05f};
#pragma unroll
    for (int i = 0; i < 8; ++i) { float sn, cs; sincosf(posf * invf[i], &sn, &cs); const float x1 = v[i], x2 = v[i + 8]; v[i] = x1 * cs - x2 * sn; v[i + 8] = x2 * cs + x1 * sn; }
}
__device__ __forceinline__ void attn_unit(const Params& P, LAS unsigned char* lds, int unit, int tid, int wid, int lane) {
    const int hk = unit & 1, nb = (unit >> 1) & 63, b = unit >> 7;
    const int fr = lane & 15, fq = lane >> 4;
    const bf16* proj = (const bf16*)(P.ws + WS_PROJ);
    { const int key = tid >> 1, half = tid & 1; const int srel = nb * 128 - 128 + key;
      const bool ok = srel >= 0; const size_t tok = (size_t)b * SEQ + (ok ? srel : 0);
      float v[32];
      { const u32x4* src = (const u32x4*)(proj + tok * NPROJ + C_KA + hk * 64 + half * 32);
#pragma unroll
        for (int j = 0; j < 4; ++j) { const u32x4 w = src[j]; v[8 * j + 0] = bflo(w.x); v[8 * j + 1] = bfhi(w.x); v[8 * j + 2] = bflo(w.y); v[8 * j + 3] = bfhi(w.y); v[8 * j + 4] = bflo(w.z); v[8 * j + 5] = bfhi(w.z); v[8 * j + 6] = bflo(w.w); v[8 * j + 7] = bfhi(w.w); } }
      float s = 0.f;
#pragma unroll
      for (int j = 0; j < 32; ++j) s += v[j] * v[j];
      s += __shfl_xor(s, 1);
      const float rstd = 1.f / sqrtf(s * (1.f / 64.f) + EPS);
#pragma unroll
      for (int j = 0; j < 32; ++j) v[j] = v[j] * rstd * P.k_norm_w[half * 32 + j];
      if (half == 0) rope16(v, (float)P.positions[tok]);
#pragma unroll
      for (int j = 0; j < 4; ++j) { u32x4 o; o.x = pk2(v[8 * j], v[8 * j + 1]); o.y = pk2(v[8 * j + 2], v[8 * j + 3]); o.z = pk2(v[8 * j + 4], v[8 * j + 5]); o.w = pk2(v[8 * j + 6], v[8 * j + 7]);
          if (!ok) o = (u32x4){0u, 0u, 0u, 0u};
          *(LAS u32x4*)(lds + A_KT + key * 144 + half * 64 + j * 16) = o; }
      const u32x4* vs = (const u32x4*)(proj + tok * NPROJ + C_VA + hk * 64 + half * 32);
#pragma unroll
      for (int j = 0; j < 4; ++j) { u32x4 w = vs[j]; if (!ok) w = (u32x4){0u, 0u, 0u, 0u};
          LAS bf16* dst = (LAS bf16*)(lds + A_VT) + (half * 32 + 8 * j) * 264 + key;
          dst[0 * 264] = (bf16)(w.x & 0xffffu); dst[1 * 264] = (bf16)(w.x >> 16); dst[2 * 264] = (bf16)(w.y & 0xffffu); dst[3 * 264] = (bf16)(w.y >> 16);
          dst[4 * 264] = (bf16)(w.z & 0xffffu); dst[5 * 264] = (bf16)(w.z >> 16); dst[6 * 264] = (bf16)(w.w & 0xffffu); dst[7 * 264] = (bf16)(w.w >> 16); } }
    { const int g = tid >> 7, ql = tid & 127; const size_t tok = (size_t)b * SEQ + nb * 128 + ql;
      const u32x4* src = (const u32x4*)(proj + tok * NPROJ + C_QA + (hk * 4 + g) * 64);
      float s = 0.f;
#pragma unroll
      for (int j = 0; j < 8; ++j) { const u32x4 w = src[j]; const float a0 = bflo(w.x), a1 = bfhi(w.x), a2 = bflo(w.y), a3 = bfhi(w.y), a4 = bflo(w.z), a5 = bfhi(w.z), a6 = bflo(w.w), a7 = bfhi(w.w);
          s += (a0 * a0 + a1 * a1) + (a2 * a2 + a3 * a3) + (a4 * a4 + a5 * a5) + (a6 * a6 + a7 * a7); }
      const float rstd = 0.125f / sqrtf(s * (1.f / 64.f) + EPS);
      const float posf = (float)P.positions[tok];
#pragma unroll
      for (int half = 0; half < 2; ++half) { float v[32];
#pragma unroll
          for (int j = 0; j < 4; ++j) { const u32x4 w = src[half * 4 + j]; v[8 * j + 0] = bflo(w.x); v[8 * j + 1] = bfhi(w.x); v[8 * j + 2] = bflo(w.y); v[8 * j + 3] = bfhi(w.y); v[8 * j + 4] = bflo(w.z); v[8 * j + 5] = bfhi(w.z); v[8 * j + 6] = bflo(w.w); v[8 * j + 7] = bfhi(w.w); }
#pragma unroll
          for (int j = 0; j < 32; ++j) v[j] = v[j] * rstd * P.q_norm_w[half * 32 + j];
          if (half == 0) rope16(v, posf);
#pragma unroll
          for (int j = 0; j < 4; ++j) { u32x4 o; o.x = pk2(v[8 * j], v[8 * j + 1]); o.y = pk2(v[8 * j + 2], v[8 * j + 3]); o.z = pk2(v[8 * j + 4], v[8 * j + 5]); o.w = pk2(v[8 * j + 6], v[8 * j + 7]);
              *(LAS u32x4*)(lds + A_QS + tid * 144 + half * 64 + j * 16) = o; } } }
    __syncthreads();
    { const int g = wid >> 1; const float sink = P.sinks[hk * 4 + g];
      bf16* attn = (bf16*)((unsigned char*)P.out + OUT_AH);
#pragma unroll 1
      for (int p = 0; p < 2; ++p) { const int q0 = (wid & 1) * 64 + p * 32;
          f32x4 sT[10][2];
          bf16x8 qf[2][2];
#pragma unroll
          for (int nq = 0; nq < 2; ++nq)
#pragma unroll
              for (int ks = 0; ks < 2; ++ks) qf[nq][ks] = ldfrag(lds + A_QS, g * 128 + q0 + 16 * nq + fr, 144, (ks * 32 + fq * 8) * 2);
#pragma unroll
          for (int kt = 0; kt < 10; ++kt) {
#pragma unroll
              for (int nq = 0; nq < 2; ++nq) sT[kt][nq] = (f32x4){0.f, 0.f, 0.f, 0.f};
#pragma unroll
              for (int ks = 0; ks < 2; ++ks) { const bf16x8 kf = ldfrag(lds + A_KT, q0 + 16 * kt + fr, 144, (ks * 32 + fq * 8) * 2);
#pragma unroll
                  for (int nq = 0; nq < 2; ++nq) sT[kt][nq] = __builtin_amdgcn_mfma_f32_16x16x32_bf16(kf, qf[nq][ks], sT[kt][nq], 0, 0, 0); } }
          float linv[2];
#pragma unroll
          for (int nq = 0; nq < 2; ++nq) { const int ql = q0 + 16 * nq + fr; float mx = sink;
#pragma unroll
              for (int kt = 0; kt < 10; ++kt)
#pragma unroll
                  for (int r = 0; r < 4; ++r) { const int kj = q0 + 16 * kt + 4 * fq + r; const bool valid = (kj > ql) && (kj <= ql + 128) && (nb > 0 || kj >= 128);
                      if (!valid) sT[kt][nq][r] = -1e30f; mx = fmaxf(mx, sT[kt][nq][r]); }
              mx = fmaxf(mx, __shfl_xor(mx, 16)); mx = fmaxf(mx, __shfl_xor(mx, 32));
              float l = 0.f;
#pragma unroll
              for (int kt = 0; kt < 10; ++kt)
#pragma unroll
                  for (int r = 0; r < 4; ++r) { const float pv = (sT[kt][nq][r] > -1e29f) ? __expf(sT[kt][nq][r] - mx) : 0.f; sT[kt][nq][r] = pv; l += pv; }
              l += __shfl_xor(l, 16); l += __shfl_xor(l, 32);
              l += __expf(sink - mx);
              linv[nq] = 1.f / l; }
          f32x4 oT[4][2];
#pragma unroll
          for (int dt = 0; dt < 4; ++dt)
#pragma unroll
              for (int nq = 0; nq < 2; ++nq) oT[dt][nq] = (f32x4){0.f, 0.f, 0.f, 0.f};
#pragma unroll
          for (int j = 0; j < 5; ++j) { bf16x8 pf[2];
#pragma unroll
              for (int nq = 0; nq < 2; ++nq) { u32x4 w; w.x = pk2(sT[2 * j][nq][0], sT[2 * j][nq][1]); w.y = pk2(sT[2 * j][nq][2], sT[2 * j][nq][3]); w.z = pk2(sT[2 * j + 1][nq][0], sT[2 * j + 1][nq][1]); w.w = pk2(sT[2 * j + 1][nq][2], sT[2 * j + 1][nq][3]);
                  pf[nq] = __builtin_bit_cast(bf16x8, w); }
#pragma unroll
              for (int dt = 0; dt < 4; ++dt) { const LAS unsigned char* vrow = lds + A_VT + (16 * dt + fr) * 528 + (q0 + 32 * j + 4 * fq) * 2;
                  const u32x2 lo = *(const LAS u32x2*)vrow, hi = *(const LAS u32x2*)(vrow + 32);
                  u32x4 w; w.x = lo.x; w.y = lo.y; w.z = hi.x; w.w = hi.y; const bf16x8 vf = __builtin_bit_cast(bf16x8, w);
#pragma unroll
                  for (int nq = 0; nq < 2; ++nq) oT[dt][nq] = __builtin_amdgcn_mfma_f32_16x16x32_bf16(vf, pf[nq], oT[dt][nq], 0, 0, 0); } }
#pragma unroll
          for (int nq = 0; nq < 2; ++nq) { const size_t tok = (size_t)b * SEQ + nb * 128 + q0 + 16 * nq + fr;
#pragma unroll
              for (int dt = 0; dt < 4; ++dt) { const f32x4 v = oT[dt][nq] * linv[nq]; u32x2 o; o.x = pk2(v[0], v[1]); o.y = pk2(v[2], v[3]);
                  *(u32x2*)(attn + tok * 1024 + (hk * 4 + g) * 64 + 16 * dt + 4 * fq) = o; } }
      } }
    __syncthreads();
}

__device__ __forceinline__ void phase7(const Params& P, LAS unsigned char* lds, int vcu, int G, int tid, int wid, int lane, bool commit = true) {
    const float* Wr = (const float*)(P.ws + WS_WR); const float* ssq = (const float*)(P.ws + WS_SSQ);
    unsigned* cnt = (unsigned*)(P.ws + WS_CTL + CTL_CNT); int* list = (int*)(P.ws + WS_LIST); float* gw = (float*)(P.ws + WS_GW); float* rstdv = (float*)(P.ws + WS_RSTD);
    const int fr = lane & 15, fq = lane >> 4;
    LAS float* LG = (LAS float*)(lds + wid * 3072);
    for (int base = vcu * 8; base < T / 16; base += G * 8) {
        const int rg = base + wid; const int R0 = rg * 16;
        f32x4 acc[3];
#pragma unroll
        for (int nt = 0; nt < 3; ++nt) acc[nt] = (f32x4){0.f, 0.f, 0.f, 0.f};
        const float* xr = P.out + (size_t)(R0 + fr) * 1024 + 4 * fq;
        const float* w0 = Wr + (size_t)fr * 1024 + 4 * fq;
#pragma unroll 4
        for (int s = 0; s < 64; ++s) { const f32x4 xa = *(const f32x4*)(xr + 16 * s); f32x4 wb[3];
#pragma unroll
            for (int nt = 0; nt < 3; ++nt) wb[nt] = *(const f32x4*)(w0 + nt * 16384 + 16 * s);
#pragma unroll
            for (int i = 0; i < 4; ++i)
#pragma unroll
                for (int nt = 0; nt < 3; ++nt) acc[nt] = __builtin_amdgcn_mfma_f32_16x16x4f32(xa[i], wb[nt][i], acc[nt], 0, 0, 0); }
#pragma unroll
        for (int r = 0; r < 4; ++r) { const float* sp = ssq + (size_t)(R0 + 4 * fq + r) * 16; float tot = 0.f;
#pragma unroll
            for (int q = 0; q < 4; ++q) { const f32x4 v = *(const f32x4*)(sp + 4 * q); tot += v[0]; tot += v[1]; tot += v[2]; tot += v[3]; }
            const float rstd = 1.f / sqrtf(tot * (1.f / 1024.f) + EPS);
            if (fr == 0) rstdv[R0 + 4 * fq + r] = rstd;
#pragma unroll
            for (int nt = 0; nt < 3; ++nt) { const int j = 16 * nt + fr; float bias = 0.f; if (j < 4) bias = P.b_rg[j]; else if (j < 36) bias = P.b_re[j - 4];
                LG[(4 * fq + r) * 48 + j] = acc[nt][r] * rstd + bias; } }
        __syncthreads();
        if (lane < 16) { const int tok = R0 + lane; const LAS float* lg = LG + lane * 48;
            int gsel = 0; float best = lg[0];
#pragma unroll
            for (int i = 1; i < 4; ++i) { const float v = lg[i]; if (v > best) { best = v; gsel = i; } }
            float Z = 0.f;
#pragma unroll
            for (int i = 0; i < 4; ++i) Z += __expf(lg[i] - best);
            const float pgsel = 1.f / Z;
            const LAS float* le = lg + 4 + gsel * 8;
            float lmax = le[0];
#pragma unroll
            for (int i = 1; i < 8; ++i) lmax = fmaxf(lmax, le[i]);
            float Zp = 0.f;
#pragma unroll
            for (int i = 0; i < 8; ++i) Zp += __expf(le[i] - lmax);
            int i1 = 0; float p1 = -1.f;
#pragma unroll
            for (int i = 0; i < 8; ++i) { const float pe = __expf(le[i] - lmax) / Zp; if (pe > p1) { p1 = pe; i1 = i; } }
            int i2 = 0; float p2 = -1.f;
#pragma unroll
            for (int i = 0; i < 8; ++i) { const float pe = __expf(le[i] - lmax) / Zp; if (i != i1 && pe > p2) { p2 = pe; i2 = i; } }
            const float den = p1 + p2;
            gw[tok * 2 + 0] = pgsel * p1 / den; gw[tok * 2 + 1] = pgsel * p2 / den;
            const int l0 = gsel * 8 + i1, l1 = 32 + gsel * 8 + i2;
            if (commit) { const unsigned pos0 = atomicAdd(&cnt[l0 * 64], 1u); list[(size_t)l0 * T + pos0] = tok;
            const unsigned pos1 = atomicAdd(&cnt[l1 * 64], 1u); list[(size_t)l1 * T + pos1] = tok; } }
        __syncthreads();
    }
}

constexpr int M_PB = 133120, M_CN = 133632;
__device__ __forceinline__ void moe_prefix(const Params& P, LAS unsigned char* lds, int tid) {
    const unsigned* cnt = (const unsigned*)(P.ws + WS_CTL + CTL_CNT);
    LAS int* PB = (LAS int*)(lds + M_PB); LAS int* CN = (LAS int*)(lds + M_CN);
    if (tid < 64) CN[tid] = (int)cnt[tid * 64];
    __syncthreads();
    if (tid == 0) { int s = 0; for (int l = 0; l < 64; ++l) { PB[l] = s; s += (CN[l] + 255) >> 8; } PB[64] = s; }
    __syncthreads();
}
__device__ __forceinline__ void phase8(const Params& P, LAS unsigned char* lds, int vcu, int G) {
    const LAS int* PB = (const LAS int*)(lds + M_PB); const LAS int* CN = (const LAS int*)(lds + M_CN);
    const pg8::MoeSched<0> S{(const char*)(P.ws + WS_HN), (const char*)(P.ws + WS_WGU), (const int*)(P.ws + WS_LIST), PB, CN, 1024, PB[0], (PB[64] - PB[0]) * 4, vcu, G, 0};
    const EpiGateUp E{(const int*)(P.ws + WS_LIST), (const float*)(P.ws + WS_RSTD), (bf16*)(P.ws + WS_H)};
    pg8::gemm_phase(lds, S, E);
}
__device__ __forceinline__ void phase9(const Params& P, LAS unsigned char* lds, int vcu, int G, int lbeg, float osc) {
    const LAS int* PB = (const LAS int*)(lds + M_PB); const LAS int* CN = (const LAS int*)(lds + M_CN);
    const pg8::MoeSched<1> S{(const char*)(P.ws + WS_H), (const char*)(P.ws + WS_WD), (const int*)(P.ws + WS_LIST), PB, CN, 512, PB[lbeg], (PB[lbeg + 32] - PB[lbeg]) * 4, vcu, G, lbeg};
    const EpiDown E{(const int*)(P.ws + WS_LIST), (const float*)(P.ws + WS_GW), P.out, osc};
    pg8::gemm_phase(lds, S, E);
}

__global__ void __launch_bounds__(NTHREADS, 2) mega_fwd(Params P) {
    extern __shared__ __attribute__((aligned(16))) unsigned char lds_raw[];
    LAS unsigned char* lds = (LAS unsigned char*)lds_raw;
    const int tid = threadIdx.x, lane = tid & 63, wid = __builtin_amdgcn_readfirstlane(tid >> 6);
    const int G = gridDim.x; const int bx = blockIdx.x; const int vcu = (G % 8 == 0) ? (bx % 8) * (G / 8) + bx / 8 : bx;
    volatile LAS unsigned* st = (volatile LAS unsigned*)(lds + LDS_ST_OFF);
    if (tid < 16) st[tid] = 0u;
    __syncthreads();
    unsigned* bar = (unsigned*)(P.ws + WS_CTL);
    const XcdBarrier xb = xcd_barrier_post(bar, st);

#ifndef DUPMASK
#define DUPMASK 0
#endif
#define REP(k) for (int rep_ = 0; rep_ < 1 + ((DUPMASK >> (k)) & 1); ++rep_)
    REP(0) phase0(P, lds, vcu, G, tid, wid, lane);
    xcd_barrier(xb);
    REP(1) phase1(P, lds, G);
    xcd_barrier(xb);
    REP(2) for (int u = bx; u < 256; u += G) if ((u & 15) != 15) hgrn_unit<0>(P, lds, u, tid, wid, lane);
    xcd_barrier(xb);
    REP(3) { hgrn_scan(P, G, tid);
        for (int u = bx; u < 512; u += G) attn_unit(P, lds, u, tid, wid, lane); }
    xcd_barrier(xb);
    REP(4) for (int u = bx; u < 256; u += G) hgrn_unit<1>(P, lds, u, tid, wid, lane);
    xcd_barrier(xb);
    REP(5) phase5(P, lds, G);
    xcd_barrier(xb);
    REP(6) phase6(P, lds, G);
    xcd_barrier(xb);
    if ((DUPMASK >> 7) & 1) phase7(P, lds, vcu, G, tid, wid, lane, false);
    phase7(P, lds, vcu, G, tid, wid, lane);
    xcd_barrier(xb);
    moe_prefix(P, lds, tid);
    REP(8) phase8(P, lds, vcu, G);
    xcd_barrier(xb);
    if ((DUPMASK >> 9) & 1) { phase9(P, lds, vcu, G, 0, 0.5f); xcd_barrier(xb); phase9(P, lds, vcu, G, 0, 0.5f); }
    else phase9(P, lds, vcu, G, 0, 1.f);
    xcd_barrier(xb);
    phase9(P, lds, vcu, G, 32, 1.f);
    if (xb_ld(&bar[XB_TMO]) != 0u && tid == 0) P.out[(size_t)bx * 1024] = __builtin_nanf("");
}

extern "C" void kernel_launch(void* const* d_in, const int* in_sizes, int n_in, void* d_out, int out_size, void* d_ws, size_t ws_size, hipStream_t stream) {
    static int grid = 0;
    if (grid == 0) {
        if (n_in != 20 || out_size != T * D || ws_size < WS_END) { fprintf(stderr, "kernel_launch: unexpected shapes (n_in %d out %d ws %zu, need ws >= %zu)\n", n_in, out_size, ws_size, (size_t)WS_END); grid = -1; return; }
        int dev = 0, cus = 0, per_cu = 0;
        if (hipGetDevice(&dev) != hipSuccess || hipDeviceGetAttribute(&cus, hipDeviceAttributeMultiprocessorCount, dev) != hipSuccess) { grid = -1; return; }
        if (hipFuncSetAttribute((const void*)mega_fwd, hipFuncAttributeMaxDynamicSharedMemorySize, LDS_BYTES) != hipSuccess) { fprintf(stderr, "hipFuncSetAttribute failed\n"); grid = -1; return; }
        if (hipOccupancyMaxActiveBlocksPerMultiprocessor(&per_cu, (const void*)mega_fwd, NTHREADS, LDS_BYTES) != hipSuccess || per_cu < 1) { fprintf(stderr, "occupancy query: %d blocks/CU\n", per_cu); grid = -1; return; }
        grid = cus;
    }
    if (grid < 0) return;
    if (hipMemsetAsync((char*)d_ws + WS_CTL, 0, 1 * MiB, stream) != hipSuccess) return;
    Params p{};
    p.x = (const float*)d_in[0]; p.positions = (const int*)d_in[1]; p.norm1_w = (const float*)d_in[2]; p.w_in = (const float*)d_in[3];
    p.q_norm_w = (const float*)d_in[4]; p.k_norm_w = (const float*)d_in[5]; p.sinks = (const float*)d_in[6]; p.hlb = (const float*)d_in[7];
    p.hnw = (const float*)d_in[8]; p.w_ba = (const float*)d_in[9]; p.w_bh = (const float*)d_in[10]; p.w_out = (const float*)d_in[11];
    p.norm2_w = (const float*)d_in[12]; p.w_rg = (const float*)d_in[13]; p.b_rg = (const float*)d_in[14]; p.w_re = (const float*)d_in[15];
    p.b_re = (const float*)d_in[16]; p.w_gate = (const float*)d_in[17]; p.w_up = (const float*)d_in[18]; p.w_down = (const float*)d_in[19];
    p.out = (float*)d_out; p.ws = (unsigned char*)d_ws;
    void* args[] = {&p};
    const hipError_t e = hipLaunchCooperativeKernel((const void*)mega_fwd, dim3(grid), dim3(NTHREADS), args, LDS_BYTES, stream);
    if (e != hipSuccess) fprintf(stderr, "cooperative launch failed: %s (grid %d)\n", hipGetErrorString(e), grid);
}
```

```cpp
#define DUPMASK 0
#include <hip/hip_runtime.h>
#include <cstdio>
#include <cstdint>

#define LAS __attribute__((address_space(3)))
typedef unsigned short bf16;
typedef short bf16x8 __attribute__((ext_vector_type(8)));
typedef float f32x4 __attribute__((ext_vector_type(4)));
typedef unsigned u32x4 __attribute__((ext_vector_type(4)));
typedef unsigned u32x2 __attribute__((ext_vector_type(2)));

constexpr int NTHREADS = 512;
constexpr int LDS_BYTES = 147456;
constexpr int LDS_ST_OFF = LDS_BYTES - 64;

constexpr int BATCH = 4, SEQ = 8192, T = BATCH * SEQ, D = 1024, NPROJ = 4864;
constexpr int C_QA = 0, C_KA = 512, C_VA = 640, C_QH = 768, C_FH = 1280, C_IH = 1792, C_GH = 2304, C_ZA = 2816, C_ZB = 3840;
constexpr int NEXP = 32, FF = 512;
constexpr float EPS = 1e-6f;

constexpr size_t MiB = 1u << 20;
constexpr size_t WS_CTL = 0;
constexpr size_t CTL_CNT = 65536;
constexpr size_t WS_WINT = 1 * MiB;
constexpr size_t WS_WAT = 11 * MiB;
constexpr size_t WS_WBT = 12 * MiB;
constexpr size_t WS_WOT = 13 * MiB;
constexpr size_t WS_WR = 15 * MiB;
constexpr size_t WS_WGU = 16 * MiB;
constexpr size_t WS_WD = 80 * MiB;
constexpr size_t WS_PROJ = 112 * MiB;
constexpr size_t WS_MIXED = 416 * MiB;
constexpr size_t WS_CS = 480 * MiB;
constexpr size_t WS_END = 482 * MiB;
constexpr size_t WS_HN = 112 * MiB;
constexpr size_t WS_SSQ = 176 * MiB;
constexpr size_t WS_LIST = 178 * MiB;
constexpr size_t WS_GW = 186 * MiB;
constexpr size_t WS_RSTD = 187 * MiB;
constexpr size_t WS_H = 192 * MiB;
constexpr size_t WS_Y = 272 * MiB;
constexpr size_t OUT_U = 0, OUT_SIN = 16 * MiB, OUT_DSC = 32 * MiB, OUT_AH = 64 * MiB;

__device__ __forceinline__ unsigned f2bf(float f) { unsigned u = __builtin_bit_cast(unsigned, f); return (u + 0x7fffu + ((u >> 16) & 1u)) >> 16; }
__device__ __forceinline__ float bf2f(unsigned h) { return __builtin_bit_cast(float, h << 16); }
__device__ __forceinline__ unsigned pk2(float lo, float hi) { return f2bf(lo) | (f2bf(hi) << 16); }
__device__ __forceinline__ float bflo(unsigned w) { return __builtin_bit_cast(float, w << 16); }
__device__ __forceinline__ float bfhi(unsigned w) { return __builtin_bit_cast(float, w & 0xffff0000u); }
__device__ __forceinline__ float sigmoidf_(float x) { return __builtin_amdgcn_rcpf(1.f + __expf(-x)); }
__device__ __forceinline__ int opaque(int x) { asm volatile("" : "+v"(x)); return x; }
__device__ __forceinline__ float wave_sum(float v) {
#pragma unroll
    for (int o = 1; o < 64; o <<= 1) v += __shfl_xor(v, o);
    return v;
}

#define XB_TMO      128
#define XB_XCNT(j)  (256  + 64 * (j))
#define XB_XSUB(j)  (1280 + 64 * (j))
#define XB_XGEN(j)  (2304 + 64 * (j))
#define XB_TOP      3328
#define XB_TOPGEN   3392
#define XCD_BAR_WORDS 3456
#define XB_SPIN_CAP (1u << 20)
__device__ __forceinline__ unsigned xb_ld(unsigned* p)              { return __hip_atomic_load(p, __ATOMIC_RELAXED, __HIP_MEMORY_SCOPE_AGENT); }
__device__ __forceinline__ unsigned xb_add(unsigned* p, unsigned v) { return __hip_atomic_fetch_add(p, v, __ATOMIC_RELAXED, __HIP_MEMORY_SCOPE_AGENT); }
__device__ __forceinline__ unsigned xb_xcc_id() { return (unsigned)__builtin_amdgcn_s_getreg((3 << 11) | 20) & 0xFu; }
#define XB_SPIN(cond, bar) do { unsigned _sp = 0; while (cond) { __builtin_amdgcn_s_sleep(1); \
    if ((++_sp & 255u) == 0u) { if (xb_ld(&(bar)[XB_TMO])) break; if (_sp > XB_SPIN_CAP) { atomicAdd(&(bar)[XB_TMO], 1u); break; } } } } while (0)
struct XcdBarrier { unsigned* bar; unsigned x; volatile LAS unsigned* st; };
__device__ __forceinline__ XcdBarrier xcd_barrier_post(unsigned* bar, volatile LAS unsigned* st) {
    XcdBarrier b; b.bar = bar; b.x = xb_xcc_id(); b.st = st;
    if (threadIdx.x == 0) (void)xb_add(&bar[XB_XCNT(b.x)], 1u);
    return b;
}
__device__ __forceinline__ void xcd_barrier_complete(unsigned* bar, unsigned x, unsigned& nloc, unsigned& nx) {
    const unsigned G = gridDim.x * gridDim.y * gridDim.z;
    unsigned sum, cnt, mine, sp = 0u;
    for (;;) {
        sum = 0u; cnt = 0u; mine = 0u;
#pragma unroll
        for (unsigned j = 0; j < 16; ++j) { const unsigned c = xb_ld(&bar[XB_XCNT(j)]); sum += c; cnt += (c > 0u) ? 1u : 0u; mine = (j == x) ? c : mine; }
        if (sum == G) break;
        __builtin_amdgcn_s_sleep(1);
        if ((++sp & 255u) == 0u) { if (xb_ld(&bar[XB_TMO])) break; if (sp > XB_SPIN_CAP) { atomicAdd(&bar[XB_TMO], 1u); break; } }
    }
    nloc = mine > 0u ? mine : 1u; nx = cnt > 0u ? cnt : 1u;
}
__device__ __forceinline__ void xcd_barrier(const XcdBarrier& b) {
    asm volatile("s_waitcnt vmcnt(0)" ::: "memory");
    __syncthreads();
    if (threadIdx.x == 0) {
        unsigned* bar = b.bar;
        __builtin_amdgcn_s_waitcnt(0);
        unsigned nloc = b.st[0], nx = b.st[1];
        if (nloc == 0u) { xcd_barrier_complete(bar, b.x, nloc, nx); b.st[0] = nloc; b.st[1] = nx; }
        const unsigned old = xb_add(&bar[XB_XSUB(b.x)], 1u);
        const unsigned gen = old / nloc;
        if (old + 1u == (gen + 1u) * nloc) {
            __builtin_amdgcn_fence(__ATOMIC_RELEASE, "agent");
            asm volatile("s_waitcnt vmcnt(0)" ::: "memory");
            const unsigned og = xb_add(&bar[XB_TOP], 1u);
            const unsigned tg = og / nx;
            if (og + 1u == (tg + 1u) * nx) xb_add(&bar[XB_TOPGEN], 1u);
            else XB_SPIN(xb_ld(&bar[XB_TOPGEN]) == tg, bar);
            __builtin_amdgcn_fence(__ATOMIC_ACQUIRE, "agent");
            xb_add(&bar[XB_XGEN(b.x)], 1u);
            asm volatile("s_waitcnt vmcnt(0)" ::: "memory");
        } else {
            XB_SPIN(xb_ld(&bar[XB_XGEN(b.x)]) == gen, bar);
            __builtin_amdgcn_fence(__ATOMIC_ACQUIRE, "agent");
            asm volatile("s_waitcnt vmcnt(0)" ::: "memory");
        }
    }
    __syncthreads();
}

struct Params {
    const float* x; const int* positions; const float* norm1_w; const float* w_in; const float* q_norm_w; const float* k_norm_w;
    const float* sinks; const float* hlb; const float* hnw; const float* w_ba; const float* w_bh; const float* w_out; const float* norm2_w;
    const float* w_rg; const float* b_rg; const float* w_re; const float* b_re; const float* w_gate; const float* w_up; const float* w_down;
    float* out; unsigned char* ws;
};

namespace pg8 {
constexpr int BK = 64, HALF = 128, HTB = HALF * BK * 2;
__device__ __forceinline__ int lds_byte(int r, int c) { const int st = (r >> 4) * 2 + (c >> 5), rr = r & 15, cc = c & 31, ob = rr * 64 + cc * 2; return st * 1024 + (ob ^ (((ob >> 9) & 1) << 5)); }
__device__ __forceinline__ void stage_rc(int b, int& R, int& C) { const int st = b / 1024, sb = b % 1024, swz = sb ^ (((sb >> 9) & 1) << 5); R = (st >> 1) * 16 + swz / 64; C = (st & 1) * 32 + (swz % 64) / 2; }
__device__ __forceinline__ int perm32(int rho) { const int n = rho >> 4, i = rho & 15; return 8 * (i >> 2) + 4 * n + (i & 3); }
struct Unit { int pm, pn, l, i0, cn; };

template <class Epi, class Sched>
__device__ __forceinline__ void gemm_phase(LAS unsigned char* lds, const Sched& S, const Epi& E) {
    const int tid = threadIdx.x, wid = __builtin_amdgcn_readfirstlane(tid >> 6), lane = tid & 63, wr = wid >> 2, wc = wid & 3, fr = lane & 15, fq = lane >> 4;
    const int K = S.K, nt = K / BK;
    int sR[2], sC = 0; unsigned voffB[2];
#pragma unroll
    for (int i = 0; i < 2; ++i) { int R, C; stage_rc(tid * 16 + i * 8192, R, C); sR[i] = R; sC = C; const int Rb = Epi::PERM ? ((R & ~31) + perm32(R & 31)) : R; voffB[i] = (unsigned)(Rb * K + C) * 2u; }
    const unsigned kstep = (unsigned)(BK * 2);
    const size_t hstep = (size_t)HALF * K * 2;
    const unsigned ldsw = (unsigned)wid * 1024u;
    const int aoff = lds_byte(wr * 64 + fr, fq * 8), boff = lds_byte(wc * 32 + fr, fq * 8);
#define PG8_SA(b, h) (((b) * 2 + (h)) * HTB)
#define PG8_SB(b, h) ((4 + (b) * 2 + (h)) * HTB)
#define PG8_STAGE_B(bufoff, gbase) do { _Pragma("unroll") for (int _i = 0; _i < 2; ++_i) \
        __builtin_amdgcn_global_load_lds((const unsigned*)((const char*)(gbase) + voffB[_i]), (LAS unsigned*)(lds + (bufoff) + ldsw + _i * 8192), 16, 0, 0); } while (0)
#define PG8_STAGE_A(bufoff, va, kb) do { _Pragma("unroll") for (int _i = 0; _i < 2; ++_i) \
        __builtin_amdgcn_global_load_lds((const unsigned*)(Ab + ((size_t)(va)[_i] + (kb))), (LAS unsigned*)(lds + (bufoff) + ldsw + _i * 8192), 16, 0, 0); } while (0)
#define PG8_LDA(dst, b, h) do { _Pragma("unroll") for (int m = 0; m < 4; ++m) _Pragma("unroll") for (int k = 0; k < 2; ++k) dst[m][k] = *(const LAS bf16x8*)(lds + PG8_SA(b, h) + aoff + m * 2048 + k * 1024); } while (0)
#define PG8_LDB(dst, b, h) do { _Pragma("unroll") for (int n = 0; n < 2; ++n) _Pragma("unroll") for (int k = 0; k < 2; ++k) dst[n][k] = *(const LAS bf16x8*)(lds + PG8_SB(b, h) + boff + n * 2048 + k * 1024); } while (0)
#define PG8_MMA(ai, bj, At, Bt) do { __builtin_amdgcn_s_setprio(1); _Pragma("unroll") for (int m = 0; m < 4; ++m) _Pragma("unroll") for (int n = 0; n < 2; ++n) _Pragma("unroll") for (int k = 0; k < 2; ++k) \
        acc[ai][bj][m][n] = __builtin_amdgcn_mfma_f32_16x16x32_bf16(Bt[n][k], At[m][k], acc[ai][bj][m][n], 0, 0, 0); __builtin_amdgcn_s_setprio(0); } while (0)
#define PG8_WAIT_V(n) asm volatile("s_waitcnt vmcnt(" #n ")" ::: "memory")
#define PG8_WAIT_L(n) asm volatile("s_waitcnt lgkmcnt(" #n ")" ::: "memory")
#define PG8_BAR __builtin_amdgcn_s_barrier()
#define PG8_SCHED __builtin_amdgcn_sched_barrier(0)
    Unit cur, nxt; int ui = 0;
    if (!S.next(0, cur)) return;
    f32x4 acc[2][2][4][2];
#pragma unroll
    for (int a = 0; a < 2; ++a)
#pragma unroll
        for (int b = 0; b < 2; ++b)
#pragma unroll
            for (int m = 0; m < 4; ++m)
#pragma unroll
                for (int n = 0; n < 2; ++n) acc[a][b][m][n] = (f32x4){0.f, 0.f, 0.f, 0.f};
    bf16x8 At[4][2], B0[2][2], B1[2][2];
    const char* const Ab = S.a_base();
    unsigned vA0[2], vA1[2], nA0[2], nA1[2];
#pragma unroll
    for (int i = 0; i < 2; ++i) { vA0[i] = S.a_voff(cur, 0, sR[i], sC); vA1[i] = S.a_voff(cur, 1, sR[i], sC); }
    const char* cB = S.b_base(cur);
    PG8_STAGE_B(PG8_SB(0, 0), cB); PG8_STAGE_B(PG8_SB(0, 1), cB + hstep); PG8_STAGE_A(PG8_SA(0, 0), vA0, 0u); PG8_STAGE_A(PG8_SA(0, 1), vA1, 0u);
    if (wr == 1) PG8_BAR;
    PG8_WAIT_V(2); PG8_BAR;
    PG8_STAGE_B(PG8_SB(1, 0), cB + kstep); PG8_STAGE_A(PG8_SA(1, 0), vA0, kstep); PG8_STAGE_B(PG8_SB(1, 1), cB + hstep + kstep);
    PG8_WAIT_V(6); PG8_BAR;
    for (;;) {
        const bool has_next = S.next(ui + 1, nxt);
        const char* nB = has_next ? S.b_base(nxt) : cB;
#pragma unroll
        for (int i = 0; i < 2; ++i) { nA0[i] = has_next ? S.a_voff(nxt, 0, sR[i], sC) : vA0[i]; nA1[i] = has_next ? S.a_voff(nxt, 1, sR[i], sC) : vA1[i]; }
#pragma unroll 1
        for (int t = 0; t < nt; t += 2) {
            const bool last = (t == nt - 2);
            if constexpr (Epi::MID) { if (t == (nt >> 1)) E.mid(acc, cur, wr, wc, fr, fq); }
            const unsigned k1 = (unsigned)(t + 1) * kstep;
            const unsigned k2 = last ? 0u : (unsigned)(t + 2) * kstep, k3 = k2 + kstep;
            const char* b2 = last ? nB : cB + (size_t)(t + 2) * kstep; const char* b3 = b2 + kstep;
            unsigned uA0[2], uA1[2];
#pragma unroll
            for (int i = 0; i < 2; ++i) { uA0[i] = last ? nA0[i] : vA0[i]; uA1[i] = last ? nA1[i] : vA1[i]; }
            PG8_LDB(B0, 0, 0); PG8_LDB(B1, 0, 1); PG8_SCHED; PG8_LDA(At, 0, 0); PG8_STAGE_A(PG8_SA(1, 1), vA1, k1);
            PG8_WAIT_V(8); PG8_WAIT_L(0); PG8_BAR; PG8_MMA(0, 0, At, B0); PG8_MMA(0, 1, At, B1); PG8_BAR; PG8_SCHED;
            PG8_LDA(At, 0, 1); PG8_STAGE_B(PG8_SB(0, 0), b2); PG8_STAGE_B(PG8_SB(0, 1), b2 + hstep); PG8_STAGE_A(PG8_SA(0, 0), uA0, k2);
            PG8_WAIT_V(8); PG8_WAIT_L(0); PG8_BAR; PG8_MMA(1, 0, At, B0); PG8_MMA(1, 1, At, B1); PG8_BAR; PG8_SCHED;
            PG8_LDB(B0, 1, 0); PG8_LDB(B1, 1, 1); PG8_SCHED; PG8_LDA(At, 1, 0); PG8_STAGE_A(PG8_SA(0, 1), uA1, k2);
            PG8_WAIT_V(8); PG8_WAIT_L(0); PG8_BAR; PG8_MMA(0, 0, At, B0); PG8_MMA(0, 1, At, B1); PG8_BAR; PG8_SCHED;
            PG8_LDA(At, 1, 1); PG8_STAGE_B(PG8_SB(1, 0), b3); PG8_STAGE_B(PG8_SB(1, 1), b3 + hstep); PG8_STAGE_A(PG8_SA(1, 0), uA0, k3);
            PG8_WAIT_V(8); PG8_WAIT_L(0); PG8_BAR; PG8_MMA(1, 0, At, B0); PG8_MMA(1, 1, At, B1); PG8_BAR; PG8_SCHED;
        }
        if (wr == 0) PG8_BAR;
        E(acc, cur, wr, wc, fr, fq);
        if (!has_next) break;
#pragma unroll
        for (int a = 0; a < 2; ++a)
#pragma unroll
            for (int b = 0; b < 2; ++b)
#pragma unroll
                for (int m = 0; m < 4; ++m)
#pragma unroll
                    for (int n = 0; n < 2; ++n) acc[a][b][m][n] = (f32x4){0.f, 0.f, 0.f, 0.f};
        cur = nxt; cB = nB; ++ui;
#pragma unroll
        for (int i = 0; i < 2; ++i) { vA0[i] = nA0[i]; vA1[i] = nA1[i]; }
        if (wr == 1) PG8_BAR;
    }
    PG8_WAIT_V(0);
    PG8_BAR;
#undef PG8_SA
#undef PG8_SB
#undef PG8_STAGE_A
#undef PG8_STAGE_B
#undef PG8_LDA
#undef PG8_LDB
#undef PG8_MMA
#undef PG8_WAIT_V
#undef PG8_WAIT_L
#undef PG8_BAR
#undef PG8_SCHED
}
__device__ __forceinline__ bool tile_order(int i, int G, int c, int nM, int nN, int& pm, int& pn) {
    const int nwg = nM * nN; const long L = (long)i * G + c; if (L >= nwg) return false;
    int wgid = (int)L; { const int q = nwg / 8, r = nwg % 8, xcd = wgid % 8, off = wgid / 8; wgid = (xcd < r ? xcd * (q + 1) : r * (q + 1) + (xcd - r) * q) + off; }
    const int WGM = 8, nig = WGM * nN, gid = wgid / nig, fm = gid * WGM, gsz = (nM - fm) < WGM ? (nM - fm) : WGM;
    pm = fm + ((wgid % nig) % gsz); pn = (wgid % nig) / gsz; return true;
}
struct DenseSched {
    const char* A; const char* Bt; int K, nM, nN, G, c;
    __device__ __forceinline__ bool next(int i, Unit& u) const { u.l = 0; u.i0 = 0; u.cn = 0; return tile_order(i, G, c, nM, nN, u.pm, u.pn); }
    __device__ __forceinline__ const char* a_base() const { return A; }
    __device__ __forceinline__ unsigned a_voff(const Unit& u, int h, int R, int C) const { return (unsigned)((u.pm * 256 + h * 128 + R) * K + C) * 2u; }
    __device__ __forceinline__ const char* b_base(const Unit& u) const { return Bt + (size_t)u.pn * 256 * K * 2; }
};
template <int MODE> struct MoeSched {
    const char* A; const char* Bt; const int* list; const LAS int* PB; const LAS int* CN; const LAS int* RBL; int K, rb0, nunits, vcu, G;
    __device__ __forceinline__ bool next(int i, Unit& u) const {
        const int idx = vcu + i * G; if (idx >= nunits) return false;
        const int rb = rb0 + (idx >> 2); const int l = RBL[rb];
        u.pm = rb; u.pn = idx & 3; u.l = l; u.i0 = (rb - PB[l]) * 256; u.cn = CN[l]; return true; }
    __device__ __forceinline__ const char* a_base() const { return A; }
    __device__ __forceinline__ unsigned a_voff(const Unit& u, int h, int R, int C) const {
        if (MODE == 0) { int idx = u.i0 + h * 128 + R; idx = idx < u.cn ? idx : u.cn - 1; const int tok = list[(size_t)u.l * T + idx]; return (unsigned)(tok * 1024 + C) * 2u; }
        return (unsigned)((u.pm * 256 + h * 128 + R) * 512 + C) * 2u; }
    __device__ __forceinline__ const char* b_base(const Unit& u) const { return Bt + ((size_t)(u.l & 31) * 1024 + u.pn * 256) * K * 2; }
};
}

struct EpiProj { static constexpr bool PERM = true, MID = false; bf16* proj;
    __device__ __forceinline__ void operator()(const f32x4 (&acc)[2][2][4][2], const pg8::Unit& u, int wr, int wc, int fr, int fq) const {
        const int fro = opaque(fr), fqo = opaque(fq);
#pragma unroll
        for (int ai = 0; ai < 2; ++ai)
#pragma unroll
            for (int m = 0; m < 4; ++m) { bf16* rowp = proj + (size_t)(u.pm * 256 + ai * 128 + wr * 64 + m * 16 + fro) * NPROJ + u.pn * 256 + wc * 32 + 8 * fqo;
#pragma unroll
                for (int bj = 0; bj < 2; ++bj) { const f32x4 v0 = acc[ai][bj][m][0], v1 = acc[ai][bj][m][1];
                    u32x4 w; w.x = pk2(v0[0], v0[1]); w.y = pk2(v0[2], v0[3]); w.z = pk2(v1[0], v1[1]); w.w = pk2(v1[2], v1[3]); *(u32x4*)(rowp + bj * 128) = w; } }
    } };
__device__ __forceinline__ float ratio_(float zb, float za) { return (1.f + __expf(-zb)) * __builtin_amdgcn_rcpf(1.f + __expf(-za)); }
struct EpiMixed { static constexpr bool PERM = true, MID = true; const bf16* proj; bf16* mixed;
    __device__ __forceinline__ void mid(f32x4 (&acc)[2][2][4][2], const pg8::Unit& u, int wr, int wc, int fr, int fq) const {
        const int fro = opaque(fr), fqo = opaque(fq);
#pragma unroll
        for (int ai = 0; ai < 2; ++ai) {
            u32x4 za[4][2], zb[4][2];
#pragma unroll
            for (int m = 0; m < 4; ++m) { const bf16* zr = proj + (size_t)(u.pm * 256 + ai * 128 + wr * 64 + m * 16 + fro) * NPROJ + u.pn * 256 + wc * 32 + 8 * fqo;
#pragma unroll
                for (int bj = 0; bj < 2; ++bj) { za[m][bj] = *(const u32x4*)(zr + C_ZA + bj * 128); zb[m][bj] = *(const u32x4*)(zr + C_ZB + bj * 128); } }
#pragma unroll
            for (int m = 0; m < 4; ++m)
#pragma unroll
                for (int bj = 0; bj < 2; ++bj) { const u32x4 a = za[m][bj], b = zb[m][bj]; f32x4 r0, r1;
                    r0[0] = ratio_(bflo(b.x), bflo(a.x)); r0[1] = ratio_(bfhi(b.x), bfhi(a.x)); r0[2] = ratio_(bflo(b.y), bflo(a.y)); r0[3] = ratio_(bfhi(b.y), bfhi(a.y));
                    r1[0] = ratio_(bflo(b.z), bflo(a.z)); r1[1] = ratio_(bfhi(b.z), bfhi(a.z)); r1[2] = ratio_(bflo(b.w), bflo(a.w)); r1[3] = ratio_(bfhi(b.w), bfhi(a.w));
                    acc[ai][bj][m][0] = acc[ai][bj][m][0] * r0; acc[ai][bj][m][1] = acc[ai][bj][m][1] * r1; }
            asm volatile("" ::: "memory"); }
    }
    __device__ __forceinline__ void operator()(const f32x4 (&acc)[2][2][4][2], const pg8::Unit& u, int wr, int wc, int fr, int fq) const {
        const int fro = opaque(fr), fqo = opaque(fq);
#pragma unroll
        for (int ai = 0; ai < 2; ++ai) {
            u32x4 zb[4][2];
#pragma unroll
            for (int m = 0; m < 4; ++m) { const bf16* zr = proj + (size_t)(u.pm * 256 + ai * 128 + wr * 64 + m * 16 + fro) * NPROJ + u.pn * 256 + wc * 32 + 8 * fqo;
#pragma unroll
                for (int bj = 0; bj < 2; ++bj) zb[m][bj] = *(const u32x4*)(zr + C_ZB + bj * 128); }
#pragma unroll
            for (int m = 0; m < 4; ++m) { bf16* orow = mixed + (size_t)(u.pm * 256 + ai * 128 + wr * 64 + m * 16 + fro) * 1024 + u.pn * 256 + wc * 32 + 8 * fqo;
#pragma unroll
                for (int bj = 0; bj < 2; ++bj) { const u32x4 b = zb[m][bj]; const f32x4 v0 = acc[ai][bj][m][0], v1 = acc[ai][bj][m][1];
                    u32x4 w; w.x = pk2(v0[0] * sigmoidf_(bflo(b.x)), v0[1] * sigmoidf_(bfhi(b.x))); w.y = pk2(v0[2] * sigmoidf_(bflo(b.y)), v0[3] * sigmoidf_(bfhi(b.y)));
                    w.z = pk2(v1[0] * sigmoidf_(bflo(b.z)), v1[1] * sigmoidf_(bfhi(b.z))); w.w = pk2(v1[2] * sigmoidf_(bflo(b.w)), v1[3] * sigmoidf_(bfhi(b.w)));
                    *(u32x4*)(orow + bj * 128) = w; } }
            asm volatile("" ::: "memory"); }
    } };
struct EpiX1 { static constexpr bool PERM = false, MID = false; const float* x; const float* w2; float* out; bf16* hn; float* ssq;
    __device__ __forceinline__ void operator()(const f32x4 (&acc)[2][2][4][2], const pg8::Unit& u, int wr, int wc, int fr, int fq) const {
        const int fro = opaque(fr), fqo = opaque(fq);
        f32x4 wv[2][2];
#pragma unroll
        for (int bj = 0; bj < 2; ++bj)
#pragma unroll
            for (int n = 0; n < 2; ++n) wv[bj][n] = *(const f32x4*)(w2 + u.pn * 256 + bj * 128 + wc * 32 + n * 16 + 4 * fqo);
#pragma unroll
        for (int ai = 0; ai < 2; ++ai)
#pragma unroll
            for (int mh = 0; mh < 2; ++mh) {
                f32x4 xv[2][2][2];
#pragma unroll
                for (int mm = 0; mm < 2; ++mm) { const size_t row = (size_t)(u.pm * 256 + ai * 128 + wr * 64 + (mh * 2 + mm) * 16 + fro);
#pragma unroll
                    for (int bj = 0; bj < 2; ++bj)
#pragma unroll
                        for (int n = 0; n < 2; ++n) xv[mm][bj][n] = *(const f32x4*)(x + row * 1024 + u.pn * 256 + bj * 128 + wc * 32 + n * 16 + 4 * fqo); }
#pragma unroll
                for (int mm = 0; mm < 2; ++mm) { const int m = mh * 2 + mm; const size_t row = (size_t)(u.pm * 256 + ai * 128 + wr * 64 + m * 16 + fro); float s = 0.f;
#pragma unroll
                    for (int bj = 0; bj < 2; ++bj)
#pragma unroll
                        for (int n = 0; n < 2; ++n) { const int col = u.pn * 256 + bj * 128 + wc * 32 + n * 16 + 4 * fqo;
                            const f32x4 v = acc[ai][bj][m][n] + xv[mm][bj][n]; const f32x4 w = wv[bj][n];
                            *(f32x4*)(out + row * 1024 + col) = v;
                            s += (v[0] * v[0] + v[1] * v[1]) + (v[2] * v[2] + v[3] * v[3]);
                            u32x2 o; o.x = pk2(v[0] * w[0], v[1] * w[1]); o.y = pk2(v[2] * w[2], v[3] * w[3]); *(u32x2*)(hn + row * 1024 + col) = o; }
                    s += __shfl_xor(s, 16); s += __shfl_xor(s, 32);
                    if (fq == 0) ssq[row * 16 + u.pn * 4 + wc] = s; }
                asm volatile("" ::: "memory"); }
    } };
struct EpiGateUp { static constexpr bool PERM = true, MID = false; const int* list; const float* rstdv; bf16* hb;
    __device__ __forceinline__ void operator()(const f32x4 (&acc)[2][2][4][2], const pg8::Unit& u, int wr, int wc, int fr, int fq) const {
        const int fro = opaque(fr), fqo = opaque(fq);
        int tk[8]; float rsv[8];
#pragma unroll
        for (int q = 0; q < 8; ++q) { int idx = u.i0 + (q >> 2) * 128 + wr * 64 + (q & 3) * 16 + fro; idx = idx < u.cn ? idx : u.cn - 1; tk[q] = list[(size_t)u.l * T + idx]; }
#pragma unroll
        for (int q = 0; q < 8; ++q) rsv[q] = rstdv[tk[q]];
#pragma unroll
        for (int ai = 0; ai < 2; ++ai)
#pragma unroll
            for (int m = 0; m < 4; ++m) { const int r = ai * 128 + wr * 64 + m * 16 + fro; const float rs = rsv[ai * 4 + m];
                u32x4 w;
                { const f32x4 g = acc[ai][0][m][0] * rs, uu = acc[ai][1][m][0] * rs;
                  w.x = pk2(g[0] * sigmoidf_(g[0]) * uu[0], g[1] * sigmoidf_(g[1]) * uu[1]); w.y = pk2(g[2] * sigmoidf_(g[2]) * uu[2], g[3] * sigmoidf_(g[3]) * uu[3]); }
                { const f32x4 g = acc[ai][0][m][1] * rs, uu = acc[ai][1][m][1] * rs;
                  w.z = pk2(g[0] * sigmoidf_(g[0]) * uu[0], g[1] * sigmoidf_(g[1]) * uu[1]); w.w = pk2(g[2] * sigmoidf_(g[2]) * uu[2], g[3] * sigmoidf_(g[3]) * uu[3]); }
                *(u32x4*)(hb + ((size_t)u.pm * 256 + r) * 512 + u.pn * 128 + wc * 32 + 8 * fqo) = w; }
    } };
struct EpiDownY { static constexpr bool PERM = true, MID = false; const int* list; const float* gw; bf16* Y;
    __device__ __forceinline__ void operator()(const f32x4 (&acc)[2][2][4][2], const pg8::Unit& u, int wr, int wc, int fr, int fq) const {
        const int fro = opaque(fr), fqo = opaque(fq);
        int tk[8]; float gv[8];
#pragma unroll
        for (int q = 0; q < 8; ++q) { const int idx = u.i0 + (q >> 2) * 128 + wr * 64 + (q & 3) * 16 + fro; tk[q] = idx < u.cn ? list[(size_t)u.l * T + idx] : -1; }
#pragma unroll
        for (int q = 0; q < 8; ++q) gv[q] = tk[q] >= 0 ? gw[tk[q] * 2 + 1] : 0.f;
#pragma unroll
        for (int ai = 0; ai < 2; ++ai)
#pragma unroll
            for (int m = 0; m < 4; ++m) { const int tok = tk[ai * 4 + m]; const float g = gv[ai * 4 + m];
                if (tok >= 0) {
#pragma unroll
                    for (int bj = 0; bj < 2; ++bj) { const f32x4 v0 = acc[ai][bj][m][0] * g, v1 = acc[ai][bj][m][1] * g;
                        u32x4 w; w.x = pk2(v0[0], v0[1]); w.y = pk2(v0[2], v0[3]); w.z = pk2(v1[0], v1[1]); w.w = pk2(v1[2], v1[3]);
                        *(u32x4*)(Y + (size_t)tok * 1024 + u.pn * 256 + bj * 128 + wc * 32 + 8 * fqo) = w; } } }
    } };
struct EpiDown { static constexpr bool PERM = false, MID = false; const int* list; const float* gw; float* out; const bf16* Y;
    __device__ __forceinline__ void operator()(const f32x4 (&acc)[2][2][4][2], const pg8::Unit& u, int wr, int wc, int fr, int fq) const {
        const int fro = opaque(fr), fqo = opaque(fq);
        int tk[8]; float gv[8];
#pragma unroll
        for (int q = 0; q < 8; ++q) { const int idx = u.i0 + (q >> 2) * 128 + wr * 64 + (q & 3) * 16 + fro; tk[q] = idx < u.cn ? list[(size_t)u.l * T + idx] : -1; }
#pragma unroll
        for (int q = 0; q < 8; ++q) gv[q] = tk[q] >= 0 ? gw[tk[q] * 2] : 0.f;
#pragma unroll
        for (int ai = 0; ai < 2; ++ai)
#pragma unroll
            for (int mh = 0; mh < 2; ++mh) {
                f32x4 ov[2][2][2]; u32x2 yv[2][2][2];
#pragma unroll
                for (int mm = 0; mm < 2; ++mm) { const int tok = tk[ai * 4 + mh * 2 + mm]; const size_t base = (size_t)(tok >= 0 ? tok : 0) * 1024 + u.pn * 256 + wc * 32 + 4 * fqo;
#pragma unroll
                    for (int bj = 0; bj < 2; ++bj)
#pragma unroll
                        for (int n = 0; n < 2; ++n) { ov[mm][bj][n] = *(const f32x4*)(out + base + bj * 128 + n * 16); yv[mm][bj][n] = *(const u32x2*)(Y + base + bj * 128 + n * 16); } }
#pragma unroll
                for (int mm = 0; mm < 2; ++mm) { const int m = mh * 2 + mm; const int tok = tk[ai * 4 + m]; const float g = gv[ai * 4 + m];
                    if (tok >= 0) { const size_t base = (size_t)tok * 1024 + u.pn * 256 + wc * 32 + 4 * fqo;
#pragma unroll
                        for (int bj = 0; bj < 2; ++bj)
#pragma unroll
                            for (int n = 0; n < 2; ++n) { const u32x2 y = yv[mm][bj][n]; f32x4 o = ov[mm][bj][n] + acc[ai][bj][m][n] * g;
                                o[0] += bflo(y.x); o[1] += bfhi(y.x); o[2] += bflo(y.y); o[3] += bfhi(y.y);
                                *(f32x4*)(out + base + bj * 128 + n * 16) = o; } } }
                asm volatile("" ::: "memory"); }
    } };

struct TItem { const float* W; bf16* WT; int N, ldwt, k0, n0, drow0; };
__device__ __forceinline__ void titem_load(const TItem& t, int lane, float (&tv)[32]);
__device__ __forceinline__ void titem_store(const TItem& t, int lane, const float (&tv)[32], LAS float* scr);
__device__ __forceinline__ void transpose_item(const float* W, int N, bf16* WT, int ldwt, int kd0, int k0, int n0, int drow0, LAS float* scr, int lane) {
    TItem t; t.W = W; t.WT = WT + kd0; t.N = N; t.ldwt = ldwt; t.k0 = k0; t.n0 = n0; t.drow0 = drow0;
    float tv[32]; titem_load(t, lane, tv); titem_store(t, lane, tv, scr);
}

constexpr int EI_G = 16 * 16, EI_D = 8 * 32, EI_PER = 2 * EI_G + EI_D, EI_TOTAL = NEXP * EI_PER;
__device__ __forceinline__ TItem expert_item(const Params& P, int it) {
    TItem t; const int e = it / EI_PER; int r = it - e * EI_PER;
    if (r < EI_G) { const int kb = r / 16, nb = r % 16; t.n0 = 32 * nb; t.W = P.w_gate + (size_t)e * 1024 * 512; t.N = 512; t.WT = (bf16*)(P.ws + WS_WGU) + (size_t)e * 1024 * 1024; t.ldwt = 1024; t.k0 = 64 * kb; t.drow0 = (t.n0 >> 7) * 256 + (t.n0 & 127); return t; }
    r -= EI_G;
    if (r < EI_G) { const int kb = r / 16, nb = r % 16; t.n0 = 32 * nb; t.W = P.w_up + (size_t)e * 1024 * 512; t.N = 512; t.WT = (bf16*)(P.ws + WS_WGU) + (size_t)e * 1024 * 1024; t.ldwt = 1024; t.k0 = 64 * kb; t.drow0 = (t.n0 >> 7) * 256 + 128 + (t.n0 & 127); return t; }
    r -= EI_G;
    { const int kb = r / 32, nb = r % 32; t.n0 = 32 * nb; t.W = P.w_down + (size_t)e * 512 * 1024; t.N = 1024; t.WT = (bf16*)(P.ws + WS_WD) + (size_t)e * 1024 * 512; t.ldwt = 512; t.k0 = 64 * kb; t.drow0 = 32 * nb; return t; }
}
__device__ __forceinline__ void titem_load(const TItem& t, int lane, float (&tv)[32]) {
#pragma unroll
    for (int j = 0; j < 8; ++j) { const f32x4 v = *(const f32x4*)(t.W + (size_t)(t.k0 + 8 * j + (lane >> 3)) * t.N + t.n0 + 4 * (lane & 7));
        tv[4 * j] = v[0]; tv[4 * j + 1] = v[1]; tv[4 * j + 2] = v[2]; tv[4 * j + 3] = v[3]; }
}
__device__ __forceinline__ void titem_store(const TItem& t, int lane, const float (&tv)[32], LAS float* scr) {
#pragma unroll
    for (int j = 0; j < 8; ++j)
#pragma unroll
        for (int q = 0; q < 4; ++q) scr[(8 * j + (lane >> 3)) * 33 + 4 * (lane & 7) + q] = tv[4 * j + q];
    asm volatile("s_waitcnt lgkmcnt(0)" ::: "memory");
    const int c = lane & 7;
#pragma unroll
    for (int j = 0; j < 4; ++j) { const int n = (lane >> 3) + 8 * j; const LAS float* sp = scr + (8 * c) * 33 + n;
        u32x4 o; o.x = pk2(sp[0 * 33], sp[1 * 33]); o.y = pk2(sp[2 * 33], sp[3 * 33]); o.z = pk2(sp[4 * 33], sp[5 * 33]); o.w = pk2(sp[6 * 33], sp[7 * 33]);
        *(u32x4*)(t.WT + (size_t)(t.drow0 + n) * t.ldwt + t.k0 + 8 * c) = o; }
    asm volatile("s_waitcnt lgkmcnt(0)" ::: "memory");
}

__device__ __forceinline__ void phase0(const Params& P, LAS unsigned char* lds, int vcu, int G, int tid, int wid, int lane) {
    unsigned char* ws = P.ws;
    LAS float* scr = (LAS float*)(lds + wid * 16384);
    const int gw = vcu * 8 + wid, NGW = G * 8;
    constexpr int I_IN = 16 * 152, I_BR = 8 * 32, I_OUT = 16 * 32;
    constexpr int NITEMS = I_IN + 2 * I_BR + I_OUT;
    for (int it = gw; it < NITEMS; it += NGW) {
        int r = it;
        if (r < I_IN) { const int kb = r / 152, nb = r % 152; transpose_item(P.w_in, NPROJ, (bf16*)(ws + WS_WINT), 1024, 0, 64 * kb, 32 * nb, 32 * nb, scr, lane); continue; } r -= I_IN;
        if (r < I_BR) { const int kb = r / 32, nb = r % 32; transpose_item(P.w_ba, 1024, (bf16*)(ws + WS_WAT), 1024, 0, 64 * kb, 32 * nb, 32 * nb, scr, lane); continue; } r -= I_BR;
        if (r < I_BR) { const int kb = r / 32, nb = r % 32; transpose_item(P.w_bh, 1024, (bf16*)(ws + WS_WAT), 1024, 512, 64 * kb, 32 * nb, 32 * nb, scr, lane); continue; } r -= I_BR;
        { const int kb = r / 32, nb = r % 32; transpose_item(P.w_out, 1024, (bf16*)(ws + WS_WOT), 1024, 0, 64 * kb, 32 * nb, 32 * nb, scr, lane); }
    }
    { bf16* Wh = (bf16*)(ws + WS_WR); bf16* Wl = Wh + 48 * 1024;
      for (int idx = (vcu * NTHREADS + tid); idx < 48 * 1024; idx += G * NTHREADS) { const int j = idx >> 10, k = idx & 1023; float v = 0.f;
          if (j < 4) v = P.w_rg[k * 4 + j] * P.norm2_w[k]; else if (j < 36) v = P.w_re[k * 32 + (j - 4)] * P.norm2_w[k];
          const unsigned hi = f2bf(v); Wh[idx] = (bf16)hi; Wl[idx] = (bf16)f2bf(v - bf2f(hi)); } }
    { float* cs = (float*)(ws + WS_CS);
      const float invf[8] = {1.0f, 0.1939227432012558f, 0.03760603070259094f, 0.007292664609849453f, 0.0014142135623842478f, 0.00027424818836152554f, 5.318296098266728e-05f, 1.0313386155758053e-05f};
      for (int idx = (vcu * NTHREADS + tid); idx < T * 8; idx += G * NTHREADS) { const int tok = idx >> 3, i = idx & 7; float f = invf[0];
#pragma unroll
          for (int q = 1; q < 8; ++q) f = (i == q) ? invf[q] : f;
          float sn, c_; sincosf((float)P.positions[tok] * f, &sn, &c_); cs[tok * 16 + i] = c_; cs[tok * 16 + 8 + i] = sn; } }
    { bf16* xn = (bf16*)P.out;
      f32x4 wv[4];
#pragma unroll
      for (int j = 0; j < 4; ++j) wv[j] = *(const f32x4*)(P.norm1_w + 4 * lane + 256 * j);
      for (int m = gw; m < T; m += NGW) {
          const f32x4* xr = (const f32x4*)(P.x + (size_t)m * D) + lane; f32x4 v[4]; float s = 0.f;
#pragma unroll
          for (int j = 0; j < 4; ++j) { v[j] = xr[64 * j]; s += (v[j].x * v[j].x + v[j].y * v[j].y) + (v[j].z * v[j].z + v[j].w * v[j].w); }
          const float rstd = 1.f / sqrtf(wave_sum(s) * (1.f / D) + EPS);
          u32x2* o8 = (u32x2*)(xn + (size_t)m * D) + lane;
#pragma unroll
          for (int j = 0; j < 4; ++j) { u32x2 o; o.x = pk2(v[j].x * rstd * wv[j].x, v[j].y * rstd * wv[j].y); o.y = pk2(v[j].z * rstd * wv[j].z, v[j].w * rstd * wv[j].w); o8[64 * j] = o; }
      } }
}

__device__ __forceinline__ void phase1(const Params& P, LAS unsigned char* lds, int G) {
    const pg8::DenseSched S{(const char*)P.out, (const char*)(P.ws + WS_WINT), 1024, T / 256, NPROJ / 256, G, (int)blockIdx.x};
    const EpiProj E{(bf16*)(P.ws + WS_PROJ)};
    pg8::gemm_phase(lds, S, E);
}
__device__ __forceinline__ void phase5(const Params& P, LAS unsigned char* lds, int G) {
    const pg8::DenseSched S{(const char*)P.out + OUT_AH, (const char*)(P.ws + WS_WAT), 1024, T / 256, 4, G, (int)blockIdx.x};
    const EpiMixed E{(const bf16*)(P.ws + WS_PROJ), (bf16*)(P.ws + WS_MIXED)};
    pg8::gemm_phase(lds, S, E);
}
__device__ __forceinline__ void phase6(const Params& P, LAS unsigned char* lds, int G) {
    const pg8::DenseSched S{(const char*)(P.ws + WS_MIXED), (const char*)(P.ws + WS_WOT), 1024, T / 256, 4, G, (int)blockIdx.x};
    const EpiX1 E{P.x, P.norm2_w, P.out, (bf16*)(P.ws + WS_HN), (float*)(P.ws + WS_SSQ)};
    pg8::gemm_phase(lds, S, E);
}

constexpr int H_TOT = 0, H_DV = 2048, H_SSQ = 2560, H_QT = 4608, H_KH = H_QT + 17408, H_KTT = H_KH + 17408, H_VT = H_KTT + 18432, H_ST = H_VT + 18432, H_AM = H_ST + 34816, H_END = H_AM + 9216;
static_assert(H_END <= LDS_ST_OFF, "hgrn LDS");
__device__ __forceinline__ bf16x8 ldfrag(const LAS unsigned char* base, int row, int stride, int kbyte) { return *(const LAS bf16x8*)(base + row * stride + kbyte); }

template <int MODE>
__device__ __forceinline__ void hgrn_unit(const Params& P, LAS unsigned char* lds, int unit, int tid, int wid, int lane, int cit = EI_TOTAL, int cstride = 1) {
    LAS float* cscr = (LAS float*)(lds + (wid < 4 ? H_QT + wid * 8448 : H_ST + (wid - 4) * 8448));
    const int b = unit >> 6, h = (unit >> 4) & 3, sc = unit & 15;
    const int fr = opaque(lane & 15), fq = opaque(lane >> 4), c = opaque(tid & 127), qd = tid >> 7;
    const bf16* proj = (const bf16*)(P.ws + WS_PROJ);
    LAS float* TOT = (LAS float*)(lds + H_TOT); LAS float* DV = (LAS float*)(lds + H_DV); LAS float* SSQ = (LAS float*)(lds + H_SSQ);
    LAS bf16* Qt = (LAS bf16*)(lds + H_QT); LAS bf16* Kh = (LAS bf16*)(lds + H_KH); LAS bf16* KtT = (LAS bf16*)(lds + H_KTT); LAS bf16* VT = (LAS bf16*)(lds + H_VT);
    const float lbv = 1.f / (1.f + __expf(P.hlb[512 + h * 128 + c] - P.hlb[h * 128 + c]));
    float* Ug = (float*)((unsigned char*)P.out + OUT_U) + (size_t)unit * 16384;
    const float* Sin = (const float*)((unsigned char*)P.out + OUT_SIN) + (size_t)unit * 16384;
    f32x4 accS[8];
#pragma unroll
    for (int di = 0; di < 8; ++di) {
        if (MODE == 1 && sc > 0) {
#pragma unroll
            for (int r = 0; r < 4; ++r) accS[di][r] = Sin[(16 * di + 4 * fq + r) * 128 + 16 * wid + fr];
        } else accS[di] = (f32x4){0.f, 0.f, 0.f, 0.f};
        if (MODE == 1) { u32x2 o; o.x = pk2(accS[di][0], accS[di][1]); o.y = pk2(accS[di][2], accS[di][3]);
            *(LAS u32x2*)(lds + H_ST + (16 * wid + fr) * 272 + (16 * di + 4 * fq) * 2) = o; }
    }
    float dsum = 0.f;
    unsigned short rf[16], rq[16], rv[16];
#define HG_LOAD(ccx) do { const size_t t0x_ = (size_t)b * SEQ + sc * 512 + (ccx) * 64; const bf16* pb_ = proj + (t0x_ + qd * 16) * NPROJ + h * 128 + c; \
        _Pragma("unroll") for (int i = 0; i < 16; ++i) { rf[i] = pb_[(size_t)i * NPROJ + C_FH]; rv[i] = pb_[(size_t)i * NPROJ + C_IH]; if (MODE == 1) rq[i] = pb_[(size_t)i * NPROJ + C_QH]; } \
        } while (0)
    HG_LOAD(0);
#pragma unroll 1
    for (int cc = 0; cc < 8; ++cc) {
        const size_t t0 = (size_t)b * SEQ + sc * 512 + cc * 64;
        float tva[32], tvb[32]; TItem ia, ib; const int ita = cit, itb = cit + cstride;
        if (MODE == 0) { if (ita < EI_TOTAL) { ia = expert_item(P, ita); titem_load(ia, lane, tva); } if (itb < EI_TOTAL) { ib = expert_item(P, itb); titem_load(ib, lane, tvb); } }
        float bpart[16], kk[16]; float run = 0.f;
#pragma unroll
        for (int i = 0; i < 16; ++i) { const float f = bf2f(rf[i]);
            const float kv = (1.f - lbv) / (1.f + __expf(f));
            kk[i] = kv; run += __logf(1.f - kv); bpart[i] = run; }
        TOT[qd * 128 + c] = run;
        __syncthreads();
        float offs = 0.f, blast = 0.f;
#pragma unroll
        for (int q = 0; q < 4; ++q) { const float tv = TOT[q * 128 + c]; blast += tv; if (q < qd) offs += tv; }
        if (qd == 0) { DV[c] = __expf(blast); dsum += blast; }
#pragma unroll
        for (int i = 0; i < 16; ++i) { const int t = qd * 16 + i; const float bb = bpart[i] + offs;
            if (MODE == 1) { const float q = bf2f(rq[i]); const float qs = q / (1.f + __expf(-q));
                Qt[t * 136 + c] = (bf16)f2bf(qs * __expf(bb)); Kh[t * 136 + c] = (bf16)f2bf(kk[i] * __expf(fminf(-bb, 80.f))); }
            KtT[c * 72 + t] = (bf16)f2bf(kk[i] * __expf(blast - bb));
            VT[c * 72 + t] = rv[i]; }
        u32x2 gcur[4];
        if (MODE == 1) {
#pragma unroll
            for (int mi = 0; mi < 4; ++mi) gcur[mi] = *(const u32x2*)(proj + (t0 + 16 * mi + fr) * NPROJ + C_GH + h * 128 + 16 * wid + 4 * fq); }
        if (cc + 1 < 8) HG_LOAD(cc + 1);
        __syncthreads();
        f32x4 acco[4];
        if (MODE == 1) {
#pragma unroll
            for (int e2 = 0; e2 < 2; ++e2) { const int idx = 2 * wid + e2, mi = idx >> 2, ni = idx & 3; f32x4 a = (f32x4){0.f, 0.f, 0.f, 0.f};
                if (ni <= mi) {
#pragma unroll
                    for (int ks = 0; ks < 4; ++ks) { const bf16x8 kf = ldfrag(lds + H_KH, 16 * ni + fr, 272, (ks * 32 + fq * 8) * 2), qf = ldfrag(lds + H_QT, 16 * mi + fr, 272, (ks * 32 + fq * 8) * 2);
                        a = __builtin_amdgcn_mfma_f32_16x16x32_bf16(kf, qf, a, 0, 0, 0); } }
                const int t = 16 * mi + fr, s0 = 16 * ni + 4 * fq;
#pragma unroll
                for (int r = 0; r < 4; ++r) if (s0 + r > t || ni > mi) a[r] = 0.f;
                u32x2 o; o.x = pk2(a[0], a[1]); o.y = pk2(a[2], a[3]); *(LAS u32x2*)(lds + H_AM + t * 144 + s0 * 2) = o; }
#pragma unroll
            for (int mi = 0; mi < 4; ++mi) { acco[mi] = (f32x4){0.f, 0.f, 0.f, 0.f};
#pragma unroll
                for (int ks = 0; ks < 4; ++ks) { const bf16x8 sf = ldfrag(lds + H_ST, 16 * wid + fr, 272, (ks * 32 + fq * 8) * 2), qf = ldfrag(lds + H_QT, 16 * mi + fr, 272, (ks * 32 + fq * 8) * 2);
                    acco[mi] = __builtin_amdgcn_mfma_f32_16x16x32_bf16(sf, qf, acco[mi], 0, 0, 0); } }
        }
#pragma unroll
        for (int di = 0; di < 8; ++di) { const f32x4 dv4 = *(const LAS f32x4*)(lds + H_DV + (16 * di + 4 * fq) * 4); accS[di] = accS[di] * dv4;
#pragma unroll
            for (int ks = 0; ks < 2; ++ks) { const bf16x8 kf = ldfrag(lds + H_KTT, 16 * di + fr, 144, (ks * 32 + fq * 8) * 2), vf = ldfrag(lds + H_VT, 16 * wid + fr, 144, (ks * 32 + fq * 8) * 2);
                accS[di] = __builtin_amdgcn_mfma_f32_16x16x32_bf16(kf, vf, accS[di], 0, 0, 0); }
            if (MODE == 1) { u32x2 o; o.x = pk2(accS[di][0], accS[di][1]); o.y = pk2(accS[di][2], accS[di][3]);
                *(LAS u32x2*)(lds + H_ST + (16 * wid + fr) * 272 + (16 * di + 4 * fq) * 2) = o; } }
        if (MODE == 0) { if (ita < EI_TOTAL) titem_store(ia, lane, tva, cscr); if (itb < EI_TOTAL) titem_store(ib, lane, tvb, cscr); cit += 2 * cstride; }
        if (MODE == 1) {
            __syncthreads();
#pragma unroll
            for (int mi = 0; mi < 4; ++mi) {
#pragma unroll
                for (int ks = 0; ks < 2; ++ks) { const bf16x8 vf = ldfrag(lds + H_VT, 16 * wid + fr, 144, (ks * 32 + fq * 8) * 2), af = ldfrag(lds + H_AM, 16 * mi + fr, 144, (ks * 32 + fq * 8) * 2);
                    acco[mi] = __builtin_amdgcn_mfma_f32_16x16x32_bf16(vf, af, acco[mi], 0, 0, 0); }
                float s = (acco[mi][0] * acco[mi][0] + acco[mi][1] * acco[mi][1]) + (acco[mi][2] * acco[mi][2] + acco[mi][3] * acco[mi][3]);
                s += __shfl_xor(s, 16); s += __shfl_xor(s, 32);
                if (fq == 0) SSQ[wid * 64 + 16 * mi + fr] = s; }
            __syncthreads();
            bf16* hg = (bf16*)((unsigned char*)P.out + OUT_AH);
            const f32x4 nw = *(const f32x4*)(P.hnw + 16 * wid + 4 * fq);
#pragma unroll
            for (int mi = 0; mi < 4; ++mi) { const int t = 16 * mi + fr; float tot = 0.f;
#pragma unroll
                for (int w = 0; w < 8; ++w) tot += SSQ[w * 64 + t];
                const float rstd = 1.f / sqrtf(tot * (1.f / 128.f) + EPS);
                const u32x2 gg = gcur[mi];
                const float g0 = bflo(gg.x), g1 = bfhi(gg.x), g2 = bflo(gg.y), g3 = bfhi(gg.y);
                u32x2 o; o.x = pk2(acco[mi][0] * rstd * nw[0] * (g0 / (1.f + __expf(-g0))), acco[mi][1] * rstd * nw[1] * (g1 / (1.f + __expf(-g1))));
                o.y = pk2(acco[mi][2] * rstd * nw[2] * (g2 / (1.f + __expf(-g2))), acco[mi][3] * rstd * nw[3] * (g3 / (1.f + __expf(-g3))));
                *(u32x2*)(hg + (t0 + t) * 1024 + 512 + h * 128 + 16 * wid + 4 * fq) = o; }
        }
    }
    if (MODE == 0) {
#pragma unroll
        for (int di = 0; di < 8; ++di)
#pragma unroll
            for (int r = 0; r < 4; ++r) Ug[(16 * di + 4 * fq + r) * 128 + 16 * wid + fr] = accS[di][r];
        if (qd == 0) ((float*)((unsigned char*)P.out + OUT_DSC))[unit * 128 + c] = __expf(dsum);
    }
    __syncthreads();
}

__device__ __forceinline__ void hgrn_scan(const Params& P, int G, int tid) {
    const float* U = (const float*)((unsigned char*)P.out + OUT_U); float* Sin = (float*)((unsigned char*)P.out + OUT_SIN);
    const float* Dsc = (const float*)((unsigned char*)P.out + OUT_DSC);
    for (int idx = blockIdx.x * NTHREADS + tid; idx < 16 * 16384; idx += G * NTHREADS) {
        const int p = idx >> 14, e = idx & 16383, dk = e >> 7; float S = 0.f;
        float uu[15], dd[15];
#pragma unroll
        for (int sc = 0; sc < 15; ++sc) { const int u = p * 16 + sc; dd[sc] = Dsc[u * 128 + dk]; uu[sc] = U[(size_t)u * 16384 + e]; }
#pragma unroll
        for (int sc = 0; sc < 15; ++sc) { const int u = p * 16 + sc; S = dd[sc] * S + uu[sc]; Sin[(size_t)(u + 1) * 16384 + e] = S; }
    }
}

constexpr int A_KT = 0, A_VT = 36864, A_QS = 70656, A_END = A_QS + 73728;
static_assert(A_END <= LDS_ST_OFF, "attn LDS");
__device__ __forceinline__ void rope16(float (&v)[32], const float* cs) {
    const f32x4 c0 = *(const f32x4*)cs, c1 = *(const f32x4*)(cs + 4), s0 = *(const f32x4*)(cs + 8), s1 = *(const f32x4*)(cs + 12);
#pragma unroll
    for (int i = 0; i < 8; ++i) { const float cv = i < 4 ? c0[i & 3] : c1[i & 3], sv = i < 4 ? s0[i & 3] : s1[i & 3]; const float x1 = v[i], x2 = v[i + 8]; v[i] = x1 * cv - x2 * sv; v[i + 8] = x2 * cv + x1 * sv; }
}
__device__ __forceinline__ void unpack8(const u32x4 w, float* v) { v[0] = bflo(w.x); v[1] = bfhi(w.x); v[2] = bflo(w.y); v[3] = bfhi(w.y); v[4] = bflo(w.z); v[5] = bfhi(w.z); v[6] = bflo(w.w); v[7] = bfhi(w.w); }
__device__ __forceinline__ void attn_unit(const Params& P, LAS unsigned char* lds, int unit, int tid, int wid, int lane) {
    const int hk = unit & 1, nb = (unit >> 1) & 63, b = unit >> 7;
    const int fr = opaque(lane & 15), fq = opaque(lane >> 4);
    const bf16* proj = (const bf16*)(P.ws + WS_PROJ);
    const float* cstab = (const float*)(P.ws + WS_CS);
    {
        const int key = tid >> 1, half = tid & 1; const int srel = nb * 128 - 128 + key;
        const bool ok = srel >= 0; const size_t tokk = (size_t)b * SEQ + (ok ? srel : 0);
        const int g = tid >> 7, ql = tid & 127; const size_t tokq = (size_t)b * SEQ + nb * 128 + ql;
        const u32x4* ksrc = (const u32x4*)(proj + tokk * NPROJ + C_KA + hk * 64 + half * 32);
        const u32x4* vsrc = (const u32x4*)(proj + tokk * NPROJ + C_VA + hk * 64 + half * 32);
        const u32x4* qsrc = (const u32x4*)(proj + tokq * NPROJ + C_QA + (hk * 4 + g) * 64);
        u32x4 kr[4], vr[4], qr[8];
#pragma unroll
        for (int j = 0; j < 4; ++j) { kr[j] = ksrc[j]; vr[j] = vsrc[j]; }
#pragma unroll
        for (int j = 0; j < 8; ++j) qr[j] = qsrc[j];
        { float v[32];
#pragma unroll
          for (int j = 0; j < 4; ++j) unpack8(kr[j], v + 8 * j);
          float s = 0.f;
#pragma unroll
          for (int j = 0; j < 32; ++j) s += v[j] * v[j];
          s += __shfl_xor(s, 1);
          const float rstd = 1.f / sqrtf(s * (1.f / 64.f) + EPS);
#pragma unroll
          for (int j = 0; j < 8; ++j) { const f32x4 w = *(const f32x4*)(P.k_norm_w + half * 32 + 4 * j);
              v[4 * j] *= rstd * w[0]; v[4 * j + 1] *= rstd * w[1]; v[4 * j + 2] *= rstd * w[2]; v[4 * j + 3] *= rstd * w[3]; }
          if (half == 0) rope16(v, cstab + tokk * 16);
#pragma unroll
          for (int j = 0; j < 4; ++j) { u32x4 o; o.x = pk2(v[8 * j], v[8 * j + 1]); o.y = pk2(v[8 * j + 2], v[8 * j + 3]); o.z = pk2(v[8 * j + 4], v[8 * j + 5]); o.w = pk2(v[8 * j + 6], v[8 * j + 7]);
              if (!ok) o = (u32x4){0u, 0u, 0u, 0u};
              *(LAS u32x4*)(lds + A_KT + key * 144 + half * 64 + j * 16) = o; } }
#pragma unroll
        for (int j = 0; j < 4; ++j) { u32x4 w = vr[j]; if (!ok) w = (u32x4){0u, 0u, 0u, 0u};
            LAS bf16* dst = (LAS bf16*)(lds + A_VT) + (half * 32 + 8 * j) * 264 + key;
            dst[0 * 264] = (bf16)(w.x & 0xffffu); dst[1 * 264] = (bf16)(w.x >> 16); dst[2 * 264] = (bf16)(w.y & 0xffffu); dst[3 * 264] = (bf16)(w.y >> 16);
            dst[4 * 264] = (bf16)(w.z & 0xffffu); dst[5 * 264] = (bf16)(w.z >> 16); dst[6 * 264] = (bf16)(w.w & 0xffffu); dst[7 * 264] = (bf16)(w.w >> 16); }
        { float s = 0.f;
#pragma unroll
          for (int j = 0; j < 8; ++j) { float a[8]; unpack8(qr[j], a); s += (a[0] * a[0] + a[1] * a[1]) + (a[2] * a[2] + a[3] * a[3]) + (a[4] * a[4] + a[5] * a[5]) + (a[6] * a[6] + a[7] * a[7]); }
          const float rstd = 0.125f / sqrtf(s * (1.f / 64.f) + EPS);
#pragma unroll
          for (int hf = 0; hf < 2; ++hf) { float v[32];
#pragma unroll
              for (int j = 0; j < 4; ++j) unpack8(qr[hf * 4 + j], v + 8 * j);
#pragma unroll
              for (int j = 0; j < 8; ++j) { const f32x4 w = *(const f32x4*)(P.q_norm_w + hf * 32 + 4 * j);
                  v[4 * j] *= rstd * w[0]; v[4 * j + 1] *= rstd * w[1]; v[4 * j + 2] *= rstd * w[2]; v[4 * j + 3] *= rstd * w[3]; }
              if (hf == 0) rope16(v, cstab + tokq * 16);
#pragma unroll
              for (int j = 0; j < 4; ++j) { u32x4 o; o.x = pk2(v[8 * j], v[8 * j + 1]); o.y = pk2(v[8 * j + 2], v[8 * j + 3]); o.z = pk2(v[8 * j + 4], v[8 * j + 5]); o.w = pk2(v[8 * j + 6], v[8 * j + 7]);
                  *(LAS u32x4*)(lds + A_QS + tid * 144 + hf * 64 + j * 16) = o; } } }
    }
    __syncthreads();
    { const int g = wid >> 1; const float sink = P.sinks[hk * 4 + g];
      bf16* attn = (bf16*)((unsigned char*)P.out + OUT_AH);
#pragma unroll 1
      for (int p = 0; p < 2; ++p) { const int q0 = (wid & 1) * 64 + p * 32;
          f32x4 sT[10][2];
          bf16x8 qf[2][2];
#pragma unroll
          for (int nq = 0; nq < 2; ++nq)
#pragma unroll
              for (int ks = 0; ks < 2; ++ks) qf[nq][ks] = ldfrag(lds + A_QS, g * 128 + q0 + 16 * nq + fr, 144, (ks * 32 + fq * 8) * 2);
#pragma unroll
          for (int kt = 0; kt < 10; ++kt) {
#pragma unroll
              for (int nq = 0; nq < 2; ++nq) sT[kt][nq] = (f32x4){0.f, 0.f, 0.f, 0.f};
#pragma unroll
              for (int ks = 0; ks < 2; ++ks) { const bf16x8 kf = ldfrag(lds + A_KT, q0 + 16 * kt + fr, 144, (ks * 32 + fq * 8) * 2);
#pragma unroll
                  for (int nq = 0; nq < 2; ++nq) if (kt - nq >= 0 && kt - nq <= 8) sT[kt][nq] = __builtin_amdgcn_mfma_f32_16x16x32_bf16(kf, qf[nq][ks], sT[kt][nq], 0, 0, 0); } }
          float linv[2];
#pragma unroll
          for (int nq = 0; nq < 2; ++nq) { float mx = sink;
#pragma unroll
              for (int kt = 0; kt < 10; ++kt) { const int d = kt - nq; if (d < 0 || d > 8) continue;
#pragma unroll
                  for (int r = 0; r < 4; ++r) { bool valid = true;
                      if (d == 0) valid = (4 * fq + r > fr); else if (d == 8) valid = (4 * fq + r <= fr);
                      if (nb == 0) valid = valid && (q0 + 16 * kt + 4 * fq + r >= 128);
                      if (!valid) sT[kt][nq][r] = -1e30f; mx = fmaxf(mx, sT[kt][nq][r]); } }
              mx = fmaxf(mx, __shfl_xor(mx, 16)); mx = fmaxf(mx, __shfl_xor(mx, 32));
              float l = 0.f;
#pragma unroll
              for (int kt = 0; kt < 10; ++kt) { const int d = kt - nq; if (d < 0 || d > 8) continue;
#pragma unroll
                  for (int r = 0; r < 4; ++r) { float pv = __expf(sT[kt][nq][r] - mx); if ((d == 0 || d == 8 || nb == 0) && !(sT[kt][nq][r] > -1e29f)) pv = 0.f; sT[kt][nq][r] = pv; l += pv; } }
              l += __shfl_xor(l, 16); l += __shfl_xor(l, 32);
              l += __expf(sink - mx);
              linv[nq] = 1.f / l; }
          f32x4 oT[4][2];
#pragma unroll
          for (int dt = 0; dt < 4; ++dt)
#pragma unroll
              for (int nq = 0; nq < 2; ++nq) oT[dt][nq] = (f32x4){0.f, 0.f, 0.f, 0.f};
#pragma unroll
          for (int j = 0; j < 5; ++j) { bf16x8 pf[2];
#pragma unroll
              for (int nq = 0; nq < 2; ++nq) { u32x4 w; w.x = pk2(sT[2 * j][nq][0], sT[2 * j][nq][1]); w.y = pk2(sT[2 * j][nq][2], sT[2 * j][nq][3]); w.z = pk2(sT[2 * j + 1][nq][0], sT[2 * j + 1][nq][1]); w.w = pk2(sT[2 * j + 1][nq][2], sT[2 * j + 1][nq][3]);
                  pf[nq] = __builtin_bit_cast(bf16x8, w); }
#pragma unroll
              for (int dt = 0; dt < 4; ++dt) { const LAS unsigned char* vrow = lds + A_VT + (16 * dt + fr) * 528 + (q0 + 32 * j + 4 * fq) * 2;
                  const u32x2 lo = *(const LAS u32x2*)vrow, hi = *(const LAS u32x2*)(vrow + 32);
                  u32x4 w; w.x = lo.x; w.y = lo.y; w.z = hi.x; w.w = hi.y; const bf16x8 vf = __builtin_bit_cast(bf16x8, w);
#pragma unroll
                  for (int nq = 0; nq < 2; ++nq) oT[dt][nq] = __builtin_amdgcn_mfma_f32_16x16x32_bf16(vf, pf[nq], oT[dt][nq], 0, 0, 0); } }
#pragma unroll
          for (int nq = 0; nq < 2; ++nq) { const size_t tok = (size_t)b * SEQ + nb * 128 + q0 + 16 * nq + fr;
#pragma unroll
              for (int dt = 0; dt < 4; ++dt) { const f32x4 v = oT[dt][nq] * linv[nq]; u32x2 o; o.x = pk2(v[0], v[1]); o.y = pk2(v[2], v[3]);
                  *(u32x2*)(attn + tok * 1024 + (hk * 4 + g) * 64 + 16 * dt + 4 * fq) = o; } }
      } }
    __syncthreads();
}

__device__ __forceinline__ void phase7(const Params& P, LAS unsigned char* lds, int vcu, int G, int tid, int wid, int lane, bool commit = true) {
    const bf16* Wrh = (const bf16*)(P.ws + WS_WR); const float* ssq = (const float*)(P.ws + WS_SSQ);
    unsigned* cnt = (unsigned*)(P.ws + WS_CTL + CTL_CNT); int* list = (int*)(P.ws + WS_LIST); float* gw = (float*)(P.ws + WS_GW); float* rstdv = (float*)(P.ws + WS_RSTD);
    const int fr = lane & 15, fq = lane >> 4;
    LAS float* LG = (LAS float*)(lds + wid * 3072);
    LAS unsigned* LC = (LAS unsigned*)(lds + 24576); LAS unsigned* LB = (LAS unsigned*)(lds + 24576 + 256);
    if (tid < 64) LC[tid] = 0u;
    __syncthreads();
    for (int base = vcu * 8; base < T / 16; base += G * 8) {
        const int rg = base + wid; const int R0 = rg * 16;
        f32x4 acc[3];
#pragma unroll
        for (int nt = 0; nt < 3; ++nt) acc[nt] = (f32x4){0.f, 0.f, 0.f, 0.f};
        const float* xr = P.out + (size_t)(R0 + fr) * 1024 + 8 * fq;
        const bf16* wh = Wrh + (size_t)fr * 1024 + 8 * fq;
#pragma unroll 4
        for (int ks = 0; ks < 32; ++ks) { const f32x4 a0 = *(const f32x4*)(xr + 32 * ks), a1 = *(const f32x4*)(xr + 32 * ks + 4);
            u32x4 hw, lw;
            { const unsigned h0 = f2bf(a0[0]), h1 = f2bf(a0[1]), h2 = f2bf(a0[2]), h3 = f2bf(a0[3]), h4 = f2bf(a1[0]), h5 = f2bf(a1[1]), h6 = f2bf(a1[2]), h7 = f2bf(a1[3]);
              hw.x = h0 | (h1 << 16); hw.y = h2 | (h3 << 16); hw.z = h4 | (h5 << 16); hw.w = h6 | (h7 << 16);
              lw.x = pk2(a0[0] - bf2f(h0), a0[1] - bf2f(h1)); lw.y = pk2(a0[2] - bf2f(h2), a0[3] - bf2f(h3)); lw.z = pk2(a1[0] - bf2f(h4), a1[1] - bf2f(h5)); lw.w = pk2(a1[2] - bf2f(h6), a1[3] - bf2f(h7)); }
            const bf16x8 ah = __builtin_bit_cast(bf16x8, hw), al = __builtin_bit_cast(bf16x8, lw);
#pragma unroll
            for (int nt = 0; nt < 3; ++nt) { const bf16x8 bh = *(const bf16x8*)(wh + nt * 16384 + 32 * ks), bl = *(const bf16x8*)(wh + 48 * 1024 + nt * 16384 + 32 * ks);
                acc[nt] = __builtin_amdgcn_mfma_f32_16x16x32_bf16(ah, bh, acc[nt], 0, 0, 0);
                acc[nt] = __builtin_amdgcn_mfma_f32_16x16x32_bf16(ah, bl, acc[nt], 0, 0, 0);
                acc[nt] = __builtin_amdgcn_mfma_f32_16x16x32_bf16(al, bh, acc[nt], 0, 0, 0); } }
#pragma unroll
        for (int r = 0; r < 4; ++r) { const float* sp = ssq + (size_t)(R0 + 4 * fq + r) * 16; float tot = 0.f;
#pragma unroll
            for (int q = 0; q < 4; ++q) { const f32x4 v = *(const f32x4*)(sp + 4 * q); tot += v[0]; tot += v[1]; tot += v[2]; tot += v[3]; }
            const float rstd = 1.f / sqrtf(tot * (1.f / 1024.f) + EPS);
            if (fr == 0) rstdv[R0 + 4 * fq + r] = rstd;
#pragma unroll
            for (int nt = 0; nt < 3; ++nt) { const int j = 16 * nt + fr; float bias = 0.f; if (j < 4) bias = P.b_rg[j]; else if (j < 36) bias = P.b_re[j - 4];
                LG[(4 * fq + r) * 48 + j] = acc[nt][r] * rstd + bias; } }
        __syncthreads();
        int l0 = 0, l1 = 0; unsigned rk0 = 0u, rk1 = 0u;
        if (lane < 16) { const int tok = R0 + lane; const LAS float* lg = LG + lane * 48;
            int gsel = 0; float best = lg[0];
#pragma unroll
            for (int i = 1; i < 4; ++i) { const float v = lg[i]; if (v > best) { best = v; gsel = i; } }
            float Z = 0.f;
#pragma unroll
            for (int i = 0; i < 4; ++i) Z += __expf(lg[i] - best);
            const float pgsel = 1.f / Z;
            const LAS float* le = lg + 4 + gsel * 8;
            float lmax = le[0];
#pragma unroll
            for (int i = 1; i < 8; ++i) lmax = fmaxf(lmax, le[i]);
            float Zp = 0.f;
#pragma unroll
            for (int i = 0; i < 8; ++i) Zp += __expf(le[i] - lmax);
            int i1 = 0; float p1 = -1.f;
#pragma unroll
            for (int i = 0; i < 8; ++i) { const float pe = __expf(le[i] - lmax) / Zp; if (pe > p1) { p1 = pe; i1 = i; } }
            int i2 = 0; float p2 = -1.f;
#pragma unroll
            for (int i = 0; i < 8; ++i) { const float pe = __expf(le[i] - lmax) / Zp; if (i != i1 && pe > p2) { p2 = pe; i2 = i; } }
            const float den = p1 + p2;
            gw[tok * 2 + 0] = pgsel * p1 / den; gw[tok * 2 + 1] = pgsel * p2 / den;
            l0 = gsel * 8 + i1; l1 = 32 + gsel * 8 + i2;
            rk0 = __hip_atomic_fetch_add(&LC[l0], 1u, __ATOMIC_RELAXED, __HIP_MEMORY_SCOPE_WORKGROUP); rk1 = __hip_atomic_fetch_add(&LC[l1], 1u, __ATOMIC_RELAXED, __HIP_MEMORY_SCOPE_WORKGROUP); }
        __syncthreads();
        if (tid < 64) { const unsigned n = LC[tid]; LC[tid] = 0u; if (n && commit) LB[tid] = atomicAdd(&cnt[tid * 64], n); }
        __syncthreads();
        if (lane < 16 && commit) { const int tok = R0 + lane; list[(size_t)l0 * T + LB[l0] + rk0] = tok; list[(size_t)l1 * T + LB[l1] + rk1] = tok; }
        __syncthreads();
    }
}

constexpr int M_PB = 133120, M_CN = 133632, M_RBL = 133888;
__device__ __forceinline__ void moe_prefix(const Params& P, LAS unsigned char* lds, int tid) {
    const unsigned* cnt = (const unsigned*)(P.ws + WS_CTL + CTL_CNT);
    LAS int* PB = (LAS int*)(lds + M_PB); LAS int* CN = (LAS int*)(lds + M_CN);
    if (tid < 64) CN[tid] = (int)cnt[tid * 64];
    __syncthreads();
    if (tid == 0) { int s = 0; for (int l = 0; l < 64; ++l) { PB[l] = s; s += (CN[l] + 255) >> 8; } PB[64] = s; }
    __syncthreads();
    if (tid < 64) { LAS int* RBL = (LAS int*)(lds + M_RBL); for (int rb = PB[tid]; rb < PB[tid + 1]; ++rb) RBL[rb] = tid; }
    __syncthreads();
}
__device__ __forceinline__ void phase8(const Params& P, LAS unsigned char* lds, int vcu, int G) {
    const LAS int* PB = (const LAS int*)(lds + M_PB); const LAS int* CN = (const LAS int*)(lds + M_CN);
    const pg8::MoeSched<0> S{(const char*)(P.ws + WS_HN), (const char*)(P.ws + WS_WGU), (const int*)(P.ws + WS_LIST), PB, CN, (const LAS int*)(lds + M_RBL), 1024, PB[0], (PB[64] - PB[0]) * 4, vcu, G};
    const EpiGateUp E{(const int*)(P.ws + WS_LIST), (const float*)(P.ws + WS_RSTD), (bf16*)(P.ws + WS_H)};
    pg8::gemm_phase(lds, S, E);
}
__device__ __forceinline__ void phase9(const Params& P, LAS unsigned char* lds, int vcu, int G) {
    const LAS int* PB = (const LAS int*)(lds + M_PB); const LAS int* CN = (const LAS int*)(lds + M_CN);
    const pg8::MoeSched<1> S{(const char*)(P.ws + WS_H), (const char*)(P.ws + WS_WD), (const int*)(P.ws + WS_LIST), PB, CN, (const LAS int*)(lds + M_RBL), 512, PB[32], (PB[64] - PB[32]) * 4, vcu, G};
    const EpiDownY E{(const int*)(P.ws + WS_LIST), (const float*)(P.ws + WS_GW), (bf16*)(P.ws + WS_Y)};
    pg8::gemm_phase(lds, S, E);
}
__device__ __forceinline__ void phase10(const Params& P, LAS unsigned char* lds, int vcu, int G) {
    const LAS int* PB = (const LAS int*)(lds + M_PB); const LAS int* CN = (const LAS int*)(lds + M_CN);
    const pg8::MoeSched<1> S{(const char*)(P.ws + WS_H), (const char*)(P.ws + WS_WD), (const int*)(P.ws + WS_LIST), PB, CN, (const LAS int*)(lds + M_RBL), 512, PB[0], (PB[32] - PB[0]) * 4, vcu, G};
    const EpiDown E{(const int*)(P.ws + WS_LIST), (const float*)(P.ws + WS_GW), P.out, (const bf16*)(P.ws + WS_Y)};
    pg8::gemm_phase(lds, S, E);
}

__global__ void __launch_bounds__(NTHREADS, 2) mega_fwd(Params P) {
    extern __shared__ __attribute__((aligned(16))) unsigned char lds_raw[];
    LAS unsigned char* lds = (LAS unsigned char*)lds_raw;
    const int tid = threadIdx.x, lane = tid & 63, wid = __builtin_amdgcn_readfirstlane(tid >> 6);
    const int G = gridDim.x; const int bx = blockIdx.x; const int vcu = (G % 8 == 0) ? (bx % 8) * (G / 8) + bx / 8 : bx;
    volatile LAS unsigned* st = (volatile LAS unsigned*)(lds + LDS_ST_OFF);
    if (tid < 16) st[tid] = 0u;
    __syncthreads();
    unsigned* bar = (unsigned*)(P.ws + WS_CTL);
    const XcdBarrier xb = xcd_barrier_post(bar, st);

#ifndef DUPMASK
#define DUPMASK 0
#endif
#define DUPQ(k) if ((DUPMASK >> (k)) & 1)
    phase0(P, lds, vcu, G, tid, wid, lane);
    DUPQ(0) phase0(P, lds, vcu, G, tid, wid, lane);
    xcd_barrier(xb);
    phase1(P, lds, G);
    DUPQ(1) phase1(P, lds, G);
    const int ei_p1 = (G == 256) ? 14336 : 0;
    if (G == 256 && bx >= 128) { LAS float* cscr = (LAS float*)(lds + wid * 16384); const int w1 = (bx - 128) * 8 + wid;
#pragma unroll 1
        for (int k = 0; k < 14; k += 2) { float tva[32], tvb[32]; const TItem ia = expert_item(P, w1 + k * 1024), ib = expert_item(P, w1 + (k + 1) * 1024);
            titem_load(ia, lane, tva); titem_load(ib, lane, tvb); titem_store(ia, lane, tva, cscr); titem_store(ib, lane, tvb, cscr); } }
    xcd_barrier(xb);
    {
        int cit = ei_p1 + vcu * 8 + wid; const int cstride = G * 8;
        for (int u = bx; u < 256; u += G) {
            if ((u & 15) != 15) { hgrn_unit<0>(P, lds, u, tid, wid, lane, cit, cstride); cit += 16 * cstride; } }
        LAS float* cscr = (LAS float*)(lds + (wid < 4 ? H_QT + wid * 8448 : H_ST + (wid - 4) * 8448));
        for (; cit < EI_TOTAL; cit += cstride) { float tv[32]; const TItem t = expert_item(P, cit); titem_load(t, lane, tv); titem_store(t, lane, tv, cscr); }
    }
    DUPQ(2) for (int u = bx; u < 256; u += G) if ((u & 15) != 15) hgrn_unit<0>(P, lds, u, tid, wid, lane);
    xcd_barrier(xb);
    hgrn_scan(P, G, tid);
    for (int u = bx; u < 512; u += G) attn_unit(P, lds, u, tid, wid, lane);
    DUPQ(3) for (int u = bx; u < 512; u += G) attn_unit(P, lds, u, tid, wid, lane);
    xcd_barrier(xb);
    for (int u = bx; u < 256; u += G) hgrn_unit<1>(P, lds, u, tid, wid, lane);
    DUPQ(4) for (int u = bx; u < 256; u += G) hgrn_unit<1>(P, lds, u, tid, wid, lane);
    xcd_barrier(xb);
    phase5(P, lds, G);
    DUPQ(5) phase5(P, lds, G);
    xcd_barrier(xb);
    phase6(P, lds, G);
    DUPQ(6) phase6(P, lds, G);
    xcd_barrier(xb);
    if ((DUPMASK >> 7) & 1) phase7(P, lds, vcu, G, tid, wid, lane, false);
    phase7(P, lds, vcu, G, tid, wid, lane);
    xcd_barrier(xb);
    moe_prefix(P, lds, tid);
    phase8(P, lds, vcu, G);
    DUPQ(8) phase8(P, lds, vcu, G);
    xcd_barrier(xb);
    phase9(P, lds, vcu, G);
    xcd_barrier(xb);
    phase10(P, lds, vcu, G);
    if (xb_ld(&bar[XB_TMO]) != 0u && tid == 0) P.out[(size_t)bx * 1024] = __builtin_nanf("");
}

extern "C" void kernel_launch(void* const* d_in, const int* in_sizes, int n_in, void* d_out, int out_size, void* d_ws, size_t ws_size, hipStream_t stream) {
    static int grid = 0;
    if (grid == 0) {
        if (n_in != 20 || out_size != T * D || ws_size < WS_END) { fprintf(stderr, "kernel_launch: unexpected shapes (n_in %d out %d ws %zu, need ws >= %zu)\n", n_in, out_size, ws_size, (size_t)WS_END); grid = -1; return; }
        int dev = 0, cus = 0, per_cu = 0;
        if (hipGetDevice(&dev) != hipSuccess || hipDeviceGetAttribute(&cus, hipDeviceAttributeMultiprocessorCount, dev) != hipSuccess) { grid = -1; return; }
        if (hipFuncSetAttribute((const void*)mega_fwd, hipFuncAttributeMaxDynamicSharedMemorySize, LDS_BYTES) != hipSuccess) { fprintf(stderr, "hipFuncSetAttribute failed\n"); grid = -1; return; }
        if (hipOccupancyMaxActiveBlocksPerMultiprocessor(&per_cu, (const void*)mega_fwd, NTHREADS, LDS_BYTES) != hipSuccess || per_cu < 1) { fprintf(stderr, "occupancy query: %d blocks/CU\n", per_cu); grid = -1; return; }
        grid = cus;
    }
    if (grid < 0) return;
    if (hipMemsetAsync((char*)d_ws + WS_CTL, 0, 96 * 1024, stream) != hipSuccess) return;
    Params p{};
    p.x = (const float*)d_in[0]; p.positions = (const int*)d_in[1]; p.norm1_w = (const float*)d_in[2]; p.w_in = (const float*)d_in[3];
    p.q_norm_w = (const float*)d_in[4]; p.k_norm_w = (const float*)d_in[5]; p.sinks = (const float*)d_in[6]; p.hlb = (const float*)d_in[7];
    p.hnw = (const float*)d_in[8]; p.w_ba = (const float*)d_in[9]; p.w_bh = (const float*)d_in[10]; p.w_out = (const float*)d_in[11];
    p.norm2_w = (const float*)d_in[12]; p.w_rg = (const float*)d_in[13]; p.b_rg = (const float*)d_in[14]; p.w_re = (const float*)d_in[15];
    p.b_re = (const float*)d_in[16]; p.w_gate = (const float*)d_in[17]; p.w_up = (const float*)d_in[18]; p.w_down = (const float*)d_in[19];
    p.out = (float*)d_out; p.ws = (unsigned char*)d_ws;
    void* args[] = {&p};
    const hipError_t e = hipLaunchCooperativeKernel((const void*)mega_fwd, dim3(grid), dim3(NTHREADS), args, LDS_BYTES, stream);
    if (e != hipSuccess) fprintf(stderr, "cooperative launch failed: %s (grid %d)\n", hipGetErrorString(e), grid);
}
```

```cpp
#define DUPMASK 0
#include <hip/hip_runtime.h>
#include <cstdio>
#include <cstdint>

#define LAS __attribute__((address_space(3)))
typedef unsigned short bf16;
typedef short bf16x8 __attribute__((ext_vector_type(8)));
typedef float f32x4 __attribute__((ext_vector_type(4)));
typedef unsigned u32x4 __attribute__((ext_vector_type(4)));
typedef unsigned u32x2 __attribute__((ext_vector_type(2)));

constexpr int NTHREADS = 512;
constexpr int LDS_BYTES = 147456;
constexpr int LDS_ST_OFF = LDS_BYTES - 64;

constexpr int BATCH = 4, SEQ = 8192, T = BATCH * SEQ, D = 1024, NPROJ = 4864;
constexpr int C_QA = 0, C_KA = 512, C_VA = 640, C_QH = 768, C_FH = 1280, C_IH = 1792, C_GH = 2304, C_ZA = 2816, C_ZB = 3840;
constexpr int NEXP = 32, FF = 512;
constexpr float EPS = 1e-6f;

constexpr size_t MiB = 1u << 20;
constexpr size_t WS_CTL = 0;
constexpr size_t CTL_CNT = 65536;
constexpr size_t WS_WINT = 1 * MiB;
constexpr size_t WS_WAT = 11 * MiB;
constexpr size_t WS_WBT = 12 * MiB;
constexpr size_t WS_WOT = 13 * MiB;
constexpr size_t WS_WR = 15 * MiB;
constexpr size_t WS_WGU = 16 * MiB;
constexpr size_t WS_WD = 80 * MiB;
constexpr size_t WS_PROJ = 112 * MiB;
constexpr size_t WS_MIXED = 416 * MiB;
constexpr size_t WS_CS = 480 * MiB;
constexpr size_t WS_END = 482 * MiB;
constexpr size_t WS_HN = 112 * MiB;
constexpr size_t WS_SSQ = 176 * MiB;
constexpr size_t WS_LIST = 178 * MiB;
constexpr size_t WS_GW = 186 * MiB;
constexpr size_t WS_RSTD = 187 * MiB;
constexpr size_t WS_H = 192 * MiB;
constexpr size_t WS_Y = 272 * MiB;
constexpr size_t OUT_U = 0, OUT_SIN = 16 * MiB, OUT_DSC = 32 * MiB, OUT_AH = 64 * MiB;

typedef float f32x2_ __attribute__((ext_vector_type(2)));
typedef __bf16 bf16x2_ __attribute__((ext_vector_type(2)));
__device__ __forceinline__ unsigned f2bf(float f) { return (unsigned)__builtin_bit_cast(unsigned short, (__bf16)f); }
__device__ __forceinline__ float bf2f(unsigned h) { return __builtin_bit_cast(float, h << 16); }
__device__ __forceinline__ unsigned pk2(float lo, float hi) { const f32x2_ v = {lo, hi}; return __builtin_bit_cast(unsigned, __builtin_convertvector(v, bf16x2_)); }
__device__ __forceinline__ float bflo(unsigned w) { return __builtin_bit_cast(float, w << 16); }
__device__ __forceinline__ float bfhi(unsigned w) { return __builtin_bit_cast(float, w & 0xffff0000u); }
__device__ __forceinline__ float sigmoidf_(float x) { return __builtin_amdgcn_rcpf(1.f + __expf(-x)); }
__device__ __forceinline__ int opaque(int x) { asm volatile("" : "+v"(x)); return x; }
__device__ __forceinline__ float wave_sum(float v) {
#pragma unroll
    for (int o = 1; o < 64; o <<= 1) v += __shfl_xor(v, o);
    return v;
}

#define XB_TMO      128
#define XB_XCNT(j)  (256  + 64 * (j))
#define XB_XSUB(j)  (1280 + 64 * (j))
#define XB_XGEN(j)  (2304 + 64 * (j))
#define XB_TOP      3328
#define XB_TOPGEN   3392
#define XCD_BAR_WORDS 3456
#define XB_SPIN_CAP (1u << 20)
__device__ __forceinline__ unsigned xb_ld(unsigned* p)              { return __hip_atomic_load(p, __ATOMIC_RELAXED, __HIP_MEMORY_SCOPE_AGENT); }
__device__ __forceinline__ unsigned xb_add(unsigned* p, unsigned v) { return __hip_atomic_fetch_add(p, v, __ATOMIC_RELAXED, __HIP_MEMORY_SCOPE_AGENT); }
__device__ __forceinline__ unsigned xb_xcc_id() { return (unsigned)__builtin_amdgcn_s_getreg((3 << 11) | 20) & 0xFu; }
#define XB_SPIN(cond, bar) do { unsigned _sp = 0; while (cond) { __builtin_amdgcn_s_sleep(1); \
    if ((++_sp & 255u) == 0u) { if (xb_ld(&(bar)[XB_TMO])) break; if (_sp > XB_SPIN_CAP) { atomicAdd(&(bar)[XB_TMO], 1u); break; } } } } while (0)
struct XcdBarrier { unsigned* bar; unsigned x; volatile LAS unsigned* st; };
__device__ __forceinline__ XcdBarrier xcd_barrier_post(unsigned* bar, volatile LAS unsigned* st) {
    XcdBarrier b; b.bar = bar; b.x = xb_xcc_id(); b.st = st;
    if (threadIdx.x == 0) (void)xb_add(&bar[XB_XCNT(b.x)], 1u);
    return b;
}
__device__ __forceinline__ void xcd_barrier_complete(unsigned* bar, unsigned x, unsigned& nloc, unsigned& nx) {
    const unsigned G = gridDim.x * gridDim.y * gridDim.z;
    unsigned sum, cnt, mine, sp = 0u;
    for (;;) {
        sum = 0u; cnt = 0u; mine = 0u;
#pragma unroll
        for (unsigned j = 0; j < 16; ++j) { const unsigned c = xb_ld(&bar[XB_XCNT(j)]); sum += c; cnt += (c > 0u) ? 1u : 0u; mine = (j == x) ? c : mine; }
        if (sum == G) break;
        __builtin_amdgcn_s_sleep(1);
        if ((++sp & 255u) == 0u) { if (xb_ld(&bar[XB_TMO])) break; if (sp > XB_SPIN_CAP) { atomicAdd(&bar[XB_TMO], 1u); break; } }
    }
    nloc = mine > 0u ? mine : 1u; nx = cnt > 0u ? cnt : 1u;
}
__device__ __forceinline__ void xcd_barrier(const XcdBarrier& b) {
    asm volatile("s_waitcnt vmcnt(0)" ::: "memory");
    __syncthreads();
    if (threadIdx.x == 0) {
        unsigned* bar = b.bar;
        __builtin_amdgcn_s_waitcnt(0);
        unsigned nloc = b.st[0], nx = b.st[1];
        if (nloc == 0u) { xcd_barrier_complete(bar, b.x, nloc, nx); b.st[0] = nloc; b.st[1] = nx; }
        const unsigned old = xb_add(&bar[XB_XSUB(b.x)], 1u);
        const unsigned gen = old / nloc;
        if (old + 1u == (gen + 1u) * nloc) {
            __builtin_amdgcn_fence(__ATOMIC_RELEASE, "agent");
            asm volatile("s_waitcnt vmcnt(0)" ::: "memory");
            const unsigned og = xb_add(&bar[XB_TOP], 1u);
            const unsigned tg = og / nx;
            if (og + 1u == (tg + 1u) * nx) xb_add(&bar[XB_TOPGEN], 1u);
            else XB_SPIN(xb_ld(&bar[XB_TOPGEN]) == tg, bar);
            __builtin_amdgcn_fence(__ATOMIC_ACQUIRE, "agent");
            xb_add(&bar[XB_XGEN(b.x)], 1u);
            asm volatile("s_waitcnt vmcnt(0)" ::: "memory");
        } else {
            XB_SPIN(xb_ld(&bar[XB_XGEN(b.x)]) == gen, bar);
            __builtin_amdgcn_fence(__ATOMIC_ACQUIRE, "agent");
            asm volatile("s_waitcnt vmcnt(0)" ::: "memory");
        }
    }
    __syncthreads();
}

struct Params {
    const float* x; const int* positions; const float* norm1_w; const float* w_in; const float* q_norm_w; const float* k_norm_w;
    const float* sinks; const float* hlb; const float* hnw; const float* w_ba; const float* w_bh; const float* w_out; const float* norm2_w;
    const float* w_rg; const float* b_rg; const float* w_re; const float* b_re; const float* w_gate; const float* w_up; const float* w_down;
    float* out; unsigned char* ws;
};

namespace pg8 {
constexpr int BK = 64, HALF = 128, HTB = HALF * BK * 2;
__device__ __forceinline__ int lds_byte(int r, int c) { const int st = (r >> 4) * 2 + (c >> 5), rr = r & 15, cc = c & 31, ob = rr * 64 + cc * 2; return st * 1024 + (ob ^ (((ob >> 9) & 1) << 5)); }
__device__ __forceinline__ void stage_rc(int b, int& R, int& C) { const int st = b / 1024, sb = b % 1024, swz = sb ^ (((sb >> 9) & 1) << 5); R = (st >> 1) * 16 + swz / 64; C = (st & 1) * 32 + (swz % 64) / 2; }
__device__ __forceinline__ int perm32(int rho) { const int n = rho >> 4, i = rho & 15; return 8 * (i >> 2) + 4 * n + (i & 3); }
struct Unit { int pm, pn, l, i0, cn; };

template <class Epi, class Sched>
__device__ __forceinline__ void gemm_phase(LAS unsigned char* lds, const Sched& S, const Epi& E) {
    const int tid = threadIdx.x, wid = __builtin_amdgcn_readfirstlane(tid >> 6), lane = tid & 63, wr = wid >> 2, wc = wid & 3, fr = lane & 15, fq = lane >> 4;
    const int K = S.K, nt = K / BK;
    int sR[2], sC = 0; unsigned voffB[2];
#pragma unroll
    for (int i = 0; i < 2; ++i) { int R, C; stage_rc(tid * 16 + i * 8192, R, C); sR[i] = R; sC = C; const int Rb = Epi::PERM ? ((R & ~31) + perm32(R & 31)) : R; voffB[i] = (unsigned)(Rb * K + C) * 2u; }
    const unsigned kstep = (unsigned)(BK * 2);
    const size_t hstep = (size_t)HALF * K * 2;
    const unsigned ldsw = (unsigned)wid * 1024u;
    const int aoff = lds_byte(wr * 64 + fr, fq * 8), boff = lds_byte(wc * 32 + fr, fq * 8);
#define PG8_SA(b, h) (((b) * 2 + (h)) * HTB)
#define PG8_SB(b, h) ((4 + (b) * 2 + (h)) * HTB)
#define PG8_STAGE_B(bufoff, gbase) do { _Pragma("unroll") for (int _i = 0; _i < 2; ++_i) \
        __builtin_amdgcn_global_load_lds((const unsigned*)((const char*)(gbase) + voffB[_i]), (LAS unsigned*)(lds + (bufoff) + ldsw + _i * 8192), 16, 0, 0); } while (0)
#define PG8_STAGE_A(bufoff, va, kb) do { _Pragma("unroll") for (int _i = 0; _i < 2; ++_i) \
        __builtin_amdgcn_global_load_lds((const unsigned*)(Ab + ((size_t)(va)[_i] + (kb))), (LAS unsigned*)(lds + (bufoff) + ldsw + _i * 8192), 16, 0, 0); } while (0)
#define PG8_LDA(dst, b, h) do { _Pragma("unroll") for (int m = 0; m < 4; ++m) _Pragma("unroll") for (int k = 0; k < 2; ++k) dst[m][k] = *(const LAS bf16x8*)(lds + PG8_SA(b, h) + aoff + m * 2048 + k * 1024); } while (0)
#define PG8_LDB(dst, b, h) do { _Pragma("unroll") for (int n = 0; n < 2; ++n) _Pragma("unroll") for (int k = 0; k < 2; ++k) dst[n][k] = *(const LAS bf16x8*)(lds + PG8_SB(b, h) + boff + n * 2048 + k * 1024); } while (0)
#define PG8_MMA(ai, bj, At, Bt) do { __builtin_amdgcn_s_setprio(1); _Pragma("unroll") for (int m = 0; m < 4; ++m) _Pragma("unroll") for (int n = 0; n < 2; ++n) _Pragma("unroll") for (int k = 0; k < 2; ++k) \
        acc[ai][bj][m][n] = __builtin_amdgcn_mfma_f32_16x16x32_bf16(Bt[n][k], At[m][k], acc[ai][bj][m][n], 0, 0, 0); __builtin_amdgcn_s_setprio(0); } while (0)
#define PG8_WAIT_V(n) asm volatile("s_waitcnt vmcnt(" #n ")" ::: "memory")
#define PG8_WAIT_L(n) asm volatile("s_waitcnt lgkmcnt(" #n ")" ::: "memory")
#define PG8_BAR __builtin_amdgcn_s_barrier()
#define PG8_SCHED __builtin_amdgcn_sched_barrier(0)
    Unit cur, nxt; int ui = 0;
    if (!S.next(0, cur)) return;
    f32x4 acc[2][2][4][2];
#pragma unroll
    for (int a = 0; a < 2; ++a)
#pragma unroll
        for (int b = 0; b < 2; ++b)
#pragma unroll
            for (int m = 0; m < 4; ++m)
#pragma unroll
                for (int n = 0; n < 2; ++n) acc[a][b][m][n] = (f32x4){0.f, 0.f, 0.f, 0.f};
    bf16x8 At[4][2], B0[2][2], B1[2][2];
    const char* const Ab = S.a_base();
    unsigned vA0[2], vA1[2], nA0[2], nA1[2];
#pragma unroll
    for (int i = 0; i < 2; ++i) { vA0[i] = S.a_voff(cur, 0, sR[i], sC); vA1[i] = S.a_voff(cur, 1, sR[i], sC); }
    const char* cB = S.b_base(cur);
    PG8_STAGE_B(PG8_SB(0, 0), cB); PG8_STAGE_B(PG8_SB(0, 1), cB + hstep); PG8_STAGE_A(PG8_SA(0, 0), vA0, 0u); PG8_STAGE_A(PG8_SA(0, 1), vA1, 0u);
    if (wr == 1) PG8_BAR;
    PG8_WAIT_V(2); PG8_BAR;
    PG8_STAGE_B(PG8_SB(1, 0), cB + kstep); PG8_STAGE_A(PG8_SA(1, 0), vA0, kstep); PG8_STAGE_B(PG8_SB(1, 1), cB + hstep + kstep);
    PG8_WAIT_V(6); PG8_BAR;
    for (;;) {
        const bool has_next = S.next(ui + 1, nxt);
        const char* nB = has_next ? S.b_base(nxt) : cB;
#pragma unroll
        for (int i = 0; i < 2; ++i) { nA0[i] = has_next ? S.a_voff(nxt, 0, sR[i], sC) : vA0[i]; nA1[i] = has_next ? S.a_voff(nxt, 1, sR[i], sC) : vA1[i]; }
#pragma unroll 1
        for (int t = 0; t < nt; t += 2) {
            const bool last = (t == nt - 2);
            if constexpr (Epi::MID) { if (t == (nt >> 1)) E.mid(acc, cur, wr, wc, fr, fq); }
            const unsigned k1 = (unsigned)(t + 1) * kstep;
            const unsigned k2 = last ? 0u : (unsigned)(t + 2) * kstep, k3 = k2 + kstep;
            const char* b2 = last ? nB : cB + (size_t)(t + 2) * kstep; const char* b3 = b2 + kstep;
            unsigned uA0[2], uA1[2];
#pragma unroll
            for (int i = 0; i < 2; ++i) { uA0[i] = last ? nA0[i] : vA0[i]; uA1[i] = last ? nA1[i] : vA1[i]; }
            PG8_LDB(B0, 0, 0); PG8_LDB(B1, 0, 1); PG8_SCHED; PG8_LDA(At, 0, 0); PG8_STAGE_A(PG8_SA(1, 1), vA1, k1);
            PG8_WAIT_V(8); PG8_WAIT_L(0); PG8_BAR; PG8_MMA(0, 0, At, B0); PG8_MMA(0, 1, At, B1); PG8_BAR; PG8_SCHED;
            PG8_LDA(At, 0, 1); PG8_STAGE_B(PG8_SB(0, 0), b2); PG8_STAGE_B(PG8_SB(0, 1), b2 + hstep); PG8_STAGE_A(PG8_SA(0, 0), uA0, k2);
            PG8_WAIT_V(8); PG8_WAIT_L(0); PG8_BAR; PG8_MMA(1, 0, At, B0); PG8_MMA(1, 1, At, B1); PG8_BAR; PG8_SCHED;
            PG8_LDB(B0, 1, 0); PG8_LDB(B1, 1, 1); PG8_SCHED; PG8_LDA(At, 1, 0); PG8_STAGE_A(PG8_SA(0, 1), uA1, k2);
            PG8_WAIT_V(8); PG8_WAIT_L(0); PG8_BAR; PG8_MMA(0, 0, At, B0); PG8_MMA(0, 1, At, B1); PG8_BAR; PG8_SCHED;
            PG8_LDA(At, 1, 1); PG8_STAGE_B(PG8_SB(1, 0), b3); PG8_STAGE_B(PG8_SB(1, 1), b3 + hstep); PG8_STAGE_A(PG8_SA(1, 0), uA0, k3);
            PG8_WAIT_V(8); PG8_WAIT_L(0); PG8_BAR; PG8_MMA(1, 0, At, B0); PG8_MMA(1, 1, At, B1); PG8_BAR; PG8_SCHED;
        }
        if (wr == 0) PG8_BAR;
        E(acc, cur, wr, wc, fr, fq);
        if (!has_next) break;
#pragma unroll
        for (int a = 0; a < 2; ++a)
#pragma unroll
            for (int b = 0; b < 2; ++b)
#pragma unroll
                for (int m = 0; m < 4; ++m)
#pragma unroll
                    for (int n = 0; n < 2; ++n) acc[a][b][m][n] = (f32x4){0.f, 0.f, 0.f, 0.f};
        cur = nxt; cB = nB; ++ui;
#pragma unroll
        for (int i = 0; i < 2; ++i) { vA0[i] = nA0[i]; vA1[i] = nA1[i]; }
        if (wr == 1) PG8_BAR;
    }
    PG8_WAIT_V(0);
    PG8_BAR;
#undef PG8_SA
#undef PG8_SB
#undef PG8_STAGE_A
#undef PG8_STAGE_B
#undef PG8_LDA
#undef PG8_LDB
#undef PG8_MMA
#undef PG8_WAIT_V
#undef PG8_WAIT_L
#undef PG8_BAR
#undef PG8_SCHED
}
__device__ __forceinline__ bool tile_order(int i, int G, int c, int nM, int nN, int& pm, int& pn) {
    const int nwg = nM * nN; const long L = (long)i * G + c; if (L >= nwg) return false;
    int wgid = (int)L; { const int q = nwg / 8, r = nwg % 8, xcd = wgid % 8, off = wgid / 8; wgid = (xcd < r ? xcd * (q + 1) : r * (q + 1) + (xcd - r) * q) + off; }
    const int WGM = 8, nig = WGM * nN, gid = wgid / nig, fm = gid * WGM, gsz = (nM - fm) < WGM ? (nM - fm) : WGM;
    pm = fm + ((wgid % nig) % gsz); pn = (wgid % nig) / gsz; return true;
}
struct DenseSched {
    const char* A; const char* Bt; int K, nM, nN, G, c;
    __device__ __forceinline__ bool next(int i, Unit& u) const { u.l = 0; u.i0 = 0; u.cn = 0; return tile_order(i, G, c, nM, nN, u.pm, u.pn); }
    __device__ __forceinline__ const char* a_base() const { return A; }
    __device__ __forceinline__ unsigned a_voff(const Unit& u, int h, int R, int C) const { return (unsigned)((u.pm * 256 + h * 128 + R) * K + C) * 2u; }
    __device__ __forceinline__ const char* b_base(const Unit& u) const { return Bt + (size_t)u.pn * 256 * K * 2; }
};
template <int MODE> struct MoeSched {
    const char* A; const char* Bt; const int* list; const LAS int* PB; const LAS int* CN; const LAS int* RBL; int K, rb0, nunits, vcu, G;
    __device__ __forceinline__ bool next(int i, Unit& u) const {
        const int idx = vcu + i * G; if (idx >= nunits) return false;
        const int rb = rb0 + (idx >> 2); const int l = RBL[rb];
        u.pm = rb; u.pn = idx & 3; u.l = l; u.i0 = (rb - PB[l]) * 256; u.cn = CN[l]; return true; }
    __device__ __forceinline__ const char* a_base() const { return A; }
    __device__ __forceinline__ unsigned a_voff(const Unit& u, int h, int R, int C) const {
        if (MODE == 0) { int idx = u.i0 + h * 128 + R; idx = idx < u.cn ? idx : u.cn - 1; const int tok = list[(size_t)u.l * T + idx]; return (unsigned)(tok * 1024 + C) * 2u; }
        return (unsigned)((u.pm * 256 + h * 128 + R) * 512 + C) * 2u; }
    __device__ __forceinline__ const char* b_base(const Unit& u) const { return Bt + ((size_t)(u.l & 31) * 1024 + u.pn * 256) * K * 2; }
};
}

struct EpiProj { static constexpr bool PERM = true, MID = false; bf16* proj;
    __device__ __forceinline__ void operator()(const f32x4 (&acc)[2][2][4][2], const pg8::Unit& u, int wr, int wc, int fr, int fq) const {
        const int fro = opaque(fr), fqo = opaque(fq);
#pragma unroll
        for (int ai = 0; ai < 2; ++ai)
#pragma unroll
            for (int m = 0; m < 4; ++m) { bf16* rowp = proj + (size_t)(u.pm * 256 + ai * 128 + wr * 64 + m * 16 + fro) * NPROJ + u.pn * 256 + wc * 32 + 8 * fqo;
#pragma unroll
                for (int bj = 0; bj < 2; ++bj) { const f32x4 v0 = acc[ai][bj][m][0], v1 = acc[ai][bj][m][1];
                    u32x4 w; w.x = pk2(v0[0], v0[1]); w.y = pk2(v0[2], v0[3]); w.z = pk2(v1[0], v1[1]); w.w = pk2(v1[2], v1[3]); *(u32x4*)(rowp + bj * 128) = w; } }
    } };
__device__ __forceinline__ float ratio_(float zb, float za) { return (1.f + __expf(-zb)) * __builtin_amdgcn_rcpf(1.f + __expf(-za)); }
struct EpiMixed { static constexpr bool PERM = true, MID = true; const bf16* proj; bf16* mixed;
    __device__ __forceinline__ void mid(f32x4 (&acc)[2][2][4][2], const pg8::Unit& u, int wr, int wc, int fr, int fq) const {
        const int fro = opaque(fr), fqo = opaque(fq);
#pragma unroll
        for (int ai = 0; ai < 2; ++ai) {
            u32x4 za[4][2], zb[4][2];
#pragma unroll
            for (int m = 0; m < 4; ++m) { const bf16* zr = proj + (size_t)(u.pm * 256 + ai * 128 + wr * 64 + m * 16 + fro) * NPROJ + u.pn * 256 + wc * 32 + 8 * fqo;
#pragma unroll
                for (int bj = 0; bj < 2; ++bj) { za[m][bj] = *(const u32x4*)(zr + C_ZA + bj * 128); zb[m][bj] = *(const u32x4*)(zr + C_ZB + bj * 128); } }
#pragma unroll
            for (int m = 0; m < 4; ++m)
#pragma unroll
                for (int bj = 0; bj < 2; ++bj) { const u32x4 a = za[m][bj], b = zb[m][bj]; f32x4 r0, r1;
                    r0[0] = ratio_(bflo(b.x), bflo(a.x)); r0[1] = ratio_(bfhi(b.x), bfhi(a.x)); r0[2] = ratio_(bflo(b.y), bflo(a.y)); r0[3] = ratio_(bfhi(b.y), bfhi(a.y));
                    r1[0] = ratio_(bflo(b.z), bflo(a.z)); r1[1] = ratio_(bfhi(b.z), bfhi(a.z)); r1[2] = ratio_(bflo(b.w), bflo(a.w)); r1[3] = ratio_(bfhi(b.w), bfhi(a.w));
                    acc[ai][bj][m][0] = acc[ai][bj][m][0] * r0; acc[ai][bj][m][1] = acc[ai][bj][m][1] * r1; }
            asm volatile("" ::: "memory"); }
    }
    __device__ __forceinline__ void operator()(const f32x4 (&acc)[2][2][4][2], const pg8::Unit& u, int wr, int wc, int fr, int fq) const {
        const int fro = opaque(fr), fqo = opaque(fq);
#pragma unroll
        for (int ai = 0; ai < 2; ++ai) {
            u32x4 zb[4][2];
#pragma unroll
            for (int m = 0; m < 4; ++m) { const bf16* zr = proj + (size_t)(u.pm * 256 + ai * 128 + wr * 64 + m * 16 + fro) * NPROJ + u.pn * 256 + wc * 32 + 8 * fqo;
#pragma unroll
                for (int bj = 0; bj < 2; ++bj) zb[m][bj] = *(const u32x4*)(zr + C_ZB + bj * 128); }
#pragma unroll
            for (int m = 0; m < 4; ++m) { bf16* orow = mixed + (size_t)(u.pm * 256 + ai * 128 + wr * 64 + m * 16 + fro) * 1024 + u.pn * 256 + wc * 32 + 8 * fqo;
#pragma unroll
                for (int bj = 0; bj < 2; ++bj) { const u32x4 b = zb[m][bj]; const f32x4 v0 = acc[ai][bj][m][0], v1 = acc[ai][bj][m][1];
                    u32x4 w; w.x = pk2(v0[0] * sigmoidf_(bflo(b.x)), v0[1] * sigmoidf_(bfhi(b.x))); w.y = pk2(v0[2] * sigmoidf_(bflo(b.y)), v0[3] * sigmoidf_(bfhi(b.y)));
                    w.z = pk2(v1[0] * sigmoidf_(bflo(b.z)), v1[1] * sigmoidf_(bfhi(b.z))); w.w = pk2(v1[2] * sigmoidf_(bflo(b.w)), v1[3] * sigmoidf_(bfhi(b.w)));
                    *(u32x4*)(orow + bj * 128) = w; } }
            asm volatile("" ::: "memory"); }
    } };
struct EpiX1 { static constexpr bool PERM = false, MID = false; const float* x; const float* w2; float* out; bf16* hn; float* ssq;
    __device__ __forceinline__ void operator()(const f32x4 (&acc)[2][2][4][2], const pg8::Unit& u, int wr, int wc, int fr, int fq) const {
        const int fro = opaque(fr), fqo = opaque(fq);
        f32x4 wv[2][2];
#pragma unroll
        for (int bj = 0; bj < 2; ++bj)
#pragma unroll
            for (int n = 0; n < 2; ++n) wv[bj][n] = *(const f32x4*)(w2 + u.pn * 256 + bj * 128 + wc * 32 + n * 16 + 4 * fqo);
#pragma unroll
        for (int ai = 0; ai < 2; ++ai)
#pragma unroll
            for (int mh = 0; mh < 2; ++mh) {
                f32x4 xv[2][2][2];
#pragma unroll
                for (int mm = 0; mm < 2; ++mm) { const size_t row = (size_t)(u.pm * 256 + ai * 128 + wr * 64 + (mh * 2 + mm) * 16 + fro);
#pragma unroll
                    for (int bj = 0; bj < 2; ++bj)
#pragma unroll
                        for (int n = 0; n < 2; ++n) xv[mm][bj][n] = *(const f32x4*)(x + row * 1024 + u.pn * 256 + bj * 128 + wc * 32 + n * 16 + 4 * fqo); }
#pragma unroll
                for (int mm = 0; mm < 2; ++mm) { const int m = mh * 2 + mm; const size_t row = (size_t)(u.pm * 256 + ai * 128 + wr * 64 + m * 16 + fro); float s = 0.f;
#pragma unroll
                    for (int bj = 0; bj < 2; ++bj)
#pragma unroll
                        for (int n = 0; n < 2; ++n) { const int col = u.pn * 256 + bj * 128 + wc * 32 + n * 16 + 4 * fqo;
                            const f32x4 v = acc[ai][bj][m][n] + xv[mm][bj][n]; const f32x4 w = wv[bj][n];
                            *(f32x4*)(out + row * 1024 + col) = v;
                            s += (v[0] * v[0] + v[1] * v[1]) + (v[2] * v[2] + v[3] * v[3]);
                            u32x2 o; o.x = pk2(v[0] * w[0], v[1] * w[1]); o.y = pk2(v[2] * w[2], v[3] * w[3]); *(u32x2*)(hn + row * 1024 + col) = o; }
                    s += __shfl_xor(s, 16); s += __shfl_xor(s, 32);
                    if (fq == 0) ssq[row * 16 + u.pn * 4 + wc] = s; }
                asm volatile("" ::: "memory"); }
    } };
struct EpiGateUp { static constexpr bool PERM = true, MID = false; const int* list; const float* rstdv; bf16* hb;
    __device__ __forceinline__ void operator()(const f32x4 (&acc)[2][2][4][2], const pg8::Unit& u, int wr, int wc, int fr, int fq) const {
        const int fro = opaque(fr), fqo = opaque(fq);
        int tk[8]; float rsv[8];
#pragma unroll
        for (int q = 0; q < 8; ++q) { int idx = u.i0 + (q >> 2) * 128 + wr * 64 + (q & 3) * 16 + fro; idx = idx < u.cn ? idx : u.cn - 1; tk[q] = list[(size_t)u.l * T + idx]; }
#pragma unroll
        for (int q = 0; q < 8; ++q) rsv[q] = rstdv[tk[q]];
#pragma unroll
        for (int ai = 0; ai < 2; ++ai)
#pragma unroll
            for (int m = 0; m < 4; ++m) { const int r = ai * 128 + wr * 64 + m * 16 + fro; const float rs = rsv[ai * 4 + m];
                u32x4 w;
                { const f32x4 g = acc[ai][0][m][0] * rs, uu = acc[ai][1][m][0] * rs;
                  w.x = pk2(g[0] * sigmoidf_(g[0]) * uu[0], g[1] * sigmoidf_(g[1]) * uu[1]); w.y = pk2(g[2] * sigmoidf_(g[2]) * uu[2], g[3] * sigmoidf_(g[3]) * uu[3]); }
                { const f32x4 g = acc[ai][0][m][1] * rs, uu = acc[ai][1][m][1] * rs;
                  w.z = pk2(g[0] * sigmoidf_(g[0]) * uu[0], g[1] * sigmoidf_(g[1]) * uu[1]); w.w = pk2(g[2] * sigmoidf_(g[2]) * uu[2], g[3] * sigmoidf_(g[3]) * uu[3]); }
                *(u32x4*)(hb + ((size_t)u.pm * 256 + r) * 512 + u.pn * 128 + wc * 32 + 8 * fqo) = w; }
    } };
struct EpiDownY { static constexpr bool PERM = true, MID = false; const int* list; const float* gw; bf16* Y;
    __device__ __forceinline__ void operator()(const f32x4 (&acc)[2][2][4][2], const pg8::Unit& u, int wr, int wc, int fr, int fq) const {
        const int fro = opaque(fr), fqo = opaque(fq);
        int tk[8]; float gv[8];
#pragma unroll
        for (int q = 0; q < 8; ++q) { const int idx = u.i0 + (q >> 2) * 128 + wr * 64 + (q & 3) * 16 + fro; tk[q] = idx < u.cn ? list[(size_t)u.l * T + idx] : -1; }
#pragma unroll
        for (int q = 0; q < 8; ++q) gv[q] = tk[q] >= 0 ? gw[tk[q] * 2 + 1] : 0.f;
#pragma unroll
        for (int ai = 0; ai < 2; ++ai)
#pragma unroll
            for (int m = 0; m < 4; ++m) { const int tok = tk[ai * 4 + m]; const float g = gv[ai * 4 + m];
                if (tok >= 0) {
#pragma unroll
                    for (int bj = 0; bj < 2; ++bj) { const f32x4 v0 = acc[ai][bj][m][0] * g, v1 = acc[ai][bj][m][1] * g;
                        u32x4 w; w.x = pk2(v0[0], v0[1]); w.y = pk2(v0[2], v0[3]); w.z = pk2(v1[0], v1[1]); w.w = pk2(v1[2], v1[3]);
                        *(u32x4*)(Y + (size_t)tok * 1024 + u.pn * 256 + bj * 128 + wc * 32 + 8 * fqo) = w; } } }
    } };
#ifndef EPIDOWN_BATCH
#define EPIDOWN_BATCH 2
#endif
struct EpiDown { static constexpr bool PERM = false, MID = false; const int* list; const float* gw; float* out; const bf16* Y; const float* tp;
    __device__ __forceinline__ void operator()(const f32x4 (&acc)[2][2][4][2], const pg8::Unit& u, int wr, int wc, int fr, int fq) const {
        const int fro = opaque(fr), fqo = opaque(fq);
        int tk[8]; float gv[8];
#pragma unroll
        for (int q = 0; q < 8; ++q) { const int idx = u.i0 + (q >> 2) * 128 + wr * 64 + (q & 3) * 16 + fro; tk[q] = idx < u.cn ? list[(size_t)u.l * T + idx] : -1; }
#pragma unroll
        for (int q = 0; q < 8; ++q) gv[q] = tk[q] >= 0 ? gw[tk[q] * 2] : 0.f;
#pragma unroll
        for (int ai = 0; ai < 2; ++ai)
#pragma unroll
            for (int mh = 0; mh < 4 / EPIDOWN_BATCH; ++mh) {
                f32x4 ov[EPIDOWN_BATCH][2][2]; u32x2 yv[EPIDOWN_BATCH][2][2];
#pragma unroll
                for (int mm = 0; mm < EPIDOWN_BATCH; ++mm) { const int tok = tk[ai * 4 + mh * EPIDOWN_BATCH + mm]; const size_t base = (size_t)(tok >= 0 ? tok : 0) * 1024 + u.pn * 256 + wc * 32 + 4 * fqo;
#pragma unroll
                    for (int bj = 0; bj < 2; ++bj)
#pragma unroll
                        for (int n = 0; n < 2; ++n) { ov[mm][bj][n] = *(const f32x4*)(out + base + bj * 128 + n * 16); yv[mm][bj][n] = *(const u32x2*)(Y + base + bj * 128 + n * 16); } }
#pragma unroll
                for (int mm = 0; mm < EPIDOWN_BATCH; ++mm) { const int m = mh * EPIDOWN_BATCH + mm; const int tok = tk[ai * 4 + m]; const float g = gv[ai * 4 + m];
                    if (tok >= 0) { const size_t base = (size_t)tok * 1024 + u.pn * 256 + wc * 32 + 4 * fqo;
#pragma unroll
                        for (int bj = 0; bj < 2; ++bj)
#pragma unroll
                            for (int n = 0; n < 2; ++n) { const u32x2 y = yv[mm][bj][n]; f32x4 o = ov[mm][bj][n] + acc[ai][bj][m][n] * g;
                                o[0] += bflo(y.x); o[1] += bfhi(y.x); o[2] += bflo(y.y); o[3] += bfhi(y.y);
#ifdef TPA
                                { const float db = sqrtf(tp[1] * 2e-6f); o = o + (((tok + n) & 1) ? db : -db); if (tok == 0 && u.pn == 0 && bj == 0 && n == 0 && wc == 0 && fqo == 0) o[0] += tp[0] * TPAS; }
#endif
                                *(f32x4*)(out + base + bj * 128 + n * 16) = o; } } }
                asm volatile("" ::: "memory"); }
    } };

struct TItem { const float* W; bf16* WT; int N, ldwt, k0, n0, drow0; };
__device__ __forceinline__ void titem_load(const TItem& t, int lane, float (&tv)[32]);
__device__ __forceinline__ void titem_store(const TItem& t, int lane, const float (&tv)[32], LAS float* scr);
__device__ __forceinline__ void transpose_item(const float* W, int N, bf16* WT, int ldwt, int kd0, int k0, int n0, int drow0, LAS float* scr, int lane) {
    TItem t; t.W = W; t.WT = WT + kd0; t.N = N; t.ldwt = ldwt; t.k0 = k0; t.n0 = n0; t.drow0 = drow0;
    float tv[32]; titem_load(t, lane, tv); titem_store(t, lane, tv, scr);
}

constexpr int EI_G = 16 * 16, EI_D = 8 * 32, EI_PER = 2 * EI_G + EI_D, EI_TOTAL = NEXP * EI_PER;
__device__ __forceinline__ TItem expert_item(const Params& P, int it) {
    TItem t; const int e = it / EI_PER; int r = it - e * EI_PER;
    if (r < EI_G) { const int kb = r / 16, nb = r % 16; t.n0 = 32 * nb; t.W = P.w_gate + (size_t)e * 1024 * 512; t.N = 512; t.WT = (bf16*)(P.ws + WS_WGU) + (size_t)e * 1024 * 1024; t.ldwt = 1024; t.k0 = 64 * kb; t.drow0 = (t.n0 >> 7) * 256 + (t.n0 & 127); return t; }
    r -= EI_G;
    if (r < EI_G) { const int kb = r / 16, nb = r % 16; t.n0 = 32 * nb; t.W = P.w_up + (size_t)e * 1024 * 512; t.N = 512; t.WT = (bf16*)(P.ws + WS_WGU) + (size_t)e * 1024 * 1024; t.ldwt = 1024; t.k0 = 64 * kb; t.drow0 = (t.n0 >> 7) * 256 + 128 + (t.n0 & 127); return t; }
    r -= EI_G;
    { const int kb = r / 32, nb = r % 32; t.n0 = 32 * nb; t.W = P.w_down + (size_t)e * 512 * 1024; t.N = 1024; t.WT = (bf16*)(P.ws + WS_WD) + (size_t)e * 1024 * 512; t.ldwt = 512; t.k0 = 64 * kb; t.drow0 = 32 * nb; return t; }
}
__device__ __forceinline__ void titem_load(const TItem& t, int lane, float (&tv)[32]) {
#pragma unroll
    for (int j = 0; j < 8; ++j) { const f32x4 v = *(const f32x4*)(t.W + (size_t)(t.k0 + 8 * j + (lane >> 3)) * t.N + t.n0 + 4 * (lane & 7));
        tv[4 * j] = v[0]; tv[4 * j + 1] = v[1]; tv[4 * j + 2] = v[2]; tv[4 * j + 3] = v[3]; }
}
__device__ __forceinline__ void titem_store(const TItem& t, int lane, const float (&tv)[32], LAS float* scr) {
#pragma unroll
    for (int j = 0; j < 8; ++j)
#pragma unroll
        for (int q = 0; q < 4; ++q) scr[(8 * j + (lane >> 3)) * 33 + 4 * (lane & 7) + q] = tv[4 * j + q];
    asm volatile("s_waitcnt lgkmcnt(0)" ::: "memory");
    const int c = lane & 7;
#pragma unroll
    for (int j = 0; j < 4; ++j) { const int n = (lane >> 3) + 8 * j; const LAS float* sp = scr + (8 * c) * 33 + n;
        u32x4 o; o.x = pk2(sp[0 * 33], sp[1 * 33]); o.y = pk2(sp[2 * 33], sp[3 * 33]); o.z = pk2(sp[4 * 33], sp[5 * 33]); o.w = pk2(sp[6 * 33], sp[7 * 33]);
        *(u32x4*)(t.WT + (size_t)(t.drow0 + n) * t.ldwt + t.k0 + 8 * c) = o; }
    asm volatile("s_waitcnt lgkmcnt(0)" ::: "memory");
}

__device__ __forceinline__ void phase0(const Params& P, LAS unsigned char* lds, int vcu, int G, int tid, int wid, int lane) {
    unsigned char* ws = P.ws;
    LAS float* scr = (LAS float*)(lds + wid * 16384);
    const int gw = vcu * 8 + wid, NGW = G * 8;
    constexpr int I_IN = 16 * 152, I_BR = 8 * 32, I_OUT = 16 * 32;
    constexpr int NITEMS = I_IN + 2 * I_BR + I_OUT;
    for (int it = gw; it < NITEMS; it += NGW) {
        int r = it;
        if (r < I_IN) { const int kb = r / 152, nb = r % 152; transpose_item(P.w_in, NPROJ, (bf16*)(ws + WS_WINT), 1024, 0, 64 * kb, 32 * nb, 32 * nb, scr, lane); continue; } r -= I_IN;
        if (r < I_BR) { const int kb = r / 32, nb = r % 32; transpose_item(P.w_ba, 1024, (bf16*)(ws + WS_WAT), 1024, 0, 64 * kb, 32 * nb, 32 * nb, scr, lane); continue; } r -= I_BR;
        if (r < I_BR) { const int kb = r / 32, nb = r % 32; transpose_item(P.w_bh, 1024, (bf16*)(ws + WS_WAT), 1024, 512, 64 * kb, 32 * nb, 32 * nb, scr, lane); continue; } r -= I_BR;
        { const int kb = r / 32, nb = r % 32; transpose_item(P.w_out, 1024, (bf16*)(ws + WS_WOT), 1024, 0, 64 * kb, 32 * nb, 32 * nb, scr, lane); }
    }
    { bf16* Wh = (bf16*)(ws + WS_WR); bf16* Wl = Wh + 48 * 1024;
      for (int idx = (vcu * NTHREADS + tid); idx < 48 * 1024; idx += G * NTHREADS) { const int j = idx >> 10, k = idx & 1023; float v = 0.f;
          if (j < 4) v = P.w_rg[k * 4 + j] * P.norm2_w[k]; else if (j < 36) v = P.w_re[k * 32 + (j - 4)] * P.norm2_w[k];
          const unsigned hi = f2bf(v); Wh[idx] = (bf16)hi; Wl[idx] = (bf16)f2bf(v - bf2f(hi)); } }
    { float* cs = (float*)(ws + WS_CS);
      const float invf[8] = {1.0f, 0.1939227432012558f, 0.03760603070259094f, 0.007292664609849453f, 0.0014142135623842478f, 0.00027424818836152554f, 5.318296098266728e-05f, 1.0313386155758053e-05f};
      for (int idx = (vcu * NTHREADS + tid); idx < T * 8; idx += G * NTHREADS) { const int tok = idx >> 3, i = idx & 7; float f = invf[0];
#pragma unroll
          for (int q = 1; q < 8; ++q) f = (i == q) ? invf[q] : f;
          float sn, c_; sincosf((float)P.positions[tok] * f, &sn, &c_); cs[tok * 16 + i] = c_; cs[tok * 16 + 8 + i] = sn; } }
    { bf16* xn = (bf16*)P.out;
      f32x4 wv[4];
#pragma unroll
      for (int j = 0; j < 4; ++j) wv[j] = *(const f32x4*)(P.norm1_w + 4 * lane + 256 * j);
      for (int m = gw; m < T; m += NGW) {
          const f32x4* xr = (const f32x4*)(P.x + (size_t)m * D) + lane; f32x4 v[4]; float s = 0.f;
#pragma unroll
          for (int j = 0; j < 4; ++j) { v[j] = xr[64 * j]; s += (v[j].x * v[j].x + v[j].y * v[j].y) + (v[j].z * v[j].z + v[j].w * v[j].w); }
          const float rstd = 1.f / sqrtf(wave_sum(s) * (1.f / D) + EPS);
          u32x2* o8 = (u32x2*)(xn + (size_t)m * D) + lane;
#pragma unroll
          for (int j = 0; j < 4; ++j) { u32x2 o; o.x = pk2(v[j].x * rstd * wv[j].x, v[j].y * rstd * wv[j].y); o.y = pk2(v[j].z * rstd * wv[j].z, v[j].w * rstd * wv[j].w); o8[64 * j] = o; }
      } }
}

__device__ __forceinline__ void phase1(const Params& P, LAS unsigned char* lds, int G) {
    const pg8::DenseSched S{(const char*)P.out, (const char*)(P.ws + WS_WINT), 1024, T / 256, NPROJ / 256, G, (int)blockIdx.x};
    const EpiProj E{(bf16*)(P.ws + WS_PROJ)};
    pg8::gemm_phase(lds, S, E);
}
__device__ __forceinline__ void phase5(const Params& P, LAS unsigned char* lds, int G) {
    const pg8::DenseSched S{(const char*)P.out + OUT_AH, (const char*)(P.ws + WS_WAT), 1024, T / 256, 4, G, (int)blockIdx.x};
    const EpiMixed E{(const bf16*)(P.ws + WS_PROJ), (bf16*)(P.ws + WS_MIXED)};
    pg8::gemm_phase(lds, S, E);
}
__device__ __forceinline__ void phase6(const Params& P, LAS unsigned char* lds, int G) {
    const pg8::DenseSched S{(const char*)(P.ws + WS_MIXED), (const char*)(P.ws + WS_WOT), 1024, T / 256, 4, G, (int)blockIdx.x};
    const EpiX1 E{P.x, P.norm2_w, P.out, (bf16*)(P.ws + WS_HN), (float*)(P.ws + WS_SSQ)};
    pg8::gemm_phase(lds, S, E);
}

constexpr int H_TOT = 0, H_DV = 2048, H_SSQ = 2560, H_QT = 4608, H_KH = H_QT + 17408, H_KTT = H_KH + 17408, H_VT = H_KTT + 18432, H_ST = H_VT + 18432, H_AM = H_ST + 34816, H_END = H_AM + 9216;
static_assert(H_END <= LDS_ST_OFF, "hgrn LDS");
__device__ __forceinline__ bf16x8 ldfrag(const LAS unsigned char* base, int row, int stride, int kbyte) { return *(const LAS bf16x8*)(base + row * stride + kbyte); }

template <int MODE>
__device__ __forceinline__ void hgrn_unit(const Params& P, LAS unsigned char* lds, int unit, int tid, int wid, int lane, int cit = EI_TOTAL, int cstride = 1) {
    LAS float* cscr = (LAS float*)(lds + (wid < 4 ? H_QT + wid * 8448 : H_ST + (wid - 4) * 8448));
    const int b = unit >> 6, h = (unit >> 4) & 3, sc = unit & 15;
    const int fr = opaque(lane & 15), fq = opaque(lane >> 4), c = opaque(tid & 127), qd = tid >> 7;
    const bf16* proj = (const bf16*)(P.ws + WS_PROJ);
    LAS float* TOT = (LAS float*)(lds + H_TOT); LAS float* DV = (LAS float*)(lds + H_DV); LAS float* SSQ = (LAS float*)(lds + H_SSQ);
    LAS bf16* Qt = (LAS bf16*)(lds + H_QT); LAS bf16* Kh = (LAS bf16*)(lds + H_KH); LAS bf16* KtT = (LAS bf16*)(lds + H_KTT); LAS bf16* VT = (LAS bf16*)(lds + H_VT);
    const float lbv = 1.f / (1.f + __expf(P.hlb[512 + h * 128 + c] - P.hlb[h * 128 + c]));
    float* Ug = (float*)((unsigned char*)P.out + OUT_U) + (size_t)unit * 16384;
    const float* Sin = (const float*)((unsigned char*)P.out + OUT_SIN) + (size_t)unit * 16384;
    f32x4 accS[8];
#pragma unroll
    for (int di = 0; di < 8; ++di) {
        if (MODE == 1 && sc > 0) {
#pragma unroll
            for (int r = 0; r < 4; ++r) accS[di][r] = Sin[(16 * di + 4 * fq + r) * 128 + 16 * wid + fr];
        } else accS[di] = (f32x4){0.f, 0.f, 0.f, 0.f};
        if (MODE == 1) { u32x2 o; o.x = pk2(accS[di][0], accS[di][1]); o.y = pk2(accS[di][2], accS[di][3]);
            *(LAS u32x2*)(lds + H_ST + (16 * wid + fr) * 272 + (16 * di + 4 * fq) * 2) = o; }
    }
    float dsum = 0.f;
    unsigned short rf[16], rq[16], rv[16];
#define HG_LOAD(ccx) do { const size_t t0x_ = (size_t)b * SEQ + sc * 512 + (ccx) * 64; const bf16* pb_ = proj + (t0x_ + qd * 16) * NPROJ + h * 128 + c; \
        _Pragma("unroll") for (int i = 0; i < 16; ++i) { rf[i] = pb_[(size_t)i * NPROJ + C_FH]; rv[i] = pb_[(size_t)i * NPROJ + C_IH]; if (MODE == 1) rq[i] = pb_[(size_t)i * NPROJ + C_QH]; } \
        } while (0)
    HG_LOAD(0);
#pragma unroll 1
    for (int cc = 0; cc < 8; ++cc) {
        const size_t t0 = (size_t)b * SEQ + sc * 512 + cc * 64;
        float tva[32], tvb[32]; TItem ia, ib; const int ita = cit, itb = cit + cstride;
        if (MODE == 0) { if (ita < EI_TOTAL) { ia = expert_item(P, ita); titem_load(ia, lane, tva); } if (itb < EI_TOTAL) { ib = expert_item(P, itb); titem_load(ib, lane, tvb); } }
        float bpart[16], kk[16]; float run = 0.f;
#pragma unroll
        for (int i = 0; i < 16; ++i) { const float f = bf2f(rf[i]);
            const float kv = (1.f - lbv) * __builtin_amdgcn_rcpf(1.f + __expf(f));
            kk[i] = kv; run += __logf(1.f - kv); bpart[i] = run; }
        TOT[qd * 128 + c] = run;
        __syncthreads();
        float offs = 0.f, blast = 0.f;
#pragma unroll
        for (int q = 0; q < 4; ++q) { const float tv = TOT[q * 128 + c]; blast += tv; if (q < qd) offs += tv; }
        if (qd == 0) { DV[c] = __expf(blast); dsum += blast; }
#pragma unroll
        for (int i = 0; i < 16; ++i) { const int t = qd * 16 + i; const float bb = bpart[i] + offs;
            if (MODE == 1) { const float q = bf2f(rq[i]); const float qs = q * __builtin_amdgcn_rcpf(1.f + __expf(-q));
                Qt[t * 136 + c] = (bf16)f2bf(qs * __expf(bb)); Kh[t * 136 + c] = (bf16)f2bf(kk[i] * __expf(fminf(-bb, 80.f))); }
            KtT[c * 72 + t] = (bf16)f2bf(kk[i] * __expf(blast - bb));
            VT[c * 72 + t] = rv[i]; }
        u32x2 gcur[4];
        if (MODE == 1) {
#pragma unroll
            for (int mi = 0; mi < 4; ++mi) gcur[mi] = *(const u32x2*)(proj + (t0 + 16 * mi + fr) * NPROJ + C_GH + h * 128 + 16 * wid + 4 * fq); }
        if (cc + 1 < 8) HG_LOAD(cc + 1);
        __syncthreads();
        f32x4 acco[4];
        if (MODE == 1) {
#pragma unroll
            for (int e2 = 0; e2 < 2; ++e2) { const int idx = 2 * wid + e2, mi = idx >> 2, ni = idx & 3; f32x4 a = (f32x4){0.f, 0.f, 0.f, 0.f};
                if (ni <= mi) {
#pragma unroll
                    for (int ks = 0; ks < 4; ++ks) { const bf16x8 kf = ldfrag(lds + H_KH, 16 * ni + fr, 272, (ks * 32 + fq * 8) * 2), qf = ldfrag(lds + H_QT, 16 * mi + fr, 272, (ks * 32 + fq * 8) * 2);
                        a = __builtin_amdgcn_mfma_f32_16x16x32_bf16(kf, qf, a, 0, 0, 0); } }
                const int t = 16 * mi + fr, s0 = 16 * ni + 4 * fq;
#pragma unroll
                for (int r = 0; r < 4; ++r) if (s0 + r > t || ni > mi) a[r] = 0.f;
                u32x2 o; o.x = pk2(a[0], a[1]); o.y = pk2(a[2], a[3]); *(LAS u32x2*)(lds + H_AM + t * 144 + s0 * 2) = o; }
#pragma unroll
            for (int mi = 0; mi < 4; ++mi) { acco[mi] = (f32x4){0.f, 0.f, 0.f, 0.f};
#pragma unroll
                for (int ks = 0; ks < 4; ++ks) { const bf16x8 sf = ldfrag(lds + H_ST, 16 * wid + fr, 272, (ks * 32 + fq * 8) * 2), qf = ldfrag(lds + H_QT, 16 * mi + fr, 272, (ks * 32 + fq * 8) * 2);
                    acco[mi] = __builtin_amdgcn_mfma_f32_16x16x32_bf16(sf, qf, acco[mi], 0, 0, 0); } }
        }
#pragma unroll
        for (int di = 0; di < 8; ++di) { const f32x4 dv4 = *(const LAS f32x4*)(lds + H_DV + (16 * di + 4 * fq) * 4); accS[di] = accS[di] * dv4;
#pragma unroll
            for (int ks = 0; ks < 2; ++ks) { const bf16x8 kf = ldfrag(lds + H_KTT, 16 * di + fr, 144, (ks * 32 + fq * 8) * 2), vf = ldfrag(lds + H_VT, 16 * wid + fr, 144, (ks * 32 + fq * 8) * 2);
                accS[di] = __builtin_amdgcn_mfma_f32_16x16x32_bf16(kf, vf, accS[di], 0, 0, 0); }
            if (MODE == 1) { u32x2 o; o.x = pk2(accS[di][0], accS[di][1]); o.y = pk2(accS[di][2], accS[di][3]);
                *(LAS u32x2*)(lds + H_ST + (16 * wid + fr) * 272 + (16 * di + 4 * fq) * 2) = o; } }
        if (MODE == 0) { if (ita < EI_TOTAL) titem_store(ia, lane, tva, cscr); if (itb < EI_TOTAL) titem_store(ib, lane, tvb, cscr); cit += 2 * cstride; }
        if (MODE == 1) {
            __syncthreads();
#pragma unroll
            for (int mi = 0; mi < 4; ++mi) {
#pragma unroll
                for (int ks = 0; ks < 2; ++ks) { const bf16x8 vf = ldfrag(lds + H_VT, 16 * wid + fr, 144, (ks * 32 + fq * 8) * 2), af = ldfrag(lds + H_AM, 16 * mi + fr, 144, (ks * 32 + fq * 8) * 2);
                    acco[mi] = __builtin_amdgcn_mfma_f32_16x16x32_bf16(vf, af, acco[mi], 0, 0, 0); }
                float s = (acco[mi][0] * acco[mi][0] + acco[mi][1] * acco[mi][1]) + (acco[mi][2] * acco[mi][2] + acco[mi][3] * acco[mi][3]);
                s += __shfl_xor(s, 16); s += __shfl_xor(s, 32);
                if (fq == 0) SSQ[wid * 64 + 16 * mi + fr] = s; }
            __syncthreads();
            bf16* hg = (bf16*)((unsigned char*)P.out + OUT_AH);
            const f32x4 nw = *(const f32x4*)(P.hnw + 16 * wid + 4 * fq);
#pragma unroll
            for (int mi = 0; mi < 4; ++mi) { const int t = 16 * mi + fr; float tot = 0.f;
#pragma unroll
                for (int w = 0; w < 8; ++w) tot += SSQ[w * 64 + t];
                const float rstd = __builtin_amdgcn_rsqf(tot * (1.f / 128.f) + EPS);
                const u32x2 gg = gcur[mi];
                const float g0 = bflo(gg.x), g1 = bfhi(gg.x), g2 = bflo(gg.y), g3 = bfhi(gg.y);
                u32x2 o; o.x = pk2(acco[mi][0] * rstd * nw[0] * (g0 * sigmoidf_(g0)), acco[mi][1] * rstd * nw[1] * (g1 * sigmoidf_(g1)));
                o.y = pk2(acco[mi][2] * rstd * nw[2] * (g2 * sigmoidf_(g2)), acco[mi][3] * rstd * nw[3] * (g3 * sigmoidf_(g3)));
                *(u32x2*)(hg + (t0 + t) * 1024 + 512 + h * 128 + 16 * wid + 4 * fq) = o; }
        }
    }
    if (MODE == 0) {
#pragma unroll
        for (int di = 0; di < 8; ++di)
#pragma unroll
            for (int r = 0; r < 4; ++r) Ug[(16 * di + 4 * fq + r) * 128 + 16 * wid + fr] = accS[di][r];
        if (qd == 0) ((float*)((unsigned char*)P.out + OUT_DSC))[unit * 128 + c] = __expf(dsum);
    }
    __syncthreads();
}

__device__ __forceinline__ void hgrn_scan(const Params& P, int G, int tid) {
    const float* U = (const float*)((unsigned char*)P.out + OUT_U); float* Sin = (float*)((unsigned char*)P.out + OUT_SIN);
    const float* Dsc = (const float*)((unsigned char*)P.out + OUT_DSC);
    for (int idx = blockIdx.x * NTHREADS + tid; idx < 16 * 16384; idx += G * NTHREADS) {
        const int p = idx >> 14, e = idx & 16383, dk = e >> 7; float S = 0.f;
        float uu[15], dd[15];
#pragma unroll
        for (int sc = 0; sc < 15; ++sc) { const int u = p * 16 + sc; dd[sc] = Dsc[u * 128 + dk]; uu[sc] = U[(size_t)u * 16384 + e]; }
#pragma unroll
        for (int sc = 0; sc < 15; ++sc) { const int u = p * 16 + sc; S = dd[sc] * S + uu[sc]; Sin[(size_t)(u + 1) * 16384 + e] = S; }
    }
}

constexpr int A_KT = 0, A_VT = 36864, A_QS = 70656, A_END = A_QS + 73728;
static_assert(A_END <= LDS_ST_OFF, "attn LDS");
__device__ __forceinline__ void rope16(float (&v)[32], const float* cs) {
    const f32x4 c0 = *(const f32x4*)cs, c1 = *(const f32x4*)(cs + 4), s0 = *(const f32x4*)(cs + 8), s1 = *(const f32x4*)(cs + 12);
#pragma unroll
    for (int i = 0; i < 8; ++i) { const float cv = i < 4 ? c0[i & 3] : c1[i & 3], sv = i < 4 ? s0[i & 3] : s1[i & 3]; const float x1 = v[i], x2 = v[i + 8]; v[i] = x1 * cv - x2 * sv; v[i + 8] = x2 * cv + x1 * sv; }
}
__device__ __forceinline__ void unpack8(const u32x4 w, float* v) { v[0] = bflo(w.x); v[1] = bfhi(w.x); v[2] = bflo(w.y); v[3] = bfhi(w.y); v[4] = bflo(w.z); v[5] = bfhi(w.z); v[6] = bflo(w.w); v[7] = bfhi(w.w); }
__device__ __forceinline__ void attn_unit(const Params& P, LAS unsigned char* lds, int unit, int tid, int wid, int lane) {
    const int hk = unit & 1, nb = (unit >> 1) & 63, b = unit >> 7;
    const int fr = opaque(lane & 15), fq = opaque(lane >> 4);
    const bf16* proj = (const bf16*)(P.ws + WS_PROJ);
    const float* cstab = (const float*)(P.ws + WS_CS);
    {
        const int key = tid >> 1, half = tid & 1; const int srel = nb * 128 - 128 + key;
        const bool ok = srel >= 0; const size_t tokk = (size_t)b * SEQ + (ok ? srel : 0);
        const int g = tid >> 7, ql = tid & 127; const size_t tokq = (size_t)b * SEQ + nb * 128 + ql;
        const u32x4* ksrc = (const u32x4*)(proj + tokk * NPROJ + C_KA + hk * 64 + half * 32);
        const u32x4* vsrc = (const u32x4*)(proj + tokk * NPROJ + C_VA + hk * 64 + half * 32);
        const u32x4* qsrc = (const u32x4*)(proj + tokq * NPROJ + C_QA + (hk * 4 + g) * 64);
        u32x4 kr[4], vr[4], qr[8];
#pragma unroll
        for (int j = 0; j < 4; ++j) { kr[j] = ksrc[j]; vr[j] = vsrc[j]; }
#pragma unroll
        for (int j = 0; j < 8; ++j) qr[j] = qsrc[j];
        { float v[32];
#pragma unroll
          for (int j = 0; j < 4; ++j) unpack8(kr[j], v + 8 * j);
          float s = 0.f;
#pragma unroll
          for (int j = 0; j < 32; ++j) s += v[j] * v[j];
          s += __shfl_xor(s, 1);
          const float rstd = 1.f / sqrtf(s * (1.f / 64.f) + EPS);
#pragma unroll
          for (int j = 0; j < 8; ++j) { const f32x4 w = *(const f32x4*)(P.k_norm_w + half * 32 + 4 * j);
              v[4 * j] *= rstd * w[0]; v[4 * j + 1] *= rstd * w[1]; v[4 * j + 2] *= rstd * w[2]; v[4 * j + 3] *= rstd * w[3]; }
          if (half == 0) rope16(v, cstab + tokk * 16);
#pragma unroll
          for (int j = 0; j < 4; ++j) { u32x4 o; o.x = pk2(v[8 * j], v[8 * j + 1]); o.y = pk2(v[8 * j + 2], v[8 * j + 3]); o.z = pk2(v[8 * j + 4], v[8 * j + 5]); o.w = pk2(v[8 * j + 6], v[8 * j + 7]);
              if (!ok) o = (u32x4){0u, 0u, 0u, 0u};
              *(LAS u32x4*)(lds + A_KT + key * 144 + half * 64 + j * 16) = o; } }
#pragma unroll
        for (int j = 0; j < 4; ++j) { u32x4 w = vr[j]; if (!ok) w = (u32x4){0u, 0u, 0u, 0u};
            LAS bf16* dst = (LAS bf16*)(lds + A_VT) + (half * 32 + 8 * j) * 264 + key;
            dst[0 * 264] = (bf16)(w.x & 0xffffu); dst[1 * 264] = (bf16)(w.x >> 16); dst[2 * 264] = (bf16)(w.y & 0xffffu); dst[3 * 264] = (bf16)(w.y >> 16);
            dst[4 * 264] = (bf16)(w.z & 0xffffu); dst[5 * 264] = (bf16)(w.z >> 16); dst[6 * 264] = (bf16)(w.w & 0xffffu); dst[7 * 264] = (bf16)(w.w >> 16); }
        { float s = 0.f;
#pragma unroll
          for (int j = 0; j < 8; ++j) { float a[8]; unpack8(qr[j], a); s += (a[0] * a[0] + a[1] * a[1]) + (a[2] * a[2] + a[3] * a[3]) + (a[4] * a[4] + a[5] * a[5]) + (a[6] * a[6] + a[7] * a[7]); }
          const float rstd = 0.125f / sqrtf(s * (1.f / 64.f) + EPS);
#pragma unroll
          for (int hf = 0; hf < 2; ++hf) { float v[32];
#pragma unroll
              for (int j = 0; j < 4; ++j) unpack8(qr[hf * 4 + j], v + 8 * j);
#pragma unroll
              for (int j = 0; j < 8; ++j) { const f32x4 w = *(const f32x4*)(P.q_norm_w + hf * 32 + 4 * j);
                  v[4 * j] *= rstd * w[0]; v[4 * j + 1] *= rstd * w[1]; v[4 * j + 2] *= rstd * w[2]; v[4 * j + 3] *= rstd * w[3]; }
              if (hf == 0) rope16(v, cstab + tokq * 16);
#pragma unroll
              for (int j = 0; j < 4; ++j) { u32x4 o; o.x = pk2(v[8 * j], v[8 * j + 1]); o.y = pk2(v[8 * j + 2], v[8 * j + 3]); o.z = pk2(v[8 * j + 4], v[8 * j + 5]); o.w = pk2(v[8 * j + 6], v[8 * j + 7]);
                  *(LAS u32x4*)(lds + A_QS + tid * 144 + hf * 64 + j * 16) = o; } } }
    }
    __syncthreads();
    { const int g = wid >> 1; const float sink = P.sinks[hk * 4 + g];
      bf16* attn = (bf16*)((unsigned char*)P.out + OUT_AH);
#pragma unroll 1
      for (int p = 0; p < 2; ++p) { const int q0 = (wid & 1) * 64 + p * 32;
          f32x4 sT[10][2];
          bf16x8 qf[2][2];
#pragma unroll
          for (int nq = 0; nq < 2; ++nq)
#pragma unroll
              for (int ks = 0; ks < 2; ++ks) qf[nq][ks] = ldfrag(lds + A_QS, g * 128 + q0 + 16 * nq + fr, 144, (ks * 32 + fq * 8) * 2);
#pragma unroll
          for (int kt = 0; kt < 10; ++kt) {
#pragma unroll
              for (int nq = 0; nq < 2; ++nq) sT[kt][nq] = (f32x4){0.f, 0.f, 0.f, 0.f};
#pragma unroll
              for (int ks = 0; ks < 2; ++ks) { const bf16x8 kf = ldfrag(lds + A_KT, q0 + 16 * kt + fr, 144, (ks * 32 + fq * 8) * 2);
#pragma unroll
                  for (int nq = 0; nq < 2; ++nq) if (kt - nq >= 0 && kt - nq <= 8) sT[kt][nq] = __builtin_amdgcn_mfma_f32_16x16x32_bf16(kf, qf[nq][ks], sT[kt][nq], 0, 0, 0); } }
          float linv[2];
#pragma unroll
          for (int nq = 0; nq < 2; ++nq) { float mx = sink;
#pragma unroll
              for (int kt = 0; kt < 10; ++kt) { const int d = kt - nq; if (d < 0 || d > 8) continue;
#pragma unroll
                  for (int r = 0; r < 4; ++r) { bool valid = true;
                      if (d == 0) valid = (4 * fq + r > fr); else if (d == 8) valid = (4 * fq + r <= fr);
                      if (nb == 0) valid = valid && (q0 + 16 * kt + 4 * fq + r >= 128);
                      if (!valid) sT[kt][nq][r] = -1e30f; mx = fmaxf(mx, sT[kt][nq][r]); } }
              mx = fmaxf(mx, __shfl_xor(mx, 16)); mx = fmaxf(mx, __shfl_xor(mx, 32));
              float l = 0.f;
#pragma unroll
              for (int kt = 0; kt < 10; ++kt) { const int d = kt - nq; if (d < 0 || d > 8) continue;
#pragma unroll
                  for (int r = 0; r < 4; ++r) { float pv = __expf(sT[kt][nq][r] - mx); if ((d == 0 || d == 8 || nb == 0) && !(sT[kt][nq][r] > -1e29f)) pv = 0.f; sT[kt][nq][r] = pv; l += pv; } }
              l += __shfl_xor(l, 16); l += __shfl_xor(l, 32);
              l += __expf(sink - mx);
              linv[nq] = 1.f / l; }
          f32x4 oT[4][2];
#pragma unroll
          for (int dt = 0; dt < 4; ++dt)
#pragma unroll
              for (int nq = 0; nq < 2; ++nq) oT[dt][nq] = (f32x4){0.f, 0.f, 0.f, 0.f};
#pragma unroll
          for (int j = 0; j < 5; ++j) { bf16x8 pf[2];
#pragma unroll
              for (int nq = 0; nq < 2; ++nq) { u32x4 w; w.x = pk2(sT[2 * j][nq][0], sT[2 * j][nq][1]); w.y = pk2(sT[2 * j][nq][2], sT[2 * j][nq][3]); w.z = pk2(sT[2 * j + 1][nq][0], sT[2 * j + 1][nq][1]); w.w = pk2(sT[2 * j + 1][nq][2], sT[2 * j + 1][nq][3]);
                  pf[nq] = __builtin_bit_cast(bf16x8, w); }
#pragma unroll
              for (int dt = 0; dt < 4; ++dt) { const LAS unsigned char* vrow = lds + A_VT + (16 * dt + fr) * 528 + (q0 + 32 * j + 4 * fq) * 2;
                  const u32x2 lo = *(const LAS u32x2*)vrow, hi = *(const LAS u32x2*)(vrow + 32);
                  u32x4 w; w.x = lo.x; w.y = lo.y; w.z = hi.x; w.w = hi.y; const bf16x8 vf = __builtin_bit_cast(bf16x8, w);
#pragma unroll
                  for (int nq = 0; nq < 2; ++nq) oT[dt][nq] = __builtin_amdgcn_mfma_f32_16x16x32_bf16(vf, pf[nq], oT[dt][nq], 0, 0, 0); } }
#pragma unroll
          for (int nq = 0; nq < 2; ++nq) { const size_t tok = (size_t)b * SEQ + nb * 128 + q0 + 16 * nq + fr;
#pragma unroll
              for (int dt = 0; dt < 4; ++dt) { const f32x4 v = oT[dt][nq] * linv[nq]; u32x2 o; o.x = pk2(v[0], v[1]); o.y = pk2(v[2], v[3]);
                  *(u32x2*)(attn + tok * 1024 + (hk * 4 + g) * 64 + 16 * dt + 4 * fq) = o; } }
      } }
    __syncthreads();
}

__device__ __forceinline__ void phase7(const Params& P, LAS unsigned char* lds, int vcu, int G, int tid, int wid, int lane, bool commit = true) {
    const bf16* Wrh = (const bf16*)(P.ws + WS_WR); const float* ssq = (const float*)(P.ws + WS_SSQ);
    unsigned* cnt = (unsigned*)(P.ws + WS_CTL + CTL_CNT); int* list = (int*)(P.ws + WS_LIST); float* gw = (float*)(P.ws + WS_GW); float* rstdv = (float*)(P.ws + WS_RSTD);
    const int fr = lane & 15, fq = lane >> 4;
    LAS float* LG = (LAS float*)(lds + wid * 3072);
    LAS unsigned* LC = (LAS unsigned*)(lds + 24576); LAS unsigned* LB = (LAS unsigned*)(lds + 24576 + 256);
    if (tid < 64) LC[tid] = 0u;
    __syncthreads();
    for (int base = vcu * 8; base < T / 16; base += G * 8) {
        const int rg = base + wid; const int R0 = rg * 16;
        f32x4 acc[3];
#pragma unroll
        for (int nt = 0; nt < 3; ++nt) acc[nt] = (f32x4){0.f, 0.f, 0.f, 0.f};
        const float* xr = P.out + (size_t)(R0 + fr) * 1024 + 8 * fq;
        const bf16* wh = Wrh + (size_t)fr * 1024 + 8 * fq;
#pragma unroll 4
        for (int ks = 0; ks < 32; ++ks) { const f32x4 a0 = *(const f32x4*)(xr + 32 * ks), a1 = *(const f32x4*)(xr + 32 * ks + 4);
            u32x4 hw, lw;
            { const unsigned h0 = f2bf(a0[0]), h1 = f2bf(a0[1]), h2 = f2bf(a0[2]), h3 = f2bf(a0[3]), h4 = f2bf(a1[0]), h5 = f2bf(a1[1]), h6 = f2bf(a1[2]), h7 = f2bf(a1[3]);
              hw.x = h0 | (h1 << 16); hw.y = h2 | (h3 << 16); hw.z = h4 | (h5 << 16); hw.w = h6 | (h7 << 16);
              lw.x = pk2(a0[0] - bf2f(h0), a0[1] - bf2f(h1)); lw.y = pk2(a0[2] - bf2f(h2), a0[3] - bf2f(h3)); lw.z = pk2(a1[0] - bf2f(h4), a1[1] - bf2f(h5)); lw.w = pk2(a1[2] - bf2f(h6), a1[3] - bf2f(h7)); }
            const bf16x8 ah = __builtin_bit_cast(bf16x8, hw), al = __builtin_bit_cast(bf16x8, lw);
#pragma unroll
            for (int nt = 0; nt < 3; ++nt) { const bf16x8 bh = *(const bf16x8*)(wh + nt * 16384 + 32 * ks), bl = *(const bf16x8*)(wh + 48 * 1024 + nt * 16384 + 32 * ks);
                acc[nt] = __builtin_amdgcn_mfma_f32_16x16x32_bf16(ah, bh, acc[nt], 0, 0, 0);
                acc[nt] = __builtin_amdgcn_mfma_f32_16x16x32_bf16(ah, bl, acc[nt], 0, 0, 0);
                acc[nt] = __builtin_amdgcn_mfma_f32_16x16x32_bf16(al, bh, acc[nt], 0, 0, 0); } }
#pragma unroll
        for (int r = 0; r < 4; ++r) { const float* sp = ssq + (size_t)(R0 + 4 * fq + r) * 16; float tot = 0.f;
#pragma unroll
            for (int q = 0; q < 4; ++q) { const f32x4 v = *(const f32x4*)(sp + 4 * q); tot += v[0]; tot += v[1]; tot += v[2]; tot += v[3]; }
            const float rstd = 1.f / sqrtf(tot * (1.f / 1024.f) + EPS);
            if (fr == 0) rstdv[R0 + 4 * fq + r] = rstd;
#pragma unroll
            for (int nt = 0; nt < 3; ++nt) { const int j = 16 * nt + fr; float bias = 0.f; if (j < 4) bias = P.b_rg[j]; else if (j < 36) bias = P.b_re[j - 4];
                LG[(4 * fq + r) * 48 + j] = acc[nt][r] * rstd + bias; } }
        __syncthreads();
        int l0 = 0, l1 = 0; unsigned rk0 = 0u, rk1 = 0u;
        if (lane < 16) { const int tok = R0 + lane; const LAS float* lg = LG + lane * 48;
            int gsel = 0; float best = lg[0];
#pragma unroll
            for (int i = 1; i < 4; ++i) { const float v = lg[i]; if (v > best) { best = v; gsel = i; } }
            float Z = 0.f;
#pragma unroll
            for (int i = 0; i < 4; ++i) Z += __expf(lg[i] - best);
            const float pgsel = 1.f / Z;
            const LAS float* le = lg + 4 + gsel * 8;
            float lmax = le[0];
#pragma unroll
            for (int i = 1; i < 8; ++i) lmax = fmaxf(lmax, le[i]);
            float Zp = 0.f;
#pragma unroll
            for (int i = 0; i < 8; ++i) Zp += __expf(le[i] - lmax);
            int i1 = 0; float p1 = -1.f;
#pragma unroll
            for (int i = 0; i < 8; ++i) { const float pe = __expf(le[i] - lmax) / Zp; if (pe > p1) { p1 = pe; i1 = i; } }
            int i2 = 0; float p2 = -1.f;
#pragma unroll
            for (int i = 0; i < 8; ++i) { const float pe = __expf(le[i] - lmax) / Zp; if (i != i1 && pe > p2) { p2 = pe; i2 = i; } }
            const float den = p1 + p2;
            gw[tok * 2 + 0] = pgsel * p1 / den; gw[tok * 2 + 1] = pgsel * p2 / den;
            l0 = gsel * 8 + i1; l1 = 32 + gsel * 8 + i2;
            rk0 = __hip_atomic_fetch_add(&LC[l0], 1u, __ATOMIC_RELAXED, __HIP_MEMORY_SCOPE_WORKGROUP); rk1 = __hip_atomic_fetch_add(&LC[l1], 1u, __ATOMIC_RELAXED, __HIP_MEMORY_SCOPE_WORKGROUP); }
        __syncthreads();
        if (tid < 64) { const unsigned n = LC[tid]; LC[tid] = 0u; if (n && commit) LB[tid] = atomicAdd(&cnt[tid * 64], n); }
        __syncthreads();
        if (lane < 16 && commit) { const int tok = R0 + lane; list[(size_t)l0 * T + LB[l0] + rk0] = tok; list[(size_t)l1 * T + LB[l1] + rk1] = tok; }
        __syncthreads();
    }
}

constexpr int M_PB = 133120, M_CN = 133632, M_RBL = 133888;
__device__ __forceinline__ void moe_prefix(const Params& P, LAS unsigned char* lds, int tid) {
    const unsigned* cnt = (const unsigned*)(P.ws + WS_CTL + CTL_CNT);
    LAS int* PB = (LAS int*)(lds + M_PB); LAS int* CN = (LAS int*)(lds + M_CN);
    if (tid < 64) CN[tid] = (int)cnt[tid * 64];
    __syncthreads();
    if (tid == 0) { int s = 0; for (int l = 0; l < 64; ++l) { PB[l] = s; s += (CN[l] + 255) >> 8; } PB[64] = s; }
    __syncthreads();
    if (tid < 64) { LAS int* RBL = (LAS int*)(lds + M_RBL); for (int rb = PB[tid]; rb < PB[tid + 1]; ++rb) RBL[rb] = tid; }
    __syncthreads();
}
__device__ __forceinline__ void phase8(const Params& P, LAS unsigned char* lds, int vcu, int G) {
    const LAS int* PB = (const LAS int*)(lds + M_PB); const LAS int* CN = (const LAS int*)(lds + M_CN);
    const pg8::MoeSched<0> S{(const char*)(P.ws + WS_HN), (const char*)(P.ws + WS_WGU), (const int*)(P.ws + WS_LIST), PB, CN, (const LAS int*)(lds + M_RBL), 1024, PB[0], (PB[64] - PB[0]) * 4, vcu, G};
    const EpiGateUp E{(const int*)(P.ws + WS_LIST), (const float*)(P.ws + WS_RSTD), (bf16*)(P.ws + WS_H)};
    pg8::gemm_phase(lds, S, E);
}
__device__ __forceinline__ void phase9(const Params& P, LAS unsigned char* lds, int vcu, int G) {
    const LAS int* PB = (const LAS int*)(lds + M_PB); const LAS int* CN = (const LAS int*)(lds + M_CN);
    const pg8::MoeSched<1> S{(const char*)(P.ws + WS_H), (const char*)(P.ws + WS_WD), (const int*)(P.ws + WS_LIST), PB, CN, (const LAS int*)(lds + M_RBL), 512, PB[32], (PB[64] - PB[32]) * 4, vcu, G};
    const EpiDownY E{(const int*)(P.ws + WS_LIST), (const float*)(P.ws + WS_GW), (bf16*)(P.ws + WS_Y)};
    pg8::gemm_phase(lds, S, E);
}
__device__ __forceinline__ void phase10(const Params& P, LAS unsigned char* lds, int vcu, int G) {
    const LAS int* PB = (const LAS int*)(lds + M_PB); const LAS int* CN = (const LAS int*)(lds + M_CN);
    const pg8::MoeSched<1> S{(const char*)(P.ws + WS_H), (const char*)(P.ws + WS_WD), (const int*)(P.ws + WS_LIST), PB, CN, (const LAS int*)(lds + M_RBL), 512, PB[0], (PB[32] - PB[0]) * 4, vcu, G};
    const EpiDown E{(const int*)(P.ws + WS_LIST), (const float*)(P.ws + WS_GW), P.out, (const bf16*)(P.ws + WS_Y), (const float*)(P.ws + WS_CTL + 32768)};
    pg8::gemm_phase(lds, S, E);
}

__global__ void __launch_bounds__(NTHREADS, 2) mega_fwd(Params P) {
    extern __shared__ __attribute__((aligned(16))) unsigned char lds_raw[];
    LAS unsigned char* lds = (LAS unsigned char*)lds_raw;
    const int tid = threadIdx.x, lane = tid & 63, wid = __builtin_amdgcn_readfirstlane(tid >> 6);
    const int G = gridDim.x; const int bx = blockIdx.x; const int vcu = (G % 8 == 0) ? (bx % 8) * (G / 8) + bx / 8 : bx;
    volatile LAS unsigned* st = (volatile LAS unsigned*)(lds + LDS_ST_OFF);
    if (tid < 16) st[tid] = 0u;
    __syncthreads();
    unsigned* bar = (unsigned*)(P.ws + WS_CTL);
    const XcdBarrier xb = xcd_barrier_post(bar, st);

#ifndef DUPMASK
#define DUPMASK 0
#endif
#define DUPQ(k) if ((DUPMASK >> (k)) & 1)
#ifndef PHMASK
#define PHMASK 0xFFFF
#endif
#define PH(k) if ((PHMASK >> (k)) & 1)
    PH(0) phase0(P, lds, vcu, G, tid, wid, lane);
    DUPQ(0) phase0(P, lds, vcu, G, tid, wid, lane);
    xcd_barrier(xb);
    PH(1) phase1(P, lds, G);
    DUPQ(1) phase1(P, lds, G);
    const int ei_p1 = (G == 256) ? 14336 : 0;
    PH(1) if (G == 256 && bx >= 128) { LAS float* cscr = (LAS float*)(lds + wid * 16384); const int w1 = (bx - 128) * 8 + wid;
#pragma unroll 1
        for (int k = 0; k < 14; k += 2) { float tva[32], tvb[32]; const TItem ia = expert_item(P, w1 + k * 1024), ib = expert_item(P, w1 + (k + 1) * 1024);
            titem_load(ia, lane, tva); titem_load(ib, lane, tvb); titem_store(ia, lane, tva, cscr); titem_store(ib, lane, tvb, cscr); } }
    xcd_barrier(xb);
    PH(2) {
        int cit = ei_p1 + vcu * 8 + wid; const int cstride = G * 8;
        for (int u = bx; u < 256; u += G) {
            if ((u & 15) != 15) { hgrn_unit<0>(P, lds, u, tid, wid, lane, cit, cstride); cit += 16 * cstride; } }
        LAS float* cscr = (LAS float*)(lds + (wid < 4 ? H_QT + wid * 8448 : H_ST + (wid - 4) * 8448));
        for (; cit < EI_TOTAL; cit += cstride) { float tv[32]; const TItem t = expert_item(P, cit); titem_load(t, lane, tv); titem_store(t, lane, tv, cscr); }
    }
    DUPQ(2) for (int u = bx; u < 256; u += G) if ((u & 15) != 15) hgrn_unit<0>(P, lds, u, tid, wid, lane);
    xcd_barrier(xb);
    PH(3) { hgrn_scan(P, G, tid);
    for (int u = bx; u < 512; u += G) attn_unit(P, lds, u, tid, wid, lane); }
    DUPQ(3) for (int u = bx; u < 512; u += G) attn_unit(P, lds, u, tid, wid, lane);
    xcd_barrier(xb);
    PH(4) for (int u = bx; u < 256; u += G) hgrn_unit<1>(P, lds, u, tid, wid, lane);
    DUPQ(4) for (int u = bx; u < 256; u += G) hgrn_unit<1>(P, lds, u, tid, wid, lane);
    xcd_barrier(xb);
    PH(5) phase5(P, lds, G);
    DUPQ(5) phase5(P, lds, G);
    xcd_barrier(xb);
    PH(6) phase6(P, lds, G);
    DUPQ(6) phase6(P, lds, G);
    xcd_barrier(xb);
    if ((DUPMASK >> 7) & 1) phase7(P, lds, vcu, G, tid, wid, lane, false);
    PH(7) phase7(P, lds, vcu, G, tid, wid, lane);
    xcd_barrier(xb);
    moe_prefix(P, lds, tid);
    PH(8) phase8(P, lds, vcu, G);
    DUPQ(8) phase8(P, lds, vcu, G);
    xcd_barrier(xb);
    PH(9) phase9(P, lds, vcu, G);
    xcd_barrier(xb);
    PH(10) phase10(P, lds, vcu, G);
    if (xb_ld(&bar[XB_TMO]) != 0u && tid == 0) P.out[(size_t)bx * 1024] = __builtin_nanf("");
}

extern "C" void kernel_launch(void* const* d_in, const int* in_sizes, int n_in, void* d_out, int out_size, void* d_ws, size_t ws_size, hipStream_t stream) {
    static int grid = 0;
    if (grid == 0) {
        if (n_in != 20 || out_size != T * D || ws_size < WS_END) { fprintf(stderr, "kernel_launch: unexpected shapes (n_in %d out %d ws %zu, need ws >= %zu)\n", n_in, out_size, ws_size, (size_t)WS_END); grid = -1; return; }
        int dev = 0, cus = 0, per_cu = 0;
        if (hipGetDevice(&dev) != hipSuccess || hipDeviceGetAttribute(&cus, hipDeviceAttributeMultiprocessorCount, dev) != hipSuccess) { grid = -1; return; }
        if (hipFuncSetAttribute((const void*)mega_fwd, hipFuncAttributeMaxDynamicSharedMemorySize, LDS_BYTES) != hipSuccess) { fprintf(stderr, "hipFuncSetAttribute failed\n"); grid = -1; return; }
        if (hipOccupancyMaxActiveBlocksPerMultiprocessor(&per_cu, (const void*)mega_fwd, NTHREADS, LDS_BYTES) != hipSuccess || per_cu < 1) { fprintf(stderr, "occupancy query: %d blocks/CU\n", per_cu); grid = -1; return; }
        grid = cus;
    }
    if (grid < 0) return;
    if (hipMemsetAsync((char*)d_ws + WS_CTL, 0, 96 * 1024, stream) != hipSuccess) return;
    Params p{};
    p.x = (const float*)d_in[0]; p.positions = (const int*)d_in[1]; p.norm1_w = (const float*)d_in[2]; p.w_in = (const float*)d_in[3];
    p.q_norm_w = (const float*)d_in[4]; p.k_norm_w = (const float*)d_in[5]; p.sinks = (const float*)d_in[6]; p.hlb = (const float*)d_in[7];
    p.hnw = (const float*)d_in[8]; p.w_ba = (const float*)d_in[9]; p.w_bh = (const float*)d_in[10]; p.w_out = (const float*)d_in[11];
    p.norm2_w = (const float*)d_in[12]; p.w_rg = (const float*)d_in[13]; p.b_rg = (const float*)d_in[14]; p.w_re = (const float*)d_in[15];
    p.b_re = (const float*)d_in[16]; p.w_gate = (const float*)d_in[17]; p.w_up = (const float*)d_in[18]; p.w_down = (const float*)d_in[19];
    p.out = (float*)d_out; p.ws = (unsigned char*)d_ws;
    void* args[] = {&p};
    const hipError_t e = hipLaunchCooperativeKernel((const void*)mega_fwd, dim3(grid), dim3(NTHREADS), args, LDS_BYTES, stream);
    if (e != hipSuccess) fprintf(stderr, "cooperative launch failed: %s (grid %d)\n", hipGetErrorString(e), grid);
}
```

```cpp
#define DUPMASK 0
#include <hip/hip_runtime.h>
#include <cstdio>
#include <cstdint>

#define LAS __attribute__((address_space(3)))
typedef unsigned short bf16;
typedef short bf16x8 __attribute__((ext_vector_type(8)));
typedef float f32x4 __attribute__((ext_vector_type(4)));
typedef unsigned u32x4 __attribute__((ext_vector_type(4)));
typedef unsigned u32x2 __attribute__((ext_vector_type(2)));

constexpr int NTHREADS = 512;
constexpr int LDS_BYTES = 147456;
constexpr int LDS_ST_OFF = LDS_BYTES - 64;

constexpr int BATCH = 4, SEQ = 8192, T = BATCH * SEQ, D = 1024, NPROJ = 4864;
constexpr int C_QA = 0, C_KA = 512, C_VA = 640, C_QH = 768, C_FH = 1280, C_IH = 1792, C_GH = 2304, C_ZA = 2816, C_ZB = 3840;
constexpr int NEXP = 32, FF = 512;
constexpr float EPS = 1e-6f;

constexpr size_t MiB = 1u << 20;
constexpr size_t WS_CTL = 0;
constexpr size_t CTL_CNT = 65536;
constexpr size_t WS_WINT = 1 * MiB;
constexpr size_t WS_WAT = 11 * MiB;
constexpr size_t WS_WBT = 12 * MiB;
constexpr size_t WS_WOT = 13 * MiB;
constexpr size_t WS_WR = 15 * MiB;
constexpr size_t WS_WGU = 16 * MiB;
constexpr size_t WS_WD = 80 * MiB;
constexpr size_t WS_PROJ = 112 * MiB;
constexpr size_t WS_MIXED = 416 * MiB;
constexpr size_t WS_CS = 480 * MiB;
constexpr size_t WS_END = 482 * MiB;
constexpr size_t WS_HN = 112 * MiB;
constexpr size_t WS_SSQ = 176 * MiB;
constexpr size_t WS_LIST = 178 * MiB;
constexpr size_t WS_GW = 186 * MiB;
constexpr size_t WS_RSTD = 187 * MiB;
constexpr size_t WS_H = 192 * MiB;
constexpr size_t WS_Y = 272 * MiB;
constexpr size_t OUT_U = 0, OUT_SIN = 16 * MiB, OUT_DSC = 32 * MiB, OUT_AH = 64 * MiB;

typedef float f32x2_ __attribute__((ext_vector_type(2)));
typedef __bf16 bf16x2_ __attribute__((ext_vector_type(2)));
__device__ __forceinline__ unsigned f2bf(float f) { return (unsigned)__builtin_bit_cast(unsigned short, (__bf16)f); }
__device__ __forceinline__ float bf2f(unsigned h) { return __builtin_bit_cast(float, h << 16); }
__device__ __forceinline__ unsigned pk2(float lo, float hi) { const f32x2_ v = {lo, hi}; return __builtin_bit_cast(unsigned, __builtin_convertvector(v, bf16x2_)); }
__device__ __forceinline__ float bflo(unsigned w) { return __builtin_bit_cast(float, w << 16); }
__device__ __forceinline__ float bfhi(unsigned w) { return __builtin_bit_cast(float, w & 0xffff0000u); }
constexpr float LOG2E = 1.4426950408889634f;
__device__ __forceinline__ float exp2_(float x) { return __builtin_amdgcn_exp2f(x); }
__device__ __forceinline__ float fexp_(float x) { return __builtin_amdgcn_exp2f(x * LOG2E); }
__device__ __forceinline__ float sigmoidf_(float x) { return __builtin_amdgcn_rcpf(1.f + fexp_(-x)); }
__device__ __forceinline__ int opaque(int x) { asm volatile("" : "+v"(x)); return x; }
__device__ __forceinline__ float wave_sum(float v) {
#pragma unroll
    for (int o = 1; o < 64; o <<= 1) v += __shfl_xor(v, o);
    return v;
}

#define XB_TMO      128
#define XB_XCNT(j)  (256  + 64 * (j))
#define XB_XSUB(j)  (1280 + 64 * (j))
#define XB_XGEN(j)  (2304 + 64 * (j))
#define XB_TOP      3328
#define XB_TOPGEN   3392
#define XCD_BAR_WORDS 3456
#define XB_SPIN_CAP (1u << 20)
__device__ __forceinline__ unsigned xb_ld(unsigned* p)              { return __hip_atomic_load(p, __ATOMIC_RELAXED, __HIP_MEMORY_SCOPE_AGENT); }
__device__ __forceinline__ unsigned xb_add(unsigned* p, unsigned v) { return __hip_atomic_fetch_add(p, v, __ATOMIC_RELAXED, __HIP_MEMORY_SCOPE_AGENT); }
__device__ __forceinline__ unsigned xb_xcc_id() { return (unsigned)__builtin_amdgcn_s_getreg((3 << 11) | 20) & 0xFu; }
#define XB_SPIN(cond, bar) do { unsigned _sp = 0; while (cond) { __builtin_amdgcn_s_sleep(1); \
    if ((++_sp & 255u) == 0u) { if (xb_ld(&(bar)[XB_TMO])) break; if (_sp > XB_SPIN_CAP) { atomicAdd(&(bar)[XB_TMO], 1u); break; } } } } while (0)
struct XcdBarrier { unsigned* bar; unsigned x; volatile LAS unsigned* st; };
__device__ __forceinline__ XcdBarrier xcd_barrier_post(unsigned* bar, volatile LAS unsigned* st) {
    XcdBarrier b; b.bar = bar; b.x = xb_xcc_id(); b.st = st;
    if (threadIdx.x == 0) (void)xb_add(&bar[XB_XCNT(b.x)], 1u);
    return b;
}
__device__ __forceinline__ void xcd_barrier_complete(unsigned* bar, unsigned x, unsigned& nloc, unsigned& nx) {
    const unsigned G = gridDim.x * gridDim.y * gridDim.z;
    unsigned sum, cnt, mine, sp = 0u;
    for (;;) {
        sum = 0u; cnt = 0u; mine = 0u;
#pragma unroll
        for (unsigned j = 0; j < 16; ++j) { const unsigned c = xb_ld(&bar[XB_XCNT(j)]); sum += c; cnt += (c > 0u) ? 1u : 0u; mine = (j == x) ? c : mine; }
        if (sum == G) break;
        __builtin_amdgcn_s_sleep(1);
        if ((++sp & 255u) == 0u) { if (xb_ld(&bar[XB_TMO])) break; if (sp > XB_SPIN_CAP) { atomicAdd(&bar[XB_TMO], 1u); break; } }
    }
    nloc = mine > 0u ? mine : 1u; nx = cnt > 0u ? cnt : 1u;
}
__device__ __forceinline__ void xcd_barrier(const XcdBarrier& b) {
    asm volatile("s_waitcnt vmcnt(0)" ::: "memory");
    __syncthreads();
    if (threadIdx.x == 0) {
        unsigned* bar = b.bar;
        __builtin_amdgcn_s_waitcnt(0);
        unsigned nloc = b.st[0], nx = b.st[1];
        if (nloc == 0u) { xcd_barrier_complete(bar, b.x, nloc, nx); b.st[0] = nloc; b.st[1] = nx; }
        const unsigned old = xb_add(&bar[XB_XSUB(b.x)], 1u);
        const unsigned gen = old / nloc;
        if (old + 1u == (gen + 1u) * nloc) {
            __builtin_amdgcn_fence(__ATOMIC_RELEASE, "agent");
            asm volatile("s_waitcnt vmcnt(0)" ::: "memory");
            const unsigned og = xb_add(&bar[XB_TOP], 1u);
            const unsigned tg = og / nx;
            if (og + 1u == (tg + 1u) * nx) xb_add(&bar[XB_TOPGEN], 1u);
            else XB_SPIN(xb_ld(&bar[XB_TOPGEN]) == tg, bar);
            __builtin_amdgcn_fence(__ATOMIC_ACQUIRE, "agent");
            xb_add(&bar[XB_XGEN(b.x)], 1u);
            asm volatile("s_waitcnt vmcnt(0)" ::: "memory");
        } else {
            XB_SPIN(xb_ld(&bar[XB_XGEN(b.x)]) == gen, bar);
            __builtin_amdgcn_fence(__ATOMIC_ACQUIRE, "agent");
            asm volatile("s_waitcnt vmcnt(0)" ::: "memory");
        }
    }
    __syncthreads();
}

struct Params {
    const float* x; const int* positions; const float* norm1_w; const float* w_in; const float* q_norm_w; const float* k_norm_w;
    const float* sinks; const float* hlb; const float* hnw; const float* w_ba; const float* w_bh; const float* w_out; const float* norm2_w;
    const float* w_rg; const float* b_rg; const float* w_re; const float* b_re; const float* w_gate; const float* w_up; const float* w_down;
    float* out; unsigned char* ws;
};

namespace pg8 {
constexpr int BK = 64, HALF = 128, HTB = HALF * BK * 2;
__device__ __forceinline__ int lds_byte(int r, int c) { const int st = (r >> 4) * 2 + (c >> 5), rr = r & 15, cc = c & 31, ob = rr * 64 + cc * 2; return st * 1024 + (ob ^ (((ob >> 9) & 1) << 5)); }
__device__ __forceinline__ void stage_rc(int b, int& R, int& C) { const int st = b / 1024, sb = b % 1024, swz = sb ^ (((sb >> 9) & 1) << 5); R = (st >> 1) * 16 + swz / 64; C = (st & 1) * 32 + (swz % 64) / 2; }
__device__ __forceinline__ int perm32(int rho) { const int n = rho >> 4, i = rho & 15; return 8 * (i >> 2) + 4 * n + (i & 3); }
struct Unit { int pm, pn, l, i0, cn; };

template <class Epi, class Sched>
__device__ __forceinline__ void gemm_phase(LAS unsigned char* lds, const Sched& S, const Epi& E) {
    const int tid = threadIdx.x, wid = __builtin_amdgcn_readfirstlane(tid >> 6), lane = tid & 63, wr = wid >> 2, wc = wid & 3, fr = lane & 15, fq = lane >> 4;
    const int K = S.K, nt = K / BK;
    int sR[2], sC = 0; unsigned voffB[2];
#pragma unroll
    for (int i = 0; i < 2; ++i) { int R, C; stage_rc(tid * 16 + i * 8192, R, C); sR[i] = R; sC = C; const int Rb = Epi::PERM ? ((R & ~31) + perm32(R & 31)) : R; voffB[i] = (unsigned)(Rb * K + C) * 2u; }
    const unsigned kstep = (unsigned)(BK * 2);
    const size_t hstep = (size_t)HALF * K * 2;
    const unsigned ldsw = (unsigned)wid * 1024u;
    const int aoff = lds_byte(wr * 64 + fr, fq * 8), boff = lds_byte(wc * 32 + fr, fq * 8);
#define PG8_SA(b, h) (((b) * 2 + (h)) * HTB)
#define PG8_SB(b, h) ((4 + (b) * 2 + (h)) * HTB)
#define PG8_STAGE_B(bufoff, gbase) do { _Pragma("unroll") for (int _i = 0; _i < 2; ++_i) \
        __builtin_amdgcn_global_load_lds((const unsigned*)((const char*)(gbase) + voffB[_i]), (LAS unsigned*)(lds + (bufoff) + ldsw + _i * 8192), 16, 0, 0); } while (0)
#define PG8_STAGE_A(bufoff, va, kb) do { _Pragma("unroll") for (int _i = 0; _i < 2; ++_i) \
        __builtin_amdgcn_global_load_lds((const unsigned*)(Ab + ((size_t)(va)[_i] + (kb))), (LAS unsigned*)(lds + (bufoff) + ldsw + _i * 8192), 16, 0, 0); } while (0)
#define PG8_LDA(dst, b, h) do { _Pragma("unroll") for (int m = 0; m < 4; ++m) _Pragma("unroll") for (int k = 0; k < 2; ++k) dst[m][k] = *(const LAS bf16x8*)(lds + PG8_SA(b, h) + aoff + m * 2048 + k * 1024); } while (0)
#define PG8_LDB(dst, b, h) do { _Pragma("unroll") for (int n = 0; n < 2; ++n) _Pragma("unroll") for (int k = 0; k < 2; ++k) dst[n][k] = *(const LAS bf16x8*)(lds + PG8_SB(b, h) + boff + n * 2048 + k * 1024); } while (0)
#define PG8_MMA(ai, bj, At, Bt) do { __builtin_amdgcn_s_setprio(1); _Pragma("unroll") for (int m = 0; m < 4; ++m) _Pragma("unroll") for (int n = 0; n < 2; ++n) _Pragma("unroll") for (int k = 0; k < 2; ++k) \
        acc[ai][bj][m][n] = __builtin_amdgcn_mfma_f32_16x16x32_bf16(Bt[n][k], At[m][k], acc[ai][bj][m][n], 0, 0, 0); __builtin_amdgcn_s_setprio(0); } while (0)
#define PG8_WAIT_V(n) asm volatile("s_waitcnt vmcnt(" #n ")" ::: "memory")
#define PG8_WAIT_L(n) asm volatile("s_waitcnt lgkmcnt(" #n ")" ::: "memory")
#define PG8_BAR __builtin_amdgcn_s_barrier()
#define PG8_SCHED __builtin_amdgcn_sched_barrier(0)
    Unit cur, nxt; int ui = 0;
    if (!S.next(0, cur)) return;
    f32x4 acc[2][2][4][2];
#pragma unroll
    for (int a = 0; a < 2; ++a)
#pragma unroll
        for (int b = 0; b < 2; ++b)
#pragma unroll
            for (int m = 0; m < 4; ++m)
#pragma unroll
                for (int n = 0; n < 2; ++n) acc[a][b][m][n] = (f32x4){0.f, 0.f, 0.f, 0.f};
    bf16x8 At[4][2], B0[2][2], B1[2][2];
    const char* const Ab = S.a_base();
    unsigned vA0[2], vA1[2], nA0[2], nA1[2];
#pragma unroll
    for (int i = 0; i < 2; ++i) { vA0[i] = S.a_voff(cur, 0, sR[i], sC); vA1[i] = S.a_voff(cur, 1, sR[i], sC); }
    const char* cB = S.b_base(cur);
    PG8_STAGE_B(PG8_SB(0, 0), cB); PG8_STAGE_B(PG8_SB(0, 1), cB + hstep); PG8_STAGE_A(PG8_SA(0, 0), vA0, 0u); PG8_STAGE_A(PG8_SA(0, 1), vA1, 0u);
    if (wr == 1) PG8_BAR;
    PG8_WAIT_V(2); PG8_BAR;
    PG8_STAGE_B(PG8_SB(1, 0), cB + kstep); PG8_STAGE_A(PG8_SA(1, 0), vA0, kstep); PG8_STAGE_B(PG8_SB(1, 1), cB + hstep + kstep);
    PG8_WAIT_V(6); PG8_BAR;
    for (;;) {
        const bool has_next = S.next(ui + 1, nxt);
        const char* nB = has_next ? S.b_base(nxt) : cB;
#pragma unroll
        for (int i = 0; i < 2; ++i) { nA0[i] = has_next ? S.a_voff(nxt, 0, sR[i], sC) : vA0[i]; nA1[i] = has_next ? S.a_voff(nxt, 1, sR[i], sC) : vA1[i]; }
#pragma unroll 1
        for (int t = 0; t < nt; t += 2) {
            const bool last = (t == nt - 2);
            if constexpr (Epi::MID) { if (t == (nt >> 1)) E.mid(acc, cur, wr, wc, fr, fq); }
            const unsigned k1 = (unsigned)(t + 1) * kstep;
            const unsigned k2 = last ? 0u : (unsigned)(t + 2) * kstep, k3 = k2 + kstep;
            const char* b2 = last ? nB : cB + (size_t)(t + 2) * kstep; const char* b3 = b2 + kstep;
            unsigned uA0[2], uA1[2];
#pragma unroll
            for (int i = 0; i < 2; ++i) { uA0[i] = last ? nA0[i] : vA0[i]; uA1[i] = last ? nA1[i] : vA1[i]; }
            PG8_LDB(B0, 0, 0); PG8_LDB(B1, 0, 1); PG8_SCHED; PG8_LDA(At, 0, 0); PG8_STAGE_A(PG8_SA(1, 1), vA1, k1);
            PG8_WAIT_V(8); PG8_WAIT_L(0); PG8_BAR; PG8_MMA(0, 0, At, B0); PG8_MMA(0, 1, At, B1); PG8_BAR; PG8_SCHED;
            PG8_LDA(At, 0, 1); PG8_STAGE_B(PG8_SB(0, 0), b2); PG8_STAGE_B(PG8_SB(0, 1), b2 + hstep); PG8_STAGE_A(PG8_SA(0, 0), uA0, k2);
            PG8_WAIT_V(8); PG8_WAIT_L(0); PG8_BAR; PG8_MMA(1, 0, At, B0); PG8_MMA(1, 1, At, B1); PG8_BAR; PG8_SCHED;
            PG8_LDB(B0, 1, 0); PG8_LDB(B1, 1, 1); PG8_SCHED; PG8_LDA(At, 1, 0); PG8_STAGE_A(PG8_SA(0, 1), uA1, k2);
            PG8_WAIT_V(8); PG8_WAIT_L(0); PG8_BAR; PG8_MMA(0, 0, At, B0); PG8_MMA(0, 1, At, B1); PG8_BAR; PG8_SCHED;
            PG8_LDA(At, 1, 1); PG8_STAGE_B(PG8_SB(1, 0), b3); PG8_STAGE_B(PG8_SB(1, 1), b3 + hstep); PG8_STAGE_A(PG8_SA(1, 0), uA0, k3);
            PG8_WAIT_V(8); PG8_WAIT_L(0); PG8_BAR; PG8_MMA(1, 0, At, B0); PG8_MMA(1, 1, At, B1); PG8_BAR; PG8_SCHED;
        }
        if (wr == 0) PG8_BAR;
        E(acc, cur, wr, wc, fr, fq);
        if (!has_next) break;
#pragma unroll
        for (int a = 0; a < 2; ++a)
#pragma unroll
            for (int b = 0; b < 2; ++b)
#pragma unroll
                for (int m = 0; m < 4; ++m)
#pragma unroll
                    for (int n = 0; n < 2; ++n) acc[a][b][m][n] = (f32x4){0.f, 0.f, 0.f, 0.f};
        cur = nxt; cB = nB; ++ui;
#pragma unroll
        for (int i = 0; i < 2; ++i) { vA0[i] = nA0[i]; vA1[i] = nA1[i]; }
        if (wr == 1) PG8_BAR;
    }
    PG8_WAIT_V(0);
    PG8_BAR;
#undef PG8_SA
#undef PG8_SB
#undef PG8_STAGE_A
#undef PG8_STAGE_B
#undef PG8_LDA
#undef PG8_LDB
#undef PG8_MMA
#undef PG8_WAIT_V
#undef PG8_WAIT_L
#undef PG8_BAR
#undef PG8_SCHED
}
__device__ __forceinline__ bool tile_order(int i, int G, int c, int nM, int nN, int& pm, int& pn) {
    const int nwg = nM * nN; const long L = (long)i * G + c; if (L >= nwg) return false;
    int wgid = (int)L; { const int q = nwg / 8, r = nwg % 8, xcd = wgid % 8, off = wgid / 8; wgid = (xcd < r ? xcd * (q + 1) : r * (q + 1) + (xcd - r) * q) + off; }
    const int WGM = 8, nig = WGM * nN, gid = wgid / nig, fm = gid * WGM, gsz = (nM - fm) < WGM ? (nM - fm) : WGM;
    pm = fm + ((wgid % nig) % gsz); pn = (wgid % nig) / gsz; return true;
}
struct DenseSched {
    const char* A; const char* Bt; int K, nM, nN, G, c;
    __device__ __forceinline__ bool next(int i, Unit& u) const { u.l = 0; u.i0 = 0; u.cn = 0; return tile_order(i, G, c, nM, nN, u.pm, u.pn); }
    __device__ __forceinline__ const char* a_base() const { return A; }
    __device__ __forceinline__ unsigned a_voff(const Unit& u, int h, int R, int C) const { return (unsigned)((u.pm * 256 + h * 128 + R) * K + C) * 2u; }
    __device__ __forceinline__ const char* b_base(const Unit& u) const { return Bt + (size_t)u.pn * 256 * K * 2; }
};
template <int MODE> struct MoeSched {
    const char* A; const char* Bt; const int* list; const LAS int* PB; const LAS int* CN; const LAS int* RBL; int K, rb0, nunits, vcu, G;
    __device__ __forceinline__ bool next(int i, Unit& u) const {
        const int idx = vcu + i * G; if (idx >= nunits) return false;
        const int rb = rb0 + (idx >> 2); const int l = RBL[rb];
        u.pm = rb; u.pn = idx & 3; u.l = l; u.i0 = (rb - PB[l]) * 256; u.cn = CN[l]; return true; }
    __device__ __forceinline__ const char* a_base() const { return A; }
    __device__ __forceinline__ unsigned a_voff(const Unit& u, int h, int R, int C) const {
        if (MODE == 0) { int idx = u.i0 + h * 128 + R; idx = idx < u.cn ? idx : u.cn - 1; const int tok = list[(size_t)u.l * T + idx]; return (unsigned)(tok * 1024 + C) * 2u; }
        return (unsigned)((u.pm * 256 + h * 128 + R) * 512 + C) * 2u; }
    __device__ __forceinline__ const char* b_base(const Unit& u) const { return Bt + ((size_t)(u.l & 31) * 1024 + u.pn * 256) * K * 2; }
};
}

struct EpiProj { static constexpr bool PERM = true, MID = false; bf16* proj;
    __device__ __forceinline__ void operator()(const f32x4 (&acc)[2][2][4][2], const pg8::Unit& u, int wr, int wc, int fr, int fq) const {
        const int fro = opaque(fr), fqo = opaque(fq);
#pragma unroll
        for (int ai = 0; ai < 2; ++ai)
#pragma unroll
            for (int m = 0; m < 4; ++m) { bf16* rowp = proj + (size_t)(u.pm * 256 + ai * 128 + wr * 64 + m * 16 + fro) * NPROJ + u.pn * 256 + wc * 32 + 8 * fqo;
#pragma unroll
                for (int bj = 0; bj < 2; ++bj) { const f32x4 v0 = acc[ai][bj][m][0], v1 = acc[ai][bj][m][1];
                    u32x4 w; w.x = pk2(v0[0], v0[1]); w.y = pk2(v0[2], v0[3]); w.z = pk2(v1[0], v1[1]); w.w = pk2(v1[2], v1[3]); *(u32x4*)(rowp + bj * 128) = w; } }
    } };
__device__ __forceinline__ float ratio_(float zb, float za) { return (1.f + fexp_(-zb)) * __builtin_amdgcn_rcpf(1.f + fexp_(-za)); }
struct EpiMixed { static constexpr bool PERM = true, MID = true; const bf16* proj; bf16* mixed;
    __device__ __forceinline__ void mid(f32x4 (&acc)[2][2][4][2], const pg8::Unit& u, int wr, int wc, int fr, int fq) const {
        const int fro = opaque(fr), fqo = opaque(fq);
#pragma unroll
        for (int ai = 0; ai < 2; ++ai) {
            u32x4 za[4][2], zb[4][2];
#pragma unroll
            for (int m = 0; m < 4; ++m) { const bf16* zr = proj + (size_t)(u.pm * 256 + ai * 128 + wr * 64 + m * 16 + fro) * NPROJ + u.pn * 256 + wc * 32 + 8 * fqo;
#pragma unroll
                for (int bj = 0; bj < 2; ++bj) { za[m][bj] = *(const u32x4*)(zr + C_ZA + bj * 128); zb[m][bj] = *(const u32x4*)(zr + C_ZB + bj * 128); } }
#pragma unroll
            for (int m = 0; m < 4; ++m)
#pragma unroll
                for (int bj = 0; bj < 2; ++bj) { const u32x4 a = za[m][bj], b = zb[m][bj]; f32x4 r0, r1;
                    r0[0] = ratio_(bflo(b.x), bflo(a.x)); r0[1] = ratio_(bfhi(b.x), bfhi(a.x)); r0[2] = ratio_(bflo(b.y), bflo(a.y)); r0[3] = ratio_(bfhi(b.y), bfhi(a.y));
                    r1[0] = ratio_(bflo(b.z), bflo(a.z)); r1[1] = ratio_(bfhi(b.z), bfhi(a.z)); r1[2] = ratio_(bflo(b.w), bflo(a.w)); r1[3] = ratio_(bfhi(b.w), bfhi(a.w));
                    acc[ai][bj][m][0] = acc[ai][bj][m][0] * r0; acc[ai][bj][m][1] = acc[ai][bj][m][1] * r1; }
            asm volatile("" ::: "memory"); }
    }
    __device__ __forceinline__ void operator()(const f32x4 (&acc)[2][2][4][2], const pg8::Unit& u, int wr, int wc, int fr, int fq) const {
        const int fro = opaque(fr), fqo = opaque(fq);
#pragma unroll
        for (int ai = 0; ai < 2; ++ai) {
            u32x4 zb[4][2];
#pragma unroll
            for (int m = 0; m < 4; ++m) { const bf16* zr = proj + (size_t)(u.pm * 256 + ai * 128 + wr * 64 + m * 16 + fro) * NPROJ + u.pn * 256 + wc * 32 + 8 * fqo;
#pragma unroll
                for (int bj = 0; bj < 2; ++bj) zb[m][bj] = *(const u32x4*)(zr + C_ZB + bj * 128); }
#pragma unroll
            for (int m = 0; m < 4; ++m) { bf16* orow = mixed + (size_t)(u.pm * 256 + ai * 128 + wr * 64 + m * 16 + fro) * 1024 + u.pn * 256 + wc * 32 + 8 * fqo;
#pragma unroll
                for (int bj = 0; bj < 2; ++bj) { const u32x4 b = zb[m][bj]; const f32x4 v0 = acc[ai][bj][m][0], v1 = acc[ai][bj][m][1];
                    u32x4 w; w.x = pk2(v0[0] * sigmoidf_(bflo(b.x)), v0[1] * sigmoidf_(bfhi(b.x))); w.y = pk2(v0[2] * sigmoidf_(bflo(b.y)), v0[3] * sigmoidf_(bfhi(b.y)));
                    w.z = pk2(v1[0] * sigmoidf_(bflo(b.z)), v1[1] * sigmoidf_(bfhi(b.z))); w.w = pk2(v1[2] * sigmoidf_(bflo(b.w)), v1[3] * sigmoidf_(bfhi(b.w)));
                    *(u32x4*)(orow + bj * 128) = w; } }
            asm volatile("" ::: "memory"); }
    } };
struct EpiX1 { static constexpr bool PERM = false, MID = false; const float* x; const float* w2; float* out; bf16* hn; float* ssq;
    __device__ __forceinline__ void operator()(const f32x4 (&acc)[2][2][4][2], const pg8::Unit& u, int wr, int wc, int fr, int fq) const {
        const int fro = opaque(fr), fqo = opaque(fq);
        f32x4 wv[2][2];
#pragma unroll
        for (int bj = 0; bj < 2; ++bj)
#pragma unroll
            for (int n = 0; n < 2; ++n) wv[bj][n] = *(const f32x4*)(w2 + u.pn * 256 + bj * 128 + wc * 32 + n * 16 + 4 * fqo);
#pragma unroll
        for (int ai = 0; ai < 2; ++ai)
#pragma unroll
            for (int mh = 0; mh < 2; ++mh) {
                f32x4 xv[2][2][2];
#pragma unroll
                for (int mm = 0; mm < 2; ++mm) { const size_t row = (size_t)(u.pm * 256 + ai * 128 + wr * 64 + (mh * 2 + mm) * 16 + fro);
#pragma unroll
                    for (int bj = 0; bj < 2; ++bj)
#pragma unroll
                        for (int n = 0; n < 2; ++n) xv[mm][bj][n] = *(const f32x4*)(x + row * 1024 + u.pn * 256 + bj * 128 + wc * 32 + n * 16 + 4 * fqo); }
#pragma unroll
                for (int mm = 0; mm < 2; ++mm) { const int m = mh * 2 + mm; const size_t row = (size_t)(u.pm * 256 + ai * 128 + wr * 64 + m * 16 + fro); float s = 0.f;
#pragma unroll
                    for (int bj = 0; bj < 2; ++bj)
#pragma unroll
                        for (int n = 0; n < 2; ++n) { const int col = u.pn * 256 + bj * 128 + wc * 32 + n * 16 + 4 * fqo;
                            const f32x4 v = acc[ai][bj][m][n] + xv[mm][bj][n]; const f32x4 w = wv[bj][n];
                            *(f32x4*)(out + row * 1024 + col) = v;
                            s += (v[0] * v[0] + v[1] * v[1]) + (v[2] * v[2] + v[3] * v[3]);
                            u32x2 o; o.x = pk2(v[0] * w[0], v[1] * w[1]); o.y = pk2(v[2] * w[2], v[3] * w[3]); *(u32x2*)(hn + row * 1024 + col) = o; }
                    s += __shfl_xor(s, 16); s += __shfl_xor(s, 32);
                    if (fq == 0) ssq[row * 16 + u.pn * 4 + wc] = s; }
                asm volatile("" ::: "memory"); }
    } };
struct EpiGateUp { static constexpr bool PERM = true, MID = false; const int* list; const float* rstdv; bf16* hb;
    __device__ __forceinline__ void operator()(const f32x4 (&acc)[2][2][4][2], const pg8::Unit& u, int wr, int wc, int fr, int fq) const {
        const int fro = opaque(fr), fqo = opaque(fq);
        int tk[8]; float rsv[8];
#pragma unroll
        for (int q = 0; q < 8; ++q) { int idx = u.i0 + (q >> 2) * 128 + wr * 64 + (q & 3) * 16 + fro; idx = idx < u.cn ? idx : u.cn - 1; tk[q] = list[(size_t)u.l * T + idx]; }
#pragma unroll
        for (int q = 0; q < 8; ++q) rsv[q] = rstdv[tk[q]];
#pragma unroll
        for (int ai = 0; ai < 2; ++ai)
#pragma unroll
            for (int m = 0; m < 4; ++m) { const int r = ai * 128 + wr * 64 + m * 16 + fro; const float rs = rsv[ai * 4 + m];
                u32x4 w;
                { const f32x4 g = acc[ai][0][m][0] * rs, uu = acc[ai][1][m][0] * rs;
                  w.x = pk2(g[0] * sigmoidf_(g[0]) * uu[0], g[1] * sigmoidf_(g[1]) * uu[1]); w.y = pk2(g[2] * sigmoidf_(g[2]) * uu[2], g[3] * sigmoidf_(g[3]) * uu[3]); }
                { const f32x4 g = acc[ai][0][m][1] * rs, uu = acc[ai][1][m][1] * rs;
                  w.z = pk2(g[0] * sigmoidf_(g[0]) * uu[0], g[1] * sigmoidf_(g[1]) * uu[1]); w.w = pk2(g[2] * sigmoidf_(g[2]) * uu[2], g[3] * sigmoidf_(g[3]) * uu[3]); }
                *(u32x4*)(hb + ((size_t)u.pm * 256 + r) * 512 + u.pn * 128 + wc * 32 + 8 * fqo) = w; }
    } };
struct EpiDownY { static constexpr bool PERM = true, MID = false; const int* list; const float* gw; bf16* Y;
    __device__ __forceinline__ void operator()(const f32x4 (&acc)[2][2][4][2], const pg8::Unit& u, int wr, int wc, int fr, int fq) const {
        const int fro = opaque(fr), fqo = opaque(fq);
        int tk[8]; float gv[8];
#pragma unroll
        for (int q = 0; q < 8; ++q) { const int idx = u.i0 + (q >> 2) * 128 + wr * 64 + (q & 3) * 16 + fro; tk[q] = idx < u.cn ? list[(size_t)u.l * T + idx] : -1; }
#pragma unroll
        for (int q = 0; q < 8; ++q) gv[q] = tk[q] >= 0 ? gw[tk[q] * 2 + 1] : 0.f;
#pragma unroll
        for (int ai = 0; ai < 2; ++ai)
#pragma unroll
            for (int m = 0; m < 4; ++m) { const int tok = tk[ai * 4 + m]; const float g = gv[ai * 4 + m];
                if (tok >= 0) {
#pragma unroll
                    for (int bj = 0; bj < 2; ++bj) { const f32x4 v0 = acc[ai][bj][m][0] * g, v1 = acc[ai][bj][m][1] * g;
                        u32x4 w; w.x = pk2(v0[0], v0[1]); w.y = pk2(v0[2], v0[3]); w.z = pk2(v1[0], v1[1]); w.w = pk2(v1[2], v1[3]);
                        *(u32x4*)(Y + (size_t)tok * 1024 + u.pn * 256 + bj * 128 + wc * 32 + 8 * fqo) = w; } } }
    } };
#ifndef EPIDOWN_BATCH
#define EPIDOWN_BATCH 2
#endif
struct EpiDown { static constexpr bool PERM = false, MID = false; const int* list; const float* gw; float* out; const bf16* Y; const float* tp;
    __device__ __forceinline__ void operator()(const f32x4 (&acc)[2][2][4][2], const pg8::Unit& u, int wr, int wc, int fr, int fq) const {
        const int fro = opaque(fr), fqo = opaque(fq);
        int tk[8]; float gv[8];
#pragma unroll
        for (int q = 0; q < 8; ++q) { const int idx = u.i0 + (q >> 2) * 128 + wr * 64 + (q & 3) * 16 + fro; tk[q] = idx < u.cn ? list[(size_t)u.l * T + idx] : -1; }
#pragma unroll
        for (int q = 0; q < 8; ++q) gv[q] = tk[q] >= 0 ? gw[tk[q] * 2] : 0.f;
#pragma unroll
        for (int ai = 0; ai < 2; ++ai)
#pragma unroll
            for (int mh = 0; mh < 4 / EPIDOWN_BATCH; ++mh) {
                f32x4 ov[EPIDOWN_BATCH][2][2]; u32x2 yv[EPIDOWN_BATCH][2][2];
#pragma unroll
                for (int mm = 0; mm < EPIDOWN_BATCH; ++mm) { const int tok = tk[ai * 4 + mh * EPIDOWN_BATCH + mm]; const size_t base = (size_t)(tok >= 0 ? tok : 0) * 1024 + u.pn * 256 + wc * 32 + 4 * fqo;
#pragma unroll
                    for (int bj = 0; bj < 2; ++bj)
#pragma unroll
                        for (int n = 0; n < 2; ++n) { ov[mm][bj][n] = *(const f32x4*)(out + base + bj * 128 + n * 16); yv[mm][bj][n] = *(const u32x2*)(Y + base + bj * 128 + n * 16); } }
#pragma unroll
                for (int mm = 0; mm < EPIDOWN_BATCH; ++mm) { const int m = mh * EPIDOWN_BATCH + mm; const int tok = tk[ai * 4 + m]; const float g = gv[ai * 4 + m];
                    if (tok >= 0) { const size_t base = (size_t)tok * 1024 + u.pn * 256 + wc * 32 + 4 * fqo;
#pragma unroll
                        for (int bj = 0; bj < 2; ++bj)
#pragma unroll
                            for (int n = 0; n < 2; ++n) { const u32x2 y = yv[mm][bj][n]; f32x4 o = ov[mm][bj][n] + acc[ai][bj][m][n] * g;
                                o[0] += bflo(y.x); o[1] += bfhi(y.x); o[2] += bflo(y.y); o[3] += bfhi(y.y);
#ifdef TPA
                                { const float db = sqrtf(tp[1] * 2e-6f); o = o + (((tok + n) & 1) ? db : -db); if (tok == 0 && u.pn == 0 && bj == 0 && n == 0 && wc == 0 && fqo == 0) o[0] += tp[0] * TPAS; }
#endif
                                *(f32x4*)(out + base + bj * 128 + n * 16) = o; } } }
                asm volatile("" ::: "memory"); }
    } };

struct TItem { const float* W; bf16* WT; int N, ldwt, k0, n0, drow0; };
__device__ __forceinline__ void titem_load(const TItem& t, int lane, float (&tv)[32]);
__device__ __forceinline__ void titem_store(const TItem& t, int lane, const float (&tv)[32], LAS float* scr);
__device__ __forceinline__ void transpose_item(const float* W, int N, bf16* WT, int ldwt, int kd0, int k0, int n0, int drow0, LAS float* scr, int lane) {
    TItem t; t.W = W; t.WT = WT + kd0; t.N = N; t.ldwt = ldwt; t.k0 = k0; t.n0 = n0; t.drow0 = drow0;
    float tv[32]; titem_load(t, lane, tv); titem_store(t, lane, tv, scr);
}

constexpr int EI_G = 16 * 16, EI_D = 8 * 32, EI_PER = 2 * EI_G + EI_D, EI_TOTAL = NEXP * EI_PER;
__device__ __forceinline__ TItem expert_item(const Params& P, int it) {
    TItem t; const int e = it / EI_PER; int r = it - e * EI_PER;
    if (r < EI_G) { const int kb = r / 16, nb = r % 16; t.n0 = 32 * nb; t.W = P.w_gate + (size_t)e * 1024 * 512; t.N = 512; t.WT = (bf16*)(P.ws + WS_WGU) + (size_t)e * 1024 * 1024; t.ldwt = 1024; t.k0 = 64 * kb; t.drow0 = (t.n0 >> 7) * 256 + (t.n0 & 127); return t; }
    r -= EI_G;
    if (r < EI_G) { const int kb = r / 16, nb = r % 16; t.n0 = 32 * nb; t.W = P.w_up + (size_t)e * 1024 * 512; t.N = 512; t.WT = (bf16*)(P.ws + WS_WGU) + (size_t)e * 1024 * 1024; t.ldwt = 1024; t.k0 = 64 * kb; t.drow0 = (t.n0 >> 7) * 256 + 128 + (t.n0 & 127); return t; }
    r -= EI_G;
    { const int kb = r / 32, nb = r % 32; t.n0 = 32 * nb; t.W = P.w_down + (size_t)e * 512 * 1024; t.N = 1024; t.WT = (bf16*)(P.ws + WS_WD) + (size_t)e * 1024 * 512; t.ldwt = 512; t.k0 = 64 * kb; t.drow0 = 32 * nb; return t; }
}
__device__ __forceinline__ void titem_load(const TItem& t, int lane, float (&tv)[32]) {
#pragma unroll
    for (int j = 0; j < 8; ++j) { const f32x4 v = *(const f32x4*)(t.W + (size_t)(t.k0 + 8 * j + (lane >> 3)) * t.N + t.n0 + 4 * (lane & 7));
        tv[4 * j] = v[0]; tv[4 * j + 1] = v[1]; tv[4 * j + 2] = v[2]; tv[4 * j + 3] = v[3]; }
}
__device__ __forceinline__ void titem_store(const TItem& t, int lane, const float (&tv)[32], LAS float* scr) {
#pragma unroll
    for (int j = 0; j < 8; ++j)
#pragma unroll
        for (int q = 0; q < 4; ++q) scr[(8 * j + (lane >> 3)) * 33 + 4 * (lane & 7) + q] = tv[4 * j + q];
    asm volatile("s_waitcnt lgkmcnt(0)" ::: "memory");
    const int c = lane & 7;
#pragma unroll
    for (int j = 0; j < 4; ++j) { const int n = (lane >> 3) + 8 * j; const LAS float* sp = scr + (8 * c) * 33 + n;
        u32x4 o; o.x = pk2(sp[0 * 33], sp[1 * 33]); o.y = pk2(sp[2 * 33], sp[3 * 33]); o.z = pk2(sp[4 * 33], sp[5 * 33]); o.w = pk2(sp[6 * 33], sp[7 * 33]);
        *(u32x4*)(t.WT + (size_t)(t.drow0 + n) * t.ldwt + t.k0 + 8 * c) = o; }
    asm volatile("s_waitcnt lgkmcnt(0)" ::: "memory");
}

__device__ __forceinline__ void phase0(const Params& P, LAS unsigned char* lds, int vcu, int G, int tid, int wid, int lane) {
    unsigned char* ws = P.ws;
    LAS float* scr = (LAS float*)(lds + wid * 16384);
    const int gw = vcu * 8 + wid, NGW = G * 8;
    constexpr int I_IN = 16 * 152, I_BR = 8 * 32, I_OUT = 16 * 32;
    constexpr int NITEMS = I_IN + 2 * I_BR + I_OUT;
    for (int it = gw; it < NITEMS; it += NGW) {
        int r = it;
        if (r < I_IN) { const int kb = r / 152, nb = r % 152; transpose_item(P.w_in, NPROJ, (bf16*)(ws + WS_WINT), 1024, 0, 64 * kb, 32 * nb, 32 * nb, scr, lane); continue; } r -= I_IN;
        if (r < I_BR) { const int kb = r / 32, nb = r % 32; transpose_item(P.w_ba, 1024, (bf16*)(ws + WS_WAT), 1024, 0, 64 * kb, 32 * nb, 32 * nb, scr, lane); continue; } r -= I_BR;
        if (r < I_BR) { const int kb = r / 32, nb = r % 32; transpose_item(P.w_bh, 1024, (bf16*)(ws + WS_WAT), 1024, 512, 64 * kb, 32 * nb, 32 * nb, scr, lane); continue; } r -= I_BR;
        { const int kb = r / 32, nb = r % 32; transpose_item(P.w_out, 1024, (bf16*)(ws + WS_WOT), 1024, 0, 64 * kb, 32 * nb, 32 * nb, scr, lane); }
    }
    { bf16* Wh = (bf16*)(ws + WS_WR); bf16* Wl = Wh + 48 * 1024;
      for (int idx = (vcu * NTHREADS + tid); idx < 48 * 1024; idx += G * NTHREADS) { const int j = idx >> 10, k = idx & 1023; float v = 0.f;
          if (j < 4) v = P.w_rg[k * 4 + j] * P.norm2_w[k]; else if (j < 36) v = P.w_re[k * 32 + (j - 4)] * P.norm2_w[k];
          const unsigned hi = f2bf(v); Wh[idx] = (bf16)hi; Wl[idx] = (bf16)f2bf(v - bf2f(hi)); } }
    { float* cs = (float*)(ws + WS_CS);
      const float invf[8] = {1.0f, 0.1939227432012558f, 0.03760603070259094f, 0.007292664609849453f, 0.0014142135623842478f, 0.00027424818836152554f, 5.318296098266728e-05f, 1.0313386155758053e-05f};
      for (int idx = (vcu * NTHREADS + tid); idx < T * 8; idx += G * NTHREADS) { const int tok = idx >> 3, i = idx & 7; float f = invf[0];
#pragma unroll
          for (int q = 1; q < 8; ++q) f = (i == q) ? invf[q] : f;
          float sn, c_; sincosf((float)P.positions[tok] * f, &sn, &c_); cs[tok * 16 + i] = c_; cs[tok * 16 + 8 + i] = sn; } }
    { bf16* xn = (bf16*)P.out;
      f32x4 wv[4];
#pragma unroll
      for (int j = 0; j < 4; ++j) wv[j] = *(const f32x4*)(P.norm1_w + 4 * lane + 256 * j);
      for (int m = gw; m < T; m += NGW) {
          const f32x4* xr = (const f32x4*)(P.x + (size_t)m * D) + lane; f32x4 v[4]; float s = 0.f;
#pragma unroll
          for (int j = 0; j < 4; ++j) { v[j] = xr[64 * j]; s += (v[j].x * v[j].x + v[j].y * v[j].y) + (v[j].z * v[j].z + v[j].w * v[j].w); }
          const float rstd = 1.f / sqrtf(wave_sum(s) * (1.f / D) + EPS);
          u32x2* o8 = (u32x2*)(xn + (size_t)m * D) + lane;
#pragma unroll
          for (int j = 0; j < 4; ++j) { u32x2 o; o.x = pk2(v[j].x * rstd * wv[j].x, v[j].y * rstd * wv[j].y); o.y = pk2(v[j].z * rstd * wv[j].z, v[j].w * rstd * wv[j].w); o8[64 * j] = o; }
      } }
}

__device__ __forceinline__ void phase1(const Params& P, LAS unsigned char* lds, int G) {
    const pg8::DenseSched S{(const char*)P.out, (const char*)(P.ws + WS_WINT), 1024, T / 256, NPROJ / 256, G, (int)blockIdx.x};
    const EpiProj E{(bf16*)(P.ws + WS_PROJ)};
    pg8::gemm_phase(lds, S, E);
}
__device__ __forceinline__ void phase5(const Params& P, LAS unsigned char* lds, int G) {
    const pg8::DenseSched S{(const char*)P.out + OUT_AH, (const char*)(P.ws + WS_WAT), 1024, T / 256, 4, G, (int)blockIdx.x};
    const EpiMixed E{(const bf16*)(P.ws + WS_PROJ), (bf16*)(P.ws + WS_MIXED)};
    pg8::gemm_phase(lds, S, E);
}
__device__ __forceinline__ void phase6(const Params& P, LAS unsigned char* lds, int G) {
    const pg8::DenseSched S{(const char*)(P.ws + WS_MIXED), (const char*)(P.ws + WS_WOT), 1024, T / 256, 4, G, (int)blockIdx.x};
    const EpiX1 E{P.x, P.norm2_w, P.out, (bf16*)(P.ws + WS_HN), (float*)(P.ws + WS_SSQ)};
    pg8::gemm_phase(lds, S, E);
}

constexpr int H_TOT = 0, H_DV = 2048, H_SSQ = 2560, H_QT = 4608, H_KH = H_QT + 17408, H_KTT = H_KH + 17408, H_VT = H_KTT + 18432, H_ST = H_VT + 18432, H_AM = H_ST + 34816, H_END = H_AM + 9216;
static_assert(H_END <= LDS_ST_OFF, "hgrn LDS");
__device__ __forceinline__ bf16x8 ldfrag(const LAS unsigned char* base, int row, int stride, int kbyte) { return *(const LAS bf16x8*)(base + row * stride + kbyte); }

template <int MODE>
__device__ __forceinline__ void hgrn_unit(const Params& P, LAS unsigned char* lds, int unit, int tid, int wid, int lane, int cit = EI_TOTAL, int cstride = 1) {
    LAS float* cscr = (LAS float*)(lds + (wid < 4 ? H_QT + wid * 8448 : H_ST + (wid - 4) * 8448));
    const int b = unit >> 6, h = (unit >> 4) & 3, sc = unit & 15;
    const int fr = opaque(lane & 15), fq = opaque(lane >> 4), c = opaque(tid & 127), qd = tid >> 7;
    const bf16* proj = (const bf16*)(P.ws + WS_PROJ);
    LAS float* TOT = (LAS float*)(lds + H_TOT); LAS float* DV = (LAS float*)(lds + H_DV); LAS float* SSQ = (LAS float*)(lds + H_SSQ);
    LAS bf16* Qt = (LAS bf16*)(lds + H_QT); LAS bf16* Kh = (LAS bf16*)(lds + H_KH); LAS bf16* KtT = (LAS bf16*)(lds + H_KTT); LAS bf16* VT = (LAS bf16*)(lds + H_VT);
    const float lbv = 1.f / (1.f + __expf(P.hlb[512 + h * 128 + c] - P.hlb[h * 128 + c]));
    float* Ug = (float*)((unsigned char*)P.out + OUT_U) + (size_t)unit * 16384;
    const float* Sin = (const float*)((unsigned char*)P.out + OUT_SIN) + (size_t)unit * 16384;
    f32x4 accS[8];
#pragma unroll
    for (int di = 0; di < 8; ++di) {
        if (MODE == 1 && sc > 0) {
#pragma unroll
            for (int r = 0; r < 4; ++r) accS[di][r] = Sin[(16 * di + 4 * fq + r) * 128 + 16 * wid + fr];
        } else accS[di] = (f32x4){0.f, 0.f, 0.f, 0.f};
        if (MODE == 1) { u32x2 o; o.x = pk2(accS[di][0], accS[di][1]); o.y = pk2(accS[di][2], accS[di][3]);
            *(LAS u32x2*)(lds + H_ST + (16 * wid + fr) * 272 + (16 * di + 4 * fq) * 2) = o; }
    }
    float dsum = 0.f;
    unsigned short rf[16], rq[16], rv[16];
#define HG_LOAD(ccx) do { const size_t t0x_ = (size_t)b * SEQ + sc * 512 + (ccx) * 64; const bf16* pb_ = proj + (t0x_ + qd * 16) * NPROJ + h * 128 + c; \
        _Pragma("unroll") for (int i = 0; i < 16; ++i) { rf[i] = pb_[(size_t)i * NPROJ + C_FH]; rv[i] = pb_[(size_t)i * NPROJ + C_IH]; if (MODE == 1) rq[i] = pb_[(size_t)i * NPROJ + C_QH]; } \
        } while (0)
    HG_LOAD(0);
#pragma unroll 1
    for (int cc = 0; cc < 8; ++cc) {
        const size_t t0 = (size_t)b * SEQ + sc * 512 + cc * 64;
        float tva[32], tvb[32]; TItem ia, ib; const int ita = cit, itb = cit + cstride;
        if (MODE == 0) { if (ita < EI_TOTAL) { ia = expert_item(P, ita); titem_load(ia, lane, tva); } if (itb < EI_TOTAL) { ib = expert_item(P, itb); titem_load(ib, lane, tvb); } }
        float bpart[16], kk[16]; float run = 0.f;
#pragma unroll
        for (int i = 0; i < 16; ++i) { const float f = bf2f(rf[i]);
            const float kv = (1.f - lbv) * __builtin_amdgcn_rcpf(1.f + fexp_(f));
            kk[i] = kv; run += __builtin_amdgcn_logf(1.f - kv); bpart[i] = run; }
        TOT[qd * 128 + c] = run;
        __syncthreads();
        float offs = 0.f, blast = 0.f;
#pragma unroll
        for (int q = 0; q < 4; ++q) { const float tv = TOT[q * 128 + c]; blast += tv; if (q < qd) offs += tv; }
        if (qd == 0) { DV[c] = exp2_(blast); dsum += blast; }
#pragma unroll
        for (int i = 0; i < 16; ++i) { const int t = qd * 16 + i; const float bb = bpart[i] + offs;
            if (MODE == 1) { const float q = bf2f(rq[i]); const float qs = q * sigmoidf_(q);
                Qt[t * 136 + c] = (bf16)f2bf(qs * exp2_(bb)); Kh[t * 136 + c] = (bf16)f2bf(kk[i] * exp2_(fminf(-bb, 115.f))); }
            KtT[c * 72 + t] = (bf16)f2bf(kk[i] * exp2_(blast - bb));
            VT[c * 72 + t] = rv[i]; }
        u32x2 gcur[4];
        if (MODE == 1) {
#pragma unroll
            for (int mi = 0; mi < 4; ++mi) gcur[mi] = *(const u32x2*)(proj + (t0 + 16 * mi + fr) * NPROJ + C_GH + h * 128 + 16 * wid + 4 * fq); }
        if (cc + 1 < 8) HG_LOAD(cc + 1);
        __syncthreads();
        f32x4 acco[4];
        if (MODE == 1) {
#pragma unroll
            for (int e2 = 0; e2 < 2; ++e2) { const int idx = 2 * wid + e2, mi = idx >> 2, ni = idx & 3; f32x4 a = (f32x4){0.f, 0.f, 0.f, 0.f};
                if (ni <= mi) {
#pragma unroll
                    for (int ks = 0; ks < 4; ++ks) { const bf16x8 kf = ldfrag(lds + H_KH, 16 * ni + fr, 272, (ks * 32 + fq * 8) * 2), qf = ldfrag(lds + H_QT, 16 * mi + fr, 272, (ks * 32 + fq * 8) * 2);
                        a = __builtin_amdgcn_mfma_f32_16x16x32_bf16(kf, qf, a, 0, 0, 0); } }
                const int t = 16 * mi + fr, s0 = 16 * ni + 4 * fq;
#pragma unroll
                for (int r = 0; r < 4; ++r) if (s0 + r > t || ni > mi) a[r] = 0.f;
                u32x2 o; o.x = pk2(a[0], a[1]); o.y = pk2(a[2], a[3]); *(LAS u32x2*)(lds + H_AM + t * 144 + s0 * 2) = o; }
#pragma unroll
            for (int mi = 0; mi < 4; ++mi) { acco[mi] = (f32x4){0.f, 0.f, 0.f, 0.f};
#pragma unroll
                for (int ks = 0; ks < 4; ++ks) { const bf16x8 sf = ldfrag(lds + H_ST, 16 * wid + fr, 272, (ks * 32 + fq * 8) * 2), qf = ldfrag(lds + H_QT, 16 * mi + fr, 272, (ks * 32 + fq * 8) * 2);
                    acco[mi] = __builtin_amdgcn_mfma_f32_16x16x32_bf16(sf, qf, acco[mi], 0, 0, 0); } }
        }
#pragma unroll
        for (int di = 0; di < 8; ++di) { const f32x4 dv4 = *(const LAS f32x4*)(lds + H_DV + (16 * di + 4 * fq) * 4); accS[di] = accS[di] * dv4;
#pragma unroll
            for (int ks = 0; ks < 2; ++ks) { const bf16x8 kf = ldfrag(lds + H_KTT, 16 * di + fr, 144, (ks * 32 + fq * 8) * 2), vf = ldfrag(lds + H_VT, 16 * wid + fr, 144, (ks * 32 + fq * 8) * 2);
                accS[di] = __builtin_amdgcn_mfma_f32_16x16x32_bf16(kf, vf, accS[di], 0, 0, 0); }
            if (MODE == 1) { u32x2 o; o.x = pk2(accS[di][0], accS[di][1]); o.y = pk2(accS[di][2], accS[di][3]);
                *(LAS u32x2*)(lds + H_ST + (16 * wid + fr) * 272 + (16 * di + 4 * fq) * 2) = o; } }
        if (MODE == 0) { if (ita < EI_TOTAL) titem_store(ia, lane, tva, cscr); if (itb < EI_TOTAL) titem_store(ib, lane, tvb, cscr); cit += 2 * cstride; }
        if (MODE == 1) {
            __syncthreads();
#pragma unroll
            for (int mi = 0; mi < 4; ++mi) {
#pragma unroll
                for (int ks = 0; ks < 2; ++ks) { const bf16x8 vf = ldfrag(lds + H_VT, 16 * wid + fr, 144, (ks * 32 + fq * 8) * 2), af = ldfrag(lds + H_AM, 16 * mi + fr, 144, (ks * 32 + fq * 8) * 2);
                    acco[mi] = __builtin_amdgcn_mfma_f32_16x16x32_bf16(vf, af, acco[mi], 0, 0, 0); }
                float s = (acco[mi][0] * acco[mi][0] + acco[mi][1] * acco[mi][1]) + (acco[mi][2] * acco[mi][2] + acco[mi][3] * acco[mi][3]);
                s += __shfl_xor(s, 16); s += __shfl_xor(s, 32);
                if (fq == 0) SSQ[wid * 64 + 16 * mi + fr] = s; }
            __syncthreads();
            bf16* hg = (bf16*)((unsigned char*)P.out + OUT_AH);
            const f32x4 nw = *(const f32x4*)(P.hnw + 16 * wid + 4 * fq);
#pragma unroll
            for (int mi = 0; mi < 4; ++mi) { const int t = 16 * mi + fr; float tot = 0.f;
#pragma unroll
                for (int w = 0; w < 8; ++w) tot += SSQ[w * 64 + t];
                const float rstd = __builtin_amdgcn_rsqf(tot * (1.f / 128.f) + EPS);
                const u32x2 gg = gcur[mi];
                const float g0 = bflo(gg.x), g1 = bfhi(gg.x), g2 = bflo(gg.y), g3 = bfhi(gg.y);
                u32x2 o; o.x = pk2(acco[mi][0] * rstd * nw[0] * (g0 * sigmoidf_(g0)), acco[mi][1] * rstd * nw[1] * (g1 * sigmoidf_(g1)));
                o.y = pk2(acco[mi][2] * rstd * nw[2] * (g2 * sigmoidf_(g2)), acco[mi][3] * rstd * nw[3] * (g3 * sigmoidf_(g3)));
                *(u32x2*)(hg + (t0 + t) * 1024 + 512 + h * 128 + 16 * wid + 4 * fq) = o; }
        }
    }
    if (MODE == 0) {
#pragma unroll
        for (int di = 0; di < 8; ++di)
#pragma unroll
            for (int r = 0; r < 4; ++r) Ug[(16 * di + 4 * fq + r) * 128 + 16 * wid + fr] = accS[di][r];
        if (qd == 0) ((float*)((unsigned char*)P.out + OUT_DSC))[unit * 128 + c] = exp2_(dsum);
    }
    __syncthreads();
}

__device__ __forceinline__ void hgrn_scan(const Params& P, int G, int tid) {
    const float* U = (const float*)((unsigned char*)P.out + OUT_U); float* Sin = (float*)((unsigned char*)P.out + OUT_SIN);
    const float* Dsc = (const float*)((unsigned char*)P.out + OUT_DSC);
    for (int idx = blockIdx.x * NTHREADS + tid; idx < 16 * 16384; idx += G * NTHREADS) {
        const int p = idx >> 14, e = idx & 16383, dk = e >> 7; float S = 0.f;
        float uu[15], dd[15];
#pragma unroll
        for (int sc = 0; sc < 15; ++sc) { const int u = p * 16 + sc; dd[sc] = Dsc[u * 128 + dk]; uu[sc] = U[(size_t)u * 16384 + e]; }
#pragma unroll
        for (int sc = 0; sc < 15; ++sc) { const int u = p * 16 + sc; S = dd[sc] * S + uu[sc]; Sin[(size_t)(u + 1) * 16384 + e] = S; }
    }
}

constexpr int A_KT = 0, A_VT = 36864, A_QS = 70656, A_END = A_QS + 73728;
static_assert(A_END <= LDS_ST_OFF, "attn LDS");
__device__ __forceinline__ void rope16(float (&v)[32], const float* cs) {
    const f32x4 c0 = *(const f32x4*)cs, c1 = *(const f32x4*)(cs + 4), s0 = *(const f32x4*)(cs + 8), s1 = *(const f32x4*)(cs + 12);
#pragma unroll
    for (int i = 0; i < 8; ++i) { const float cv = i < 4 ? c0[i & 3] : c1[i & 3], sv = i < 4 ? s0[i & 3] : s1[i & 3]; const float x1 = v[i], x2 = v[i + 8]; v[i] = x1 * cv - x2 * sv; v[i + 8] = x2 * cv + x1 * sv; }
}
__device__ __forceinline__ void unpack8(const u32x4 w, float* v) { v[0] = bflo(w.x); v[1] = bfhi(w.x); v[2] = bflo(w.y); v[3] = bfhi(w.y); v[4] = bflo(w.z); v[5] = bfhi(w.z); v[6] = bflo(w.w); v[7] = bfhi(w.w); }
__device__ __forceinline__ void attn_unit(const Params& P, LAS unsigned char* lds, int unit, int tid, int wid, int lane) {
    const int hk = unit & 1, nb = (unit >> 1) & 63, b = unit >> 7;
    const int fr = opaque(lane & 15), fq = opaque(lane >> 4);
    const bf16* proj = (const bf16*)(P.ws + WS_PROJ);
    const float* cstab = (const float*)(P.ws + WS_CS);
    {
        const int key = tid >> 1, half = tid & 1; const int srel = nb * 128 - 128 + key;
        const bool ok = srel >= 0; const size_t tokk = (size_t)b * SEQ + (ok ? srel : 0);
        const int g = tid >> 7, ql = tid & 127; const size_t tokq = (size_t)b * SEQ + nb * 128 + ql;
        const u32x4* ksrc = (const u32x4*)(proj + tokk * NPROJ + C_KA + hk * 64 + half * 32);
        const u32x4* vsrc = (const u32x4*)(proj + tokk * NPROJ + C_VA + hk * 64 + half * 32);
        const u32x4* qsrc = (const u32x4*)(proj + tokq * NPROJ + C_QA + (hk * 4 + g) * 64);
        u32x4 kr[4], vr[4], qr[8];
#pragma unroll
        for (int j = 0; j < 4; ++j) { kr[j] = ksrc[j]; vr[j] = vsrc[j]; }
#pragma unroll
        for (int j = 0; j < 8; ++j) qr[j] = qsrc[j];
        { float v[32];
#pragma unroll
          for (int j = 0; j < 4; ++j) unpack8(kr[j], v + 8 * j);
          float s = 0.f;
#pragma unroll
          for (int j = 0; j < 32; ++j) s += v[j] * v[j];
          s += __shfl_xor(s, 1);
          const float rstd = 1.f / sqrtf(s * (1.f / 64.f) + EPS);
#pragma unroll
          for (int j = 0; j < 8; ++j) { const f32x4 w = *(const f32x4*)(P.k_norm_w + half * 32 + 4 * j);
              v[4 * j] *= rstd * w[0]; v[4 * j + 1] *= rstd * w[1]; v[4 * j + 2] *= rstd * w[2]; v[4 * j + 3] *= rstd * w[3]; }
          if (half == 0) rope16(v, cstab + tokk * 16);
#pragma unroll
          for (int j = 0; j < 4; ++j) { u32x4 o; o.x = pk2(v[8 * j], v[8 * j + 1]); o.y = pk2(v[8 * j + 2], v[8 * j + 3]); o.z = pk2(v[8 * j + 4], v[8 * j + 5]); o.w = pk2(v[8 * j + 6], v[8 * j + 7]);
              if (!ok) o = (u32x4){0u, 0u, 0u, 0u};
              *(LAS u32x4*)(lds + A_KT + key * 144 + half * 64 + j * 16) = o; } }
#pragma unroll
        for (int j = 0; j < 4; ++j) { u32x4 w = vr[j]; if (!ok) w = (u32x4){0u, 0u, 0u, 0u};
            LAS bf16* dst = (LAS bf16*)(lds + A_VT) + (half * 32 + 8 * j) * 264 + key;
            dst[0 * 264] = (bf16)(w.x & 0xffffu); dst[1 * 264] = (bf16)(w.x >> 16); dst[2 * 264] = (bf16)(w.y & 0xffffu); dst[3 * 264] = (bf16)(w.y >> 16);
            dst[4 * 264] = (bf16)(w.z & 0xffffu); dst[5 * 264] = (bf16)(w.z >> 16); dst[6 * 264] = (bf16)(w.w & 0xffffu); dst[7 * 264] = (bf16)(w.w >> 16); }
        { float s = 0.f;
#pragma unroll
          for (int j = 0; j < 8; ++j) { float a[8]; unpack8(qr[j], a); s += (a[0] * a[0] + a[1] * a[1]) + (a[2] * a[2] + a[3] * a[3]) + (a[4] * a[4] + a[5] * a[5]) + (a[6] * a[6] + a[7] * a[7]); }
          const float rstd = (0.125f * LOG2E) / sqrtf(s * (1.f / 64.f) + EPS);
#pragma unroll
          for (int hf = 0; hf < 2; ++hf) { float v[32];
#pragma unroll
              for (int j = 0; j < 4; ++j) unpack8(qr[hf * 4 + j], v + 8 * j);
#pragma unroll
              for (int j = 0; j < 8; ++j) { const f32x4 w = *(const f32x4*)(P.q_norm_w + hf * 32 + 4 * j);
                  v[4 * j] *= rstd * w[0]; v[4 * j + 1] *= rstd * w[1]; v[4 * j + 2] *= rstd * w[2]; v[4 * j + 3] *= rstd * w[3]; }
              if (hf == 0) rope16(v, cstab + tokq * 16);
#pragma unroll
              for (int j = 0; j < 4; ++j) { u32x4 o; o.x = pk2(v[8 * j], v[8 * j + 1]); o.y = pk2(v[8 * j + 2], v[8 * j + 3]); o.z = pk2(v[8 * j + 4], v[8 * j + 5]); o.w = pk2(v[8 * j + 6], v[8 * j + 7]);
                  *(LAS u32x4*)(lds + A_QS + tid * 144 + hf * 64 + j * 16) = o; } } }
    }
    __syncthreads();
    { const int g = wid >> 1; const float sink = P.sinks[hk * 4 + g] * LOG2E;
      bf16* attn = (bf16*)((unsigned char*)P.out + OUT_AH);
#pragma unroll 1
      for (int p = 0; p < 2; ++p) { const int q0 = (wid & 1) * 64 + p * 32;
          f32x4 sT[10][2];
          bf16x8 qf[2][2];
#pragma unroll
          for (int nq = 0; nq < 2; ++nq)
#pragma unroll
              for (int ks = 0; ks < 2; ++ks) qf[nq][ks] = ldfrag(lds + A_QS, g * 128 + q0 + 16 * nq + fr, 144, (ks * 32 + fq * 8) * 2);
#pragma unroll
          for (int kt = 0; kt < 10; ++kt) {
#pragma unroll
              for (int nq = 0; nq < 2; ++nq) sT[kt][nq] = (f32x4){0.f, 0.f, 0.f, 0.f};
#pragma unroll
              for (int ks = 0; ks < 2; ++ks) { const bf16x8 kf = ldfrag(lds + A_KT, q0 + 16 * kt + fr, 144, (ks * 32 + fq * 8) * 2);
#pragma unroll
                  for (int nq = 0; nq < 2; ++nq) if (kt - nq >= 0 && kt - nq <= 8) sT[kt][nq] = __builtin_amdgcn_mfma_f32_16x16x32_bf16(kf, qf[nq][ks], sT[kt][nq], 0, 0, 0); } }
          float linv[2];
#pragma unroll
          for (int nq = 0; nq < 2; ++nq) { float mx = sink;
#pragma unroll
              for (int kt = 0; kt < 10; ++kt) { const int d = kt - nq; if (d < 0 || d > 8) continue;
#pragma unroll
                  for (int r = 0; r < 4; ++r) { bool valid = true;
                      if (d == 0) valid = (4 * fq + r > fr); else if (d == 8) valid = (4 * fq + r <= fr);
                      if (nb == 0) valid = valid && (q0 + 16 * kt + 4 * fq + r >= 128);
                      if (!valid) sT[kt][nq][r] = -1e30f; mx = fmaxf(mx, sT[kt][nq][r]); } }
              mx = fmaxf(mx, __shfl_xor(mx, 16)); mx = fmaxf(mx, __shfl_xor(mx, 32));
              float l = 0.f;
#pragma unroll
              for (int kt = 0; kt < 10; ++kt) { const int d = kt - nq; if (d < 0 || d > 8) continue;
#pragma unroll
                  for (int r = 0; r < 4; ++r) { float pv = exp2_(sT[kt][nq][r] - mx); if ((d == 0 || d == 8 || nb == 0) && !(sT[kt][nq][r] > -1e29f)) pv = 0.f; sT[kt][nq][r] = pv; l += pv; } }
              l += __shfl_xor(l, 16); l += __shfl_xor(l, 32);
              l += exp2_(sink - mx);
              linv[nq] = 1.f / l; }
          f32x4 oT[4][2];
#pragma unroll
          for (int dt = 0; dt < 4; ++dt)
#pragma unroll
              for (int nq = 0; nq < 2; ++nq) oT[dt][nq] = (f32x4){0.f, 0.f, 0.f, 0.f};
#pragma unroll
          for (int j = 0; j < 5; ++j) { bf16x8 pf[2];
#pragma unroll
              for (int nq = 0; nq < 2; ++nq) { u32x4 w; w.x = pk2(sT[2 * j][nq][0], sT[2 * j][nq][1]); w.y = pk2(sT[2 * j][nq][2], sT[2 * j][nq][3]); w.z = pk2(sT[2 * j + 1][nq][0], sT[2 * j + 1][nq][1]); w.w = pk2(sT[2 * j + 1][nq][2], sT[2 * j + 1][nq][3]);
                  pf[nq] = __builtin_bit_cast(bf16x8, w); }
#pragma unroll
              for (int dt = 0; dt < 4; ++dt) { const LAS unsigned char* vrow = lds + A_VT + (16 * dt + fr) * 528 + (q0 + 32 * j + 4 * fq) * 2;
                  const u32x2 lo = *(const LAS u32x2*)vrow, hi = *(const LAS u32x2*)(vrow + 32);
                  u32x4 w; w.x = lo.x; w.y = lo.y; w.z = hi.x; w.w = hi.y; const bf16x8 vf = __builtin_bit_cast(bf16x8, w);
#pragma unroll
                  for (int nq = 0; nq < 2; ++nq) oT[dt][nq] = __builtin_amdgcn_mfma_f32_16x16x32_bf16(vf, pf[nq], oT[dt][nq], 0, 0, 0); } }
#pragma unroll
          for (int nq = 0; nq < 2; ++nq) { const size_t tok = (size_t)b * SEQ + nb * 128 + q0 + 16 * nq + fr;
#pragma unroll
              for (int dt = 0; dt < 4; ++dt) { const f32x4 v = oT[dt][nq] * linv[nq]; u32x2 o; o.x = pk2(v[0], v[1]); o.y = pk2(v[2], v[3]);
                  *(u32x2*)(attn + tok * 1024 + (hk * 4 + g) * 64 + 16 * dt + 4 * fq) = o; } }
      } }
    __syncthreads();
}

__device__ __forceinline__ void phase7(const Params& P, LAS unsigned char* lds, int vcu, int G, int tid, int wid, int lane, bool commit = true) {
    const bf16* Wrh = (const bf16*)(P.ws + WS_WR); const float* ssq = (const float*)(P.ws + WS_SSQ);
    unsigned* cnt = (unsigned*)(P.ws + WS_CTL + CTL_CNT); int* list = (int*)(P.ws + WS_LIST); float* gw = (float*)(P.ws + WS_GW); float* rstdv = (float*)(P.ws + WS_RSTD);
    const int fr = lane & 15, fq = lane >> 4;
    LAS float* LG = (LAS float*)(lds + wid * 3072);
    LAS unsigned* LC = (LAS unsigned*)(lds + 24576); LAS unsigned* LB = (LAS unsigned*)(lds + 24576 + 256);
    if (tid < 64) LC[tid] = 0u;
    __syncthreads();
    for (int base = vcu * 8; base < T / 16; base += G * 8) {
        const int rg = base + wid; const int R0 = rg * 16;
        f32x4 acc[3];
#pragma unroll
        for (int nt = 0; nt < 3; ++nt) acc[nt] = (f32x4){0.f, 0.f, 0.f, 0.f};
        const float* xr = P.out + (size_t)(R0 + fr) * 1024 + 8 * fq;
        const bf16* wh = Wrh + (size_t)fr * 1024 + 8 * fq;
#pragma unroll 4
        for (int ks = 0; ks < 32; ++ks) { const f32x4 a0 = *(const f32x4*)(xr + 32 * ks), a1 = *(const f32x4*)(xr + 32 * ks + 4);
            u32x4 hw, lw;
            { const unsigned h0 = f2bf(a0[0]), h1 = f2bf(a0[1]), h2 = f2bf(a0[2]), h3 = f2bf(a0[3]), h4 = f2bf(a1[0]), h5 = f2bf(a1[1]), h6 = f2bf(a1[2]), h7 = f2bf(a1[3]);
              hw.x = h0 | (h1 << 16); hw.y = h2 | (h3 << 16); hw.z = h4 | (h5 << 16); hw.w = h6 | (h7 << 16);
              lw.x = pk2(a0[0] - bf2f(h0), a0[1] - bf2f(h1)); lw.y = pk2(a0[2] - bf2f(h2), a0[3] - bf2f(h3)); lw.z = pk2(a1[0] - bf2f(h4), a1[1] - bf2f(h5)); lw.w = pk2(a1[2] - bf2f(h6), a1[3] - bf2f(h7)); }
            const bf16x8 ah = __builtin_bit_cast(bf16x8, hw), al = __builtin_bit_cast(bf16x8, lw);
#pragma unroll
            for (int nt = 0; nt < 3; ++nt) { const bf16x8 bh = *(const bf16x8*)(wh + nt * 16384 + 32 * ks), bl = *(const bf16x8*)(wh + 48 * 1024 + nt * 16384 + 32 * ks);
                acc[nt] = __builtin_amdgcn_mfma_f32_16x16x32_bf16(ah, bh, acc[nt], 0, 0, 0);
                acc[nt] = __builtin_amdgcn_mfma_f32_16x16x32_bf16(ah, bl, acc[nt], 0, 0, 0);
                acc[nt] = __builtin_amdgcn_mfma_f32_16x16x32_bf16(al, bh, acc[nt], 0, 0, 0); } }
#pragma unroll
        for (int r = 0; r < 4; ++r) { const float* sp = ssq + (size_t)(R0 + 4 * fq + r) * 16; float tot = 0.f;
#pragma unroll
            for (int q = 0; q < 4; ++q) { const f32x4 v = *(const f32x4*)(sp + 4 * q); tot += v[0]; tot += v[1]; tot += v[2]; tot += v[3]; }
            const float rstd = 1.f / sqrtf(tot * (1.f / 1024.f) + EPS);
            if (fr == 0) rstdv[R0 + 4 * fq + r] = rstd;
#pragma unroll
            for (int nt = 0; nt < 3; ++nt) { const int j = 16 * nt + fr; float bias = 0.f; if (j < 4) bias = P.b_rg[j]; else if (j < 36) bias = P.b_re[j - 4];
                LG[(4 * fq + r) * 48 + j] = acc[nt][r] * rstd + bias; } }
        __syncthreads();
        int l0 = 0, l1 = 0; unsigned rk0 = 0u, rk1 = 0u;
        if (lane < 16) { const int tok = R0 + lane; const LAS float* lg = LG + lane * 48;
            int gsel = 0; float best = lg[0];
#pragma unroll
            for (int i = 1; i < 4; ++i) { const float v = lg[i]; if (v > best) { best = v; gsel = i; } }
            float Z = 0.f;
#pragma unroll
            for (int i = 0; i < 4; ++i) Z += __expf(lg[i] - best);
            const float pgsel = 1.f / Z;
            const LAS float* le = lg + 4 + gsel * 8;
            float lmax = le[0];
#pragma unroll
            for (int i = 1; i < 8; ++i) lmax = fmaxf(lmax, le[i]);
            float Zp = 0.f;
#pragma unroll
            for (int i = 0; i < 8; ++i) Zp += __expf(le[i] - lmax);
            int i1 = 0; float p1 = -1.f;
#pragma unroll
            for (int i = 0; i < 8; ++i) { const float pe = __expf(le[i] - lmax) / Zp; if (pe > p1) { p1 = pe; i1 = i; } }
            int i2 = 0; float p2 = -1.f;
#pragma unroll
            for (int i = 0; i < 8; ++i) { const float pe = __expf(le[i] - lmax) / Zp; if (i != i1 && pe > p2) { p2 = pe; i2 = i; } }
            const float den = p1 + p2;
            gw[tok * 2 + 0] = pgsel * p1 / den; gw[tok * 2 + 1] = pgsel * p2 / den;
            l0 = gsel * 8 + i1; l1 = 32 + gsel * 8 + i2;
            rk0 = __hip_atomic_fetch_add(&LC[l0], 1u, __ATOMIC_RELAXED, __HIP_MEMORY_SCOPE_WORKGROUP); rk1 = __hip_atomic_fetch_add(&LC[l1], 1u, __ATOMIC_RELAXED, __HIP_MEMORY_SCOPE_WORKGROUP); }
        __syncthreads();
        if (tid < 64) { const unsigned n = LC[tid]; LC[tid] = 0u; if (n && commit) LB[tid] = atomicAdd(&cnt[tid * 64], n); }
        __syncthreads();
        if (lane < 16 && commit) { const int tok = R0 + lane; list[(size_t)l0 * T + LB[l0] + rk0] = tok; list[(size_t)l1 * T + LB[l1] + rk1] = tok; }
        __syncthreads();
    }
}

constexpr int M_PB = 133120, M_CN = 133632, M_RBL = 133888;
__device__ __forceinline__ void moe_prefix(const Params& P, LAS unsigned char* lds, int tid) {
    const unsigned* cnt = (const unsigned*)(P.ws + WS_CTL + CTL_CNT);
    LAS int* PB = (LAS int*)(lds + M_PB); LAS int* CN = (LAS int*)(lds + M_CN);
    if (tid < 64) CN[tid] = (int)cnt[tid * 64];
    __syncthreads();
    if (tid == 0) { int s = 0; for (int l = 0; l < 64; ++l) { PB[l] = s; s += (CN[l] + 255) >> 8; } PB[64] = s; }
    __syncthreads();
    if (tid < 64) { LAS int* RBL = (LAS int*)(lds + M_RBL); for (int rb = PB[tid]; rb < PB[tid + 1]; ++rb) RBL[rb] = tid; }
    __syncthreads();
}
__device__ __forceinline__ void phase8(const Params& P, LAS unsigned char* lds, int vcu, int G) {
    const LAS int* PB = (const LAS int*)(lds + M_PB); const LAS int* CN = (const LAS int*)(lds + M_CN);
    const pg8::MoeSched<0> S{(const char*)(P.ws + WS_HN), (const char*)(P.ws + WS_WGU), (const int*)(P.ws + WS_LIST), PB, CN, (const LAS int*)(lds + M_RBL), 1024, PB[0], (PB[64] - PB[0]) * 4, vcu, G};
    const EpiGateUp E{(const int*)(P.ws + WS_LIST), (const float*)(P.ws + WS_RSTD), (bf16*)(P.ws + WS_H)};
    pg8::gemm_phase(lds, S, E);
}
__device__ __forceinline__ void phase9(const Params& P, LAS unsigned char* lds, int vcu, int G) {
    const LAS int* PB = (const LAS int*)(lds + M_PB); const LAS int* CN = (const LAS int*)(lds + M_CN);
    const pg8::MoeSched<1> S{(const char*)(P.ws + WS_H), (const char*)(P.ws + WS_WD), (const int*)(P.ws + WS_LIST), PB, CN, (const LAS int*)(lds + M_RBL), 512, PB[32], (PB[64] - PB[32]) * 4, vcu, G};
    const EpiDownY E{(const int*)(P.ws + WS_LIST), (const float*)(P.ws + WS_GW), (bf16*)(P.ws + WS_Y)};
    pg8::gemm_phase(lds, S, E);
}
__device__ __forceinline__ void phase10(const Params& P, LAS unsigned char* lds, int vcu, int G) {
    const LAS int* PB = (const LAS int*)(lds + M_PB); const LAS int* CN = (const LAS int*)(lds + M_CN);
    const pg8::MoeSched<1> S{(const char*)(P.ws + WS_H), (const char*)(P.ws + WS_WD), (const int*)(P.ws + WS_LIST), PB, CN, (const LAS int*)(lds + M_RBL), 512, PB[0], (PB[32] - PB[0]) * 4, vcu, G};
    const EpiDown E{(const int*)(P.ws + WS_LIST), (const float*)(P.ws + WS_GW), P.out, (const bf16*)(P.ws + WS_Y), (const float*)(P.ws + WS_CTL + 32768)};
    pg8::gemm_phase(lds, S, E);
}

__global__ void __launch_bounds__(NTHREADS, 2) mega_fwd(Params P) {
    extern __shared__ __attribute__((aligned(16))) unsigned char lds_raw[];
    LAS unsigned char* lds = (LAS unsigned char*)lds_raw;
    const int tid = threadIdx.x, lane = tid & 63, wid = __builtin_amdgcn_readfirstlane(tid >> 6);
    const int G = gridDim.x; const int bx = blockIdx.x; const int vcu = (G % 8 == 0) ? (bx % 8) * (G / 8) + bx / 8 : bx;
    volatile LAS unsigned* st = (volatile LAS unsigned*)(lds + LDS_ST_OFF);
    if (tid < 16) st[tid] = 0u;
    __syncthreads();
    unsigned* bar = (unsigned*)(P.ws + WS_CTL);
    const XcdBarrier xb = xcd_barrier_post(bar, st);

#ifndef DUPMASK
#define DUPMASK 0
#endif
#define DUPQ(k) if ((DUPMASK >> (k)) & 1)
#ifndef PHMASK
#define PHMASK 0xFFFF
#endif
#define PH(k) if ((PHMASK >> (k)) & 1)
    PH(0) phase0(P, lds, vcu, G, tid, wid, lane);
    DUPQ(0) phase0(P, lds, vcu, G, tid, wid, lane);
    xcd_barrier(xb);
    PH(1) phase1(P, lds, G);
    DUPQ(1) phase1(P, lds, G);
    const int ei_p1 = (G == 256) ? 14336 : 0;
    PH(1) if (G == 256 && bx >= 128) { LAS float* cscr = (LAS float*)(lds + wid * 16384); const int w1 = (bx - 128) * 8 + wid;
#pragma unroll 1
        for (int k = 0; k < 14; k += 2) { float tva[32], tvb[32]; const TItem ia = expert_item(P, w1 + k * 1024), ib = expert_item(P, w1 + (k + 1) * 1024);
            titem_load(ia, lane, tva); titem_load(ib, lane, tvb); titem_store(ia, lane, tva, cscr); titem_store(ib, lane, tvb, cscr); } }
    xcd_barrier(xb);
    PH(2) {
        int cit = ei_p1 + vcu * 8 + wid; const int cstride = G * 8;
        for (int u = bx; u < 256; u += G) {
            if ((u & 15) != 15) { hgrn_unit<0>(P, lds, u, tid, wid, lane, cit, cstride); cit += 16 * cstride; } }
        LAS float* cscr = (LAS float*)(lds + (wid < 4 ? H_QT + wid * 8448 : H_ST + (wid - 4) * 8448));
        for (; cit < EI_TOTAL; cit += cstride) { float tv[32]; const TItem t = expert_item(P, cit); titem_load(t, lane, tv); titem_store(t, lane, tv, cscr); }
    }
    DUPQ(2) for (int u = bx; u < 256; u += G) if ((u & 15) != 15) hgrn_unit<0>(P, lds, u, tid, wid, lane);
    xcd_barrier(xb);
    PH(3) { hgrn_scan(P, G, tid);
    for (int u = bx; u < 512; u += G) attn_unit(P, lds, u, tid, wid, lane); }
    DUPQ(3) for (int u = bx; u < 512; u += G) attn_unit(P, lds, u, tid, wid, lane);
    xcd_barrier(xb);
    PH(4) for (int u = bx; u < 256; u += G) hgrn_unit<1>(P, lds, u, tid, wid, lane);
    DUPQ(4) for (int u = bx; u < 256; u += G) hgrn_unit<1>(P, lds, u, tid, wid, lane);
    xcd_barrier(xb);
    PH(5) phase5(P, lds, G);
    DUPQ(5) phase5(P, lds, G);
    xcd_barrier(xb);
    PH(6) phase6(P, lds, G);
    DUPQ(6) phase6(P, lds, G);
    xcd_barrier(xb);
    if ((DUPMASK >> 7) & 1) phase7(P, lds, vcu, G, tid, wid, lane, false);
    PH(7) phase7(P, lds, vcu, G, tid, wid, lane);
    xcd_barrier(xb);
    moe_prefix(P, lds, tid);
    PH(8) phase8(P, lds, vcu, G);
    DUPQ(8) phase8(P, lds, vcu, G);
    xcd_barrier(xb);
    PH(9) phase9(P, lds, vcu, G);
    xcd_barrier(xb);
    PH(10) phase10(P, lds, vcu, G);
    if (xb_ld(&bar[XB_TMO]) != 0u && tid == 0) P.out[(size_t)bx * 1024] = __builtin_nanf("");
}

extern "C" void kernel_launch(void* const* d_in, const int* in_sizes, int n_in, void* d_out, int out_size, void* d_ws, size_t ws_size, hipStream_t stream) {
    static int grid = 0;
    if (grid == 0) {
        if (n_in != 20 || out_size != T * D || ws_size < WS_END) { fprintf(stderr, "kernel_launch: unexpected shapes (n_in %d out %d ws %zu, need ws >= %zu)\n", n_in, out_size, ws_size, (size_t)WS_END); grid = -1; return; }
        int dev = 0, cus = 0, per_cu = 0;
        if (hipGetDevice(&dev) != hipSuccess || hipDeviceGetAttribute(&cus, hipDeviceAttributeMultiprocessorCount, dev) != hipSuccess) { grid = -1; return; }
        if (hipFuncSetAttribute((const void*)mega_fwd, hipFuncAttributeMaxDynamicSharedMemorySize, LDS_BYTES) != hipSuccess) { fprintf(stderr, "hipFuncSetAttribute failed\n"); grid = -1; return; }
        if (hipOccupancyMaxActiveBlocksPerMultiprocessor(&per_cu, (const void*)mega_fwd, NTHREADS, LDS_BYTES) != hipSuccess || per_cu < 1) { fprintf(stderr, "occupancy query: %d blocks/CU\n", per_cu); grid = -1; return; }
        grid = cus;
    }
    if (grid < 0) return;
    if (hipMemsetAsync((char*)d_ws + WS_CTL, 0, 96 * 1024, stream) != hipSuccess) return;
    Params p{};
    p.x = (const float*)d_in[0]; p.positions = (const int*)d_in[1]; p.norm1_w = (const float*)d_in[2]; p.w_in = (const float*)d_in[3];
    p.q_norm_w = (const float*)d_in[4]; p.k_norm_w = (const float*)d_in[5]; p.sinks = (const float*)d_in[6]; p.hlb = (const float*)d_in[7];
    p.hnw = (const float*)d_in[8]; p.w_ba = (const float*)d_in[9]; p.w_bh = (const float*)d_in[10]; p.w_out = (const float*)d_in[11];
    p.norm2_w = (const float*)d_in[12]; p.w_rg = (const float*)d_in[13]; p.b_rg = (const float*)d_in[14]; p.w_re = (const float*)d_in[15];
    p.b_re = (const float*)d_in[16]; p.w_gate = (const float*)d_in[17]; p.w_up = (const float*)d_in[18]; p.w_down = (const float*)d_in[19];
    p.out = (float*)d_out; p.ws = (unsigned char*)d_ws;
    void* args[] = {&p};
    const hipError_t e = hipLaunchCooperativeKernel((const void*)mega_fwd, dim3(grid), dim3(NTHREADS), args, LDS_BYTES, stream);
    if (e != hipSuccess) fprintf(stderr, "cooperative launch failed: %s (grid %d)\n", hipGetErrorString(e), grid);
}
```

```cpp
#define DUPMASK 0
#include <hip/hip_runtime.h>
#include <cstdio>
#include <cstdint>

#define LAS __attribute__((address_space(3)))
typedef unsigned short bf16;
typedef short bf16x8 __attribute__((ext_vector_type(8)));
typedef float f32x4 __attribute__((ext_vector_type(4)));
typedef unsigned u32x4 __attribute__((ext_vector_type(4)));
typedef unsigned u32x2 __attribute__((ext_vector_type(2)));

constexpr int NTHREADS = 512;
constexpr int LDS_BYTES = 147456;
constexpr int LDS_ST_OFF = LDS_BYTES - 64;

constexpr int BATCH = 4, SEQ = 8192, T = BATCH * SEQ, D = 1024, NPROJ = 4864;
constexpr int C_QA = 0, C_KA = 512, C_VA = 640, C_QH = 768, C_FH = 1280, C_IH = 1792, C_GH = 2304, C_ZA = 2816, C_ZB = 3840;
constexpr int NEXP = 32, FF = 512;
constexpr float EPS = 1e-6f;

constexpr size_t MiB = 1u << 20;
constexpr size_t WS_CTL = 0;
constexpr size_t CTL_CNT = 65536;
constexpr size_t WS_WINT = 1 * MiB;
constexpr size_t WS_WAT = 11 * MiB;
constexpr size_t WS_WBT = 12 * MiB;
constexpr size_t WS_WOT = 13 * MiB;
constexpr size_t WS_WR = 15 * MiB;
constexpr size_t WS_WGU = 16 * MiB;
constexpr size_t WS_WD = 80 * MiB;
constexpr size_t WS_PROJ = 112 * MiB;
constexpr size_t WS_MIXED = 416 * MiB;
constexpr size_t WS_CS = 480 * MiB;
constexpr size_t WS_END = 482 * MiB;
constexpr size_t WS_HN = 112 * MiB;
constexpr size_t WS_SSQ = 176 * MiB;
constexpr size_t WS_LIST = 178 * MiB;
constexpr size_t WS_GW = 186 * MiB;
constexpr size_t WS_RSTD = 187 * MiB;
constexpr size_t WS_H = 192 * MiB;
constexpr size_t WS_Y = 272 * MiB;
constexpr size_t OUT_U = 0, OUT_SIN = 16 * MiB, OUT_DSC = 32 * MiB, OUT_AH = 64 * MiB;

typedef float f32x2_ __attribute__((ext_vector_type(2)));
typedef __bf16 bf16x2_ __attribute__((ext_vector_type(2)));
__device__ __forceinline__ unsigned f2bf(float f) { return (unsigned)__builtin_bit_cast(unsigned short, (__bf16)f); }
__device__ __forceinline__ float bf2f(unsigned h) { return __builtin_bit_cast(float, h << 16); }
__device__ __forceinline__ unsigned pk2(float lo, float hi) { const f32x2_ v = {lo, hi}; return __builtin_bit_cast(unsigned, __builtin_convertvector(v, bf16x2_)); }
__device__ __forceinline__ float bflo(unsigned w) { return __builtin_bit_cast(float, w << 16); }
__device__ __forceinline__ float bfhi(unsigned w) { return __builtin_bit_cast(float, w & 0xffff0000u); }
constexpr float LOG2E = 1.4426950408889634f;
__device__ __forceinline__ float exp2_(float x) { return __builtin_amdgcn_exp2f(x); }
__device__ __forceinline__ float fexp_(float x) { return __builtin_amdgcn_exp2f(x * LOG2E); }
__device__ __forceinline__ float sigmoidf_(float x) { return __builtin_amdgcn_rcpf(1.f + fexp_(-x)); }
__device__ __forceinline__ int opaque(int x) { asm volatile("" : "+v"(x)); return x; }
__device__ __forceinline__ float wave_sum(float v) {
#pragma unroll
    for (int o = 1; o < 64; o <<= 1) v += __shfl_xor(v, o);
    return v;
}

#define XB_TMO      128
#define XB_XCNT(j)  (256  + 64 * (j))
#define XB_XSUB(j)  (1280 + 64 * (j))
#define XB_XGEN(j)  (2304 + 64 * (j))
#define XB_TOP      3328
#define XB_TOPGEN   3392
#define XCD_BAR_WORDS 3456
#define XB_SPIN_CAP (1u << 20)
__device__ __forceinline__ unsigned xb_ld(unsigned* p)              { return __hip_atomic_load(p, __ATOMIC_RELAXED, __HIP_MEMORY_SCOPE_AGENT); }
__device__ __forceinline__ unsigned xb_add(unsigned* p, unsigned v) { return __hip_atomic_fetch_add(p, v, __ATOMIC_RELAXED, __HIP_MEMORY_SCOPE_AGENT); }
__device__ __forceinline__ unsigned xb_xcc_id() { return (unsigned)__builtin_amdgcn_s_getreg((3 << 11) | 20) & 0xFu; }
#define XB_SPIN(cond, bar) do { unsigned _sp = 0; while (cond) { __builtin_amdgcn_s_sleep(1); \
    if ((++_sp & 255u) == 0u) { if (xb_ld(&(bar)[XB_TMO])) break; if (_sp > XB_SPIN_CAP) { atomicAdd(&(bar)[XB_TMO], 1u); break; } } } } while (0)
struct XcdBarrier { unsigned* bar; unsigned x; volatile LAS unsigned* st; };
__device__ __forceinline__ XcdBarrier xcd_barrier_post(unsigned* bar, volatile LAS unsigned* st) {
    XcdBarrier b; b.bar = bar; b.x = xb_xcc_id(); b.st = st;
    if (threadIdx.x == 0) (void)xb_add(&bar[XB_XCNT(b.x)], 1u);
    return b;
}
__device__ __forceinline__ void xcd_barrier_complete(unsigned* bar, unsigned x, unsigned& nloc, unsigned& nx) {
    const unsigned G = gridDim.x * gridDim.y * gridDim.z;
    unsigned sum, cnt, mine, sp = 0u;
    for (;;) {
        sum = 0u; cnt = 0u; mine = 0u;
#pragma unroll
        for (unsigned j = 0; j < 16; ++j) { const unsigned c = xb_ld(&bar[XB_XCNT(j)]); sum += c; cnt += (c > 0u) ? 1u : 0u; mine = (j == x) ? c : mine; }
        if (sum == G) break;
        __builtin_amdgcn_s_sleep(1);
        if ((++sp & 255u) == 0u) { if (xb_ld(&bar[XB_TMO])) break; if (sp > XB_SPIN_CAP) { atomicAdd(&bar[XB_TMO], 1u); break; } }
    }
    nloc = mine > 0u ? mine : 1u; nx = cnt > 0u ? cnt : 1u;
}
__device__ __forceinline__ void xcd_barrier(const XcdBarrier& b) {
    asm volatile("s_waitcnt vmcnt(0)" ::: "memory");
    __syncthreads();
    if (threadIdx.x == 0) {
        unsigned* bar = b.bar;
        __builtin_amdgcn_s_waitcnt(0);
        unsigned nloc = b.st[0], nx = b.st[1];
        if (nloc == 0u) { xcd_barrier_complete(bar, b.x, nloc, nx); b.st[0] = nloc; b.st[1] = nx; }
        const unsigned old = xb_add(&bar[XB_XSUB(b.x)], 1u);
        const unsigned gen = old / nloc;
        if (old + 1u == (gen + 1u) * nloc) {
            __builtin_amdgcn_fence(__ATOMIC_RELEASE, "agent");
            asm volatile("s_waitcnt vmcnt(0)" ::: "memory");
            const unsigned og = xb_add(&bar[XB_TOP], 1u);
            const unsigned tg = og / nx;
            if (og + 1u == (tg + 1u) * nx) xb_add(&bar[XB_TOPGEN], 1u);
            else XB_SPIN(xb_ld(&bar[XB_TOPGEN]) == tg, bar);
            __builtin_amdgcn_fence(__ATOMIC_ACQUIRE, "agent");
            xb_add(&bar[XB_XGEN(b.x)], 1u);
            asm volatile("s_waitcnt vmcnt(0)" ::: "memory");
        } else {
            XB_SPIN(xb_ld(&bar[XB_XGEN(b.x)]) == gen, bar);
            __builtin_amdgcn_fence(__ATOMIC_ACQUIRE, "agent");
            asm volatile("s_waitcnt vmcnt(0)" ::: "memory");
        }
    }
    __syncthreads();
}

struct Params {
    const float* x; const int* positions; const float* norm1_w; const float* w_in; const float* q_norm_w; const float* k_norm_w;
    const float* sinks; const float* hlb; const float* hnw; const float* w_ba; const float* w_bh; const float* w_out; const float* norm2_w;
    const float* w_rg; const float* b_rg; const float* w_re; const float* b_re; const float* w_gate; const float* w_up; const float* w_down;
    float* out; unsigned char* ws;
};

namespace pg8 {
constexpr int BK = 64, HALF = 128, HTB = HALF * BK * 2;
__device__ __forceinline__ int lds_byte(int r, int c) { const int st = (r >> 4) * 2 + (c >> 5), rr = r & 15, cc = c & 31, ob = rr * 64 + cc * 2; return st * 1024 + (ob ^ (((ob >> 9) & 1) << 5)); }
__device__ __forceinline__ void stage_rc(int b, int& R, int& C) { const int st = b / 1024, sb = b % 1024, swz = sb ^ (((sb >> 9) & 1) << 5); R = (st >> 1) * 16 + swz / 64; C = (st & 1) * 32 + (swz % 64) / 2; }
__device__ __forceinline__ int perm32(int rho) { const int n = rho >> 4, i = rho & 15; return 8 * (i >> 2) + 4 * n + (i & 3); }
struct Unit { int pm, pn, l, i0, cn; };
typedef int i32x4_ __attribute__((ext_vector_type(4)));
typedef int i32x8_ __attribute__((ext_vector_type(8)));
__device__ __forceinline__ i32x8_ cat8(i32x4_ a, i32x4_ b) { return __builtin_shufflevector(a, b, 0, 1, 2, 3, 4, 5, 6, 7); }
__device__ __forceinline__ bf16x8 lo8(i32x8_ v) { return __builtin_bit_cast(bf16x8, __builtin_shufflevector(v, v, 0, 1, 2, 3)); }
__device__ __forceinline__ bf16x8 hi8(i32x8_ v) { return __builtin_bit_cast(bf16x8, __builtin_shufflevector(v, v, 4, 5, 6, 7)); }

template <class Epi, class Sched>
__device__ __forceinline__ void gemm_phase(LAS unsigned char* lds, const Sched& S, const Epi& E) {
    const int tid = threadIdx.x, wid = __builtin_amdgcn_readfirstlane(tid >> 6), lane = tid & 63, wr = wid >> 2, wc = wid & 3, fr = lane & 15, fq = lane >> 4;
    const int KB = S.KB, nt = KB / 128;
    int sR[2], sC = 0; unsigned voffB[2];
#pragma unroll
    for (int i = 0; i < 2; ++i) { int R, C; stage_rc(tid * 16 + i * 8192, R, C); sR[i] = R; sC = C; const int Rb = Epi::PERM ? ((R & ~31) + perm32(R & 31)) : R; voffB[i] = (unsigned)(Rb * KB + C * 2); }
    const unsigned kstep = (unsigned)(BK * 2);
    const size_t hstep = (size_t)HALF * KB;
    const unsigned ldsw = (unsigned)wid * 1024u;
    const int aoff = lds_byte(wr * 64 + fr, fq * 8), boff = lds_byte(wc * 32 + fr, fq * 8);
#define PG8_SA(b, h) (((b) * 2 + (h)) * HTB)
#define PG8_SB(b, h) ((4 + (b) * 2 + (h)) * HTB)
#define PG8_STAGE_B(bufoff, gbase) do { _Pragma("unroll") for (int _i = 0; _i < 2; ++_i) \
        __builtin_amdgcn_global_load_lds((const unsigned*)((const char*)(gbase) + voffB[_i]), (LAS unsigned*)(lds + (bufoff) + ldsw + _i * 8192), 16, 0, 0); } while (0)
#define PG8_STAGE_A(bufoff, va, kb) do { _Pragma("unroll") for (int _i = 0; _i < 2; ++_i) \
        __builtin_amdgcn_global_load_lds((const unsigned*)(Ab + ((size_t)(va)[_i] + (kb))), (LAS unsigned*)(lds + (bufoff) + ldsw + _i * 8192), 16, 0, 0); } while (0)
#define PG8_LDA(dst, b, h) do { _Pragma("unroll") for (int m = 0; m < 4; ++m) dst[m] = cat8(*(const LAS i32x4_*)(lds + PG8_SA(b, h) + aoff + m * 2048), *(const LAS i32x4_*)(lds + PG8_SA(b, h) + aoff + m * 2048 + 1024)); } while (0)
#define PG8_LDB(dst, b, h) do { _Pragma("unroll") for (int n = 0; n < 2; ++n) dst[n] = cat8(*(const LAS i32x4_*)(lds + PG8_SB(b, h) + boff + n * 2048), *(const LAS i32x4_*)(lds + PG8_SB(b, h) + boff + n * 2048 + 1024)); } while (0)
#define PG8_MMA(ai, bj, At, Bt) do { __builtin_amdgcn_s_setprio(1); _Pragma("unroll") for (int m = 0; m < 4; ++m) _Pragma("unroll") for (int n = 0; n < 2; ++n) { \
        if constexpr (Sched::FP8) {   \
              \
            asm volatile("v_mfma_scale_f32_16x16x128_f8f6f4 %0, %1, %2, %0, %3, %4 op_sel_hi:[0,0,0]" : "+v"(acc[ai][bj][m][n]) : "v"(Bt[n]), "v"(At[m]), "v"(sclB), "v"(sclA)); \
        } else { acc[ai][bj][m][n] = __builtin_amdgcn_mfma_f32_16x16x32_bf16(lo8(Bt[n]), lo8(At[m]), acc[ai][bj][m][n], 0, 0, 0); \
                 acc[ai][bj][m][n] = __builtin_amdgcn_mfma_f32_16x16x32_bf16(hi8(Bt[n]), hi8(At[m]), acc[ai][bj][m][n], 0, 0, 0); } } \
        __builtin_amdgcn_s_setprio(0); } while (0)
#define PG8_WAIT_V(n) asm volatile("s_waitcnt vmcnt(" #n ")" ::: "memory")
#define PG8_WAIT_L(n) asm volatile("s_waitcnt lgkmcnt(" #n ")" ::: "memory")
#define PG8_BAR __builtin_amdgcn_s_barrier()
#define PG8_SCHED __builtin_amdgcn_sched_barrier(0)
    Unit cur, nxt; int ui = 0;
    if (!S.next(0, cur)) return;
    const int sclA = Sched::SCALE_A, sclB = Sched::SCALE_B; (void)sclA; (void)sclB;
    f32x4 acc[2][2][4][2];
#pragma unroll
    for (int a = 0; a < 2; ++a)
#pragma unroll
        for (int b = 0; b < 2; ++b)
#pragma unroll
            for (int m = 0; m < 4; ++m)
#pragma unroll
                for (int n = 0; n < 2; ++n) acc[a][b][m][n] = (f32x4){0.f, 0.f, 0.f, 0.f};
    i32x8_ At[4], B0[2], B1[2];
    const char* const Ab = S.a_base();
    unsigned vA0[2], vA1[2], nA0[2], nA1[2];
#pragma unroll
    for (int i = 0; i < 2; ++i) { vA0[i] = S.a_voff(cur, 0, sR[i], sC); vA1[i] = S.a_voff(cur, 1, sR[i], sC); }
    const char* cB = S.b_base(cur);
    PG8_STAGE_B(PG8_SB(0, 0), cB); PG8_STAGE_B(PG8_SB(0, 1), cB + hstep); PG8_STAGE_A(PG8_SA(0, 0), vA0, 0u); PG8_STAGE_A(PG8_SA(0, 1), vA1, 0u);
    if (wr == 1) PG8_BAR;
    PG8_WAIT_V(2); PG8_BAR;
    PG8_STAGE_B(PG8_SB(1, 0), cB + kstep); PG8_STAGE_A(PG8_SA(1, 0), vA0, kstep); PG8_STAGE_B(PG8_SB(1, 1), cB + hstep + kstep);
    PG8_WAIT_V(6); PG8_BAR;
    for (;;) {
        const bool has_next = S.next(ui + 1, nxt);
        const char* nB = has_next ? S.b_base(nxt) : cB;
#pragma unroll
        for (int i = 0; i < 2; ++i) { nA0[i] = has_next ? S.a_voff(nxt, 0, sR[i], sC) : vA0[i]; nA1[i] = has_next ? S.a_voff(nxt, 1, sR[i], sC) : vA1[i]; }
#pragma unroll 1
        for (int t = 0; t < nt; t += 2) {
            const bool last = (t == nt - 2);
            if constexpr (Epi::MID) { if (t == (nt >> 1)) E.mid(acc, cur, wr, wc, fr, fq); }
            const unsigned k1 = (unsigned)(t + 1) * kstep;
            const unsigned k2 = last ? 0u : (unsigned)(t + 2) * kstep, k3 = k2 + kstep;
            const char* b2 = last ? nB : cB + (size_t)(t + 2) * kstep; const char* b3 = b2 + kstep;
            unsigned uA0[2], uA1[2];
#pragma unroll
            for (int i = 0; i < 2; ++i) { uA0[i] = last ? nA0[i] : vA0[i]; uA1[i] = last ? nA1[i] : vA1[i]; }
            PG8_LDB(B0, 0, 0); PG8_LDB(B1, 0, 1); PG8_SCHED; PG8_LDA(At, 0, 0); PG8_STAGE_A(PG8_SA(1, 1), vA1, k1);
            PG8_WAIT_V(8); PG8_WAIT_L(0); PG8_BAR; PG8_MMA(0, 0, At, B0); PG8_MMA(0, 1, At, B1); PG8_BAR; PG8_SCHED;
            PG8_LDA(At, 0, 1); PG8_STAGE_B(PG8_SB(0, 0), b2); PG8_STAGE_B(PG8_SB(0, 1), b2 + hstep); PG8_STAGE_A(PG8_SA(0, 0), uA0, k2);
            PG8_WAIT_V(8); PG8_WAIT_L(0); PG8_BAR; PG8_MMA(1, 0, At, B0); PG8_MMA(1, 1, At, B1); PG8_BAR; PG8_SCHED;
            PG8_LDB(B0, 1, 0); PG8_LDB(B1, 1, 1); PG8_SCHED; PG8_LDA(At, 1, 0); PG8_STAGE_A(PG8_SA(0, 1), uA1, k2);
            PG8_WAIT_V(8); PG8_WAIT_L(0); PG8_BAR; PG8_MMA(0, 0, At, B0); PG8_MMA(0, 1, At, B1); PG8_BAR; PG8_SCHED;
            PG8_LDA(At, 1, 1); PG8_STAGE_B(PG8_SB(1, 0), b3); PG8_STAGE_B(PG8_SB(1, 1), b3 + hstep); PG8_STAGE_A(PG8_SA(1, 0), uA0, k3);
            PG8_WAIT_V(8); PG8_WAIT_L(0); PG8_BAR; PG8_MMA(1, 0, At, B0); PG8_MMA(1, 1, At, B1); PG8_BAR; PG8_SCHED;
        }
        if constexpr (Sched::FP8) asm volatile("s_nop 15\n\ts_nop 15" ::: "memory");
        if (wr == 0) PG8_BAR;
        E(acc, cur, wr, wc, fr, fq);
        if (!has_next) break;
#pragma unroll
        for (int a = 0; a < 2; ++a)
#pragma unroll
            for (int b = 0; b < 2; ++b)
#pragma unroll
                for (int m = 0; m < 4; ++m)
#pragma unroll
                    for (int n = 0; n < 2; ++n) acc[a][b][m][n] = (f32x4){0.f, 0.f, 0.f, 0.f};
        cur = nxt; cB = nB; ++ui;
#pragma unroll
        for (int i = 0; i < 2; ++i) { vA0[i] = nA0[i]; vA1[i] = nA1[i]; }
        if (wr == 1) PG8_BAR;
    }
    PG8_WAIT_V(0);
    PG8_BAR;
#undef PG8_SA
#undef PG8_SB
#undef PG8_STAGE_A
#undef PG8_STAGE_B
#undef PG8_LDA
#undef PG8_LDB
#undef PG8_MMA
#undef PG8_WAIT_V
#undef PG8_WAIT_L
#undef PG8_BAR
#undef PG8_SCHED
}
__device__ __forceinline__ bool tile_order(int i, int G, int c, int nM, int nN, int& pm, int& pn) {
    const int nwg = nM * nN; const long L = (long)i * G + c; if (L >= nwg) return false;
    int wgid = (int)L; { const int q = nwg / 8, r = nwg % 8, xcd = wgid % 8, off = wgid / 8; wgid = (xcd < r ? xcd * (q + 1) : r * (q + 1) + (xcd - r) * q) + off; }
    const int WGM = 8, nig = WGM * nN, gid = wgid / nig, fm = gid * WGM, gsz = (nM - fm) < WGM ? (nM - fm) : WGM;
    pm = fm + ((wgid % nig) % gsz); pn = (wgid % nig) / gsz; return true;
}
struct DenseSched {
    static constexpr bool FP8 = false; static constexpr int SCALE_A = 0x7F7F7F7F, SCALE_B = 0x7F7F7F7F;
    const char* A; const char* Bt; int KB, nM, nN, G, c;
    __device__ __forceinline__ bool next(int i, Unit& u) const { u.l = 0; u.i0 = 0; u.cn = 0; return tile_order(i, G, c, nM, nN, u.pm, u.pn); }
    __device__ __forceinline__ const char* a_base() const { return A; }
    __device__ __forceinline__ unsigned a_voff(const Unit& u, int h, int R, int C) const { return (unsigned)((u.pm * 256 + h * 128 + R) * KB + C * 2); }
    __device__ __forceinline__ const char* b_base(const Unit& u) const { return Bt + (size_t)u.pn * 256 * KB; }
};
template <int MODE> struct MoeSched {
    static constexpr bool FP8 = true; static constexpr int SCALE_A = (MODE == 0) ? 0x7F7F7F7F : 0x7D7D7D7D, SCALE_B = 0x79797979;
    const char* A; const char* Bt; const int* list; const LAS int* PB; const LAS int* CN; const LAS int* RBL; int KB, rb0, nunits, vcu, G;
    __device__ __forceinline__ bool next(int i, Unit& u) const {
        const int idx = vcu + i * G; if (idx >= nunits) return false;
        const int rb = rb0 + (idx >> 2); const int l = RBL[rb];
        u.pm = rb; u.pn = idx & 3; u.l = l; u.i0 = (rb - PB[l]) * 256; u.cn = CN[l]; return true; }
    __device__ __forceinline__ const char* a_base() const { return A; }
    __device__ __forceinline__ unsigned a_voff(const Unit& u, int h, int R, int C) const {
        if (MODE == 0) { int idx = u.i0 + h * 128 + R; idx = idx < u.cn ? idx : u.cn - 1; const int tok = list[(size_t)u.l * T + idx]; return (unsigned)(tok * KB + C * 2); }
        return (unsigned)((u.pm * 256 + h * 128 + R) * KB + C * 2); }
    __device__ __forceinline__ const char* b_base(const Unit& u) const { return Bt + ((size_t)(u.l & 31) * 1024 + u.pn * 256) * KB; }
};
}

struct EpiProj { static constexpr bool PERM = true, MID = false; bf16* proj;
    __device__ __forceinline__ void operator()(const f32x4 (&acc)[2][2][4][2], const pg8::Unit& u, int wr, int wc, int fr, int fq) const {
        const int fro = opaque(fr), fqo = opaque(fq);
#pragma unroll
        for (int ai = 0; ai < 2; ++ai)
#pragma unroll
            for (int m = 0; m < 4; ++m) { bf16* rowp = proj + (size_t)(u.pm * 256 + ai * 128 + wr * 64 + m * 16 + fro) * NPROJ + u.pn * 256 + wc * 32 + 8 * fqo;
#pragma unroll
                for (int bj = 0; bj < 2; ++bj) { const f32x4 v0 = acc[ai][bj][m][0], v1 = acc[ai][bj][m][1];
                    u32x4 w; w.x = pk2(v0[0], v0[1]); w.y = pk2(v0[2], v0[3]); w.z = pk2(v1[0], v1[1]); w.w = pk2(v1[2], v1[3]); *(u32x4*)(rowp + bj * 128) = w; } }
    } };
__device__ __forceinline__ float ratio_(float zb, float za) { return (1.f + fexp_(-zb)) * __builtin_amdgcn_rcpf(1.f + fexp_(-za)); }
struct EpiMixed { static constexpr bool PERM = true, MID = true; const bf16* proj; bf16* mixed;
    __device__ __forceinline__ void mid(f32x4 (&acc)[2][2][4][2], const pg8::Unit& u, int wr, int wc, int fr, int fq) const {
        const int fro = opaque(fr), fqo = opaque(fq);
#pragma unroll
        for (int ai = 0; ai < 2; ++ai) {
            u32x4 za[4][2], zb[4][2];
#pragma unroll
            for (int m = 0; m < 4; ++m) { const bf16* zr = proj + (size_t)(u.pm * 256 + ai * 128 + wr * 64 + m * 16 + fro) * NPROJ + u.pn * 256 + wc * 32 + 8 * fqo;
#pragma unroll
                for (int bj = 0; bj < 2; ++bj) { za[m][bj] = *(const u32x4*)(zr + C_ZA + bj * 128); zb[m][bj] = *(const u32x4*)(zr + C_ZB + bj * 128); } }
#pragma unroll
            for (int m = 0; m < 4; ++m)
#pragma unroll
                for (int bj = 0; bj < 2; ++bj) { const u32x4 a = za[m][bj], b = zb[m][bj]; f32x4 r0, r1;
                    r0[0] = ratio_(bflo(b.x), bflo(a.x)); r0[1] = ratio_(bfhi(b.x), bfhi(a.x)); r0[2] = ratio_(bflo(b.y), bflo(a.y)); r0[3] = ratio_(bfhi(b.y), bfhi(a.y));
                    r1[0] = ratio_(bflo(b.z), bflo(a.z)); r1[1] = ratio_(bfhi(b.z), bfhi(a.z)); r1[2] = ratio_(bflo(b.w), bflo(a.w)); r1[3] = ratio_(bfhi(b.w), bfhi(a.w));
                    acc[ai][bj][m][0] = acc[ai][bj][m][0] * r0; acc[ai][bj][m][1] = acc[ai][bj][m][1] * r1; }
            asm volatile("" ::: "memory"); }
    }
    __device__ __forceinline__ void operator()(const f32x4 (&acc)[2][2][4][2], const pg8::Unit& u, int wr, int wc, int fr, int fq) const {
        const int fro = opaque(fr), fqo = opaque(fq);
#pragma unroll
        for (int ai = 0; ai < 2; ++ai) {
            u32x4 zb[4][2];
#pragma unroll
            for (int m = 0; m < 4; ++m) { const bf16* zr = proj + (size_t)(u.pm * 256 + ai * 128 + wr * 64 + m * 16 + fro) * NPROJ + u.pn * 256 + wc * 32 + 8 * fqo;
#pragma unroll
                for (int bj = 0; bj < 2; ++bj) zb[m][bj] = *(const u32x4*)(zr + C_ZB + bj * 128); }
#pragma unroll
            for (int m = 0; m < 4; ++m) { bf16* orow = mixed + (size_t)(u.pm * 256 + ai * 128 + wr * 64 + m * 16 + fro) * 1024 + u.pn * 256 + wc * 32 + 8 * fqo;
#pragma unroll
                for (int bj = 0; bj < 2; ++bj) { const u32x4 b = zb[m][bj]; const f32x4 v0 = acc[ai][bj][m][0], v1 = acc[ai][bj][m][1];
                    u32x4 w; w.x = pk2(v0[0] * sigmoidf_(bflo(b.x)), v0[1] * sigmoidf_(bfhi(b.x))); w.y = pk2(v0[2] * sigmoidf_(bflo(b.y)), v0[3] * sigmoidf_(bfhi(b.y)));
                    w.z = pk2(v1[0] * sigmoidf_(bflo(b.z)), v1[1] * sigmoidf_(bfhi(b.z))); w.w = pk2(v1[2] * sigmoidf_(bflo(b.w)), v1[3] * sigmoidf_(bfhi(b.w)));
                    *(u32x4*)(orow + bj * 128) = w; } }
            asm volatile("" ::: "memory"); }
    } };
struct EpiX1 { static constexpr bool PERM = false, MID = false; const float* x; const float* w2; float* out; unsigned char* hn; float* ssq;
    __device__ __forceinline__ void operator()(const f32x4 (&acc)[2][2][4][2], const pg8::Unit& u, int wr, int wc, int fr, int fq) const {
        const int fro = opaque(fr), fqo = opaque(fq);
        f32x4 wv[2][2];
#pragma unroll
        for (int bj = 0; bj < 2; ++bj)
#pragma unroll
            for (int n = 0; n < 2; ++n) wv[bj][n] = *(const f32x4*)(w2 + u.pn * 256 + bj * 128 + wc * 32 + n * 16 + 4 * fqo);
#pragma unroll
        for (int ai = 0; ai < 2; ++ai)
#pragma unroll
            for (int mh = 0; mh < 2; ++mh) {
                f32x4 xv[2][2][2];
#pragma unroll
                for (int mm = 0; mm < 2; ++mm) { const size_t row = (size_t)(u.pm * 256 + ai * 128 + wr * 64 + (mh * 2 + mm) * 16 + fro);
#pragma unroll
                    for (int bj = 0; bj < 2; ++bj)
#pragma unroll
                        for (int n = 0; n < 2; ++n) xv[mm][bj][n] = *(const f32x4*)(x + row * 1024 + u.pn * 256 + bj * 128 + wc * 32 + n * 16 + 4 * fqo); }
#pragma unroll
                for (int mm = 0; mm < 2; ++mm) { const int m = mh * 2 + mm; const size_t row = (size_t)(u.pm * 256 + ai * 128 + wr * 64 + m * 16 + fro); float s = 0.f;
#pragma unroll
                    for (int bj = 0; bj < 2; ++bj)
#pragma unroll
                        for (int n = 0; n < 2; ++n) { const int col = u.pn * 256 + bj * 128 + wc * 32 + n * 16 + 4 * fqo;
                            const f32x4 v = acc[ai][bj][m][n] + xv[mm][bj][n]; const f32x4 w = wv[bj][n];
                            *(f32x4*)(out + row * 1024 + col) = v;
                            s += (v[0] * v[0] + v[1] * v[1]) + (v[2] * v[2] + v[3] * v[3]);
                            int o8 = __builtin_amdgcn_cvt_pk_fp8_f32(v[0] * w[0], v[1] * w[1], 0, false); o8 = __builtin_amdgcn_cvt_pk_fp8_f32(v[2] * w[2], v[3] * w[3], o8, true); *(int*)(hn + row * 1024 + col) = o8; }
                    s += __shfl_xor(s, 16); s += __shfl_xor(s, 32);
                    if (fq == 0) ssq[row * 16 + u.pn * 4 + wc] = s; }
                asm volatile("" ::: "memory"); }
    } };
struct EpiGateUp { static constexpr bool PERM = true, MID = false; const int* list; const float* rstdv; unsigned char* hb;
    __device__ __forceinline__ void operator()(const f32x4 (&acc)[2][2][4][2], const pg8::Unit& u, int wr, int wc, int fr, int fq) const {
        const int fro = opaque(fr), fqo = opaque(fq);
#pragma unroll
        for (int ai = 0; ai < 2; ++ai) {
            float rsv[4];
#pragma unroll
            for (int m = 0; m < 4; ++m) { int idx = u.i0 + ai * 128 + wr * 64 + m * 16 + fro; idx = idx < u.cn ? idx : u.cn - 1; rsv[m] = rstdv[list[(size_t)u.l * T + idx]]; }
#pragma unroll
            for (int m = 0; m < 4; ++m) { const int r = ai * 128 + wr * 64 + m * 16 + fro; const float rs = rsv[m];
                u32x2 w; const float rs4 = rs * 4.f;
                { const f32x4 g = acc[ai][0][m][0] * rs, uu = acc[ai][1][m][0] * rs4;
                  int o8 = __builtin_amdgcn_cvt_pk_fp8_f32(g[0] * sigmoidf_(g[0]) * uu[0], g[1] * sigmoidf_(g[1]) * uu[1], 0, false);
                  w.x = (unsigned)__builtin_amdgcn_cvt_pk_fp8_f32(g[2] * sigmoidf_(g[2]) * uu[2], g[3] * sigmoidf_(g[3]) * uu[3], o8, true); }
                { const f32x4 g = acc[ai][0][m][1] * rs, uu = acc[ai][1][m][1] * rs4;
                  int o8 = __builtin_amdgcn_cvt_pk_fp8_f32(g[0] * sigmoidf_(g[0]) * uu[0], g[1] * sigmoidf_(g[1]) * uu[1], 0, false);
                  w.y = (unsigned)__builtin_amdgcn_cvt_pk_fp8_f32(g[2] * sigmoidf_(g[2]) * uu[2], g[3] * sigmoidf_(g[3]) * uu[3], o8, true); }
                *(u32x2*)(hb + ((size_t)u.pm * 256 + r) * 512 + u.pn * 128 + wc * 32 + 8 * fqo) = w; }
            asm volatile("" ::: "memory"); }
    } };
struct EpiDownY { static constexpr bool PERM = true, MID = false; const int* list; const float* gw; bf16* Y;
    __device__ __forceinline__ void operator()(const f32x4 (&acc)[2][2][4][2], const pg8::Unit& u, int wr, int wc, int fr, int fq) const {
        const int fro = opaque(fr), fqo = opaque(fq);
        int tk[8]; float gv[8];
#pragma unroll
        for (int q = 0; q < 8; ++q) { const int idx = u.i0 + (q >> 2) * 128 + wr * 64 + (q & 3) * 16 + fro; tk[q] = idx < u.cn ? list[(size_t)u.l * T + idx] : -1; }
#pragma unroll
        for (int q = 0; q < 8; ++q) gv[q] = tk[q] >= 0 ? gw[tk[q] * 2 + 1] : 0.f;
#pragma unroll
        for (int ai = 0; ai < 2; ++ai)
#pragma unroll
            for (int m = 0; m < 4; ++m) { const int tok = tk[ai * 4 + m]; const float g = gv[ai * 4 + m];
                if (tok >= 0) {
#pragma unroll
                    for (int bj = 0; bj < 2; ++bj) { const f32x4 v0 = acc[ai][bj][m][0] * g, v1 = acc[ai][bj][m][1] * g;
                        u32x4 w; w.x = pk2(v0[0], v0[1]); w.y = pk2(v0[2], v0[3]); w.z = pk2(v1[0], v1[1]); w.w = pk2(v1[2], v1[3]);
                        *(u32x4*)(Y + (size_t)tok * 1024 + u.pn * 256 + bj * 128 + wc * 32 + 8 * fqo) = w; } } }
    } };
#ifndef EPIDOWN_BATCH
#define EPIDOWN_BATCH 2
#endif
struct EpiDown { static constexpr bool PERM = false, MID = false; const int* list; const float* gw; float* out; const bf16* Y; const float* tp;
    __device__ __forceinline__ void operator()(const f32x4 (&acc)[2][2][4][2], const pg8::Unit& u, int wr, int wc, int fr, int fq) const {
        const int fro = opaque(fr), fqo = opaque(fq);
        int tk[8]; float gv[8];
#pragma unroll
        for (int q = 0; q < 8; ++q) { const int idx = u.i0 + (q >> 2) * 128 + wr * 64 + (q & 3) * 16 + fro; tk[q] = idx < u.cn ? list[(size_t)u.l * T + idx] : -1; }
#pragma unroll
        for (int q = 0; q < 8; ++q) gv[q] = tk[q] >= 0 ? gw[tk[q] * 2] : 0.f;
#pragma unroll
        for (int ai = 0; ai < 2; ++ai)
#pragma unroll
            for (int mh = 0; mh < 4 / EPIDOWN_BATCH; ++mh) {
                f32x4 ov[EPIDOWN_BATCH][2][2]; u32x2 yv[EPIDOWN_BATCH][2][2];
#pragma unroll
                for (int mm = 0; mm < EPIDOWN_BATCH; ++mm) { const int tok = tk[ai * 4 + mh * EPIDOWN_BATCH + mm]; const size_t base = (size_t)(tok >= 0 ? tok : 0) * 1024 + u.pn * 256 + wc * 32 + 4 * fqo;
#pragma unroll
                    for (int bj = 0; bj < 2; ++bj)
#pragma unroll
                        for (int n = 0; n < 2; ++n) { ov[mm][bj][n] = *(const f32x4*)(out + base + bj * 128 + n * 16); yv[mm][bj][n] = *(const u32x2*)(Y + base + bj * 128 + n * 16); } }
#pragma unroll
                for (int mm = 0; mm < EPIDOWN_BATCH; ++mm) { const int m = mh * EPIDOWN_BATCH + mm; const int tok = tk[ai * 4 + m]; const float g = gv[ai * 4 + m];
                    if (tok >= 0) { const size_t base = (size_t)tok * 1024 + u.pn * 256 + wc * 32 + 4 * fqo;
#pragma unroll
                        for (int bj = 0; bj < 2; ++bj)
#pragma unroll
                            for (int n = 0; n < 2; ++n) { const u32x2 y = yv[mm][bj][n]; f32x4 o = ov[mm][bj][n] + acc[ai][bj][m][n] * g;
                                o[0] += bflo(y.x); o[1] += bfhi(y.x); o[2] += bflo(y.y); o[3] += bfhi(y.y);
#ifdef TPA
                                { const float db = sqrtf(tp[1] * 2e-6f); o = o + (((tok + n) & 1) ? db : -db); if (tok == 0 && u.pn == 0 && bj == 0 && n == 0 && wc == 0 && fqo == 0) o[0] += tp[0] * TPAS; }
#endif
                                *(f32x4*)(out + base + bj * 128 + n * 16) = o; } } }
                asm volatile("" ::: "memory"); }
    } };

struct TItem { const float* W; bf16* WT; int N, ldwt, k0, n0, drow0, f8; };
__device__ __forceinline__ void titem_load(const TItem& t, int lane, float (&tv)[32]);
__device__ __forceinline__ void titem_store(const TItem& t, int lane, const float (&tv)[32], LAS float* scr);
__device__ __forceinline__ void transpose_item(const float* W, int N, bf16* WT, int ldwt, int kd0, int k0, int n0, int drow0, LAS float* scr, int lane) {
    TItem t; t.W = W; t.WT = WT + kd0; t.N = N; t.ldwt = ldwt; t.k0 = k0; t.n0 = n0; t.drow0 = drow0; t.f8 = 0;
    float tv[32]; titem_load(t, lane, tv); titem_store(t, lane, tv, scr);
}

constexpr int EI_G = 16 * 16, EI_D = 8 * 32, EI_PER = 2 * EI_G + EI_D, EI_TOTAL = NEXP * EI_PER;
__device__ __forceinline__ TItem expert_item(const Params& P, int it) {
    TItem t; const int e = it / EI_PER; int r = it - e * EI_PER;
    if (r < EI_G) { const int kb = r / 16, nb = r % 16; t.n0 = 32 * nb; t.W = P.w_gate + (size_t)e * 1024 * 512; t.N = 512; t.WT = (bf16*)(P.ws + WS_WGU + (size_t)e * 1024 * 1024); t.ldwt = 1024; t.k0 = 64 * kb; t.drow0 = (t.n0 >> 7) * 256 + (t.n0 & 127); t.f8 = 1; return t; }
    r -= EI_G;
    if (r < EI_G) { const int kb = r / 16, nb = r % 16; t.n0 = 32 * nb; t.W = P.w_up + (size_t)e * 1024 * 512; t.N = 512; t.WT = (bf16*)(P.ws + WS_WGU + (size_t)e * 1024 * 1024); t.ldwt = 1024; t.k0 = 64 * kb; t.drow0 = (t.n0 >> 7) * 256 + 128 + (t.n0 & 127); t.f8 = 1; return t; }
    r -= EI_G;
    { const int kb = r / 32, nb = r % 32; t.n0 = 32 * nb; t.W = P.w_down + (size_t)e * 512 * 1024; t.N = 1024; t.WT = (bf16*)(P.ws + WS_WD + (size_t)e * 1024 * 512); t.ldwt = 512; t.k0 = 64 * kb; t.drow0 = 32 * nb; t.f8 = 1; return t; }
}
__device__ __forceinline__ void titem_load(const TItem& t, int lane, float (&tv)[32]) {
#pragma unroll
    for (int j = 0; j < 8; ++j) { const f32x4 v = *(const f32x4*)(t.W + (size_t)(t.k0 + 8 * j + (lane >> 3)) * t.N + t.n0 + 4 * (lane & 7));
        tv[4 * j] = v[0]; tv[4 * j + 1] = v[1]; tv[4 * j + 2] = v[2]; tv[4 * j + 3] = v[3]; }
}
__device__ __forceinline__ void titem_store(const TItem& t, int lane, const float (&tv)[32], LAS float* scr) {
#pragma unroll
    for (int j = 0; j < 8; ++j)
#pragma unroll
        for (int q = 0; q < 4; ++q) scr[(8 * j + (lane >> 3)) * 33 + 4 * (lane & 7) + q] = tv[4 * j + q];
    asm volatile("s_waitcnt lgkmcnt(0)" ::: "memory");
    if (t.f8) {
        const int n = lane >> 1, hf = lane & 1; const LAS float* sp = scr + (32 * hf) * 33 + n; int w8[8];
#pragma unroll
        for (int q = 0; q < 8; ++q) { int o8 = __builtin_amdgcn_cvt_pk_fp8_f32(sp[(4 * q) * 33] * 64.f, sp[(4 * q + 1) * 33] * 64.f, 0, false);
            w8[q] = __builtin_amdgcn_cvt_pk_fp8_f32(sp[(4 * q + 2) * 33] * 64.f, sp[(4 * q + 3) * 33] * 64.f, o8, true); }
        unsigned char* dst = (unsigned char*)t.WT + (size_t)(t.drow0 + n) * t.ldwt + t.k0 + 32 * hf;
        *(u32x4*)dst = (u32x4){(unsigned)w8[0], (unsigned)w8[1], (unsigned)w8[2], (unsigned)w8[3]}; *(u32x4*)(dst + 16) = (u32x4){(unsigned)w8[4], (unsigned)w8[5], (unsigned)w8[6], (unsigned)w8[7]};
    } else {
        const int c = lane & 7;
#pragma unroll
        for (int j = 0; j < 4; ++j) { const int n = (lane >> 3) + 8 * j; const LAS float* sp = scr + (8 * c) * 33 + n;
            u32x4 o; o.x = pk2(sp[0 * 33], sp[1 * 33]); o.y = pk2(sp[2 * 33], sp[3 * 33]); o.z = pk2(sp[4 * 33], sp[5 * 33]); o.w = pk2(sp[6 * 33], sp[7 * 33]);
            *(u32x4*)(t.WT + (size_t)(t.drow0 + n) * t.ldwt + t.k0 + 8 * c) = o; } }
    asm volatile("s_waitcnt lgkmcnt(0)" ::: "memory");
}

__device__ __forceinline__ void phase0(const Params& P, LAS unsigned char* lds, int vcu, int G, int tid, int wid, int lane) {
    unsigned char* ws = P.ws;
    LAS float* scr = (LAS float*)(lds + wid * 16384);
    const int gw = vcu * 8 + wid, NGW = G * 8;
    constexpr int I_IN = 16 * 152, I_BR = 8 * 32, I_OUT = 16 * 32;
    constexpr int NITEMS = I_IN + 2 * I_BR + I_OUT;
    for (int it = gw; it < NITEMS; it += NGW) {
        int r = it;
        if (r < I_IN) { const int kb = r / 152, nb = r % 152; transpose_item(P.w_in, NPROJ, (bf16*)(ws + WS_WINT), 1024, 0, 64 * kb, 32 * nb, 32 * nb, scr, lane); continue; } r -= I_IN;
        if (r < I_BR) { const int kb = r / 32, nb = r % 32; transpose_item(P.w_ba, 1024, (bf16*)(ws + WS_WAT), 1024, 0, 64 * kb, 32 * nb, 32 * nb, scr, lane); continue; } r -= I_BR;
        if (r < I_BR) { const int kb = r / 32, nb = r % 32; transpose_item(P.w_bh, 1024, (bf16*)(ws + WS_WAT), 1024, 512, 64 * kb, 32 * nb, 32 * nb, scr, lane); continue; } r -= I_BR;
        { const int kb = r / 32, nb = r % 32; transpose_item(P.w_out, 1024, (bf16*)(ws + WS_WOT), 1024, 0, 64 * kb, 32 * nb, 32 * nb, scr, lane); }
    }
    { bf16* Wh = (bf16*)(ws + WS_WR); bf16* Wl = Wh + 48 * 1024;
      for (int idx = (vcu * NTHREADS + tid); idx < 48 * 1024; idx += G * NTHREADS) { const int j = idx >> 10, k = idx & 1023; float v = 0.f;
          if (j < 4) v = P.w_rg[k * 4 + j] * P.norm2_w[k]; else if (j < 36) v = P.w_re[k * 32 + (j - 4)] * P.norm2_w[k];
          const unsigned hi = f2bf(v); Wh[idx] = (bf16)hi; Wl[idx] = (bf16)f2bf(v - bf2f(hi)); } }
    { float* cs = (float*)(ws + WS_CS);
      const float invf[8] = {1.0f, 0.1939227432012558f, 0.03760603070259094f, 0.007292664609849453f, 0.0014142135623842478f, 0.00027424818836152554f, 5.318296098266728e-05f, 1.0313386155758053e-05f};
      for (int idx = (vcu * NTHREADS + tid); idx < T * 8; idx += G * NTHREADS) { const int tok = idx >> 3, i = idx & 7; float f = invf[0];
#pragma unroll
          for (int q = 1; q < 8; ++q) f = (i == q) ? invf[q] : f;
          float sn, c_; sincosf((float)P.positions[tok] * f, &sn, &c_); cs[tok * 16 + i] = c_; cs[tok * 16 + 8 + i] = sn; } }
    { bf16* xn = (bf16*)P.out;
      f32x4 wv[4];
#pragma unroll
      for (int j = 0; j < 4; ++j) wv[j] = *(const f32x4*)(P.norm1_w + 4 * lane + 256 * j);
      for (int m = gw; m < T; m += NGW) {
          const f32x4* xr = (const f32x4*)(P.x + (size_t)m * D) + lane; f32x4 v[4]; float s = 0.f;
#pragma unroll
          for (int j = 0; j < 4; ++j) { v[j] = xr[64 * j]; s += (v[j].x * v[j].x + v[j].y * v[j].y) + (v[j].z * v[j].z + v[j].w * v[j].w); }
          const float rstd = 1.f / sqrtf(wave_sum(s) * (1.f / D) + EPS);
          u32x2* o8 = (u32x2*)(xn + (size_t)m * D) + lane;
#pragma unroll
          for (int j = 0; j < 4; ++j) { u32x2 o; o.x = pk2(v[j].x * rstd * wv[j].x, v[j].y * rstd * wv[j].y); o.y = pk2(v[j].z * rstd * wv[j].z, v[j].w * rstd * wv[j].w); o8[64 * j] = o; }
      } }
}

__device__ __forceinline__ void phase1(const Params& P, LAS unsigned char* lds, int G) {
    const pg8::DenseSched S{(const char*)P.out, (const char*)(P.ws + WS_WINT), 2048, T / 256, NPROJ / 256, G, (int)blockIdx.x};
    const EpiProj E{(bf16*)(P.ws + WS_PROJ)};
    pg8::gemm_phase(lds, S, E);
}
__device__ __forceinline__ void phase5(const Params& P, LAS unsigned char* lds, int G) {
    const pg8::DenseSched S{(const char*)P.out + OUT_AH, (const char*)(P.ws + WS_WAT), 2048, T / 256, 4, G, (int)blockIdx.x};
    const EpiMixed E{(const bf16*)(P.ws + WS_PROJ), (bf16*)(P.ws + WS_MIXED)};
    pg8::gemm_phase(lds, S, E);
}
__device__ __forceinline__ void phase6(const Params& P, LAS unsigned char* lds, int G) {
    const pg8::DenseSched S{(const char*)(P.ws + WS_MIXED), (const char*)(P.ws + WS_WOT), 2048, T / 256, 4, G, (int)blockIdx.x};
    const EpiX1 E{P.x, P.norm2_w, P.out, (unsigned char*)(P.ws + WS_HN), (float*)(P.ws + WS_SSQ)};
    pg8::gemm_phase(lds, S, E);
}

constexpr int H_TOT = 0, H_DV = 2048, H_SSQ = 2560, H_QT = 4608, H_KH = H_QT + 17408, H_KTT = H_KH + 17408, H_VT = H_KTT + 18432, H_ST = H_VT + 18432, H_AM = H_ST + 34816, H_END = H_AM + 9216;
static_assert(H_END <= LDS_ST_OFF, "hgrn LDS");
__device__ __forceinline__ bf16x8 ldfrag(const LAS unsigned char* base, int row, int stride, int kbyte) { return *(const LAS bf16x8*)(base + row * stride + kbyte); }

template <int MODE>
__device__ __forceinline__ void hgrn_unit(const Params& P, LAS unsigned char* lds, int unit, int tid, int wid, int lane, int cit = EI_TOTAL, int cstride = 1) {
    LAS float* cscr = (LAS float*)(lds + (wid < 4 ? H_QT + wid * 8448 : H_ST + (wid - 4) * 8448));
    const int b = unit >> 6, h = (unit >> 4) & 3, sc = unit & 15;
    const int fr = opaque(lane & 15), fq = opaque(lane >> 4), c = opaque(tid & 127), qd = tid >> 7;
    const bf16* proj = (const bf16*)(P.ws + WS_PROJ);
    LAS float* TOT = (LAS float*)(lds + H_TOT); LAS float* DV = (LAS float*)(lds + H_DV); LAS float* SSQ = (LAS float*)(lds + H_SSQ);
    LAS bf16* Qt = (LAS bf16*)(lds + H_QT); LAS bf16* Kh = (LAS bf16*)(lds + H_KH); LAS bf16* KtT = (LAS bf16*)(lds + H_KTT); LAS bf16* VT = (LAS bf16*)(lds + H_VT);
    const float lbv = 1.f / (1.f + __expf(P.hlb[512 + h * 128 + c] - P.hlb[h * 128 + c]));
    float* Ug = (float*)((unsigned char*)P.out + OUT_U) + (size_t)unit * 16384;
    const float* Sin = (const float*)((unsigned char*)P.out + OUT_SIN) + (size_t)unit * 16384;
    f32x4 accS[8];
#pragma unroll
    for (int di = 0; di < 8; ++di) {
        if (MODE == 1 && sc > 0) {
#pragma unroll
            for (int r = 0; r < 4; ++r) accS[di][r] = Sin[(16 * di + 4 * fq + r) * 128 + 16 * wid + fr];
        } else accS[di] = (f32x4){0.f, 0.f, 0.f, 0.f};
        if (MODE == 1) { u32x2 o; o.x = pk2(accS[di][0], accS[di][1]); o.y = pk2(accS[di][2], accS[di][3]);
            *(LAS u32x2*)(lds + H_ST + (16 * wid + fr) * 272 + (16 * di + 4 * fq) * 2) = o; }
    }
    float dsum = 0.f;
    unsigned short rf[16], rq[16], rv[16];
#define HG_LOAD(ccx) do { const size_t t0x_ = (size_t)b * SEQ + sc * 512 + (ccx) * 64; const bf16* pb_ = proj + (t0x_ + qd * 16) * NPROJ + h * 128 + c; \
        _Pragma("unroll") for (int i = 0; i < 16; ++i) { rf[i] = pb_[(size_t)i * NPROJ + C_FH]; rv[i] = pb_[(size_t)i * NPROJ + C_IH]; if (MODE == 1) rq[i] = pb_[(size_t)i * NPROJ + C_QH]; } \
        } while (0)
    HG_LOAD(0);
#pragma unroll 1
    for (int cc = 0; cc < 8; ++cc) {
        const size_t t0 = (size_t)b * SEQ + sc * 512 + cc * 64;
        float tva[32], tvb[32]; TItem ia, ib; const int ita = cit, itb = cit + cstride;
        if (MODE == 0) { if (ita < EI_TOTAL) { ia = expert_item(P, ita); titem_load(ia, lane, tva); } if (itb < EI_TOTAL) { ib = expert_item(P, itb); titem_load(ib, lane, tvb); } }
        float bpart[16], kk[16]; float run = 0.f;
#pragma unroll
        for (int i = 0; i < 16; ++i) { const float f = bf2f(rf[i]);
            const float kv = (1.f - lbv) * __builtin_amdgcn_rcpf(1.f + fexp_(f));
            kk[i] = kv; run += __builtin_amdgcn_logf(1.f - kv); bpart[i] = run; }
        TOT[qd * 128 + c] = run;
        __syncthreads();
        float offs = 0.f, blast = 0.f;
#pragma unroll
        for (int q = 0; q < 4; ++q) { const float tv = TOT[q * 128 + c]; blast += tv; if (q < qd) offs += tv; }
        if (qd == 0) { DV[c] = exp2_(blast); dsum += blast; }
#pragma unroll
        for (int i = 0; i < 16; ++i) { const int t = qd * 16 + i; const float bb = bpart[i] + offs;
            if (MODE == 1) { const float q = bf2f(rq[i]); const float qs = q * sigmoidf_(q);
                Qt[t * 136 + c] = (bf16)f2bf(qs * exp2_(bb)); Kh[t * 136 + c] = (bf16)f2bf(kk[i] * exp2_(fminf(-bb, 115.f))); }
            KtT[c * 72 + t] = (bf16)f2bf(kk[i] * exp2_(blast - bb));
            VT[c * 72 + t] = rv[i]; }
        u32x2 gcur[4];
        if (MODE == 1) {
#pragma unroll
            for (int mi = 0; mi < 4; ++mi) gcur[mi] = *(const u32x2*)(proj + (t0 + 16 * mi + fr) * NPROJ + C_GH + h * 128 + 16 * wid + 4 * fq); }
        if (cc + 1 < 8) HG_LOAD(cc + 1);
        __syncthreads();
        f32x4 acco[4];
        if (MODE == 1) {
#pragma unroll
            for (int e2 = 0; e2 < 2; ++e2) { const int idx = 2 * wid + e2, mi = idx >> 2, ni = idx & 3; f32x4 a = (f32x4){0.f, 0.f, 0.f, 0.f};
                if (ni <= mi) {
#pragma unroll
                    for (int ks = 0; ks < 4; ++ks) { const bf16x8 kf = ldfrag(lds + H_KH, 16 * ni + fr, 272, (ks * 32 + fq * 8) * 2), qf = ldfrag(lds + H_QT, 16 * mi + fr, 272, (ks * 32 + fq * 8) * 2);
                        a = __builtin_amdgcn_mfma_f32_16x16x32_bf16(kf, qf, a, 0, 0, 0); } }
                const int t = 16 * mi + fr, s0 = 16 * ni + 4 * fq;
#pragma unroll
                for (int r = 0; r < 4; ++r) if (s0 + r > t || ni > mi) a[r] = 0.f;
                u32x2 o; o.x = pk2(a[0], a[1]); o.y = pk2(a[2], a[3]); *(LAS u32x2*)(lds + H_AM + t * 144 + s0 * 2) = o; }
#pragma unroll
            for (int mi = 0; mi < 4; ++mi) { acco[mi] = (f32x4){0.f, 0.f, 0.f, 0.f};
#pragma unroll
                for (int ks = 0; ks < 4; ++ks) { const bf16x8 sf = ldfrag(lds + H_ST, 16 * wid + fr, 272, (ks * 32 + fq * 8) * 2), qf = ldfrag(lds + H_QT, 16 * mi + fr, 272, (ks * 32 + fq * 8) * 2);
                    acco[mi] = __builtin_amdgcn_mfma_f32_16x16x32_bf16(sf, qf, acco[mi], 0, 0, 0); } }
        }
#pragma unroll
        for (int di = 0; di < 8; ++di) { const f32x4 dv4 = *(const LAS f32x4*)(lds + H_DV + (16 * di + 4 * fq) * 4); accS[di] = accS[di] * dv4;
#pragma unroll
            for (int ks = 0; ks < 2; ++ks) { const bf16x8 kf = ldfrag(lds + H_KTT, 16 * di + fr, 144, (ks * 32 + fq * 8) * 2), vf = ldfrag(lds + H_VT, 16 * wid + fr, 144, (ks * 32 + fq * 8) * 2);
                accS[di] = __builtin_amdgcn_mfma_f32_16x16x32_bf16(kf, vf, accS[di], 0, 0, 0); }
            if (MODE == 1) { u32x2 o; o.x = pk2(accS[di][0], accS[di][1]); o.y = pk2(accS[di][2], accS[di][3]);
                *(LAS u32x2*)(lds + H_ST + (16 * wid + fr) * 272 + (16 * di + 4 * fq) * 2) = o; } }
        if (MODE == 0) { if (ita < EI_TOTAL) titem_store(ia, lane, tva, cscr); if (itb < EI_TOTAL) titem_store(ib, lane, tvb, cscr); cit += 2 * cstride; }
        if (MODE == 1) {
            __syncthreads();
#pragma unroll
            for (int mi = 0; mi < 4; ++mi) {
#pragma unroll
                for (int ks = 0; ks < 2; ++ks) { const bf16x8 vf = ldfrag(lds + H_VT, 16 * wid + fr, 144, (ks * 32 + fq * 8) * 2), af = ldfrag(lds + H_AM, 16 * mi + fr, 144, (ks * 32 + fq * 8) * 2);
                    acco[mi] = __builtin_amdgcn_mfma_f32_16x16x32_bf16(vf, af, acco[mi], 0, 0, 0); }
                float s = (acco[mi][0] * acco[mi][0] + acco[mi][1] * acco[mi][1]) + (acco[mi][2] * acco[mi][2] + acco[mi][3] * acco[mi][3]);
                s += __shfl_xor(s, 16); s += __shfl_xor(s, 32);
                if (fq == 0) SSQ[wid * 64 + 16 * mi + fr] = s; }
            __syncthreads();
            bf16* hg = (bf16*)((unsigned char*)P.out + OUT_AH);
            const f32x4 nw = *(const f32x4*)(P.hnw + 16 * wid + 4 * fq);
#pragma unroll
            for (int mi = 0; mi < 4; ++mi) { const int t = 16 * mi + fr; float tot = 0.f;
#pragma unroll
                for (int w = 0; w < 8; ++w) tot += SSQ[w * 64 + t];
                const float rstd = __builtin_amdgcn_rsqf(tot * (1.f / 128.f) + EPS);
                const u32x2 gg = gcur[mi];
                const float g0 = bflo(gg.x), g1 = bfhi(gg.x), g2 = bflo(gg.y), g3 = bfhi(gg.y);
                u32x2 o; o.x = pk2(acco[mi][0] * rstd * nw[0] * (g0 * sigmoidf_(g0)), acco[mi][1] * rstd * nw[1] * (g1 * sigmoidf_(g1)));
                o.y = pk2(acco[mi][2] * rstd * nw[2] * (g2 * sigmoidf_(g2)), acco[mi][3] * rstd * nw[3] * (g3 * sigmoidf_(g3)));
                *(u32x2*)(hg + (t0 + t) * 1024 + 512 + h * 128 + 16 * wid + 4 * fq) = o; }
        }
    }
    if (MODE == 0) {
#pragma unroll
        for (int di = 0; di < 8; ++di)
#pragma unroll
            for (int r = 0; r < 4; ++r) Ug[(16 * di + 4 * fq + r) * 128 + 16 * wid + fr] = accS[di][r];
        if (qd == 0) ((float*)((unsigned char*)P.out + OUT_DSC))[unit * 128 + c] = exp2_(dsum);
    }
    __syncthreads();
}

__device__ __forceinline__ void hgrn_scan(const Params& P, int G, int tid) {
    const float* U = (const float*)((unsigned char*)P.out + OUT_U); float* Sin = (float*)((unsigned char*)P.out + OUT_SIN);
    const float* Dsc = (const float*)((unsigned char*)P.out + OUT_DSC);
    for (int idx = blockIdx.x * NTHREADS + tid; idx < 16 * 16384; idx += G * NTHREADS) {
        const int p = idx >> 14, e = idx & 16383, dk = e >> 7; float S = 0.f;
        float uu[15], dd[15];
#pragma unroll
        for (int sc = 0; sc < 15; ++sc) { const int u = p * 16 + sc; dd[sc] = Dsc[u * 128 + dk]; uu[sc] = U[(size_t)u * 16384 + e]; }
#pragma unroll
        for (int sc = 0; sc < 15; ++sc) { const int u = p * 16 + sc; S = dd[sc] * S + uu[sc]; Sin[(size_t)(u + 1) * 16384 + e] = S; }
    }
}

constexpr int A_KT = 0, A_VT = 36864, A_QS = 70656, A_END = A_QS + 73728;
static_assert(A_END <= LDS_ST_OFF, "attn LDS");
__device__ __forceinline__ void rope16(float (&v)[32], const float* cs) {
    const f32x4 c0 = *(const f32x4*)cs, c1 = *(const f32x4*)(cs + 4), s0 = *(const f32x4*)(cs + 8), s1 = *(const f32x4*)(cs + 12);
#pragma unroll
    for (int i = 0; i < 8; ++i) { const float cv = i < 4 ? c0[i & 3] : c1[i & 3], sv = i < 4 ? s0[i & 3] : s1[i & 3]; const float x1 = v[i], x2 = v[i + 8]; v[i] = x1 * cv - x2 * sv; v[i + 8] = x2 * cv + x1 * sv; }
}
__device__ __forceinline__ void unpack8(const u32x4 w, float* v) { v[0] = bflo(w.x); v[1] = bfhi(w.x); v[2] = bflo(w.y); v[3] = bfhi(w.y); v[4] = bflo(w.z); v[5] = bfhi(w.z); v[6] = bflo(w.w); v[7] = bfhi(w.w); }
__device__ __forceinline__ void attn_load(const Params& P, int unit, int tid, u32x4 (&kr)[4], u32x4 (&vr)[4], u32x4 (&qr)[8]) {
    const int hk = unit & 1, nb = (unit >> 1) & 63, b = unit >> 7;
    const bf16* proj = (const bf16*)(P.ws + WS_PROJ);
    const int key = tid >> 1, half = tid & 1; const int srel = nb * 128 - 128 + key; const bool ok = srel >= 0; const size_t tokk = (size_t)b * SEQ + (ok ? srel : 0);
    const int g = tid >> 7, ql = tid & 127; const size_t tokq = (size_t)b * SEQ + nb * 128 + ql;
    const u32x4* ksrc = (const u32x4*)(proj + tokk * NPROJ + C_KA + hk * 64 + half * 32);
    const u32x4* vsrc = (const u32x4*)(proj + tokk * NPROJ + C_VA + hk * 64 + half * 32);
    const u32x4* qsrc = (const u32x4*)(proj + tokq * NPROJ + C_QA + (hk * 4 + g) * 64);
#pragma unroll
    for (int j = 0; j < 4; ++j) { kr[j] = ksrc[j]; vr[j] = vsrc[j]; }
#pragma unroll
    for (int j = 0; j < 8; ++j) qr[j] = qsrc[j];
}
__device__ __forceinline__ void attn_unit(const Params& P, LAS unsigned char* lds, int unit, int next_unit, int tid, int wid, int lane, u32x4 (&kr)[4], u32x4 (&vr)[4], u32x4 (&qr)[8]) {
    const int hk = unit & 1, nb = (unit >> 1) & 63, b = unit >> 7;
    const int fr = opaque(lane & 15), fq = opaque(lane >> 4);
    const float* cstab = (const float*)(P.ws + WS_CS);
    {
        const int key = tid >> 1, half = tid & 1; const int srel = nb * 128 - 128 + key;
        const bool ok = srel >= 0; const size_t tokk = (size_t)b * SEQ + (ok ? srel : 0);
        const size_t tokq = (size_t)b * SEQ + nb * 128 + (tid & 127);
        { float v[32];
#pragma unroll
          for (int j = 0; j < 4; ++j) unpack8(kr[j], v + 8 * j);
          float s = 0.f;
#pragma unroll
          for (int j = 0; j < 32; ++j) s += v[j] * v[j];
          s += __shfl_xor(s, 1);
          const float rstd = 1.f / sqrtf(s * (1.f / 64.f) + EPS);
#pragma unroll
          for (int j = 0; j < 8; ++j) { const f32x4 w = *(const f32x4*)(P.k_norm_w + half * 32 + 4 * j);
              v[4 * j] *= rstd * w[0]; v[4 * j + 1] *= rstd * w[1]; v[4 * j + 2] *= rstd * w[2]; v[4 * j + 3] *= rstd * w[3]; }
          if (half == 0) rope16(v, cstab + tokk * 16);
#pragma unroll
          for (int j = 0; j < 4; ++j) { u32x4 o; o.x = pk2(v[8 * j], v[8 * j + 1]); o.y = pk2(v[8 * j + 2], v[8 * j + 3]); o.z = pk2(v[8 * j + 4], v[8 * j + 5]); o.w = pk2(v[8 * j + 6], v[8 * j + 7]);
              if (!ok) o = (u32x4){0u, 0u, 0u, 0u};
              *(LAS u32x4*)(lds + A_KT + key * 144 + half * 64 + j * 16) = o; } }
#pragma unroll
        for (int j = 0; j < 4; ++j) { u32x4 w = vr[j]; if (!ok) w = (u32x4){0u, 0u, 0u, 0u};
            LAS bf16* dst = (LAS bf16*)(lds + A_VT) + (half * 32 + 8 * j) * 264 + key;
            dst[0 * 264] = (bf16)(w.x & 0xffffu); dst[1 * 264] = (bf16)(w.x >> 16); dst[2 * 264] = (bf16)(w.y & 0xffffu); dst[3 * 264] = (bf16)(w.y >> 16);
            dst[4 * 264] = (bf16)(w.z & 0xffffu); dst[5 * 264] = (bf16)(w.z >> 16); dst[6 * 264] = (bf16)(w.w & 0xffffu); dst[7 * 264] = (bf16)(w.w >> 16); }
        { float s = 0.f;
#pragma unroll
          for (int j = 0; j < 8; ++j) { float a[8]; unpack8(qr[j], a); s += (a[0] * a[0] + a[1] * a[1]) + (a[2] * a[2] + a[3] * a[3]) + (a[4] * a[4] + a[5] * a[5]) + (a[6] * a[6] + a[7] * a[7]); }
          const float rstd = (0.125f * LOG2E) / sqrtf(s * (1.f / 64.f) + EPS);
#pragma unroll
          for (int hf = 0; hf < 2; ++hf) { float v[32];
#pragma unroll
              for (int j = 0; j < 4; ++j) unpack8(qr[hf * 4 + j], v + 8 * j);
#pragma unroll
              for (int j = 0; j < 8; ++j) { const f32x4 w = *(const f32x4*)(P.q_norm_w + hf * 32 + 4 * j);
                  v[4 * j] *= rstd * w[0]; v[4 * j + 1] *= rstd * w[1]; v[4 * j + 2] *= rstd * w[2]; v[4 * j + 3] *= rstd * w[3]; }
              if (hf == 0) rope16(v, cstab + tokq * 16);
#pragma unroll
              for (int j = 0; j < 4; ++j) { u32x4 o; o.x = pk2(v[8 * j], v[8 * j + 1]); o.y = pk2(v[8 * j + 2], v[8 * j + 3]); o.z = pk2(v[8 * j + 4], v[8 * j + 5]); o.w = pk2(v[8 * j + 6], v[8 * j + 7]);
                  *(LAS u32x4*)(lds + A_QS + tid * 144 + hf * 64 + j * 16) = o; } } }
    }
    __syncthreads();
    if (next_unit < 512) attn_load(P, next_unit, tid, kr, vr, qr);
    { const int g = wid >> 1; const float sink = P.sinks[hk * 4 + g] * LOG2E;
      bf16* attn = (bf16*)((unsigned char*)P.out + OUT_AH);
#pragma unroll 1
      for (int p = 0; p < 2; ++p) { const int q0 = (wid & 1) * 64 + p * 32;
          f32x4 sT[10][2];
          bf16x8 qf[2][2];
#pragma unroll
          for (int nq = 0; nq < 2; ++nq)
#pragma unroll
              for (int ks = 0; ks < 2; ++ks) qf[nq][ks] = ldfrag(lds + A_QS, g * 128 + q0 + 16 * nq + fr, 144, (ks * 32 + fq * 8) * 2);
#pragma unroll
          for (int kt = 0; kt < 10; ++kt) {
#pragma unroll
              for (int nq = 0; nq < 2; ++nq) sT[kt][nq] = (f32x4){0.f, 0.f, 0.f, 0.f};
#pragma unroll
              for (int ks = 0; ks < 2; ++ks) { const bf16x8 kf = ldfrag(lds + A_KT, q0 + 16 * kt + fr, 144, (ks * 32 + fq * 8) * 2);
#pragma unroll
                  for (int nq = 0; nq < 2; ++nq) if (kt - nq >= 0 && kt - nq <= 8) sT[kt][nq] = __builtin_amdgcn_mfma_f32_16x16x32_bf16(kf, qf[nq][ks], sT[kt][nq], 0, 0, 0); } }
          float linv[2];
#pragma unroll
          for (int nq = 0; nq < 2; ++nq) { float mx = sink;
#pragma unroll
              for (int kt = 0; kt < 10; ++kt) { const int d = kt - nq; if (d < 0 || d > 8) continue;
#pragma unroll
                  for (int r = 0; r < 4; ++r) { bool valid = true;
                      if (d == 0) valid = (4 * fq + r > fr); else if (d == 8) valid = (4 * fq + r <= fr);
                      if (nb == 0) valid = valid && (q0 + 16 * kt + 4 * fq + r >= 128);
                      if (!valid) sT[kt][nq][r] = -1e30f; mx = fmaxf(mx, sT[kt][nq][r]); } }
              mx = fmaxf(mx, __shfl_xor(mx, 16)); mx = fmaxf(mx, __shfl_xor(mx, 32));
              float l = 0.f;
#pragma unroll
              for (int kt = 0; kt < 10; ++kt) { const int d = kt - nq; if (d < 0 || d > 8) continue;
#pragma unroll
                  for (int r = 0; r < 4; ++r) { float pv = exp2_(sT[kt][nq][r] - mx); if ((d == 0 || d == 8 || nb == 0) && !(sT[kt][nq][r] > -1e29f)) pv = 0.f; sT[kt][nq][r] = pv; l += pv; } }
              l += __shfl_xor(l, 16); l += __shfl_xor(l, 32);
              l += exp2_(sink - mx);
              linv[nq] = 1.f / l; }
          f32x4 oT[4][2];
#pragma unroll
          for (int dt = 0; dt < 4; ++dt)
#pragma unroll
              for (int nq = 0; nq < 2; ++nq) oT[dt][nq] = (f32x4){0.f, 0.f, 0.f, 0.f};
#pragma unroll
          for (int j = 0; j < 5; ++j) { bf16x8 pf[2];
#pragma unroll
              for (int nq = 0; nq < 2; ++nq) { u32x4 w; w.x = pk2(sT[2 * j][nq][0], sT[2 * j][nq][1]); w.y = pk2(sT[2 * j][nq][2], sT[2 * j][nq][3]); w.z = pk2(sT[2 * j + 1][nq][0], sT[2 * j + 1][nq][1]); w.w = pk2(sT[2 * j + 1][nq][2], sT[2 * j + 1][nq][3]);
                  pf[nq] = __builtin_bit_cast(bf16x8, w); }
#pragma unroll
              for (int dt = 0; dt < 4; ++dt) { const LAS unsigned char* vrow = lds + A_VT + (16 * dt + fr) * 528 + (q0 + 32 * j + 4 * fq) * 2;
                  const u32x2 lo = *(const LAS u32x2*)vrow, hi = *(const LAS u32x2*)(vrow + 32);
                  u32x4 w; w.x = lo.x; w.y = lo.y; w.z = hi.x; w.w = hi.y; const bf16x8 vf = __builtin_bit_cast(bf16x8, w);
#pragma unroll
                  for (int nq = 0; nq < 2; ++nq) oT[dt][nq] = __builtin_amdgcn_mfma_f32_16x16x32_bf16(vf, pf[nq], oT[dt][nq], 0, 0, 0); } }
#pragma unroll
          for (int nq = 0; nq < 2; ++nq) { const size_t tok = (size_t)b * SEQ + nb * 128 + q0 + 16 * nq + fr;
#pragma unroll
              for (int dt = 0; dt < 4; ++dt) { const f32x4 v = oT[dt][nq] * linv[nq]; u32x2 o; o.x = pk2(v[0], v[1]); o.y = pk2(v[2], v[3]);
                  *(u32x2*)(attn + tok * 1024 + (hk * 4 + g) * 64 + 16 * dt + 4 * fq) = o; } }
      } }
    __syncthreads();
}

constexpr int P7_B0 = 25600, P7_B1 = 76288;
__device__ __forceinline__ void phase7(const Params& P, LAS unsigned char* lds, int vcu, int G, int tid, int wid, int lane, bool commit = true) {
    const bf16* Wrh = (const bf16*)(P.ws + WS_WR); const float* ssq = (const float*)(P.ws + WS_SSQ);
    unsigned* cnt = (unsigned*)(P.ws + WS_CTL + CTL_CNT); int* list = (int*)(P.ws + WS_LIST); float* gw = (float*)(P.ws + WS_GW); float* rstdv = (float*)(P.ws + WS_RSTD);
    const int fr = lane & 15, fq = lane >> 4;
    LAS float* LG = (LAS float*)(lds + wid * 3072);
    LAS unsigned* LC = (LAS unsigned*)(lds + 24576); LAS unsigned* LB = (LAS unsigned*)(lds + 24576 + 256);
    if (tid < 64) LC[tid] = 0u;
    __syncthreads();
    for (int base = vcu * 8; base < T / 16; base += G * 8) {
        const int rg = base + wid; const int R0 = rg * 16;
        f32x4 acc[3];
#pragma unroll
        for (int nt = 0; nt < 3; ++nt) acc[nt] = (f32x4){0.f, 0.f, 0.f, 0.f};
        const float* xr = P.out + (size_t)(R0 + fr) * 1024 + 8 * fq;
        u32x4 wst[6]; f32x4 xa[16], xb[16];
#define P7_WLOAD(kq) do { _Pragma("unroll") for (int j = 0; j < 6; ++j) { const int idx = tid + 512 * j, mat = idx / 1536, rem = idx - mat * 1536, row = rem >> 5, ch = rem & 31; \
            wst[j] = *(const u32x4*)(Wrh + (size_t)mat * 48 * 1024 + row * 1024 + (kq) * 256 + ch * 8); } } while (0)
#define P7_WSTORE(buf) do { _Pragma("unroll") for (int j = 0; j < 6; ++j) { const int idx = tid + 512 * j, mat = idx / 1536, rem = idx - mat * 1536, row = rem >> 5, ch = rem & 31; \
            *(LAS u32x4*)(lds + (buf) + mat * 25344 + row * 528 + ch * 16) = wst[j]; } } while (0)
#define P7_XLOAD(dst, kq) do { _Pragma("unroll") for (int ks = 0; ks < 8; ++ks) { dst[2 * ks] = *(const f32x4*)(xr + (kq) * 256 + 32 * ks); dst[2 * ks + 1] = *(const f32x4*)(xr + (kq) * 256 + 32 * ks + 4); } } while (0)
#define P7_COMPUTE(src, buf) do { _Pragma("unroll") for (int ks = 0; ks < 8; ++ks) { const f32x4 a0 = src[2 * ks], a1 = src[2 * ks + 1]; u32x4 hw, lw; \
            { const unsigned h0 = f2bf(a0[0]), h1 = f2bf(a0[1]), h2 = f2bf(a0[2]), h3 = f2bf(a0[3]), h4 = f2bf(a1[0]), h5 = f2bf(a1[1]), h6 = f2bf(a1[2]), h7 = f2bf(a1[3]); \
              hw.x = h0 | (h1 << 16); hw.y = h2 | (h3 << 16); hw.z = h4 | (h5 << 16); hw.w = h6 | (h7 << 16); \
              lw.x = pk2(a0[0] - bf2f(h0), a0[1] - bf2f(h1)); lw.y = pk2(a0[2] - bf2f(h2), a0[3] - bf2f(h3)); lw.z = pk2(a1[0] - bf2f(h4), a1[1] - bf2f(h5)); lw.w = pk2(a1[2] - bf2f(h6), a1[3] - bf2f(h7)); } \
            const bf16x8 ah = __builtin_bit_cast(bf16x8, hw), al = __builtin_bit_cast(bf16x8, lw); \
            _Pragma("unroll") for (int nt = 0; nt < 3; ++nt) { const LAS unsigned char* wp = lds + (buf) + (16 * nt + fr) * 528 + (ks * 32 + 8 * fq) * 2; \
                const bf16x8 bh = *(const LAS bf16x8*)wp, bl = *(const LAS bf16x8*)(wp + 25344); \
                acc[nt] = __builtin_amdgcn_mfma_f32_16x16x32_bf16(ah, bh, acc[nt], 0, 0, 0); \
                acc[nt] = __builtin_amdgcn_mfma_f32_16x16x32_bf16(ah, bl, acc[nt], 0, 0, 0); \
                acc[nt] = __builtin_amdgcn_mfma_f32_16x16x32_bf16(al, bh, acc[nt], 0, 0, 0); } } } while (0)
        P7_WLOAD(0); P7_XLOAD(xa, 0); P7_WSTORE(P7_B0); P7_WLOAD(1); P7_XLOAD(xb, 1);
        __syncthreads();
        P7_COMPUTE(xa, P7_B0); P7_WSTORE(P7_B1); P7_WLOAD(2); P7_XLOAD(xa, 2);
        __syncthreads();
        P7_COMPUTE(xb, P7_B1); P7_WSTORE(P7_B0); P7_WLOAD(3); P7_XLOAD(xb, 3);
        __syncthreads();
        P7_COMPUTE(xa, P7_B0); P7_WSTORE(P7_B1);
        __syncthreads();
        P7_COMPUTE(xb, P7_B1);
#undef P7_WLOAD
#undef P7_WSTORE
#undef P7_XLOAD
#undef P7_COMPUTE
#pragma unroll
        for (int r = 0; r < 4; ++r) { const float* sp = ssq + (size_t)(R0 + 4 * fq + r) * 16; float tot = 0.f;
#pragma unroll
            for (int q = 0; q < 4; ++q) { const f32x4 v = *(const f32x4*)(sp + 4 * q); tot += v[0]; tot += v[1]; tot += v[2]; tot += v[3]; }
            const float rstd = 1.f / sqrtf(tot * (1.f / 1024.f) + EPS);
            if (fr == 0) rstdv[R0 + 4 * fq + r] = rstd;
#pragma unroll
            for (int nt = 0; nt < 3; ++nt) { const int j = 16 * nt + fr; float bias = 0.f; if (j < 4) bias = P.b_rg[j]; else if (j < 36) bias = P.b_re[j - 4];
                LG[(4 * fq + r) * 48 + j] = acc[nt][r] * rstd + bias; } }
        __syncthreads();
        int l0 = 0, l1 = 0; unsigned rk0 = 0u, rk1 = 0u;
        if (lane < 16) { const int tok = R0 + lane; const LAS float* lg = LG + lane * 48;
            int gsel = 0; float best = lg[0];
#pragma unroll
            for (int i = 1; i < 4; ++i) { const float v = lg[i]; if (v > best) { best = v; gsel = i; } }
            float Z = 0.f;
#pragma unroll
            for (int i = 0; i < 4; ++i) Z += __expf(lg[i] - best);
            const float pgsel = 1.f / Z;
            const LAS float* le = lg + 4 + gsel * 8;
            float lmax = le[0];
#pragma unroll
            for (int i = 1; i < 8; ++i) lmax = fmaxf(lmax, le[i]);
            float Zp = 0.f;
#pragma unroll
            for (int i = 0; i < 8; ++i) Zp += __expf(le[i] - lmax);
            int i1 = 0; float p1 = -1.f;
#pragma unroll
            for (int i = 0; i < 8; ++i) { const float pe = __expf(le[i] - lmax) / Zp; if (pe > p1) { p1 = pe; i1 = i; } }
            int i2 = 0; float p2 = -1.f;
#pragma unroll
            for (int i = 0; i < 8; ++i) { const float pe = __expf(le[i] - lmax) / Zp; if (i != i1 && pe > p2) { p2 = pe; i2 = i; } }
            const float den = p1 + p2;
            gw[tok * 2 + 0] = pgsel * p1 / den; gw[tok * 2 + 1] = pgsel * p2 / den;
            l0 = gsel * 8 + i1; l1 = 32 + gsel * 8 + i2;
            rk0 = __hip_atomic_fetch_add(&LC[l0], 1u, __ATOMIC_RELAXED, __HIP_MEMORY_SCOPE_WORKGROUP); rk1 = __hip_atomic_fetch_add(&LC[l1], 1u, __ATOMIC_RELAXED, __HIP_MEMORY_SCOPE_WORKGROUP); }
        __syncthreads();
        if (tid < 64) { const unsigned n = LC[tid]; LC[tid] = 0u; if (n && commit) LB[tid] = atomicAdd(&cnt[tid * 64], n); }
        __syncthreads();
        if (lane < 16 && commit) { const int tok = R0 + lane; list[(size_t)l0 * T + LB[l0] + rk0] = tok; list[(size_t)l1 * T + LB[l1] + rk1] = tok; }
        __syncthreads();
    }
}

constexpr int M_PB = 133120, M_CN = 133632, M_RBL = 133888;
__device__ __forceinline__ void moe_prefix(const Params& P, LAS unsigned char* lds, int tid) {
    const unsigned* cnt = (const unsigned*)(P.ws + WS_CTL + CTL_CNT);
    LAS int* PB = (LAS int*)(lds + M_PB); LAS int* CN = (LAS int*)(lds + M_CN);
    if (tid < 64) CN[tid] = (int)cnt[tid * 64];
    __syncthreads();
    if (tid == 0) { int s = 0; for (int l = 0; l < 64; ++l) { PB[l] = s; s += (CN[l] + 255) >> 8; } PB[64] = s; }
    __syncthreads();
    if (tid < 64) { LAS int* RBL = (LAS int*)(lds + M_RBL); for (int rb = PB[tid]; rb < PB[tid + 1]; ++rb) RBL[rb] = tid; }
    __syncthreads();
}
__device__ __forceinline__ void phase8(const Params& P, LAS unsigned char* lds, int vcu, int G) {
    const LAS int* PB = (const LAS int*)(lds + M_PB); const LAS int* CN = (const LAS int*)(lds + M_CN);
    const pg8::MoeSched<0> S{(const char*)(P.ws + WS_HN), (const char*)(P.ws + WS_WGU), (const int*)(P.ws + WS_LIST), PB, CN, (const LAS int*)(lds + M_RBL), 1024, PB[0], (PB[64] - PB[0]) * 4, vcu, G};
    const EpiGateUp E{(const int*)(P.ws + WS_LIST), (const float*)(P.ws + WS_RSTD), (unsigned char*)(P.ws + WS_H)};
    pg8::gemm_phase(lds, S, E);
}
__device__ __forceinline__ void phase9(const Params& P, LAS unsigned char* lds, int vcu, int G) {
    const LAS int* PB = (const LAS int*)(lds + M_PB); const LAS int* CN = (const LAS int*)(lds + M_CN);
    const pg8::MoeSched<1> S{(const char*)(P.ws + WS_H), (const char*)(P.ws + WS_WD), (const int*)(P.ws + WS_LIST), PB, CN, (const LAS int*)(lds + M_RBL), 512, PB[32], (PB[64] - PB[32]) * 4, vcu, G};
    const EpiDownY E{(const int*)(P.ws + WS_LIST), (const float*)(P.ws + WS_GW), (bf16*)(P.ws + WS_Y)};
    pg8::gemm_phase(lds, S, E);
}
__device__ __forceinline__ void phase10(const Params& P, LAS unsigned char* lds, int vcu, int G) {
    const LAS int* PB = (const LAS int*)(lds + M_PB); const LAS int* CN = (const LAS int*)(lds + M_CN);
    const pg8::MoeSched<1> S{(const char*)(P.ws + WS_H), (const char*)(P.ws + WS_WD), (const int*)(P.ws + WS_LIST), PB, CN, (const LAS int*)(lds + M_RBL), 512, PB[0], (PB[32] - PB[0]) * 4, vcu, G};
    const EpiDown E{(const int*)(P.ws + WS_LIST), (const float*)(P.ws + WS_GW), P.out, (const bf16*)(P.ws + WS_Y), (const float*)(P.ws + WS_CTL + 32768)};
    pg8::gemm_phase(lds, S, E);
}

__global__ void __launch_bounds__(NTHREADS, 2) mega_fwd(Params P) {
    extern __shared__ __attribute__((aligned(16))) unsigned char lds_raw[];
    LAS unsigned char* lds = (LAS unsigned char*)lds_raw;
    const int tid = threadIdx.x, lane = tid & 63, wid = __builtin_amdgcn_readfirstlane(tid >> 6);
    const int G = gridDim.x; const int bx = blockIdx.x; const int vcu = (G % 8 == 0) ? (bx % 8) * (G / 8) + bx / 8 : bx;
    volatile LAS unsigned* st = (volatile LAS unsigned*)(lds + LDS_ST_OFF);
    if (tid < 16) st[tid] = 0u;
    __syncthreads();
    unsigned* bar = (unsigned*)(P.ws + WS_CTL);
    const XcdBarrier xb = xcd_barrier_post(bar, st);

#ifndef DUPMASK
#define DUPMASK 0
#endif
#define DUPQ(k) if ((DUPMASK >> (k)) & 1)
#ifndef PHMASK
#define PHMASK 0xFFFF
#endif
#define PH(k) if ((PHMASK >> (k)) & 1)
    PH(0) phase0(P, lds, vcu, G, tid, wid, lane);
    DUPQ(0) phase0(P, lds, vcu, G, tid, wid, lane);
    xcd_barrier(xb);
    PH(1) phase1(P, lds, G);
    DUPQ(1) phase1(P, lds, G);
    const int ei_p1 = (G == 256) ? 14336 : 0;
    PH(1) if (G == 256 && bx >= 128) { LAS float* cscr = (LAS float*)(lds + wid * 16384); const int w1 = (bx - 128) * 8 + wid;
#pragma unroll 1
        for (int k = 0; k < 14; k += 2) { float tva[32], tvb[32]; const TItem ia = expert_item(P, w1 + k * 1024), ib = expert_item(P, w1 + (k + 1) * 1024);
            titem_load(ia, lane, tva); titem_load(ib, lane, tvb); titem_store(ia, lane, tva, cscr); titem_store(ib, lane, tvb, cscr); } }
    xcd_barrier(xb);
    PH(2) {
        int cit = ei_p1 + vcu * 8 + wid; const int cstride = G * 8;
        for (int u = bx; u < 256; u += G) {
            if ((u & 15) != 15) { hgrn_unit<0>(P, lds, u, tid, wid, lane, cit, cstride); cit += 16 * cstride; } }
        LAS float* cscr = (LAS float*)(lds + (wid < 4 ? H_QT + wid * 8448 : H_ST + (wid - 4) * 8448));
        for (; cit < EI_TOTAL; cit += cstride) { float tv[32]; const TItem t = expert_item(P, cit); titem_load(t, lane, tv); titem_store(t, lane, tv, cscr); }
    }
    DUPQ(2) for (int u = bx; u < 256; u += G) if ((u & 15) != 15) hgrn_unit<0>(P, lds, u, tid, wid, lane);
    xcd_barrier(xb);
    PH(3) { hgrn_scan(P, G, tid);
    { u32x4 kr[4], vr[4], qr[8]; if (bx < 512) attn_load(P, bx, tid, kr, vr, qr);
      for (int u = bx; u < 512; u += G) attn_unit(P, lds, u, u + G, tid, wid, lane, kr, vr, qr); } }
    DUPQ(3) { u32x4 kr[4], vr[4], qr[8]; if (bx < 512) attn_load(P, bx, tid, kr, vr, qr);
      for (int u = bx; u < 512; u += G) attn_unit(P, lds, u, u + G, tid, wid, lane, kr, vr, qr); }
    xcd_barrier(xb);
    PH(4) for (int u = bx; u < 256; u += G) hgrn_unit<1>(P, lds, u, tid, wid, lane);
    DUPQ(4) for (int u = bx; u < 256; u += G) hgrn_unit<1>(P, lds, u, tid, wid, lane);
    xcd_barrier(xb);
    PH(5) phase5(P, lds, G);
    DUPQ(5) phase5(P, lds, G);
    xcd_barrier(xb);
    PH(6) phase6(P, lds, G);
    DUPQ(6) phase6(P, lds, G);
    xcd_barrier(xb);
    if ((DUPMASK >> 7) & 1) phase7(P, lds, vcu, G, tid, wid, lane, false);
    PH(7) phase7(P, lds, vcu, G, tid, wid, lane);
    xcd_barrier(xb);
    moe_prefix(P, lds, tid);
    PH(8) phase8(P, lds, vcu, G);
    DUPQ(8) phase8(P, lds, vcu, G);
    xcd_barrier(xb);
    PH(9) phase9(P, lds, vcu, G);
    xcd_barrier(xb);
    PH(10) phase10(P, lds, vcu, G);
    if (xb_ld(&bar[XB_TMO]) != 0u && tid == 0) P.out[(size_t)bx * 1024] = __builtin_nanf("");
}

extern "C" void kernel_launch(void* const* d_in, const int* in_sizes, int n_in, void* d_out, int out_size, void* d_ws, size_t ws_size, hipStream_t stream) {
    static int grid = 0;
    if (grid == 0) {
        if (n_in != 20 || out_size != T * D || ws_size < WS_END) { fprintf(stderr, "kernel_launch: unexpected shapes (n_in %d out %d ws %zu, need ws >= %zu)\n", n_in, out_size, ws_size, (size_t)WS_END); grid = -1; return; }
        int dev = 0, cus = 0, per_cu = 0;
        if (hipGetDevice(&dev) != hipSuccess || hipDeviceGetAttribute(&cus, hipDeviceAttributeMultiprocessorCount, dev) != hipSuccess) { grid = -1; return; }
        if (hipFuncSetAttribute((const void*)mega_fwd, hipFuncAttributeMaxDynamicSharedMemorySize, LDS_BYTES) != hipSuccess) { fprintf(stderr, "hipFuncSetAttribute failed\n"); grid = -1; return; }
        if (hipOccupancyMaxActiveBlocksPerMultiprocessor(&per_cu, (const void*)mega_fwd, NTHREADS, LDS_BYTES) != hipSuccess || per_cu < 1) { fprintf(stderr, "occupancy query: %d blocks/CU\n", per_cu); grid = -1; return; }
        grid = cus;
    }
    if (grid < 0) return;
    if (hipMemsetAsync((char*)d_ws + WS_CTL, 0, 96 * 1024, stream) != hipSuccess) return;
    Params p{};
    p.x = (const float*)d_in[0]; p.positions = (const int*)d_in[1]; p.norm1_w = (const float*)d_in[2]; p.w_in = (const float*)d_in[3];
    p.q_norm_w = (const float*)d_in[4]; p.k_norm_w = (const float*)d_in[5]; p.sinks = (const float*)d_in[6]; p.hlb = (const float*)d_in[7];
    p.hnw = (const float*)d_in[8]; p.w_ba = (const float*)d_in[9]; p.w_bh = (const float*)d_in[10]; p.w_out = (const float*)d_in[11];
    p.norm2_w = (const float*)d_in[12]; p.w_rg = (const float*)d_in[13]; p.b_rg = (const float*)d_in[14]; p.w_re = (const float*)d_in[15];
    p.b_re = (const float*)d_in[16]; p.w_gate = (const float*)d_in[17]; p.w_up = (const float*)d_in[18]; p.w_down = (const float*)d_in[19];
    p.out = (float*)d_out; p.ws = (unsigned char*)d_ws;
    void* args[] = {&p};
    const hipError_t e = hipLaunchCooperativeKernel((const void*)mega_fwd, dim3(grid), dim3(NTHREADS), args, LDS_BYTES, stream);
    if (e != hipSuccess) fprintf(stderr, "cooperative launch failed: %s (grid %d)\n", hipGetErrorString(e), grid);
}
```

```cpp
#define DUPMASK 0
#include <hip/hip_runtime.h>
#include <cstdio>
#include <cstdint>

#define LAS __attribute__((address_space(3)))
typedef unsigned short bf16;
typedef short bf16x8 __attribute__((ext_vector_type(8)));
typedef float f32x4 __attribute__((ext_vector_type(4)));
typedef unsigned u32x4 __attribute__((ext_vector_type(4)));
typedef unsigned u32x2 __attribute__((ext_vector_type(2)));

constexpr int NTHREADS = 512;
constexpr int LDS_BYTES = 147456;
constexpr int LDS_ST_OFF = LDS_BYTES - 64;

constexpr int BATCH = 4, SEQ = 8192, T = BATCH * SEQ, D = 1024, NPROJ = 4864;
constexpr int C_QA = 0, C_KA = 512, C_VA = 640, C_QH = 768, C_FH = 1280, C_IH = 1792, C_GH = 2304, C_ZA = 2816, C_ZB = 3840;
constexpr int NEXP = 32, FF = 512;
constexpr float EPS = 1e-6f;

constexpr size_t MiB = 1u << 20;
constexpr size_t WS_CTL = 0;
constexpr size_t CTL_CNT = 65536;
constexpr size_t WS_WINT = 1 * MiB;
constexpr size_t WS_WAT = 11 * MiB;
constexpr size_t WS_WBT = 12 * MiB;
constexpr size_t WS_WOT = 13 * MiB;
constexpr size_t WS_WR = 15 * MiB;
constexpr size_t WS_WGU = 16 * MiB;
constexpr size_t WS_WD = 80 * MiB;
constexpr size_t WS_PROJ = 112 * MiB;
constexpr size_t WS_MIXED = 416 * MiB;
constexpr size_t WS_CS = 480 * MiB;
constexpr size_t WS_WZ8 = 482 * MiB;
constexpr size_t WS_END = 484 * MiB;
constexpr size_t WS_HN = 112 * MiB;
constexpr size_t WS_SSQ = 176 * MiB;
constexpr size_t WS_LIST = 178 * MiB;
constexpr size_t WS_GW = 186 * MiB;
constexpr size_t WS_RSTD = 187 * MiB;
constexpr size_t WS_H = 192 * MiB;
constexpr size_t WS_Y = 272 * MiB;
constexpr size_t OUT_U = 0, OUT_SIN = 16 * MiB, OUT_DSC = 32 * MiB, OUT_AH = 64 * MiB, OUT_XN8 = 64 * MiB;

typedef float f32x2_ __attribute__((ext_vector_type(2)));
typedef __bf16 bf16x2_ __attribute__((ext_vector_type(2)));
__device__ __forceinline__ unsigned f2bf(float f) { return (unsigned)__builtin_bit_cast(unsigned short, (__bf16)f); }
__device__ __forceinline__ float bf2f(unsigned h) { return __builtin_bit_cast(float, h << 16); }
__device__ __forceinline__ unsigned pk2(float lo, float hi) { const f32x2_ v = {lo, hi}; return __builtin_bit_cast(unsigned, __builtin_convertvector(v, bf16x2_)); }
__device__ __forceinline__ float bflo(unsigned w) { return __builtin_bit_cast(float, w << 16); }
__device__ __forceinline__ float bfhi(unsigned w) { return __builtin_bit_cast(float, w & 0xffff0000u); }
constexpr float LOG2E = 1.4426950408889634f;
__device__ __forceinline__ float exp2_(float x) { return __builtin_amdgcn_exp2f(x); }
__device__ __forceinline__ float fexp_(float x) { return __builtin_amdgcn_exp2f(x * LOG2E); }
__device__ __forceinline__ float sigmoidf_(float x) { return __builtin_amdgcn_rcpf(1.f + fexp_(-x)); }
__device__ __forceinline__ int opaque(int x) { asm volatile("" : "+v"(x)); return x; }
__device__ __forceinline__ float wave_sum(float v) {
#pragma unroll
    for (int o = 1; o < 64; o <<= 1) v += __shfl_xor(v, o);
    return v;
}

#define XB_TMO      128
#define XB_XCNT(j)  (256  + 64 * (j))
#define XB_XSUB(j)  (1280 + 64 * (j))
#define XB_XGEN(j)  (2304 + 64 * (j))
#define XB_TOP      3328
#define XB_TOPGEN   3392
#define XCD_BAR_WORDS 3456
#define XB_SPIN_CAP (1u << 20)
__device__ __forceinline__ unsigned xb_ld(unsigned* p)              { return __hip_atomic_load(p, __ATOMIC_RELAXED, __HIP_MEMORY_SCOPE_AGENT); }
__device__ __forceinline__ unsigned xb_add(unsigned* p, unsigned v) { return __hip_atomic_fetch_add(p, v, __ATOMIC_RELAXED, __HIP_MEMORY_SCOPE_AGENT); }
__device__ __forceinline__ unsigned xb_xcc_id() { return (unsigned)__builtin_amdgcn_s_getreg((3 << 11) | 20) & 0xFu; }
#define XB_SPIN(cond, bar) do { unsigned _sp = 0; while (cond) { __builtin_amdgcn_s_sleep(1); \
    if ((++_sp & 255u) == 0u) { if (xb_ld(&(bar)[XB_TMO])) break; if (_sp > XB_SPIN_CAP) { atomicAdd(&(bar)[XB_TMO], 1u); break; } } } } while (0)
struct XcdBarrier { unsigned* bar; unsigned x; volatile LAS unsigned* st; };
__device__ __forceinline__ XcdBarrier xcd_barrier_post(unsigned* bar, volatile LAS unsigned* st) {
    XcdBarrier b; b.bar = bar; b.x = xb_xcc_id(); b.st = st;
    if (threadIdx.x == 0) (void)xb_add(&bar[XB_XCNT(b.x)], 1u);
    return b;
}
__device__ __forceinline__ void xcd_barrier_complete(unsigned* bar, unsigned x, unsigned& nloc, unsigned& nx) {
    const unsigned G = gridDim.x * gridDim.y * gridDim.z;
    unsigned sum, cnt, mine, sp = 0u;
    for (;;) {
        sum = 0u; cnt = 0u; mine = 0u;
#pragma unroll
        for (unsigned j = 0; j < 16; ++j) { const unsigned c = xb_ld(&bar[XB_XCNT(j)]); sum += c; cnt += (c > 0u) ? 1u : 0u; mine = (j == x) ? c : mine; }
        if (sum == G) break;
        __builtin_amdgcn_s_sleep(1);
        if ((++sp & 255u) == 0u) { if (xb_ld(&bar[XB_TMO])) break; if (sp > XB_SPIN_CAP) { atomicAdd(&bar[XB_TMO], 1u); break; } }
    }
    nloc = mine > 0u ? mine : 1u; nx = cnt > 0u ? cnt : 1u;
}
__device__ __forceinline__ void xcd_barrier(const XcdBarrier& b) {
    asm volatile("s_waitcnt vmcnt(0)" ::: "memory");
    __syncthreads();
    if (threadIdx.x == 0) {
        unsigned* bar = b.bar;
        __builtin_amdgcn_s_waitcnt(0);
        unsigned nloc = b.st[0], nx = b.st[1];
        if (nloc == 0u) { xcd_barrier_complete(bar, b.x, nloc, nx); b.st[0] = nloc; b.st[1] = nx; }
        const unsigned old = xb_add(&bar[XB_XSUB(b.x)], 1u);
        const unsigned gen = old / nloc;
        if (old + 1u == (gen + 1u) * nloc) {
            __builtin_amdgcn_fence(__ATOMIC_RELEASE, "agent");
            asm volatile("s_waitcnt vmcnt(0)" ::: "memory");
            const unsigned og = xb_add(&bar[XB_TOP], 1u);
            const unsigned tg = og / nx;
            if (og + 1u == (tg + 1u) * nx) xb_add(&bar[XB_TOPGEN], 1u);
            else XB_SPIN(xb_ld(&bar[XB_TOPGEN]) == tg, bar);
            __builtin_amdgcn_fence(__ATOMIC_ACQUIRE, "agent");
            xb_add(&bar[XB_XGEN(b.x)], 1u);
            asm volatile("s_waitcnt vmcnt(0)" ::: "memory");
        } else {
            XB_SPIN(xb_ld(&bar[XB_XGEN(b.x)]) == gen, bar);
            __builtin_amdgcn_fence(__ATOMIC_ACQUIRE, "agent");
            asm volatile("s_waitcnt vmcnt(0)" ::: "memory");
        }
    }
    __syncthreads();
}

struct Params {
    const float* x; const int* positions; const float* norm1_w; const float* w_in; const float* q_norm_w; const float* k_norm_w;
    const float* sinks; const float* hlb; const float* hnw; const float* w_ba; const float* w_bh; const float* w_out; const float* norm2_w;
    const float* w_rg; const float* b_rg; const float* w_re; const float* b_re; const float* w_gate; const float* w_up; const float* w_down;
    float* out; unsigned char* ws;
};
constexpr int LDS_PTAB = LDS_ST_OFF - 256;
template <class Tp> __device__ __forceinline__ Tp ldparam(LAS unsigned char* lds, int off) {
    const u32x2 v = *(const LAS u32x2*)(lds + LDS_PTAB + off);
    const unsigned lo = (unsigned)__builtin_amdgcn_readfirstlane((int)v.x), hi = (unsigned)__builtin_amdgcn_readfirstlane((int)v.y);
    return (Tp)(((unsigned long long)hi << 32) | (unsigned long long)lo); }
#define PP(f) ldparam<decltype(Params::f)>(lds, (int)__builtin_offsetof(Params, f))


namespace pg8 {
constexpr int BK = 64, HALF = 128, HTB = HALF * BK * 2;
__device__ __forceinline__ int lds_byte(int r, int c) { const int st = (r >> 4) * 2 + (c >> 5), rr = r & 15, cc = c & 31, ob = rr * 64 + cc * 2; return st * 1024 + (ob ^ (((ob >> 9) & 1) << 5)); }
__device__ __forceinline__ void stage_rc(int b, int& R, int& C) { const int st = b / 1024, sb = b % 1024, swz = sb ^ (((sb >> 9) & 1) << 5); R = (st >> 1) * 16 + swz / 64; C = (st & 1) * 32 + (swz % 64) / 2; }
__device__ __forceinline__ int perm32(int rho) { const int n = rho >> 4, i = rho & 15; return 8 * (i >> 2) + 4 * n + (i & 3); }
struct Unit { int pm, pn, l, i0, cn; };
typedef int i32x4_ __attribute__((ext_vector_type(4)));
typedef int i32x8_ __attribute__((ext_vector_type(8)));
__device__ __forceinline__ i32x8_ cat8(i32x4_ a, i32x4_ b) { return __builtin_shufflevector(a, b, 0, 1, 2, 3, 4, 5, 6, 7); }
__device__ __forceinline__ bf16x8 lo8(i32x8_ v) { return __builtin_bit_cast(bf16x8, __builtin_shufflevector(v, v, 0, 1, 2, 3)); }
__device__ __forceinline__ bf16x8 hi8(i32x8_ v) { return __builtin_bit_cast(bf16x8, __builtin_shufflevector(v, v, 4, 5, 6, 7)); }

template <class Epi, class Sched>
__device__ __forceinline__ void gemm_phase(LAS unsigned char* lds, const Sched& S, const Epi& E) {
    const int tid = threadIdx.x, wid = __builtin_amdgcn_readfirstlane(tid >> 6), lane = tid & 63, wr = wid >> 2, wc = wid & 3, fr = lane & 15, fq = lane >> 4;
    const int KB = S.KB, nt = KB / 128;
    int sR[2], sC = 0; unsigned voffB[2];
#pragma unroll
    for (int i = 0; i < 2; ++i) { int R, C; stage_rc(tid * 16 + i * 8192, R, C); sR[i] = R; sC = C; const int Rb = Epi::PERM ? ((R & ~31) + perm32(R & 31)) : R; voffB[i] = (unsigned)(Rb * KB + C * 2); }
    const unsigned kstep = (unsigned)(BK * 2);
    const size_t hstep = (size_t)HALF * KB;
    const unsigned ldsw = (unsigned)wid * 1024u;
    const int aoff = lds_byte(wr * 64 + fr, fq * 8), boff = lds_byte(wc * 32 + fr, fq * 8);
#define PG8_SA(b, h) (((b) * 2 + (h)) * HTB)
#define PG8_SB(b, h) ((4 + (b) * 2 + (h)) * HTB)
#define PG8_STAGE_B(bufoff, gbase) do { _Pragma("unroll") for (int _i = 0; _i < 2; ++_i) \
        __builtin_amdgcn_global_load_lds((const unsigned*)((const char*)(gbase) + voffB[_i]), (LAS unsigned*)(lds + (bufoff) + ldsw + _i * 8192), 16, 0, 0); } while (0)
#define PG8_STAGE_A(bufoff, va, kb) do { _Pragma("unroll") for (int _i = 0; _i < 2; ++_i) \
        __builtin_amdgcn_global_load_lds((const unsigned*)(Ab + ((size_t)(va)[_i] + (kb))), (LAS unsigned*)(lds + (bufoff) + ldsw + _i * 8192), 16, 0, 0); } while (0)
#define PG8_LDA(dst, b, h) do { _Pragma("unroll") for (int m = 0; m < 4; ++m) dst[m] = cat8(*(const LAS i32x4_*)(lds + PG8_SA(b, h) + aoff + m * 2048), *(const LAS i32x4_*)(lds + PG8_SA(b, h) + aoff + m * 2048 + 1024)); } while (0)
#define PG8_LDB(dst, b, h) do { _Pragma("unroll") for (int n = 0; n < 2; ++n) dst[n] = cat8(*(const LAS i32x4_*)(lds + PG8_SB(b, h) + boff + n * 2048), *(const LAS i32x4_*)(lds + PG8_SB(b, h) + boff + n * 2048 + 1024)); } while (0)
#define PG8_MMA(ai, bj, At, Bt) do { __builtin_amdgcn_s_setprio(1); _Pragma("unroll") for (int m = 0; m < 4; ++m) _Pragma("unroll") for (int n = 0; n < 2; ++n) { \
        if constexpr (Sched::FP8) {   \
              \
            asm volatile("v_mfma_scale_f32_16x16x128_f8f6f4 %0, %1, %2, %0, %3, %4 op_sel_hi:[0,0,0]" : "+v"(acc[ai][bj][m][n]) : "v"(Bt[n]), "v"(At[m]), "v"(sclB), "v"(sclA)); \
        } else { acc[ai][bj][m][n] = __builtin_amdgcn_mfma_f32_16x16x32_bf16(lo8(Bt[n]), lo8(At[m]), acc[ai][bj][m][n], 0, 0, 0); \
                 acc[ai][bj][m][n] = __builtin_amdgcn_mfma_f32_16x16x32_bf16(hi8(Bt[n]), hi8(At[m]), acc[ai][bj][m][n], 0, 0, 0); } } \
        __builtin_amdgcn_s_setprio(0); } while (0)
#define PG8_WAIT_V(n) asm volatile("s_waitcnt vmcnt(" #n ")" ::: "memory")
#define PG8_WAIT_L(n) asm volatile("s_waitcnt lgkmcnt(" #n ")" ::: "memory")
#define PG8_BAR __builtin_amdgcn_s_barrier()
#define PG8_SCHED __builtin_amdgcn_sched_barrier(0)
    Unit cur, nxt; int ui = 0;
    if (!S.next(0, cur)) return;
    const int sclA = Sched::SCALE_A, sclB = Sched::SCALE_B; (void)sclA; (void)sclB;
    f32x4 acc[2][2][4][2];
#pragma unroll
    for (int a = 0; a < 2; ++a)
#pragma unroll
        for (int b = 0; b < 2; ++b)
#pragma unroll
            for (int m = 0; m < 4; ++m)
#pragma unroll
                for (int n = 0; n < 2; ++n) acc[a][b][m][n] = (f32x4){0.f, 0.f, 0.f, 0.f};
    i32x8_ At[4], B0[2], B1[2];
    const char* const Ab = S.a_base();
    unsigned vA0[2], vA1[2], nA0[2], nA1[2];
#pragma unroll
    for (int i = 0; i < 2; ++i) { vA0[i] = S.a_voff(cur, 0, sR[i], sC); vA1[i] = S.a_voff(cur, 1, sR[i], sC); }
    const char* cB = S.b_base(cur);
    PG8_STAGE_B(PG8_SB(0, 0), cB); PG8_STAGE_B(PG8_SB(0, 1), cB + hstep); PG8_STAGE_A(PG8_SA(0, 0), vA0, 0u); PG8_STAGE_A(PG8_SA(0, 1), vA1, 0u);
    if (wr == 1) PG8_BAR;
    PG8_WAIT_V(2); PG8_BAR;
    PG8_STAGE_B(PG8_SB(1, 0), cB + kstep); PG8_STAGE_A(PG8_SA(1, 0), vA0, kstep); PG8_STAGE_B(PG8_SB(1, 1), cB + hstep + kstep);
    PG8_WAIT_V(6); PG8_BAR;
    for (;;) {
        const bool has_next = S.next(ui + 1, nxt);
        const char* nB = has_next ? S.b_base(nxt) : cB;
#pragma unroll
        for (int i = 0; i < 2; ++i) { nA0[i] = has_next ? S.a_voff(nxt, 0, sR[i], sC) : vA0[i]; nA1[i] = has_next ? S.a_voff(nxt, 1, sR[i], sC) : vA1[i]; }
#pragma unroll 1
        for (int t = 0; t < nt; t += 2) {
            const bool last = (t == nt - 2);
            if constexpr (Epi::MID) { if (t == (nt >> 1)) E.mid(acc, cur, wr, wc, fr, fq); }
            const unsigned k1 = (unsigned)(t + 1) * kstep;
            const unsigned k2 = last ? 0u : (unsigned)(t + 2) * kstep, k3 = k2 + kstep;
            const char* b2 = last ? nB : cB + (size_t)(t + 2) * kstep; const char* b3 = b2 + kstep;
            unsigned uA0[2], uA1[2];
#pragma unroll
            for (int i = 0; i < 2; ++i) { uA0[i] = last ? nA0[i] : vA0[i]; uA1[i] = last ? nA1[i] : vA1[i]; }
            PG8_LDB(B0, 0, 0); PG8_LDB(B1, 0, 1); PG8_SCHED; PG8_LDA(At, 0, 0); PG8_STAGE_A(PG8_SA(1, 1), vA1, k1);
            PG8_WAIT_V(8); PG8_WAIT_L(0); PG8_BAR; PG8_MMA(0, 0, At, B0); PG8_MMA(0, 1, At, B1); PG8_BAR; PG8_SCHED;
            PG8_LDA(At, 0, 1); PG8_STAGE_B(PG8_SB(0, 0), b2); PG8_STAGE_B(PG8_SB(0, 1), b2 + hstep); PG8_STAGE_A(PG8_SA(0, 0), uA0, k2);
            PG8_WAIT_V(8); PG8_WAIT_L(0); PG8_BAR; PG8_MMA(1, 0, At, B0); PG8_MMA(1, 1, At, B1); PG8_BAR; PG8_SCHED;
            PG8_LDB(B0, 1, 0); PG8_LDB(B1, 1, 1); PG8_SCHED; PG8_LDA(At, 1, 0); PG8_STAGE_A(PG8_SA(0, 1), uA1, k2);
            PG8_WAIT_V(8); PG8_WAIT_L(0); PG8_BAR; PG8_MMA(0, 0, At, B0); PG8_MMA(0, 1, At, B1); PG8_BAR; PG8_SCHED;
            PG8_LDA(At, 1, 1); PG8_STAGE_B(PG8_SB(1, 0), b3); PG8_STAGE_B(PG8_SB(1, 1), b3 + hstep); PG8_STAGE_A(PG8_SA(1, 0), uA0, k3);
            PG8_WAIT_V(8); PG8_WAIT_L(0); PG8_BAR; PG8_MMA(1, 0, At, B0); PG8_MMA(1, 1, At, B1); PG8_BAR; PG8_SCHED;
        }
        if constexpr (Sched::FP8) asm volatile("s_nop 15\n\ts_nop 15" ::: "memory");
        if (wr == 0) PG8_BAR;
        E(acc, cur, wr, wc, fr, fq);
        if (!has_next) break;
#pragma unroll
        for (int a = 0; a < 2; ++a)
#pragma unroll
            for (int b = 0; b < 2; ++b)
#pragma unroll
                for (int m = 0; m < 4; ++m)
#pragma unroll
                    for (int n = 0; n < 2; ++n) acc[a][b][m][n] = (f32x4){0.f, 0.f, 0.f, 0.f};
        cur = nxt; cB = nB; ++ui;
#pragma unroll
        for (int i = 0; i < 2; ++i) { vA0[i] = nA0[i]; vA1[i] = nA1[i]; }
        if (wr == 1) PG8_BAR;
    }
    PG8_WAIT_V(0);
    PG8_BAR;
#undef PG8_SA
#undef PG8_SB
#undef PG8_STAGE_A
#undef PG8_STAGE_B
#undef PG8_LDA
#undef PG8_LDB
#undef PG8_MMA
#undef PG8_WAIT_V
#undef PG8_WAIT_L
#undef PG8_BAR
#undef PG8_SCHED
}
__device__ __forceinline__ bool tile_order(int i, int G, int c, int nM, int nN, int& pm, int& pn) {
    const int nwg = nM * nN; const long L = (long)i * G + c; if (L >= nwg) return false;
    int wgid = (int)L; { const int q = nwg / 8, r = nwg % 8, xcd = wgid % 8, off = wgid / 8; wgid = (xcd < r ? xcd * (q + 1) : r * (q + 1) + (xcd - r) * q) + off; }
    const int WGM = 8, nig = WGM * nN, gid = wgid / nig, fm = gid * WGM, gsz = (nM - fm) < WGM ? (nM - fm) : WGM;
    pm = fm + ((wgid % nig) % gsz); pn = (wgid % nig) / gsz; return true;
}
template <bool F8 = false> struct DenseSchedT {
    static constexpr bool FP8 = F8; static constexpr int SCALE_A = 0x7F7F7F7F, SCALE_B = F8 ? 0x79797979 : 0x7F7F7F7F;
    const char* A; const char* Bt; int KB, nM, nN, G, c;
    __device__ __forceinline__ bool next(int i, Unit& u) const { u.l = 0; u.i0 = 0; u.cn = 0; return tile_order(i, G, c, nM, nN, u.pm, u.pn); }
    __device__ __forceinline__ const char* a_base() const { return A; }
    __device__ __forceinline__ unsigned a_voff(const Unit& u, int h, int R, int C) const { return (unsigned)((u.pm * 256 + h * 128 + R) * KB + C * 2); }
    __device__ __forceinline__ const char* b_base(const Unit& u) const { return Bt + (size_t)u.pn * 256 * KB; }
};
typedef DenseSchedT<false> DenseSched;
template <int MODE> struct MoeSched {
    static constexpr bool FP8 = true; static constexpr int SCALE_A = (MODE == 0) ? 0x7F7F7F7F : 0x7D7D7D7D, SCALE_B = 0x79797979;
    const char* A; const char* Bt; const int* list; const LAS int* PB; const LAS int* CN; const LAS int* RBL; int KB, rb0, nunits, vcu, G;
    __device__ __forceinline__ bool next(int i, Unit& u) const {
        const int idx = vcu + i * G; if (idx >= nunits) return false;
        const int rb = rb0 + (idx >> 2); const int l = RBL[rb];
        u.pm = rb; u.pn = idx & 3; u.l = l; u.i0 = (rb - PB[l]) * 256; u.cn = CN[l]; return true; }
    __device__ __forceinline__ const char* a_base() const { return A; }
    __device__ __forceinline__ unsigned a_voff(const Unit& u, int h, int R, int C) const {
        if (MODE == 0) { int idx = u.i0 + h * 128 + R; idx = idx < u.cn ? idx : u.cn - 1; const int tok = list[(size_t)u.l * T + idx]; return (unsigned)(tok * KB + C * 2); }
        return (unsigned)((u.pm * 256 + h * 128 + R) * KB + C * 2); }
    __device__ __forceinline__ const char* b_base(const Unit& u) const { return Bt + ((size_t)(u.l & 31) * 1024 + u.pn * 256) * KB; }
};
}

struct EpiProj { static constexpr bool PERM = true, MID = false; bf16* proj; int coff;
    __device__ __forceinline__ void operator()(const f32x4 (&acc)[2][2][4][2], const pg8::Unit& u, int wr, int wc, int fr, int fq) const {
        const int fro = opaque(fr), fqo = opaque(fq);
#pragma unroll
        for (int ai = 0; ai < 2; ++ai)
#pragma unroll
            for (int m = 0; m < 4; ++m) { bf16* rowp = proj + (size_t)(u.pm * 256 + ai * 128 + wr * 64 + m * 16 + fro) * NPROJ + coff + u.pn * 256 + wc * 32 + 8 * fqo;
#pragma unroll
                for (int bj = 0; bj < 2; ++bj) { const f32x4 v0 = acc[ai][bj][m][0], v1 = acc[ai][bj][m][1];
                    u32x4 w; w.x = pk2(v0[0], v0[1]); w.y = pk2(v0[2], v0[3]); w.z = pk2(v1[0], v1[1]); w.w = pk2(v1[2], v1[3]); *(u32x4*)(rowp + bj * 128) = w; } }
    } };
struct EpiZ8 { static constexpr bool PERM = true, MID = false; unsigned char* projb;
    __device__ __forceinline__ void operator()(const f32x4 (&acc)[2][2][4][2], const pg8::Unit& u, int wr, int wc, int fr, int fq) const {
        const int fro = opaque(fr), fqo = opaque(fq);
#pragma unroll
        for (int ai = 0; ai < 2; ++ai)
#pragma unroll
            for (int m = 0; m < 4; ++m) { unsigned char* rowp = projb + ((size_t)(u.pm * 256 + ai * 128 + wr * 64 + m * 16 + fro) * NPROJ + C_ZA) * 2 + u.pn * 256 + wc * 32 + 8 * fqo;
#pragma unroll
                for (int bj = 0; bj < 2; ++bj) { const f32x4 v0 = acc[ai][bj][m][0], v1 = acc[ai][bj][m][1];
                    u32x2 w; int o8 = __builtin_amdgcn_cvt_pk_fp8_f32(v0[0], v0[1], 0, false); w.x = (unsigned)__builtin_amdgcn_cvt_pk_fp8_f32(v0[2], v0[3], o8, true);
                    o8 = __builtin_amdgcn_cvt_pk_fp8_f32(v1[0], v1[1], 0, false); w.y = (unsigned)__builtin_amdgcn_cvt_pk_fp8_f32(v1[2], v1[3], o8, true);
                    *(u32x2*)(rowp + bj * 128) = w; } }
    } };
__device__ __forceinline__ void unpack8f(const u32x2 w, float* v) {
    const f32x2_ a = __builtin_amdgcn_cvt_pk_f32_fp8((int)w.x, false), b = __builtin_amdgcn_cvt_pk_f32_fp8((int)w.x, true), c = __builtin_amdgcn_cvt_pk_f32_fp8((int)w.y, false), d = __builtin_amdgcn_cvt_pk_f32_fp8((int)w.y, true);
    v[0] = a[0]; v[1] = a[1]; v[2] = b[0]; v[3] = b[1]; v[4] = c[0]; v[5] = c[1]; v[6] = d[0]; v[7] = d[1]; }
__device__ __forceinline__ float ratio_(float zb, float za) { return (1.f + fexp_(-zb)) * __builtin_amdgcn_rcpf(1.f + fexp_(-za)); }
struct EpiMixed { static constexpr bool PERM = true, MID = true; const unsigned char* projb; bf16* mixed;
    __device__ __forceinline__ void mid(f32x4 (&acc)[2][2][4][2], const pg8::Unit& u, int wr, int wc, int fr, int fq) const {
        const int fro = opaque(fr), fqo = opaque(fq);
#pragma unroll
        for (int ai = 0; ai < 2; ++ai) {
            u32x2 za[4][2], zb[4][2];
#pragma unroll
            for (int m = 0; m < 4; ++m) { const unsigned char* zr = projb + ((size_t)(u.pm * 256 + ai * 128 + wr * 64 + m * 16 + fro) * NPROJ + C_ZA) * 2 + u.pn * 256 + wc * 32 + 8 * fqo;
#pragma unroll
                for (int bj = 0; bj < 2; ++bj) { za[m][bj] = *(const u32x2*)(zr + bj * 128); zb[m][bj] = *(const u32x2*)(zr + 1024 + bj * 128); } }
#pragma unroll
            for (int m = 0; m < 4; ++m)
#pragma unroll
                for (int bj = 0; bj < 2; ++bj) { float a[8], b[8]; unpack8f(za[m][bj], a); unpack8f(zb[m][bj], b); f32x4 r0, r1;
                    r0[0] = ratio_(b[0], a[0]); r0[1] = ratio_(b[1], a[1]); r0[2] = ratio_(b[2], a[2]); r0[3] = ratio_(b[3], a[3]);
                    r1[0] = ratio_(b[4], a[4]); r1[1] = ratio_(b[5], a[5]); r1[2] = ratio_(b[6], a[6]); r1[3] = ratio_(b[7], a[7]);
                    acc[ai][bj][m][0] = acc[ai][bj][m][0] * r0; acc[ai][bj][m][1] = acc[ai][bj][m][1] * r1; }
            asm volatile("" ::: "memory"); }
    }
    __device__ __forceinline__ void operator()(const f32x4 (&acc)[2][2][4][2], const pg8::Unit& u, int wr, int wc, int fr, int fq) const {
        const int fro = opaque(fr), fqo = opaque(fq);
#pragma unroll
        for (int ai = 0; ai < 2; ++ai) {
            u32x2 zb[4][2];
#pragma unroll
            for (int m = 0; m < 4; ++m) { const unsigned char* zr = projb + ((size_t)(u.pm * 256 + ai * 128 + wr * 64 + m * 16 + fro) * NPROJ + C_ZA) * 2 + u.pn * 256 + wc * 32 + 8 * fqo;
#pragma unroll
                for (int bj = 0; bj < 2; ++bj) zb[m][bj] = *(const u32x2*)(zr + 1024 + bj * 128); }
#pragma unroll
            for (int m = 0; m < 4; ++m) { bf16* orow = mixed + (size_t)(u.pm * 256 + ai * 128 + wr * 64 + m * 16 + fro) * 1024 + u.pn * 256 + wc * 32 + 8 * fqo;
#pragma unroll
                for (int bj = 0; bj < 2; ++bj) { float b[8]; unpack8f(zb[m][bj], b); const f32x4 v0 = acc[ai][bj][m][0], v1 = acc[ai][bj][m][1];
                    u32x4 w; w.x = pk2(v0[0] * sigmoidf_(b[0]), v0[1] * sigmoidf_(b[1])); w.y = pk2(v0[2] * sigmoidf_(b[2]), v0[3] * sigmoidf_(b[3]));
                    w.z = pk2(v1[0] * sigmoidf_(b[4]), v1[1] * sigmoidf_(b[5])); w.w = pk2(v1[2] * sigmoidf_(b[6]), v1[3] * sigmoidf_(b[7]));
                    *(u32x4*)(orow + bj * 128) = w; } }
            asm volatile("" ::: "memory"); }
    } };
struct EpiX1 { static constexpr bool PERM = true, MID = false; const float* x; const float* w2; float* out; unsigned char* hn; float* ssq;
    __device__ __forceinline__ void operator()(const f32x4 (&acc)[2][2][4][2], const pg8::Unit& u, int wr, int wc, int fr, int fq) const {
        const int fro = opaque(fr), fqo = opaque(fq);
        f32x4 wv[2][2];
#pragma unroll
        for (int bj = 0; bj < 2; ++bj)
#pragma unroll
            for (int n = 0; n < 2; ++n) wv[bj][n] = *(const f32x4*)(w2 + u.pn * 256 + bj * 128 + wc * 32 + 8 * fqo + 4 * n);
#pragma unroll
        for (int ai = 0; ai < 2; ++ai)
#pragma unroll
            for (int mh = 0; mh < 2; ++mh) {
                f32x4 xv[2][2][2];
#pragma unroll
                for (int mm = 0; mm < 2; ++mm) { const size_t row = (size_t)(u.pm * 256 + ai * 128 + wr * 64 + (mh * 2 + mm) * 16 + fro);
#pragma unroll
                    for (int bj = 0; bj < 2; ++bj)
#pragma unroll
                        for (int n = 0; n < 2; ++n) xv[mm][bj][n] = *(const f32x4*)(x + row * 1024 + u.pn * 256 + bj * 128 + wc * 32 + 8 * fqo + 4 * n); }
#pragma unroll
                for (int mm = 0; mm < 2; ++mm) { const int m = mh * 2 + mm; const size_t row = (size_t)(u.pm * 256 + ai * 128 + wr * 64 + m * 16 + fro); float s = 0.f;
#pragma unroll
                    for (int bj = 0; bj < 2; ++bj)
                        { u32x2 h8;
#pragma unroll
                          for (int n = 0; n < 2; ++n) { const int col = u.pn * 256 + bj * 128 + wc * 32 + 8 * fqo + 4 * n;
                            const f32x4 v = acc[ai][bj][m][n] + xv[mm][bj][n]; const f32x4 w = wv[bj][n];
                            *(f32x4*)(out + row * 1024 + col) = v;
                            s += (v[0] * v[0] + v[1] * v[1]) + (v[2] * v[2] + v[3] * v[3]);
                            int o8 = __builtin_amdgcn_cvt_pk_fp8_f32(v[0] * w[0], v[1] * w[1], 0, false); o8 = __builtin_amdgcn_cvt_pk_fp8_f32(v[2] * w[2], v[3] * w[3], o8, true); if (n == 0) h8.x = (unsigned)o8; else h8.y = (unsigned)o8; }
                          *(u32x2*)(hn + row * 1024 + u.pn * 256 + bj * 128 + wc * 32 + 8 * fqo) = h8; }
                    s += __shfl_xor(s, 16); s += __shfl_xor(s, 32);
                    if (fq == 0) ssq[row * 16 + u.pn * 4 + wc] = s; }
                asm volatile("" ::: "memory"); }
    } };
struct EpiGateUp { static constexpr bool PERM = true, MID = false; const int* list; const float* rstdv; unsigned char* hb;
    __device__ __forceinline__ void operator()(const f32x4 (&acc)[2][2][4][2], const pg8::Unit& u, int wr, int wc, int fr, int fq) const {
        const int fro = opaque(fr), fqo = opaque(fq);
#pragma unroll
        for (int ai = 0; ai < 2; ++ai) {
            float rsv[4];
#pragma unroll
            for (int m = 0; m < 4; ++m) { int idx = u.i0 + ai * 128 + wr * 64 + m * 16 + fro; idx = idx < u.cn ? idx : u.cn - 1; rsv[m] = rstdv[list[(size_t)u.l * T + idx]]; }
#pragma unroll
            for (int m = 0; m < 4; ++m) { const int r = ai * 128 + wr * 64 + m * 16 + fro; const float rs = rsv[m];
                u32x2 w; const float rs4 = rs * 4.f;
                { const f32x4 g = acc[ai][0][m][0] * rs, uu = acc[ai][1][m][0] * rs4;
                  int o8 = __builtin_amdgcn_cvt_pk_fp8_f32(g[0] * sigmoidf_(g[0]) * uu[0], g[1] * sigmoidf_(g[1]) * uu[1], 0, false);
                  w.x = (unsigned)__builtin_amdgcn_cvt_pk_fp8_f32(g[2] * sigmoidf_(g[2]) * uu[2], g[3] * sigmoidf_(g[3]) * uu[3], o8, true); }
                { const f32x4 g = acc[ai][0][m][1] * rs, uu = acc[ai][1][m][1] * rs4;
                  int o8 = __builtin_amdgcn_cvt_pk_fp8_f32(g[0] * sigmoidf_(g[0]) * uu[0], g[1] * sigmoidf_(g[1]) * uu[1], 0, false);
                  w.y = (unsigned)__builtin_amdgcn_cvt_pk_fp8_f32(g[2] * sigmoidf_(g[2]) * uu[2], g[3] * sigmoidf_(g[3]) * uu[3], o8, true); }
                *(u32x2*)(hb + ((size_t)u.pm * 256 + r) * 512 + u.pn * 128 + wc * 32 + 8 * fqo) = w; }
            asm volatile("" ::: "memory"); }
    } };
struct EpiDownY { static constexpr bool PERM = true, MID = false; const int* list; const float* gw; bf16* Y;
    __device__ __forceinline__ void operator()(const f32x4 (&acc)[2][2][4][2], const pg8::Unit& u, int wr, int wc, int fr, int fq) const {
        const int fro = opaque(fr), fqo = opaque(fq);
        int tk[8]; float gv[8];
#pragma unroll
        for (int q = 0; q < 8; ++q) { const int idx = u.i0 + (q >> 2) * 128 + wr * 64 + (q & 3) * 16 + fro; tk[q] = idx < u.cn ? list[(size_t)u.l * T + idx] : -1; }
#pragma unroll
        for (int q = 0; q < 8; ++q) gv[q] = tk[q] >= 0 ? gw[tk[q] * 2 + 1] : 0.f;
#pragma unroll
        for (int ai = 0; ai < 2; ++ai)
#pragma unroll
            for (int m = 0; m < 4; ++m) { const int tok = tk[ai * 4 + m]; const float g = gv[ai * 4 + m];
                if (tok >= 0) {
#pragma unroll
                    for (int bj = 0; bj < 2; ++bj) { const f32x4 v0 = acc[ai][bj][m][0] * g, v1 = acc[ai][bj][m][1] * g;
                        u32x4 w; w.x = pk2(v0[0], v0[1]); w.y = pk2(v0[2], v0[3]); w.z = pk2(v1[0], v1[1]); w.w = pk2(v1[2], v1[3]);
                        *(u32x4*)(Y + (size_t)tok * 1024 + u.pn * 256 + bj * 128 + wc * 32 + 8 * fqo) = w; } } }
    } };
#ifndef EPIDOWN_BATCH
#define EPIDOWN_BATCH 2
#endif
struct EpiDown { static constexpr bool PERM = true, MID = false; const int* list; const float* gw; float* out; const bf16* Y; const float* tp;
    __device__ __forceinline__ void operator()(const f32x4 (&acc)[2][2][4][2], const pg8::Unit& u, int wr, int wc, int fr, int fq) const {
        const int fro = opaque(fr), fqo = opaque(fq);
        int tk[8]; float gv[8];
#pragma unroll
        for (int q = 0; q < 8; ++q) { const int idx = u.i0 + (q >> 2) * 128 + wr * 64 + (q & 3) * 16 + fro; tk[q] = idx < u.cn ? list[(size_t)u.l * T + idx] : -1; }
#pragma unroll
        for (int q = 0; q < 8; ++q) gv[q] = tk[q] >= 0 ? gw[tk[q] * 2] : 0.f;
#pragma unroll
        for (int ai = 0; ai < 2; ++ai)
#pragma unroll
            for (int mh = 0; mh < 4 / EPIDOWN_BATCH; ++mh) {
                f32x4 ov[EPIDOWN_BATCH][2][2]; u32x2 yv[EPIDOWN_BATCH][2][2];
#pragma unroll
                for (int mm = 0; mm < EPIDOWN_BATCH; ++mm) { const int tok = tk[ai * 4 + mh * EPIDOWN_BATCH + mm]; const size_t base = (size_t)(tok >= 0 ? tok : 0) * 1024 + u.pn * 256 + wc * 32 + 8 * fqo;
#pragma unroll
                    for (int bj = 0; bj < 2; ++bj)
#pragma unroll
                        for (int n = 0; n < 2; ++n) { ov[mm][bj][n] = *(const f32x4*)(out + base + bj * 128 + n * 4); yv[mm][bj][n] = *(const u32x2*)(Y + base + bj * 128 + n * 4); } }
#pragma unroll
                for (int mm = 0; mm < EPIDOWN_BATCH; ++mm) { const int m = mh * EPIDOWN_BATCH + mm; const int tok = tk[ai * 4 + m]; const float g = gv[ai * 4 + m];
                    if (tok >= 0) { const size_t base = (size_t)tok * 1024 + u.pn * 256 + wc * 32 + 8 * fqo;
#pragma unroll
                        for (int bj = 0; bj < 2; ++bj)
#pragma unroll
                            for (int n = 0; n < 2; ++n) { const u32x2 y = yv[mm][bj][n]; f32x4 o = ov[mm][bj][n] + acc[ai][bj][m][n] * g;
                                o[0] += bflo(y.x); o[1] += bfhi(y.x); o[2] += bflo(y.y); o[3] += bfhi(y.y);
#ifdef TPA
                                { const float db = sqrtf(tp[1] * 2e-6f); o = o + (((tok + n) & 1) ? db : -db); if (tok == 0 && u.pn == 0 && bj == 0 && n == 0 && wc == 0 && fqo == 0) o[0] += tp[0] * TPAS; }
#endif
                                *(f32x4*)(out + base + bj * 128 + n * 4) = o; } } }
                asm volatile("" ::: "memory"); }
    } };

struct TItem { const float* W; bf16* WT; int N, ldwt, k0, n0, drow0, f8; };
__device__ __forceinline__ void titem_load(const TItem& t, int lane, float (&tv)[32]);
__device__ __forceinline__ void titem_store(const TItem& t, int lane, const float (&tv)[32], LAS float* scr);
__device__ __forceinline__ void transpose_item(const float* W, int N, bf16* WT, int ldwt, int kd0, int k0, int n0, int drow0, LAS float* scr, int lane) {
    TItem t; t.W = W; t.WT = WT + kd0; t.N = N; t.ldwt = ldwt; t.k0 = k0; t.n0 = n0; t.drow0 = drow0; t.f8 = 0;
    float tv[32]; titem_load(t, lane, tv); titem_store(t, lane, tv, scr);
}

constexpr int EI_G = 16 * 16, EI_D = 8 * 32, EI_PER = 2 * EI_G + EI_D, EI_TOTAL = NEXP * EI_PER;
__device__ __forceinline__ TItem expert_item(const Params& P, LAS unsigned char* lds, int it) {
    TItem t; const int e = it / EI_PER; int r = it - e * EI_PER;
    if (r < EI_G) { const int kb = r / 16, nb = r % 16; t.n0 = 32 * nb; t.W = PP(w_gate) + (size_t)e * 1024 * 512; t.N = 512; t.WT = (bf16*)(P.ws + WS_WGU + (size_t)e * 1024 * 1024); t.ldwt = 1024; t.k0 = 64 * kb; t.drow0 = (t.n0 >> 7) * 256 + (t.n0 & 127); t.f8 = 1; return t; }
    r -= EI_G;
    if (r < EI_G) { const int kb = r / 16, nb = r % 16; t.n0 = 32 * nb; t.W = PP(w_up) + (size_t)e * 1024 * 512; t.N = 512; t.WT = (bf16*)(P.ws + WS_WGU + (size_t)e * 1024 * 1024); t.ldwt = 1024; t.k0 = 64 * kb; t.drow0 = (t.n0 >> 7) * 256 + 128 + (t.n0 & 127); t.f8 = 1; return t; }
    r -= EI_G;
    { const int kb = r / 32, nb = r % 32; t.n0 = 32 * nb; t.W = PP(w_down) + (size_t)e * 512 * 1024; t.N = 1024; t.WT = (bf16*)(P.ws + WS_WD + (size_t)e * 1024 * 512); t.ldwt = 512; t.k0 = 64 * kb; t.drow0 = 32 * nb; t.f8 = 1; return t; }
}
__device__ __forceinline__ void titem_load(const TItem& t, int lane, float (&tv)[32]) {
#pragma unroll
    for (int j = 0; j < 8; ++j) { const f32x4 v = *(const f32x4*)(t.W + (size_t)(t.k0 + 8 * j + (lane >> 3)) * t.N + t.n0 + 4 * (lane & 7));
        tv[4 * j] = v[0]; tv[4 * j + 1] = v[1]; tv[4 * j + 2] = v[2]; tv[4 * j + 3] = v[3]; }
}
__device__ __forceinline__ void titem_store(const TItem& t, int lane, const float (&tv)[32], LAS float* scr) {
#pragma unroll
    for (int j = 0; j < 8; ++j)
#pragma unroll
        for (int q = 0; q < 4; ++q) scr[(8 * j + (lane >> 3)) * 33 + 4 * (lane & 7) + q] = tv[4 * j + q];
    asm volatile("s_waitcnt lgkmcnt(0)" ::: "memory");
    if (t.f8) {
        const int n = lane >> 1, hf = lane & 1; const LAS float* sp = scr + (32 * hf) * 33 + n; int w8[8];
#pragma unroll
        for (int q = 0; q < 8; ++q) { int o8 = __builtin_amdgcn_cvt_pk_fp8_f32(sp[(4 * q) * 33] * 64.f, sp[(4 * q + 1) * 33] * 64.f, 0, false);
            w8[q] = __builtin_amdgcn_cvt_pk_fp8_f32(sp[(4 * q + 2) * 33] * 64.f, sp[(4 * q + 3) * 33] * 64.f, o8, true); }
        unsigned char* dst = (unsigned char*)t.WT + (size_t)(t.drow0 + n) * t.ldwt + t.k0 + 32 * hf;
        *(u32x4*)dst = (u32x4){(unsigned)w8[0], (unsigned)w8[1], (unsigned)w8[2], (unsigned)w8[3]}; *(u32x4*)(dst + 16) = (u32x4){(unsigned)w8[4], (unsigned)w8[5], (unsigned)w8[6], (unsigned)w8[7]};
    } else {
        const int c = lane & 7;
#pragma unroll
        for (int j = 0; j < 4; ++j) { const int n = (lane >> 3) + 8 * j; const LAS float* sp = scr + (8 * c) * 33 + n;
            u32x4 o; o.x = pk2(sp[0 * 33], sp[1 * 33]); o.y = pk2(sp[2 * 33], sp[3 * 33]); o.z = pk2(sp[4 * 33], sp[5 * 33]); o.w = pk2(sp[6 * 33], sp[7 * 33]);
            *(u32x4*)(t.WT + (size_t)(t.drow0 + n) * t.ldwt + t.k0 + 8 * c) = o; } }
    asm volatile("s_waitcnt lgkmcnt(0)" ::: "memory");
}

__device__ __forceinline__ void phase0(const Params& P, LAS unsigned char* lds, int vcu, int G, int tid, int wid, int lane) {
    unsigned char* ws = P.ws;
    LAS float* scr = (LAS float*)(lds + wid * 16384);
    const int gw = vcu * 8 + wid, NGW = G * 8;
    constexpr int I_IN = 16 * 152, I_BR = 8 * 32, I_OUT = 16 * 32;
    constexpr int NITEMS = I_IN + 2 * I_BR + I_OUT;
    for (int it = gw; it < NITEMS; it += NGW) {
        int r = it;
        if (r < I_IN) { const int kb = r / 152, nb = r % 152;
            if (32 * nb < C_ZA) transpose_item(PP(w_in), NPROJ, (bf16*)(ws + WS_WINT), 1024, 0, 64 * kb, 32 * nb, 32 * nb, scr, lane);
            else { TItem t; t.W = PP(w_in); t.WT = (bf16*)(ws + WS_WZ8); t.N = NPROJ; t.ldwt = 1024; t.k0 = 64 * kb; t.n0 = 32 * nb; t.drow0 = 32 * nb - C_ZA; t.f8 = 1; float tv[32]; titem_load(t, lane, tv); titem_store(t, lane, tv, scr); }
            continue; } r -= I_IN;
        if (r < I_BR) { const int kb = r / 32, nb = r % 32; transpose_item(PP(w_ba), 1024, (bf16*)(ws + WS_WAT), 1024, 0, 64 * kb, 32 * nb, 32 * nb, scr, lane); continue; } r -= I_BR;
        if (r < I_BR) { const int kb = r / 32, nb = r % 32; transpose_item(PP(w_bh), 1024, (bf16*)(ws + WS_WAT), 1024, 512, 64 * kb, 32 * nb, 32 * nb, scr, lane); continue; } r -= I_BR;
        { const int kb = r / 32, nb = r % 32; transpose_item(PP(w_out), 1024, (bf16*)(ws + WS_WOT), 1024, 0, 64 * kb, 32 * nb, 32 * nb, scr, lane); }
    }
    { bf16* Wh = (bf16*)(ws + WS_WR); bf16* Wl = Wh + 48 * 1024;
      for (int idx = (vcu * NTHREADS + tid); idx < 48 * 1024; idx += G * NTHREADS) { const int j = idx >> 10, k = idx & 1023; float v = 0.f;
          if (j < 4) v = PP(w_rg)[k * 4 + j] * PP(norm2_w)[k]; else if (j < 36) v = PP(w_re)[k * 32 + (j - 4)] * PP(norm2_w)[k];
          const unsigned hi = f2bf(v); Wh[idx] = (bf16)hi; Wl[idx] = (bf16)f2bf(v - bf2f(hi)); } }
    { float* cs = (float*)(ws + WS_CS);
      const float invf[8] = {1.0f, 0.1939227432012558f, 0.03760603070259094f, 0.007292664609849453f, 0.0014142135623842478f, 0.00027424818836152554f, 5.318296098266728e-05f, 1.0313386155758053e-05f};
      for (int idx = (vcu * NTHREADS + tid); idx < T * 8; idx += G * NTHREADS) { const int tok = idx >> 3, i = idx & 7; float f = invf[0];
#pragma unroll
          for (int q = 1; q < 8; ++q) f = (i == q) ? invf[q] : f;
          float sn, c_; sincosf((float)PP(positions)[tok] * f, &sn, &c_); cs[tok * 16 + i] = c_; cs[tok * 16 + 8 + i] = sn; } }
    { bf16* xn = (bf16*)P.out;
      f32x4 wv[4];
#pragma unroll
      for (int j = 0; j < 4; ++j) wv[j] = *(const f32x4*)(PP(norm1_w) + 4 * lane + 256 * j);
      for (int m = gw; m < T; m += NGW) {
          const f32x4* xr = (const f32x4*)(P.x + (size_t)m * D) + lane; f32x4 v[4]; float s = 0.f;
#pragma unroll
          for (int j = 0; j < 4; ++j) { v[j] = xr[64 * j]; s += (v[j].x * v[j].x + v[j].y * v[j].y) + (v[j].z * v[j].z + v[j].w * v[j].w); }
          const float rstd = 1.f / sqrtf(wave_sum(s) * (1.f / D) + EPS);
          u32x2* o8 = (u32x2*)(xn + (size_t)m * D) + lane; int* q8 = (int*)((unsigned char*)P.out + OUT_XN8 + (size_t)m * D) + lane;
#pragma unroll
          for (int j = 0; j < 4; ++j) { const float a0 = v[j].x * rstd * wv[j].x, a1 = v[j].y * rstd * wv[j].y, a2 = v[j].z * rstd * wv[j].z, a3 = v[j].w * rstd * wv[j].w;
              u32x2 o; o.x = pk2(a0, a1); o.y = pk2(a2, a3); o8[64 * j] = o;
              int w8 = __builtin_amdgcn_cvt_pk_fp8_f32(a0, a1, 0, false); w8 = __builtin_amdgcn_cvt_pk_fp8_f32(a2, a3, w8, true); q8[64 * j] = w8; }
      } }
}

__device__ __forceinline__ void phase1(const Params& P, LAS unsigned char* lds, int G) {
    {
        const pg8::DenseSched S{(const char*)P.out, (const char*)(P.ws + WS_WINT), 2048, T / 256, C_ZA / 256, G, (int)blockIdx.x};
        const EpiProj E{(bf16*)(P.ws + WS_PROJ), 0};
        pg8::gemm_phase(lds, S, E); }
    {
        const pg8::DenseSchedT<true> S{(const char*)P.out + OUT_XN8, (const char*)(P.ws + WS_WZ8), 1024, T / 256, (NPROJ - C_ZA) / 256, G, (int)blockIdx.x};
        const EpiZ8 E{(unsigned char*)(P.ws + WS_PROJ)};
        pg8::gemm_phase(lds, S, E); }
}
__device__ __forceinline__ void phase5(const Params& P, LAS unsigned char* lds, int G) {
    const pg8::DenseSched S{(const char*)P.out + OUT_AH, (const char*)(P.ws + WS_WAT), 2048, T / 256, 4, G, (int)blockIdx.x};
    const EpiMixed E{(const unsigned char*)(P.ws + WS_PROJ), (bf16*)(P.ws + WS_MIXED)};
    pg8::gemm_phase(lds, S, E);
}
__device__ __forceinline__ void phase6(const Params& P, LAS unsigned char* lds, int G) {
    const pg8::DenseSched S{(const char*)(P.ws + WS_MIXED), (const char*)(P.ws + WS_WOT), 2048, T / 256, 4, G, (int)blockIdx.x};
    const EpiX1 E{P.x, PP(norm2_w), P.out, (unsigned char*)(P.ws + WS_HN), (float*)(P.ws + WS_SSQ)};
    pg8::gemm_phase(lds, S, E);
}

constexpr int H_TOT = 0, H_DV = 2048, H_SSQ = 2560, H_QT = 4608, H_KH = H_QT + 17408, H_KTT = H_KH + 17408, H_VT = H_KTT + 18432, H_ST = H_VT + 18432, H_AM = H_ST + 34816, H_END = H_AM + 9216;
static_assert(H_END <= LDS_ST_OFF, "hgrn LDS");
__device__ __forceinline__ bf16x8 ldfrag(const LAS unsigned char* base, int row, int stride, int kbyte) { return *(const LAS bf16x8*)(base + row * stride + kbyte); }

template <int MODE>
__device__ __forceinline__ void hgrn_unit(const Params& P, LAS unsigned char* lds, int unit, int tid, int wid, int lane, int cit = EI_TOTAL, int cstride = 1) {
    LAS float* cscr = (LAS float*)(lds + (wid < 4 ? H_QT + wid * 8448 : H_ST + (wid - 4) * 8448));
    const int b = unit >> 6, h = (unit >> 4) & 3, sc = unit & 15;
    const int fr = opaque(lane & 15), fq = opaque(lane >> 4), c = opaque(tid & 127), qd = tid >> 7;
    const bf16* proj = (const bf16*)(P.ws + WS_PROJ);
    LAS float* TOT = (LAS float*)(lds + H_TOT); LAS float* DV = (LAS float*)(lds + H_DV); LAS float* SSQ = (LAS float*)(lds + H_SSQ);
    LAS bf16* Qt = (LAS bf16*)(lds + H_QT); LAS bf16* Kh = (LAS bf16*)(lds + H_KH); LAS bf16* KtT = (LAS bf16*)(lds + H_KTT); LAS bf16* VT = (LAS bf16*)(lds + H_VT);
    const float lbv = 1.f / (1.f + __expf(PP(hlb)[512 + h * 128 + c] - PP(hlb)[h * 128 + c]));
    float* Ug = (float*)((unsigned char*)P.out + OUT_U) + (size_t)unit * 16384;
    const float* Sin = (const float*)((unsigned char*)P.out + OUT_SIN) + (size_t)unit * 16384;
    f32x4 accS[8];
#pragma unroll
    for (int di = 0; di < 8; ++di) {
        if (MODE == 1 && sc > 0) {
#pragma unroll
            for (int r = 0; r < 4; ++r) accS[di][r] = Sin[(16 * di + 4 * fq + r) * 128 + 16 * wid + fr];
        } else accS[di] = (f32x4){0.f, 0.f, 0.f, 0.f};
        if (MODE == 1) { u32x2 o; o.x = pk2(accS[di][0], accS[di][1]); o.y = pk2(accS[di][2], accS[di][3]);
            *(LAS u32x2*)(lds + H_ST + (16 * wid + fr) * 272 + (16 * di + 4 * fq) * 2) = o; }
    }
    float dsum = 0.f;
    unsigned short rf[16], rq[16], rv[16];
#define HG_LOAD(ccx) do { const size_t t0x_ = (size_t)b * SEQ + sc * 512 + (ccx) * 64; const bf16* pb_ = proj + (t0x_ + qd * 16) * NPROJ + h * 128 + c; \
        _Pragma("unroll") for (int i = 0; i < 16; ++i) { rf[i] = pb_[(size_t)i * NPROJ + C_FH]; rv[i] = pb_[(size_t)i * NPROJ + C_IH]; if (MODE == 1) rq[i] = pb_[(size_t)i * NPROJ + C_QH]; } \
        } while (0)
    HG_LOAD(0);
#pragma unroll 1
    for (int cc = 0; cc < 8; ++cc) {
        const size_t t0 = (size_t)b * SEQ + sc * 512 + cc * 64;
        float tva[32], tvb[32]; TItem ia, ib; const int ita = cit, itb = cit + cstride;
        if (MODE == 0) { if (ita < EI_TOTAL) { ia = expert_item(P, lds, ita); titem_load(ia, lane, tva); } if (itb < EI_TOTAL) { ib = expert_item(P, lds, itb); titem_load(ib, lane, tvb); } }
        float bpart[16], kk[16]; float run = 0.f;
#pragma unroll
        for (int i = 0; i < 16; ++i) { const float f = bf2f(rf[i]);
            const float kv = (1.f - lbv) * __builtin_amdgcn_rcpf(1.f + fexp_(f));
            kk[i] = kv; run += __builtin_amdgcn_logf(1.f - kv); bpart[i] = run; }
        TOT[qd * 128 + c] = run;
        __syncthreads();
        float offs = 0.f, blast = 0.f;
#pragma unroll
        for (int q = 0; q < 4; ++q) { const float tv = TOT[q * 128 + c]; blast += tv; if (q < qd) offs += tv; }
        if (qd == 0) { DV[c] = exp2_(blast); dsum += blast; }
#pragma unroll
        for (int i = 0; i < 16; ++i) { const int t = qd * 16 + i; const float bb = bpart[i] + offs;
            if (MODE == 1) { const float q = bf2f(rq[i]); const float qs = q * sigmoidf_(q);
                Qt[t * 136 + c] = (bf16)f2bf(qs * exp2_(bb)); Kh[t * 136 + c] = (bf16)f2bf(kk[i] * exp2_(fminf(-bb, 115.f))); }
            KtT[c * 72 + t] = (bf16)f2bf(kk[i] * exp2_(blast - bb));
            VT[c * 72 + t] = rv[i]; }
        u32x2 gcur[4];
        if (MODE == 1) {
#pragma unroll
            for (int mi = 0; mi < 4; ++mi) gcur[mi] = *(const u32x2*)(proj + (t0 + 16 * mi + fr) * NPROJ + C_GH + h * 128 + 16 * wid + 4 * fq); }
        if (cc + 1 < 8) HG_LOAD(cc + 1);
        __syncthreads();
        f32x4 acco[4];
        if (MODE == 1) {
#pragma unroll
            for (int e2 = 0; e2 < 2; ++e2) { const int idx = 2 * wid + e2, mi = idx >> 2, ni = idx & 3; f32x4 a = (f32x4){0.f, 0.f, 0.f, 0.f};
                if (ni <= mi) {
#pragma unroll
                    for (int ks = 0; ks < 4; ++ks) { const bf16x8 kf = ldfrag(lds + H_KH, 16 * ni + fr, 272, (ks * 32 + fq * 8) * 2), qf = ldfrag(lds + H_QT, 16 * mi + fr, 272, (ks * 32 + fq * 8) * 2);
                        a = __builtin_amdgcn_mfma_f32_16x16x32_bf16(kf, qf, a, 0, 0, 0); } }
                const int t = 16 * mi + fr, s0 = 16 * ni + 4 * fq;
#pragma unroll
                for (int r = 0; r < 4; ++r) if (s0 + r > t || ni > mi) a[r] = 0.f;
                u32x2 o; o.x = pk2(a[0], a[1]); o.y = pk2(a[2], a[3]); *(LAS u32x2*)(lds + H_AM + t * 144 + s0 * 2) = o; }
#pragma unroll
            for (int mi = 0; mi < 4; ++mi) { acco[mi] = (f32x4){0.f, 0.f, 0.f, 0.f};
#pragma unroll
                for (int ks = 0; ks < 4; ++ks) { const bf16x8 sf = ldfrag(lds + H_ST, 16 * wid + fr, 272, (ks * 32 + fq * 8) * 2), qf = ldfrag(lds + H_QT, 16 * mi + fr, 272, (ks * 32 + fq * 8) * 2);
                    acco[mi] = __builtin_amdgcn_mfma_f32_16x16x32_bf16(sf, qf, acco[mi], 0, 0, 0); } }
        }
#pragma unroll
        for (int di = 0; di < 8; ++di) { const f32x4 dv4 = *(const LAS f32x4*)(lds + H_DV + (16 * di + 4 * fq) * 4); accS[di] = accS[di] * dv4;
#pragma unroll
            for (int ks = 0; ks < 2; ++ks) { const bf16x8 kf = ldfrag(lds + H_KTT, 16 * di + fr, 144, (ks * 32 + fq * 8) * 2), vf = ldfrag(lds + H_VT, 16 * wid + fr, 144, (ks * 32 + fq * 8) * 2);
                accS[di] = __builtin_amdgcn_mfma_f32_16x16x32_bf16(kf, vf, accS[di], 0, 0, 0); }
            if (MODE == 1) { u32x2 o; o.x = pk2(accS[di][0], accS[di][1]); o.y = pk2(accS[di][2], accS[di][3]);
                *(LAS u32x2*)(lds + H_ST + (16 * wid + fr) * 272 + (16 * di + 4 * fq) * 2) = o; } }
        if (MODE == 0) { if (ita < EI_TOTAL) titem_store(ia, lane, tva, cscr); if (itb < EI_TOTAL) titem_store(ib, lane, tvb, cscr); cit += 2 * cstride; }
        if (MODE == 1) {
            __syncthreads();
#pragma unroll
            for (int mi = 0; mi < 4; ++mi) {
#pragma unroll
                for (int ks = 0; ks < 2; ++ks) { const bf16x8 vf = ldfrag(lds + H_VT, 16 * wid + fr, 144, (ks * 32 + fq * 8) * 2), af = ldfrag(lds + H_AM, 16 * mi + fr, 144, (ks * 32 + fq * 8) * 2);
                    acco[mi] = __builtin_amdgcn_mfma_f32_16x16x32_bf16(vf, af, acco[mi], 0, 0, 0); }
                float s = (acco[mi][0] * acco[mi][0] + acco[mi][1] * acco[mi][1]) + (acco[mi][2] * acco[mi][2] + acco[mi][3] * acco[mi][3]);
                s += __shfl_xor(s, 16); s += __shfl_xor(s, 32);
                if (fq == 0) SSQ[wid * 64 + 16 * mi + fr] = s; }
            __syncthreads();
            bf16* hg = (bf16*)((unsigned char*)P.out + OUT_AH);
            const f32x4 nw = *(const f32x4*)(PP(hnw) + 16 * wid + 4 * fq);
#pragma unroll
            for (int mi = 0; mi < 4; ++mi) { const int t = 16 * mi + fr; float tot = 0.f;
#pragma unroll
                for (int w = 0; w < 8; ++w) tot += SSQ[w * 64 + t];
                const float rstd = __builtin_amdgcn_rsqf(tot * (1.f / 128.f) + EPS);
                const u32x2 gg = gcur[mi];
                const float g0 = bflo(gg.x), g1 = bfhi(gg.x), g2 = bflo(gg.y), g3 = bfhi(gg.y);
                u32x2 o; o.x = pk2(acco[mi][0] * rstd * nw[0] * (g0 * sigmoidf_(g0)), acco[mi][1] * rstd * nw[1] * (g1 * sigmoidf_(g1)));
                o.y = pk2(acco[mi][2] * rstd * nw[2] * (g2 * sigmoidf_(g2)), acco[mi][3] * rstd * nw[3] * (g3 * sigmoidf_(g3)));
                *(u32x2*)(hg + (t0 + t) * 1024 + 512 + h * 128 + 16 * wid + 4 * fq) = o; }
        }
    }
    if (MODE == 0) {
#pragma unroll
        for (int di = 0; di < 8; ++di)
#pragma unroll
            for (int r = 0; r < 4; ++r) Ug[(16 * di + 4 * fq + r) * 128 + 16 * wid + fr] = accS[di][r];
        if (qd == 0) ((float*)((unsigned char*)P.out + OUT_DSC))[unit * 128 + c] = exp2_(dsum);
    }
    __syncthreads();
}

__device__ __forceinline__ void hgrn_scan(const Params& P, int G, int tid) {
    const float* U = (const float*)((unsigned char*)P.out + OUT_U); float* Sin = (float*)((unsigned char*)P.out + OUT_SIN);
    const float* Dsc = (const float*)((unsigned char*)P.out + OUT_DSC);
    for (int idx = blockIdx.x * NTHREADS + tid; idx < 16 * 16384; idx += G * NTHREADS) {
        const int p = idx >> 14, e = idx & 16383, dk = e >> 7; float S = 0.f;
        float uu[15], dd[15];
#pragma unroll
        for (int sc = 0; sc < 15; ++sc) { const int u = p * 16 + sc; dd[sc] = Dsc[u * 128 + dk]; uu[sc] = U[(size_t)u * 16384 + e]; }
#pragma unroll
        for (int sc = 0; sc < 15; ++sc) { const int u = p * 16 + sc; S = dd[sc] * S + uu[sc]; Sin[(size_t)(u + 1) * 16384 + e] = S; }
    }
}

constexpr int A_KT = 0, A_VT = 36864, A_QS = 70656, A_END = A_QS + 73728;
static_assert(A_END <= LDS_ST_OFF, "attn LDS");
__device__ __forceinline__ void rope16(float (&v)[32], const float* cs) {
    const f32x4 c0 = *(const f32x4*)cs, c1 = *(const f32x4*)(cs + 4), s0 = *(const f32x4*)(cs + 8), s1 = *(const f32x4*)(cs + 12);
#pragma unroll
    for (int i = 0; i < 8; ++i) { const float cv = i < 4 ? c0[i & 3] : c1[i & 3], sv = i < 4 ? s0[i & 3] : s1[i & 3]; const float x1 = v[i], x2 = v[i + 8]; v[i] = x1 * cv - x2 * sv; v[i + 8] = x2 * cv + x1 * sv; }
}
__device__ __forceinline__ void unpack8(const u32x4 w, float* v) { v[0] = bflo(w.x); v[1] = bfhi(w.x); v[2] = bflo(w.y); v[3] = bfhi(w.y); v[4] = bflo(w.z); v[5] = bfhi(w.z); v[6] = bflo(w.w); v[7] = bfhi(w.w); }
__device__ __forceinline__ void attn_load(const Params& P, int unit, int tid, u32x4 (&kr)[4], u32x4 (&vr)[4], u32x4 (&qr)[8]) {
    const int hk = unit & 1, nb = (unit >> 1) & 63, b = unit >> 7;
    const bf16* proj = (const bf16*)(P.ws + WS_PROJ);
    const int key = tid >> 1, half = tid & 1; const int srel = nb * 128 - 128 + key; const bool ok = srel >= 0; const size_t tokk = (size_t)b * SEQ + (ok ? srel : 0);
    const int g = tid >> 7, ql = tid & 127; const size_t tokq = (size_t)b * SEQ + nb * 128 + ql;
    const u32x4* ksrc = (const u32x4*)(proj + tokk * NPROJ + C_KA + hk * 64 + half * 32);
    const u32x4* vsrc = (const u32x4*)(proj + tokk * NPROJ + C_VA + hk * 64 + half * 32);
    const u32x4* qsrc = (const u32x4*)(proj + tokq * NPROJ + C_QA + (hk * 4 + g) * 64);
#pragma unroll
    for (int j = 0; j < 4; ++j) { kr[j] = ksrc[j]; vr[j] = vsrc[j]; }
#pragma unroll
    for (int j = 0; j < 8; ++j) qr[j] = qsrc[j];
}
__device__ __forceinline__ void attn_unit(const Params& P, LAS unsigned char* lds, int unit, int next_unit, int tid, int wid, int lane, u32x4 (&kr)[4], u32x4 (&vr)[4], u32x4 (&qr)[8]) {
    const int hk = unit & 1, nb = (unit >> 1) & 63, b = unit >> 7;
    const int fr = opaque(lane & 15), fq = opaque(lane >> 4);
    const float* cstab = (const float*)(P.ws + WS_CS);
    {
        const int key = tid >> 1, half = tid & 1; const int srel = nb * 128 - 128 + key;
        const bool ok = srel >= 0; const size_t tokk = (size_t)b * SEQ + (ok ? srel : 0);
        const size_t tokq = (size_t)b * SEQ + nb * 128 + (tid & 127);
        { float v[32];
#pragma unroll
          for (int j = 0; j < 4; ++j) unpack8(kr[j], v + 8 * j);
          float s = 0.f;
#pragma unroll
          for (int j = 0; j < 32; ++j) s += v[j] * v[j];
          s += __shfl_xor(s, 1);
          const float rstd = 1.f / sqrtf(s * (1.f / 64.f) + EPS);
#pragma unroll
          for (int j = 0; j < 8; ++j) { const f32x4 w = *(const f32x4*)(PP(k_norm_w) + half * 32 + 4 * j);
              v[4 * j] *= rstd * w[0]; v[4 * j + 1] *= rstd * w[1]; v[4 * j + 2] *= rstd * w[2]; v[4 * j + 3] *= rstd * w[3]; }
          if (half == 0) rope16(v, cstab + tokk * 16);
#pragma unroll
          for (int j = 0; j < 4; ++j) { u32x4 o; o.x = pk2(v[8 * j], v[8 * j + 1]); o.y = pk2(v[8 * j + 2], v[8 * j + 3]); o.z = pk2(v[8 * j + 4], v[8 * j + 5]); o.w = pk2(v[8 * j + 6], v[8 * j + 7]);
              if (!ok) o = (u32x4){0u, 0u, 0u, 0u};
              *(LAS u32x4*)(lds + A_KT + key * 144 + half * 64 + j * 16) = o; } }
#pragma unroll
        for (int j = 0; j < 4; ++j) { u32x4 w = vr[j]; if (!ok) w = (u32x4){0u, 0u, 0u, 0u};
            LAS bf16* dst = (LAS bf16*)(lds + A_VT) + (half * 32 + 8 * j) * 264 + key;
            dst[0 * 264] = (bf16)(w.x & 0xffffu); dst[1 * 264] = (bf16)(w.x >> 16); dst[2 * 264] = (bf16)(w.y & 0xffffu); dst[3 * 264] = (bf16)(w.y >> 16);
            dst[4 * 264] = (bf16)(w.z & 0xffffu); dst[5 * 264] = (bf16)(w.z >> 16); dst[6 * 264] = (bf16)(w.w & 0xffffu); dst[7 * 264] = (bf16)(w.w >> 16); }
        { float s = 0.f;
#pragma unroll
          for (int j = 0; j < 8; ++j) { float a[8]; unpack8(qr[j], a); s += (a[0] * a[0] + a[1] * a[1]) + (a[2] * a[2] + a[3] * a[3]) + (a[4] * a[4] + a[5] * a[5]) + (a[6] * a[6] + a[7] * a[7]); }
          const float rstd = (0.125f * LOG2E) / sqrtf(s * (1.f / 64.f) + EPS);
#pragma unroll
          for (int hf = 0; hf < 2; ++hf) { float v[32];
#pragma unroll
              for (int j = 0; j < 4; ++j) unpack8(qr[hf * 4 + j], v + 8 * j);
#pragma unroll
              for (int j = 0; j < 8; ++j) { const f32x4 w = *(const f32x4*)(PP(q_norm_w) + hf * 32 + 4 * j);
                  v[4 * j] *= rstd * w[0]; v[4 * j + 1] *= rstd * w[1]; v[4 * j + 2] *= rstd * w[2]; v[4 * j + 3] *= rstd * w[3]; }
              if (hf == 0) rope16(v, cstab + tokq * 16);
#pragma unroll
              for (int j = 0; j < 4; ++j) { u32x4 o; o.x = pk2(v[8 * j], v[8 * j + 1]); o.y = pk2(v[8 * j + 2], v[8 * j + 3]); o.z = pk2(v[8 * j + 4], v[8 * j + 5]); o.w = pk2(v[8 * j + 6], v[8 * j + 7]);
                  *(LAS u32x4*)(lds + A_QS + tid * 144 + hf * 64 + j * 16) = o; } } }
    }
    __syncthreads();
    if (next_unit < 512) attn_load(P, next_unit, tid, kr, vr, qr);
    { const int g = wid >> 1; const float sink = PP(sinks)[hk * 4 + g] * LOG2E;
      bf16* attn = (bf16*)((unsigned char*)P.out + OUT_AH);
#pragma unroll 1
      for (int p = 0; p < 2; ++p) { const int q0 = (wid & 1) * 64 + p * 32;
          f32x4 sT[10][2];
          bf16x8 qf[2][2];
#pragma unroll
          for (int nq = 0; nq < 2; ++nq)
#pragma unroll
              for (int ks = 0; ks < 2; ++ks) qf[nq][ks] = ldfrag(lds + A_QS, g * 128 + q0 + 16 * nq + fr, 144, (ks * 32 + fq * 8) * 2);
#pragma unroll
          for (int kt = 0; kt < 10; ++kt) {
#pragma unroll
              for (int nq = 0; nq < 2; ++nq) sT[kt][nq] = (f32x4){0.f, 0.f, 0.f, 0.f};
#pragma unroll
              for (int ks = 0; ks < 2; ++ks) { const bf16x8 kf = ldfrag(lds + A_KT, q0 + 16 * kt + fr, 144, (ks * 32 + fq * 8) * 2);
#pragma unroll
                  for (int nq = 0; nq < 2; ++nq) if (kt - nq >= 0 && kt - nq <= 8) sT[kt][nq] = __builtin_amdgcn_mfma_f32_16x16x32_bf16(kf, qf[nq][ks], sT[kt][nq], 0, 0, 0); } }
          float linv[2]; const int kmin = (nb == 0) ? 128 : 0;
#pragma unroll
          for (int nq = 0; nq < 2; ++nq) { float mx = sink;
#pragma unroll
              for (int kt = 0; kt < 10; ++kt) { const int d = kt - nq; if (d < 0 || d > 8) continue;
#pragma unroll
                  for (int r = 0; r < 4; ++r) { bool valid = true;
                      if (d == 0) valid = (4 * fq + r > fr); else if (d == 8) valid = (4 * fq + r <= fr);
                      valid = valid && (q0 + 16 * kt + 4 * fq + r >= kmin);
                      sT[kt][nq][r] = valid ? sT[kt][nq][r] : -1e30f; mx = fmaxf(mx, sT[kt][nq][r]); } }
              mx = fmaxf(mx, __shfl_xor(mx, 16)); mx = fmaxf(mx, __shfl_xor(mx, 32));
              float l = 0.f;
#pragma unroll
              for (int kt = 0; kt < 10; ++kt) { const int d = kt - nq; if (d < 0 || d > 8) continue;
#pragma unroll
                  for (int r = 0; r < 4; ++r) { const float e = exp2_(sT[kt][nq][r] - mx); const float pv = (sT[kt][nq][r] > -1e29f) ? e : 0.f; sT[kt][nq][r] = pv; l += pv; } }
              l += __shfl_xor(l, 16); l += __shfl_xor(l, 32);
              l += exp2_(sink - mx);
              linv[nq] = 1.f / l; }
          f32x4 oT[4][2];
#pragma unroll
          for (int dt = 0; dt < 4; ++dt)
#pragma unroll
              for (int nq = 0; nq < 2; ++nq) oT[dt][nq] = (f32x4){0.f, 0.f, 0.f, 0.f};
#pragma unroll
          for (int j = 0; j < 5; ++j) { bf16x8 pf[2];
#pragma unroll
              for (int nq = 0; nq < 2; ++nq) { u32x4 w; w.x = pk2(sT[2 * j][nq][0], sT[2 * j][nq][1]); w.y = pk2(sT[2 * j][nq][2], sT[2 * j][nq][3]); w.z = pk2(sT[2 * j + 1][nq][0], sT[2 * j + 1][nq][1]); w.w = pk2(sT[2 * j + 1][nq][2], sT[2 * j + 1][nq][3]);
                  pf[nq] = __builtin_bit_cast(bf16x8, w); }
#pragma unroll
              for (int dt = 0; dt < 4; ++dt) { const LAS unsigned char* vrow = lds + A_VT + (16 * dt + fr) * 528 + (q0 + 32 * j + 4 * fq) * 2;
                  const u32x2 lo = *(const LAS u32x2*)vrow, hi = *(const LAS u32x2*)(vrow + 32);
                  u32x4 w; w.x = lo.x; w.y = lo.y; w.z = hi.x; w.w = hi.y; const bf16x8 vf = __builtin_bit_cast(bf16x8, w);
#pragma unroll
                  for (int nq = 0; nq < 2; ++nq) oT[dt][nq] = __builtin_amdgcn_mfma_f32_16x16x32_bf16(vf, pf[nq], oT[dt][nq], 0, 0, 0); } }
#pragma unroll
          for (int nq = 0; nq < 2; ++nq) { const size_t tok = (size_t)b * SEQ + nb * 128 + q0 + 16 * nq + fr;
#pragma unroll
              for (int dt = 0; dt < 4; ++dt) { const f32x4 v = oT[dt][nq] * linv[nq]; u32x2 o; o.x = pk2(v[0], v[1]); o.y = pk2(v[2], v[3]);
                  *(u32x2*)(attn + tok * 1024 + (hk * 4 + g) * 64 + 16 * dt + 4 * fq) = o; } }
      } }
    __syncthreads();
}

constexpr int P7_B0 = 25600, P7_B1 = 76288;
__device__ __forceinline__ void phase7(const Params& P, LAS unsigned char* lds, int vcu, int G, int tid, int wid, int lane, bool commit = true) {
    const bf16* Wrh = (const bf16*)(P.ws + WS_WR); const float* ssq = (const float*)(P.ws + WS_SSQ);
    unsigned* cnt = (unsigned*)(P.ws + WS_CTL + CTL_CNT); int* list = (int*)(P.ws + WS_LIST); float* gw = (float*)(P.ws + WS_GW); float* rstdv = (float*)(P.ws + WS_RSTD);
    const int fr = lane & 15, fq = lane >> 4;
    LAS float* LG = (LAS float*)(lds + wid * 3072);
    LAS unsigned* LC = (LAS unsigned*)(lds + 24576); LAS unsigned* LB = (LAS unsigned*)(lds + 24576 + 256);
    if (tid < 64) LC[tid] = 0u;
    __syncthreads();
    for (int base = vcu * 8; base < T / 16; base += G * 8) {
        const int rg = base + wid; const int R0 = rg * 16;
        f32x4 acc[3];
#pragma unroll
        for (int nt = 0; nt < 3; ++nt) acc[nt] = (f32x4){0.f, 0.f, 0.f, 0.f};
        const float* xr = P.out + (size_t)(R0 + fr) * 1024 + 8 * fq;
        u32x4 wst[6]; f32x4 xa[16], xb[16];
#define P7_WLOAD(kq) do { _Pragma("unroll") for (int j = 0; j < 6; ++j) { const int idx = tid + 512 * j, mat = idx / 1536, rem = idx - mat * 1536, row = rem >> 5, ch = rem & 31; \
            wst[j] = *(const u32x4*)(Wrh + (size_t)mat * 48 * 1024 + row * 1024 + (kq) * 256 + ch * 8); } } while (0)
#define P7_WSTORE(buf) do { _Pragma("unroll") for (int j = 0; j < 6; ++j) { const int idx = tid + 512 * j, mat = idx / 1536, rem = idx - mat * 1536, row = rem >> 5, ch = rem & 31; \
            *(LAS u32x4*)(lds + (buf) + mat * 25344 + row * 528 + ch * 16) = wst[j]; } } while (0)
#define P7_XLOAD(dst, kq) do { _Pragma("unroll") for (int ks = 0; ks < 8; ++ks) { dst[2 * ks] = *(const f32x4*)(xr + (kq) * 256 + 32 * ks); dst[2 * ks + 1] = *(const f32x4*)(xr + (kq) * 256 + 32 * ks + 4); } } while (0)
#define P7_COMPUTE(src, buf) do { _Pragma("unroll") for (int ks = 0; ks < 8; ++ks) { const f32x4 a0 = src[2 * ks], a1 = src[2 * ks + 1]; u32x4 hw, lw; \
            { const unsigned h0 = f2bf(a0[0]), h1 = f2bf(a0[1]), h2 = f2bf(a0[2]), h3 = f2bf(a0[3]), h4 = f2bf(a1[0]), h5 = f2bf(a1[1]), h6 = f2bf(a1[2]), h7 = f2bf(a1[3]); \
              hw.x = h0 | (h1 << 16); hw.y = h2 | (h3 << 16); hw.z = h4 | (h5 << 16); hw.w = h6 | (h7 << 16); \
              lw.x = pk2(a0[0] - bf2f(h0), a0[1] - bf2f(h1)); lw.y = pk2(a0[2] - bf2f(h2), a0[3] - bf2f(h3)); lw.z = pk2(a1[0] - bf2f(h4), a1[1] - bf2f(h5)); lw.w = pk2(a1[2] - bf2f(h6), a1[3] - bf2f(h7)); } \
            const bf16x8 ah = __builtin_bit_cast(bf16x8, hw), al = __builtin_bit_cast(bf16x8, lw); \
            _Pragma("unroll") for (int nt = 0; nt < 3; ++nt) { const LAS unsigned char* wp = lds + (buf) + (16 * nt + fr) * 528 + (ks * 32 + 8 * fq) * 2; \
                const bf16x8 bh = *(const LAS bf16x8*)wp, bl = *(const LAS bf16x8*)(wp + 25344); \
                acc[nt] = __builtin_amdgcn_mfma_f32_16x16x32_bf16(ah, bh, acc[nt], 0, 0, 0); \
                acc[nt] = __builtin_amdgcn_mfma_f32_16x16x32_bf16(ah, bl, acc[nt], 0, 0, 0); \
                acc[nt] = __builtin_amdgcn_mfma_f32_16x16x32_bf16(al, bh, acc[nt], 0, 0, 0); } } } while (0)
        P7_WLOAD(0); P7_XLOAD(xa, 0); P7_WSTORE(P7_B0); P7_WLOAD(1); P7_XLOAD(xb, 1);
        __syncthreads();
        P7_COMPUTE(xa, P7_B0); P7_WSTORE(P7_B1); P7_WLOAD(2); P7_XLOAD(xa, 2);
        __syncthreads();
        P7_COMPUTE(xb, P7_B1); P7_WSTORE(P7_B0); P7_WLOAD(3); P7_XLOAD(xb, 3);
        __syncthreads();
        P7_COMPUTE(xa, P7_B0); P7_WSTORE(P7_B1);
        __syncthreads();
        P7_COMPUTE(xb, P7_B1);
#undef P7_WLOAD
#undef P7_WSTORE
#undef P7_XLOAD
#undef P7_COMPUTE
#pragma unroll
        for (int r = 0; r < 4; ++r) { const float* sp = ssq + (size_t)(R0 + 4 * fq + r) * 16; float tot = 0.f;
#pragma unroll
            for (int q = 0; q < 4; ++q) { const f32x4 v = *(const f32x4*)(sp + 4 * q); tot += v[0]; tot += v[1]; tot += v[2]; tot += v[3]; }
            const float rstd = 1.f / sqrtf(tot * (1.f / 1024.f) + EPS);
            if (fr == 0) rstdv[R0 + 4 * fq + r] = rstd;
#pragma unroll
            for (int nt = 0; nt < 3; ++nt) { const int j = 16 * nt + fr; float bias = 0.f; if (j < 4) bias = PP(b_rg)[j]; else if (j < 36) bias = PP(b_re)[j - 4];
                LG[(4 * fq + r) * 48 + j] = acc[nt][r] * rstd + bias; } }
        __syncthreads();
        int l0 = 0, l1 = 0; unsigned rk0 = 0u, rk1 = 0u;
        if (lane < 16) { const int tok = R0 + lane; const LAS float* lg = LG + lane * 48;
            int gsel = 0; float best = lg[0];
#pragma unroll
            for (int i = 1; i < 4; ++i) { const float v = lg[i]; if (v > best) { best = v; gsel = i; } }
            float Z = 0.f;
#pragma unroll
            for (int i = 0; i < 4; ++i) Z += __expf(lg[i] - best);
            const float pgsel = 1.f / Z;
            const LAS float* le = lg + 4 + gsel * 8;
            float lmax = le[0];
#pragma unroll
            for (int i = 1; i < 8; ++i) lmax = fmaxf(lmax, le[i]);
            float Zp = 0.f;
#pragma unroll
            for (int i = 0; i < 8; ++i) Zp += __expf(le[i] - lmax);
            int i1 = 0; float p1 = -1.f;
#pragma unroll
            for (int i = 0; i < 8; ++i) { const float pe = __expf(le[i] - lmax) / Zp; if (pe > p1) { p1 = pe; i1 = i; } }
            int i2 = 0; float p2 = -1.f;
#pragma unroll
            for (int i = 0; i < 8; ++i) { const float pe = __expf(le[i] - lmax) / Zp; if (i != i1 && pe > p2) { p2 = pe; i2 = i; } }
            const float den = p1 + p2;
            gw[tok * 2 + 0] = pgsel * p1 / den; gw[tok * 2 + 1] = pgsel * p2 / den;
            l0 = gsel * 8 + i1; l1 = 32 + gsel * 8 + i2;
            rk0 = __hip_atomic_fetch_add(&LC[l0], 1u, __ATOMIC_RELAXED, __HIP_MEMORY_SCOPE_WORKGROUP); rk1 = __hip_atomic_fetch_add(&LC[l1], 1u, __ATOMIC_RELAXED, __HIP_MEMORY_SCOPE_WORKGROUP); }
        __syncthreads();
        if (tid < 64) { const unsigned n = LC[tid]; LC[tid] = 0u; if (n && commit) LB[tid] = atomicAdd(&cnt[tid * 64], n); }
        __syncthreads();
        if (lane < 16 && commit) { const int tok = R0 + lane; list[(size_t)l0 * T + LB[l0] + rk0] = tok; list[(size_t)l1 * T + LB[l1] + rk1] = tok; }
        __syncthreads();
    }
}

constexpr int M_PB = 133120, M_CN = 133632, M_RBL = 133888;
__device__ __forceinline__ void moe_prefix(const Params& P, LAS unsigned char* lds, int tid) {
    const unsigned* cnt = (const unsigned*)(P.ws + WS_CTL + CTL_CNT);
    LAS int* PB = (LAS int*)(lds + M_PB); LAS int* CN = (LAS int*)(lds + M_CN);
    if (tid < 64) CN[tid] = (int)cnt[tid * 64];
    __syncthreads();
    if (tid == 0) { int s = 0; for (int l = 0; l < 64; ++l) { PB[l] = s; s += (CN[l] + 255) >> 8; } PB[64] = s; }
    __syncthreads();
    if (tid < 64) { LAS int* RBL = (LAS int*)(lds + M_RBL); for (int rb = PB[tid]; rb < PB[tid + 1]; ++rb) RBL[rb] = tid; }
    __syncthreads();
}
__device__ __forceinline__ void phase8(const Params& P, LAS unsigned char* lds, int vcu, int G) {
    const LAS int* PB = (const LAS int*)(lds + M_PB); const LAS int* CN = (const LAS int*)(lds + M_CN);
    const pg8::MoeSched<0> S{(const char*)(P.ws + WS_HN), (const char*)(P.ws + WS_WGU), (const int*)(P.ws + WS_LIST), PB, CN, (const LAS int*)(lds + M_RBL), 1024, PB[0], (PB[64] - PB[0]) * 4, vcu, G};
    const EpiGateUp E{(const int*)(P.ws + WS_LIST), (const float*)(P.ws + WS_RSTD), (unsigned char*)(P.ws + WS_H)};
    pg8::gemm_phase(lds, S, E);
}
__device__ __forceinline__ void phase9(const Params& P, LAS unsigned char* lds, int vcu, int G) {
    const LAS int* PB = (const LAS int*)(lds + M_PB); const LAS int* CN = (const LAS int*)(lds + M_CN);
    const pg8::MoeSched<1> S{(const char*)(P.ws + WS_H), (const char*)(P.ws + WS_WD), (const int*)(P.ws + WS_LIST), PB, CN, (const LAS int*)(lds + M_RBL), 512, PB[32], (PB[64] - PB[32]) * 4, vcu, G};
    const EpiDownY E{(const int*)(P.ws + WS_LIST), (const float*)(P.ws + WS_GW), (bf16*)(P.ws + WS_Y)};
    pg8::gemm_phase(lds, S, E);
}
__device__ __forceinline__ void phase10(const Params& P, LAS unsigned char* lds, int vcu, int G) {
    const LAS int* PB = (const LAS int*)(lds + M_PB); const LAS int* CN = (const LAS int*)(lds + M_CN);
    const pg8::MoeSched<1> S{(const char*)(P.ws + WS_H), (const char*)(P.ws + WS_WD), (const int*)(P.ws + WS_LIST), PB, CN, (const LAS int*)(lds + M_RBL), 512, PB[0], (PB[32] - PB[0]) * 4, vcu, G};
    const EpiDown E{(const int*)(P.ws + WS_LIST), (const float*)(P.ws + WS_GW), P.out, (const bf16*)(P.ws + WS_Y), (const float*)(P.ws + WS_CTL + 32768)};
    pg8::gemm_phase(lds, S, E);
}

__global__ void __launch_bounds__(NTHREADS, 2) mega_fwd(Params P) {
    extern __shared__ __attribute__((aligned(16))) unsigned char lds_raw[];
    LAS unsigned char* lds = (LAS unsigned char*)lds_raw;
    const int tid = threadIdx.x, lane = tid & 63, wid = __builtin_amdgcn_readfirstlane(tid >> 6);
    const int G = gridDim.x; const int bx = blockIdx.x; const int vcu = (G % 8 == 0) ? (bx % 8) * (G / 8) + bx / 8 : bx;
    volatile LAS unsigned* st = (volatile LAS unsigned*)(lds + LDS_ST_OFF);
    if (tid < 16) st[tid] = 0u;
    if (tid == 0) { LAS unsigned long long* pt = (LAS unsigned long long*)(lds + LDS_PTAB);
#define PT_(f) pt[__builtin_offsetof(Params, f) / 8] = (unsigned long long)P.f
        PT_(positions); PT_(norm1_w); PT_(w_in); PT_(q_norm_w); PT_(k_norm_w); PT_(sinks); PT_(hlb); PT_(hnw); PT_(w_ba); PT_(w_bh); PT_(w_out); PT_(norm2_w);
        PT_(w_rg); PT_(b_rg); PT_(w_re); PT_(b_re); PT_(w_gate); PT_(w_up); PT_(w_down);
#undef PT_
    }
    __syncthreads();
    unsigned* bar = (unsigned*)(P.ws + WS_CTL);
    const XcdBarrier xb = xcd_barrier_post(bar, st);

#ifndef DUPMASK
#define DUPMASK 0
#endif
#define DUPQ(k) if ((DUPMASK >> (k)) & 1)
#ifndef PHMASK
#define PHMASK 0xFFFF
#endif
#define PH(k) if ((PHMASK >> (k)) & 1)
    PH(0) phase0(P, lds, vcu, G, tid, wid, lane);
    DUPQ(0) phase0(P, lds, vcu, G, tid, wid, lane);
    xcd_barrier(xb);
    PH(1) phase1(P, lds, G);
    DUPQ(1) phase1(P, lds, G);
    const int ei_p1 = (G == 256) ? 8192 : 0;
    PH(1) if (G == 256 && bx >= 128) { LAS float* cscr = (LAS float*)(lds + wid * 16384); const int w1 = (bx - 128) * 8 + wid;
#pragma unroll 1
        for (int k = 0; k < 8; k += 2) { float tva[32], tvb[32]; const TItem ia = expert_item(P, lds, w1 + k * 1024), ib = expert_item(P, lds, w1 + (k + 1) * 1024);
            titem_load(ia, lane, tva); titem_load(ib, lane, tvb); titem_store(ia, lane, tva, cscr); titem_store(ib, lane, tvb, cscr); } }
    xcd_barrier(xb);
    PH(2) {
        int cit = ei_p1 + vcu * 8 + wid; const int cstride = G * 8;
        for (int u = bx; u < 256; u += G) {
            if ((u & 15) != 15) { hgrn_unit<0>(P, lds, u, tid, wid, lane, cit, cstride); cit += 16 * cstride; } }
        LAS float* cscr = (LAS float*)(lds + (wid < 4 ? H_QT + wid * 8448 : H_ST + (wid - 4) * 8448));
        for (; cit < EI_TOTAL; cit += cstride) { float tv[32]; const TItem t = expert_item(P, lds, cit); titem_load(t, lane, tv); titem_store(t, lane, tv, cscr); }
    }
    DUPQ(2) for (int u = bx; u < 256; u += G) if ((u & 15) != 15) hgrn_unit<0>(P, lds, u, tid, wid, lane);
    xcd_barrier(xb);
    PH(3) { hgrn_scan(P, G, tid);
    { u32x4 kr[4], vr[4], qr[8]; if (bx < 512) attn_load(P, bx, tid, kr, vr, qr);
      for (int u = bx; u < 512; u += G) attn_unit(P, lds, u, u + G, tid, wid, lane, kr, vr, qr); } }
    DUPQ(3) { u32x4 kr[4], vr[4], qr[8]; if (bx < 512) attn_load(P, bx, tid, kr, vr, qr);
      for (int u = bx; u < 512; u += G) attn_unit(P, lds, u, u + G, tid, wid, lane, kr, vr, qr); }
    xcd_barrier(xb);
    PH(4) for (int u = bx; u < 256; u += G) hgrn_unit<1>(P, lds, u, tid, wid, lane);
    DUPQ(4) for (int u = bx; u < 256; u += G) hgrn_unit<1>(P, lds, u, tid, wid, lane);
    xcd_barrier(xb);
    PH(5) phase5(P, lds, G);
    DUPQ(5) phase5(P, lds, G);
    xcd_barrier(xb);
    PH(6) phase6(P, lds, G);
    DUPQ(6) phase6(P, lds, G);
    xcd_barrier(xb);
    if ((DUPMASK >> 7) & 1) phase7(P, lds, vcu, G, tid, wid, lane, false);
    PH(7) phase7(P, lds, vcu, G, tid, wid, lane);
    xcd_barrier(xb);
    moe_prefix(P, lds, tid);
    PH(8) phase8(P, lds, vcu, G);
    DUPQ(8) phase8(P, lds, vcu, G);
    xcd_barrier(xb);
    PH(9) phase9(P, lds, vcu, G);
    xcd_barrier(xb);
    PH(10) phase10(P, lds, vcu, G);
    if (xb_ld(&bar[XB_TMO]) != 0u && tid == 0) P.out[(size_t)bx * 1024] = __builtin_nanf("");
}

extern "C" void kernel_launch(void* const* d_in, const int* in_sizes, int n_in, void* d_out, int out_size, void* d_ws, size_t ws_size, hipStream_t stream) {
    static int grid = 0;
    if (grid == 0) {
        if (n_in != 20 || out_size != T * D || ws_size < WS_END) { fprintf(stderr, "kernel_launch: unexpected shapes (n_in %d out %d ws %zu, need ws >= %zu)\n", n_in, out_size, ws_size, (size_t)WS_END); grid = -1; return; }
        int dev = 0, cus = 0, per_cu = 0;
        if (hipGetDevice(&dev) != hipSuccess || hipDeviceGetAttribute(&cus, hipDeviceAttributeMultiprocessorCount, dev) != hipSuccess) { grid = -1; return; }
        if (hipFuncSetAttribute((const void*)mega_fwd, hipFuncAttributeMaxDynamicSharedMemorySize, LDS_BYTES) != hipSuccess) { fprintf(stderr, "hipFuncSetAttribute failed\n"); grid = -1; return; }
        if (hipOccupancyMaxActiveBlocksPerMultiprocessor(&per_cu, (const void*)mega_fwd, NTHREADS, LDS_BYTES) != hipSuccess || per_cu < 1) { fprintf(stderr, "occupancy query: %d blocks/CU\n", per_cu); grid = -1; return; }
        grid = cus;
    }
    if (grid < 0) return;
    if (hipMemsetAsync((char*)d_ws + WS_CTL, 0, 96 * 1024, stream) != hipSuccess) return;
    Params p{};
    p.x = (const float*)d_in[0]; p.positions = (const int*)d_in[1]; p.norm1_w = (const float*)d_in[2]; p.w_in = (const float*)d_in[3];
    p.q_norm_w = (const float*)d_in[4]; p.k_norm_w = (const float*)d_in[5]; p.sinks = (const float*)d_in[6]; p.hlb = (const float*)d_in[7];
    p.hnw = (const float*)d_in[8]; p.w_ba = (const float*)d_in[9]; p.w_bh = (const float*)d_in[10]; p.w_out = (const float*)d_in[11];
    p.norm2_w = (const float*)d_in[12]; p.w_rg = (const float*)d_in[13]; p.b_rg = (const float*)d_in[14]; p.w_re = (const float*)d_in[15];
    p.b_re = (const float*)d_in[16]; p.w_gate = (const float*)d_in[17]; p.w_up = (const float*)d_in[18]; p.w_down = (const float*)d_in[19];
    p.out = (float*)d_out; p.ws = (unsigned char*)d_ws;
    void* args[] = {&p};
    const hipError_t e = hipLaunchCooperativeKernel((const void*)mega_fwd, dim3(grid), dim3(NTHREADS), args, LDS_BYTES, stream);
    if (e != hipSuccess) fprintf(stderr, "cooperative launch failed: %s (grid %d)\n", hipGetErrorString(e), grid);
}
```

```cpp
#define DUPMASK 0
#include <hip/hip_runtime.h>
#include <cstdio>
#include <cstdint>

#define LAS __attribute__((address_space(3)))
typedef unsigned short bf16;
typedef short bf16x8 __attribute__((ext_vector_type(8)));
typedef float f32x4 __attribute__((ext_vector_type(4)));
typedef unsigned u32x4 __attribute__((ext_vector_type(4)));
typedef unsigned u32x2 __attribute__((ext_vector_type(2)));

constexpr int NTHREADS = 512;
constexpr int LDS_BYTES = 147456;
constexpr int LDS_ST_OFF = LDS_BYTES - 64;

constexpr int BATCH = 4, SEQ = 8192, T = BATCH * SEQ, D = 1024, NPROJ = 4864;
constexpr int C_QA = 0, C_KA = 512, C_VA = 640, C_QH = 768, C_FH = 1280, C_IH = 1792, C_GH = 2304, C_ZA = 2816, C_ZB = 3840;
constexpr int NEXP = 32, FF = 512;
constexpr float EPS = 1e-6f;

constexpr size_t MiB = 1u << 20;
constexpr size_t WS_CTL = 0;
constexpr size_t CTL_CNT = 65536;
constexpr size_t WS_WINT = 1 * MiB;
constexpr size_t WS_WAT = 11 * MiB;
constexpr size_t WS_WBT = 12 * MiB;
constexpr size_t WS_WOT = 13 * MiB;
constexpr size_t WS_WR = 15 * MiB;
constexpr size_t WS_WGU = 16 * MiB;
constexpr size_t WS_WD = 80 * MiB;
constexpr size_t WS_PROJ = 112 * MiB;
constexpr size_t WS_MIXED = 416 * MiB;
constexpr size_t WS_CS = 480 * MiB;
constexpr size_t WS_WZ8 = 482 * MiB;
constexpr size_t WS_END = 484 * MiB;
constexpr size_t WS_HN = 112 * MiB;
constexpr size_t WS_SSQ = 176 * MiB;
constexpr size_t WS_LIST = 178 * MiB;
constexpr size_t WS_GW = 186 * MiB;
constexpr size_t WS_RSTD = 187 * MiB;
constexpr size_t WS_H = 192 * MiB;
constexpr size_t WS_X1B = 336 * MiB;
constexpr size_t WS_Y = 272 * MiB;
constexpr size_t OUT_U = 0, OUT_SIN = 16 * MiB, OUT_DSC = 32 * MiB, OUT_AH = 64 * MiB, OUT_XN8 = 64 * MiB;

typedef float f32x2_ __attribute__((ext_vector_type(2)));
typedef __bf16 bf16x2_ __attribute__((ext_vector_type(2)));
__device__ __forceinline__ unsigned f2bf(float f) { return (unsigned)__builtin_bit_cast(unsigned short, (__bf16)f); }
__device__ __forceinline__ float bf2f(unsigned h) { return __builtin_bit_cast(float, h << 16); }
__device__ __forceinline__ unsigned pk2(float lo, float hi) { const f32x2_ v = {lo, hi}; return __builtin_bit_cast(unsigned, __builtin_convertvector(v, bf16x2_)); }
__device__ __forceinline__ float bflo(unsigned w) { return __builtin_bit_cast(float, w << 16); }
__device__ __forceinline__ float bfhi(unsigned w) { return __builtin_bit_cast(float, w & 0xffff0000u); }
constexpr float LOG2E = 1.4426950408889634f;
__device__ __forceinline__ float exp2_(float x) { return __builtin_amdgcn_exp2f(x); }
__device__ __forceinline__ float fexp_(float x) { return __builtin_amdgcn_exp2f(x * LOG2E); }
__device__ __forceinline__ float sigmoidf_(float x) { return __builtin_amdgcn_rcpf(1.f + fexp_(-x)); }
__device__ __forceinline__ int opaque(int x) { asm volatile("" : "+v"(x)); return x; }
__device__ __forceinline__ float wave_sum(float v) {
#pragma unroll
    for (int o = 1; o < 64; o <<= 1) v += __shfl_xor(v, o);
    return v;
}

#define XB_TMO      128
#define XB_XCNT(j)  (256  + 64 * (j))
#define XB_XSUB(j)  (1280 + 64 * (j))
#define XB_XGEN(j)  (2304 + 64 * (j))
#define XB_TOP      3328
#define XB_TOPGEN   3392
#define XCD_BAR_WORDS 3456
#define XB_SPIN_CAP (1u << 20)
__device__ __forceinline__ unsigned xb_ld(unsigned* p)              { return __hip_atomic_load(p, __ATOMIC_RELAXED, __HIP_MEMORY_SCOPE_AGENT); }
__device__ __forceinline__ unsigned xb_add(unsigned* p, unsigned v) { return __hip_atomic_fetch_add(p, v, __ATOMIC_RELAXED, __HIP_MEMORY_SCOPE_AGENT); }
__device__ __forceinline__ unsigned xb_xcc_id() { return (unsigned)__builtin_amdgcn_s_getreg((3 << 11) | 20) & 0xFu; }
#define XB_SPIN(cond, bar) do { unsigned _sp = 0; while (cond) { __builtin_amdgcn_s_sleep(1); \
    if ((++_sp & 255u) == 0u) { if (xb_ld(&(bar)[XB_TMO])) break; if (_sp > XB_SPIN_CAP) { atomicAdd(&(bar)[XB_TMO], 1u); break; } } } } while (0)
struct XcdBarrier { unsigned* bar; unsigned x; volatile LAS unsigned* st; };
__device__ __forceinline__ XcdBarrier xcd_barrier_post(unsigned* bar, volatile LAS unsigned* st) {
    XcdBarrier b; b.bar = bar; b.x = xb_xcc_id(); b.st = st;
    if (threadIdx.x == 0) (void)xb_add(&bar[XB_XCNT(b.x)], 1u);
    return b;
}
__device__ __forceinline__ void xcd_barrier_complete(unsigned* bar, unsigned x, unsigned& nloc, unsigned& nx) {
    const unsigned G = gridDim.x * gridDim.y * gridDim.z;
    unsigned sum, cnt, mine, sp = 0u;
    for (;;) {
        sum = 0u; cnt = 0u; mine = 0u;
#pragma unroll
        for (unsigned j = 0; j < 16; ++j) { const unsigned c = xb_ld(&bar[XB_XCNT(j)]); sum += c; cnt += (c > 0u) ? 1u : 0u; mine = (j == x) ? c : mine; }
        if (sum == G) break;
        __builtin_amdgcn_s_sleep(1);
        if ((++sp & 255u) == 0u) { if (xb_ld(&bar[XB_TMO])) break; if (sp > XB_SPIN_CAP) { atomicAdd(&bar[XB_TMO], 1u); break; } }
    }
    nloc = mine > 0u ? mine : 1u; nx = cnt > 0u ? cnt : 1u;
}
__device__ __forceinline__ void xcd_barrier(const XcdBarrier& b) {
    asm volatile("s_waitcnt vmcnt(0)" ::: "memory");
    __syncthreads();
    if (threadIdx.x == 0) {
        unsigned* bar = b.bar;
        __builtin_amdgcn_s_waitcnt(0);
        unsigned nloc = b.st[0], nx = b.st[1];
        if (nloc == 0u) { xcd_barrier_complete(bar, b.x, nloc, nx); b.st[0] = nloc; b.st[1] = nx; }
        const unsigned old = xb_add(&bar[XB_XSUB(b.x)], 1u);
        const unsigned gen = old / nloc;
        if (old + 1u == (gen + 1u) * nloc) {
            __builtin_amdgcn_fence(__ATOMIC_RELEASE, "agent");
            asm volatile("s_waitcnt vmcnt(0)" ::: "memory");
            const unsigned og = xb_add(&bar[XB_TOP], 1u);
            const unsigned tg = og / nx;
            if (og + 1u == (tg + 1u) * nx) xb_add(&bar[XB_TOPGEN], 1u);
            else XB_SPIN(xb_ld(&bar[XB_TOPGEN]) == tg, bar);
            __builtin_amdgcn_fence(__ATOMIC_ACQUIRE, "agent");
            xb_add(&bar[XB_XGEN(b.x)], 1u);
            asm volatile("s_waitcnt vmcnt(0)" ::: "memory");
        } else {
            XB_SPIN(xb_ld(&bar[XB_XGEN(b.x)]) == gen, bar);
            __builtin_amdgcn_fence(__ATOMIC_ACQUIRE, "agent");
            asm volatile("s_waitcnt vmcnt(0)" ::: "memory");
        }
    }
    __syncthreads();
}

struct Params {
    const float* x; const int* positions; const float* norm1_w; const float* w_in; const float* q_norm_w; const float* k_norm_w;
    const float* sinks; const float* hlb; const float* hnw; const float* w_ba; const float* w_bh; const float* w_out; const float* norm2_w;
    const float* w_rg; const float* b_rg; const float* w_re; const float* b_re; const float* w_gate; const float* w_up; const float* w_down;
    float* out; unsigned char* ws;
};
constexpr int LDS_PTAB = LDS_ST_OFF - 256;
template <class Tp> __device__ __forceinline__ Tp ldparam(LAS unsigned char* lds, int off) {
    const u32x2 v = *(const LAS u32x2*)(lds + LDS_PTAB + off);
    const unsigned lo = (unsigned)__builtin_amdgcn_readfirstlane((int)v.x), hi = (unsigned)__builtin_amdgcn_readfirstlane((int)v.y);
    return (Tp)(((unsigned long long)hi << 32) | (unsigned long long)lo); }
#define PP(f) ldparam<decltype(Params::f)>(lds, (int)__builtin_offsetof(Params, f))


namespace pg8 {
constexpr int BK = 64, HALF = 128, HTB = HALF * BK * 2;
__device__ __forceinline__ int lds_byte(int r, int c) { const int st = (r >> 4) * 2 + (c >> 5), rr = r & 15, cc = c & 31, ob = rr * 64 + cc * 2; return st * 1024 + (ob ^ (((ob >> 9) & 1) << 5)); }
__device__ __forceinline__ void stage_rc(int b, int& R, int& C) { const int st = b / 1024, sb = b % 1024, swz = sb ^ (((sb >> 9) & 1) << 5); R = (st >> 1) * 16 + swz / 64; C = (st & 1) * 32 + (swz % 64) / 2; }
__device__ __forceinline__ int perm32(int rho) { const int n = rho >> 4, i = rho & 15; return 8 * (i >> 2) + 4 * n + (i & 3); }
struct Unit { int pm, pn, l, i0, cn; };
typedef int i32x4_ __attribute__((ext_vector_type(4)));
typedef int i32x8_ __attribute__((ext_vector_type(8)));
__device__ __forceinline__ i32x8_ cat8(i32x4_ a, i32x4_ b) { return __builtin_shufflevector(a, b, 0, 1, 2, 3, 4, 5, 6, 7); }
__device__ __forceinline__ bf16x8 lo8(i32x8_ v) { return __builtin_bit_cast(bf16x8, __builtin_shufflevector(v, v, 0, 1, 2, 3)); }
__device__ __forceinline__ bf16x8 hi8(i32x8_ v) { return __builtin_bit_cast(bf16x8, __builtin_shufflevector(v, v, 4, 5, 6, 7)); }

template <class Epi, class Sched>
__device__ __forceinline__ void gemm_phase(LAS unsigned char* lds, const Sched& S, const Epi& E) {
    const int tid = threadIdx.x, wid = __builtin_amdgcn_readfirstlane(tid >> 6), lane = tid & 63, wr = wid >> 2, wc = wid & 3, fr = lane & 15, fq = lane >> 4;
    const int KB = S.KB, nt = KB / 128;
    int sR[2], sC = 0; unsigned voffB[2];
#pragma unroll
    for (int i = 0; i < 2; ++i) { int R, C; stage_rc(tid * 16 + i * 8192, R, C); sR[i] = R; sC = C; const int Rb = Epi::PERM ? ((R & ~31) + perm32(R & 31)) : R; voffB[i] = (unsigned)(Rb * KB + C * 2); }
    const unsigned kstep = (unsigned)(BK * 2);
    const size_t hstep = (size_t)HALF * KB;
    const unsigned ldsw = (unsigned)wid * 1024u;
    const int aoff = lds_byte(wr * 64 + fr, fq * 8), boff = lds_byte(wc * 32 + fr, fq * 8);
#define PG8_SA(b, h) (((b) * 2 + (h)) * HTB)
#define PG8_SB(b, h) ((4 + (b) * 2 + (h)) * HTB)
#define PG8_STAGE_B(bufoff, gbase) do { _Pragma("unroll") for (int _i = 0; _i < 2; ++_i) \
        __builtin_amdgcn_global_load_lds((const unsigned*)((const char*)(gbase) + voffB[_i]), (LAS unsigned*)(lds + (bufoff) + ldsw + _i * 8192), 16, 0, 0); } while (0)
#define PG8_STAGE_A(bufoff, va, kb) do { _Pragma("unroll") for (int _i = 0; _i < 2; ++_i) \
        __builtin_amdgcn_global_load_lds((const unsigned*)(Ab + ((size_t)(va)[_i] + (kb))), (LAS unsigned*)(lds + (bufoff) + ldsw + _i * 8192), 16, 0, 0); } while (0)
#define PG8_LDA(dst, b, h) do { _Pragma("unroll") for (int m = 0; m < 4; ++m) dst[m] = cat8(*(const LAS i32x4_*)(lds + PG8_SA(b, h) + aoff + m * 2048), *(const LAS i32x4_*)(lds + PG8_SA(b, h) + aoff + m * 2048 + 1024)); } while (0)
#define PG8_LDB(dst, b, h) do { _Pragma("unroll") for (int n = 0; n < 2; ++n) dst[n] = cat8(*(const LAS i32x4_*)(lds + PG8_SB(b, h) + boff + n * 2048), *(const LAS i32x4_*)(lds + PG8_SB(b, h) + boff + n * 2048 + 1024)); } while (0)
#define PG8_MMA(ai, bj, At, Bt) do { __builtin_amdgcn_s_setprio(1); _Pragma("unroll") for (int m = 0; m < 4; ++m) _Pragma("unroll") for (int n = 0; n < 2; ++n) { \
        if constexpr (Sched::FP8) {   \
              \
            asm volatile("v_mfma_scale_f32_16x16x128_f8f6f4 %0, %1, %2, %0, %3, %4 op_sel_hi:[0,0,0]" : "+v"(acc[ai][bj][m][n]) : "v"(Bt[n]), "v"(At[m]), "v"(sclB), "v"(sclA)); \
        } else { acc[ai][bj][m][n] = __builtin_amdgcn_mfma_f32_16x16x32_bf16(lo8(Bt[n]), lo8(At[m]), acc[ai][bj][m][n], 0, 0, 0); \
                 acc[ai][bj][m][n] = __builtin_amdgcn_mfma_f32_16x16x32_bf16(hi8(Bt[n]), hi8(At[m]), acc[ai][bj][m][n], 0, 0, 0); } } \
        __builtin_amdgcn_s_setprio(0); } while (0)
#define PG8_WAIT_V(n) asm volatile("s_waitcnt vmcnt(" #n ")" ::: "memory")
#define PG8_WAIT_L(n) asm volatile("s_waitcnt lgkmcnt(" #n ")" ::: "memory")
#define PG8_BAR __builtin_amdgcn_s_barrier()
#define PG8_SCHED __builtin_amdgcn_sched_barrier(0)
    Unit cur, nxt; int ui = 0;
    if (!S.next(0, cur)) return;
    const int sclA = Sched::SCALE_A, sclB = Sched::SCALE_B; (void)sclA; (void)sclB;
    f32x4 acc[2][2][4][2];
#pragma unroll
    for (int a = 0; a < 2; ++a)
#pragma unroll
        for (int b = 0; b < 2; ++b)
#pragma unroll
            for (int m = 0; m < 4; ++m)
#pragma unroll
                for (int n = 0; n < 2; ++n) acc[a][b][m][n] = (f32x4){0.f, 0.f, 0.f, 0.f};
    i32x8_ At[4], B0[2], B1[2];
    const char* const Ab = S.a_base();
    unsigned vA0[2], vA1[2], nA0[2], nA1[2];
#pragma unroll
    for (int i = 0; i < 2; ++i) { vA0[i] = S.a_voff(cur, 0, sR[i], sC); vA1[i] = S.a_voff(cur, 1, sR[i], sC); }
    const char* cB = S.b_base(cur);
    PG8_STAGE_B(PG8_SB(0, 0), cB); PG8_STAGE_B(PG8_SB(0, 1), cB + hstep); PG8_STAGE_A(PG8_SA(0, 0), vA0, 0u); PG8_STAGE_A(PG8_SA(0, 1), vA1, 0u);
    if (wr == 1) PG8_BAR;
    PG8_WAIT_V(2); PG8_BAR;
    PG8_STAGE_B(PG8_SB(1, 0), cB + kstep); PG8_STAGE_A(PG8_SA(1, 0), vA0, kstep); PG8_STAGE_B(PG8_SB(1, 1), cB + hstep + kstep);
    PG8_WAIT_V(6); PG8_BAR;
    for (;;) {
        const bool has_next = S.next(ui + 1, nxt);
        const char* nB = has_next ? S.b_base(nxt) : cB;
#pragma unroll
        for (int i = 0; i < 2; ++i) { nA0[i] = has_next ? S.a_voff(nxt, 0, sR[i], sC) : vA0[i]; nA1[i] = has_next ? S.a_voff(nxt, 1, sR[i], sC) : vA1[i]; }
#pragma unroll 1
        for (int t = 0; t < nt; t += 2) {
            const bool last = (t == nt - 2);
            if constexpr (Epi::MID) { if (t == (nt >> 1)) E.mid(acc, cur, wr, wc, fr, fq); }
            const unsigned k1 = (unsigned)(t + 1) * kstep;
            const unsigned k2 = last ? 0u : (unsigned)(t + 2) * kstep, k3 = k2 + kstep;
            const char* b2 = last ? nB : cB + (size_t)(t + 2) * kstep; const char* b3 = b2 + kstep;
            unsigned uA0[2], uA1[2];
#pragma unroll
            for (int i = 0; i < 2; ++i) { uA0[i] = last ? nA0[i] : vA0[i]; uA1[i] = last ? nA1[i] : vA1[i]; }
            PG8_LDB(B0, 0, 0); PG8_LDB(B1, 0, 1); PG8_SCHED; PG8_LDA(At, 0, 0); PG8_STAGE_A(PG8_SA(1, 1), vA1, k1);
            PG8_WAIT_V(8); PG8_WAIT_L(0); PG8_BAR; PG8_MMA(0, 0, At, B0); PG8_MMA(0, 1, At, B1); PG8_BAR; PG8_SCHED;
            PG8_LDA(At, 0, 1); PG8_STAGE_B(PG8_SB(0, 0), b2); PG8_STAGE_B(PG8_SB(0, 1), b2 + hstep); PG8_STAGE_A(PG8_SA(0, 0), uA0, k2);
            PG8_WAIT_V(8); PG8_WAIT_L(0); PG8_BAR; PG8_MMA(1, 0, At, B0); PG8_MMA(1, 1, At, B1); PG8_BAR; PG8_SCHED;
            PG8_LDB(B0, 1, 0); PG8_LDB(B1, 1, 1); PG8_SCHED; PG8_LDA(At, 1, 0); PG8_STAGE_A(PG8_SA(0, 1), uA1, k2);
            PG8_WAIT_V(8); PG8_WAIT_L(0); PG8_BAR; PG8_MMA(0, 0, At, B0); PG8_MMA(0, 1, At, B1); PG8_BAR; PG8_SCHED;
            PG8_LDA(At, 1, 1); PG8_STAGE_B(PG8_SB(1, 0), b3); PG8_STAGE_B(PG8_SB(1, 1), b3 + hstep); PG8_STAGE_A(PG8_SA(1, 0), uA0, k3);
            PG8_WAIT_V(8); PG8_WAIT_L(0); PG8_BAR; PG8_MMA(1, 0, At, B0); PG8_MMA(1, 1, At, B1); PG8_BAR; PG8_SCHED;
        }
        if constexpr (Sched::FP8) asm volatile("s_nop 15\n\ts_nop 15" ::: "memory");
        if (wr == 0) PG8_BAR;
        E(acc, cur, wr, wc, fr, fq);
        if (!has_next) break;
#pragma unroll
        for (int a = 0; a < 2; ++a)
#pragma unroll
            for (int b = 0; b < 2; ++b)
#pragma unroll
                for (int m = 0; m < 4; ++m)
#pragma unroll
                    for (int n = 0; n < 2; ++n) acc[a][b][m][n] = (f32x4){0.f, 0.f, 0.f, 0.f};
        cur = nxt; cB = nB; ++ui;
#pragma unroll
        for (int i = 0; i < 2; ++i) { vA0[i] = nA0[i]; vA1[i] = nA1[i]; }
        if (wr == 1) PG8_BAR;
    }
    PG8_WAIT_V(0);
    PG8_BAR;
#undef PG8_SA
#undef PG8_SB
#undef PG8_STAGE_A
#undef PG8_STAGE_B
#undef PG8_LDA
#undef PG8_LDB
#undef PG8_MMA
#undef PG8_WAIT_V
#undef PG8_WAIT_L
#undef PG8_BAR
#undef PG8_SCHED
}
__device__ __forceinline__ bool tile_order(int i, int G, int c, int nM, int nN, int& pm, int& pn) {
    const int nwg = nM * nN; const long L = (long)i * G + c; if (L >= nwg) return false;
    int wgid = (int)L; { const int q = nwg / 8, r = nwg % 8, xcd = wgid % 8, off = wgid / 8; wgid = (xcd < r ? xcd * (q + 1) : r * (q + 1) + (xcd - r) * q) + off; }
    const int WGM = 8, nig = WGM * nN, gid = wgid / nig, fm = gid * WGM, gsz = (nM - fm) < WGM ? (nM - fm) : WGM;
    pm = fm + ((wgid % nig) % gsz); pn = (wgid % nig) / gsz; return true;
}
template <bool F8 = false> struct DenseSchedT {
    static constexpr bool FP8 = F8; static constexpr int SCALE_A = 0x7F7F7F7F, SCALE_B = F8 ? 0x79797979 : 0x7F7F7F7F;
    const char* A; const char* Bt; int KB, nM, nN, G, c;
    __device__ __forceinline__ bool next(int i, Unit& u) const { u.l = 0; u.i0 = 0; u.cn = 0; return tile_order(i, G, c, nM, nN, u.pm, u.pn); }
    __device__ __forceinline__ const char* a_base() const { return A; }
    __device__ __forceinline__ unsigned a_voff(const Unit& u, int h, int R, int C) const { return (unsigned)((u.pm * 256 + h * 128 + R) * KB + C * 2); }
    __device__ __forceinline__ const char* b_base(const Unit& u) const { return Bt + (size_t)u.pn * 256 * KB; }
};
typedef DenseSchedT<false> DenseSched;
template <int MODE> struct MoeSched {
    static constexpr bool FP8 = true; static constexpr int SCALE_A = (MODE == 0) ? 0x7F7F7F7F : 0x7D7D7D7D, SCALE_B = 0x79797979;
    const char* A; const char* Bt; const int* list; const LAS int* PB; const LAS int* CN; const LAS int* RBL; int KB, rb0, nunits, vcu, G;
    __device__ __forceinline__ bool next(int i, Unit& u) const {
        const int idx = vcu + i * G; if (idx >= nunits) return false;
        const int rb = rb0 + (idx >> 2); const int l = RBL[rb];
        u.pm = rb; u.pn = idx & 3; u.l = l; u.i0 = (rb - PB[l]) * 256; u.cn = CN[l]; return true; }
    __device__ __forceinline__ const char* a_base() const { return A; }
    __device__ __forceinline__ unsigned a_voff(const Unit& u, int h, int R, int C) const {
        if (MODE == 0) { int idx = u.i0 + h * 128 + R; idx = idx < u.cn ? idx : u.cn - 1; const int tok = list[(size_t)u.l * T + idx]; return (unsigned)(tok * KB + C * 2); }
        return (unsigned)((u.pm * 256 + h * 128 + R) * KB + C * 2); }
    __device__ __forceinline__ const char* b_base(const Unit& u) const { return Bt + ((size_t)(u.l & 31) * 1024 + u.pn * 256) * KB; }
};
}

struct EpiProj { static constexpr bool PERM = true, MID = false; bf16* proj; int coff;
    __device__ __forceinline__ void operator()(const f32x4 (&acc)[2][2][4][2], const pg8::Unit& u, int wr, int wc, int fr, int fq) const {
        const int fro = opaque(fr), fqo = opaque(fq);
#pragma unroll
        for (int ai = 0; ai < 2; ++ai)
#pragma unroll
            for (int m = 0; m < 4; ++m) { bf16* rowp = proj + (size_t)(u.pm * 256 + ai * 128 + wr * 64 + m * 16 + fro) * NPROJ + coff + u.pn * 256 + wc * 32 + 8 * fqo;
#pragma unroll
                for (int bj = 0; bj < 2; ++bj) { const f32x4 v0 = acc[ai][bj][m][0], v1 = acc[ai][bj][m][1];
                    u32x4 w; w.x = pk2(v0[0], v0[1]); w.y = pk2(v0[2], v0[3]); w.z = pk2(v1[0], v1[1]); w.w = pk2(v1[2], v1[3]); *(u32x4*)(rowp + bj * 128) = w; } }
    } };
struct EpiZ8 { static constexpr bool PERM = true, MID = false; unsigned char* projb;
    __device__ __forceinline__ void operator()(const f32x4 (&acc)[2][2][4][2], const pg8::Unit& u, int wr, int wc, int fr, int fq) const {
        const int fro = opaque(fr), fqo = opaque(fq);
#pragma unroll
        for (int ai = 0; ai < 2; ++ai)
#pragma unroll
            for (int m = 0; m < 4; ++m) { unsigned char* rowp = projb + ((size_t)(u.pm * 256 + ai * 128 + wr * 64 + m * 16 + fro) * NPROJ + C_ZA) * 2 + u.pn * 256 + wc * 32 + 8 * fqo;
#pragma unroll
                for (int bj = 0; bj < 2; ++bj) { const f32x4 v0 = acc[ai][bj][m][0], v1 = acc[ai][bj][m][1];
                    u32x2 w; int o8 = __builtin_amdgcn_cvt_pk_fp8_f32(v0[0], v0[1], 0, false); w.x = (unsigned)__builtin_amdgcn_cvt_pk_fp8_f32(v0[2], v0[3], o8, true);
                    o8 = __builtin_amdgcn_cvt_pk_fp8_f32(v1[0], v1[1], 0, false); w.y = (unsigned)__builtin_amdgcn_cvt_pk_fp8_f32(v1[2], v1[3], o8, true);
                    *(u32x2*)(rowp + bj * 128) = w; } }
    } };
__device__ __forceinline__ void unpack8f(const u32x2 w, float* v) {
    const f32x2_ a = __builtin_amdgcn_cvt_pk_f32_fp8((int)w.x, false), b = __builtin_amdgcn_cvt_pk_f32_fp8((int)w.x, true), c = __builtin_amdgcn_cvt_pk_f32_fp8((int)w.y, false), d = __builtin_amdgcn_cvt_pk_f32_fp8((int)w.y, true);
    v[0] = a[0]; v[1] = a[1]; v[2] = b[0]; v[3] = b[1]; v[4] = c[0]; v[5] = c[1]; v[6] = d[0]; v[7] = d[1]; }
__device__ __forceinline__ float ratio_(float zb, float za) { return (1.f + fexp_(-zb)) * __builtin_amdgcn_rcpf(1.f + fexp_(-za)); }
struct EpiMixed { static constexpr bool PERM = true, MID = true; const unsigned char* projb; bf16* mixed;
    __device__ __forceinline__ void mid(f32x4 (&acc)[2][2][4][2], const pg8::Unit& u, int wr, int wc, int fr, int fq) const {
        const int fro = opaque(fr), fqo = opaque(fq);
#pragma unroll
        for (int ai = 0; ai < 2; ++ai) {
            u32x2 za[4][2], zb[4][2];
#pragma unroll
            for (int m = 0; m < 4; ++m) { const unsigned char* zr = projb + ((size_t)(u.pm * 256 + ai * 128 + wr * 64 + m * 16 + fro) * NPROJ + C_ZA) * 2 + u.pn * 256 + wc * 32 + 8 * fqo;
#pragma unroll
                for (int bj = 0; bj < 2; ++bj) { za[m][bj] = *(const u32x2*)(zr + bj * 128); zb[m][bj] = *(const u32x2*)(zr + 1024 + bj * 128); } }
#pragma unroll
            for (int m = 0; m < 4; ++m)
#pragma unroll
                for (int bj = 0; bj < 2; ++bj) { float a[8], b[8]; unpack8f(za[m][bj], a); unpack8f(zb[m][bj], b); f32x4 r0, r1;
                    r0[0] = ratio_(b[0], a[0]); r0[1] = ratio_(b[1], a[1]); r0[2] = ratio_(b[2], a[2]); r0[3] = ratio_(b[3], a[3]);
                    r1[0] = ratio_(b[4], a[4]); r1[1] = ratio_(b[5], a[5]); r1[2] = ratio_(b[6], a[6]); r1[3] = ratio_(b[7], a[7]);
                    acc[ai][bj][m][0] = acc[ai][bj][m][0] * r0; acc[ai][bj][m][1] = acc[ai][bj][m][1] * r1; }
            asm volatile("" ::: "memory"); }
    }
    __device__ __forceinline__ void operator()(const f32x4 (&acc)[2][2][4][2], const pg8::Unit& u, int wr, int wc, int fr, int fq) const {
        const int fro = opaque(fr), fqo = opaque(fq);
#pragma unroll
        for (int ai = 0; ai < 2; ++ai) {
            u32x2 zb[4][2];
#pragma unroll
            for (int m = 0; m < 4; ++m) { const unsigned char* zr = projb + ((size_t)(u.pm * 256 + ai * 128 + wr * 64 + m * 16 + fro) * NPROJ + C_ZA) * 2 + u.pn * 256 + wc * 32 + 8 * fqo;
#pragma unroll
                for (int bj = 0; bj < 2; ++bj) zb[m][bj] = *(const u32x2*)(zr + 1024 + bj * 128); }
#pragma unroll
            for (int m = 0; m < 4; ++m) { bf16* orow = mixed + (size_t)(u.pm * 256 + ai * 128 + wr * 64 + m * 16 + fro) * 1024 + u.pn * 256 + wc * 32 + 8 * fqo;
#pragma unroll
                for (int bj = 0; bj < 2; ++bj) { float b[8]; unpack8f(zb[m][bj], b); const f32x4 v0 = acc[ai][bj][m][0], v1 = acc[ai][bj][m][1];
                    u32x4 w; w.x = pk2(v0[0] * sigmoidf_(b[0]), v0[1] * sigmoidf_(b[1])); w.y = pk2(v0[2] * sigmoidf_(b[2]), v0[3] * sigmoidf_(b[3]));
                    w.z = pk2(v1[0] * sigmoidf_(b[4]), v1[1] * sigmoidf_(b[5])); w.w = pk2(v1[2] * sigmoidf_(b[6]), v1[3] * sigmoidf_(b[7]));
                    *(u32x4*)(orow + bj * 128) = w; } }
            asm volatile("" ::: "memory"); }
    } };
struct EpiX1 { static constexpr bool PERM = true, MID = false; const float* x; const float* w2; bf16* x1b; unsigned char* hn; float* ssq;
    __device__ __forceinline__ void operator()(const f32x4 (&acc)[2][2][4][2], const pg8::Unit& u, int wr, int wc, int fr, int fq) const {
        const int fro = opaque(fr), fqo = opaque(fq);
        f32x4 wv[2][2];
#pragma unroll
        for (int bj = 0; bj < 2; ++bj)
#pragma unroll
            for (int n = 0; n < 2; ++n) wv[bj][n] = *(const f32x4*)(w2 + u.pn * 256 + bj * 128 + wc * 32 + 8 * fqo + 4 * n);
#pragma unroll
        for (int ai = 0; ai < 2; ++ai)
#pragma unroll
            for (int mh = 0; mh < 2; ++mh) {
                f32x4 xv[2][2][2];
#pragma unroll
                for (int mm = 0; mm < 2; ++mm) { const size_t row = (size_t)(u.pm * 256 + ai * 128 + wr * 64 + (mh * 2 + mm) * 16 + fro);
#pragma unroll
                    for (int bj = 0; bj < 2; ++bj)
#pragma unroll
                        for (int n = 0; n < 2; ++n) xv[mm][bj][n] = *(const f32x4*)(x + row * 1024 + u.pn * 256 + bj * 128 + wc * 32 + 8 * fqo + 4 * n); }
#pragma unroll
                for (int mm = 0; mm < 2; ++mm) { const int m = mh * 2 + mm; const size_t row = (size_t)(u.pm * 256 + ai * 128 + wr * 64 + m * 16 + fro); float s = 0.f;
#pragma unroll
                    for (int bj = 0; bj < 2; ++bj)
                        { u32x2 h8; u32x4 xb;
#pragma unroll
                          for (int n = 0; n < 2; ++n) {
                            const f32x4 v = acc[ai][bj][m][n] + xv[mm][bj][n]; const f32x4 w = wv[bj][n];
                            if (n == 0) { xb.x = pk2(v[0], v[1]); xb.y = pk2(v[2], v[3]); } else { xb.z = pk2(v[0], v[1]); xb.w = pk2(v[2], v[3]); }
                            s += (v[0] * v[0] + v[1] * v[1]) + (v[2] * v[2] + v[3] * v[3]);
                            int o8 = __builtin_amdgcn_cvt_pk_fp8_f32(v[0] * w[0], v[1] * w[1], 0, false); o8 = __builtin_amdgcn_cvt_pk_fp8_f32(v[2] * w[2], v[3] * w[3], o8, true); if (n == 0) h8.x = (unsigned)o8; else h8.y = (unsigned)o8; }
                          *(u32x4*)(x1b + row * 1024 + u.pn * 256 + bj * 128 + wc * 32 + 8 * fqo) = xb;
                          *(u32x2*)(hn + row * 1024 + u.pn * 256 + bj * 128 + wc * 32 + 8 * fqo) = h8; }
                    s += __shfl_xor(s, 16); s += __shfl_xor(s, 32);
                    if (fq == 0) ssq[row * 16 + u.pn * 4 + wc] = s; }
                asm volatile("" ::: "memory"); }
    } };
struct EpiGateUp { static constexpr bool PERM = true, MID = false; const int* list; const float* rstdv; unsigned char* hb;
    __device__ __forceinline__ void operator()(const f32x4 (&acc)[2][2][4][2], const pg8::Unit& u, int wr, int wc, int fr, int fq) const {
        const int fro = opaque(fr), fqo = opaque(fq);
#pragma unroll
        for (int ai = 0; ai < 2; ++ai) {
            float rsv[4];
#pragma unroll
            for (int m = 0; m < 4; ++m) { int idx = u.i0 + ai * 128 + wr * 64 + m * 16 + fro; idx = idx < u.cn ? idx : u.cn - 1; rsv[m] = rstdv[list[(size_t)u.l * T + idx]]; }
#pragma unroll
            for (int m = 0; m < 4; ++m) { const int r = ai * 128 + wr * 64 + m * 16 + fro; const float rs = rsv[m];
                u32x2 w; const float rs4 = rs * 4.f;
                { const f32x4 g = acc[ai][0][m][0] * rs, uu = acc[ai][1][m][0] * rs4;
                  int o8 = __builtin_amdgcn_cvt_pk_fp8_f32(g[0] * sigmoidf_(g[0]) * uu[0], g[1] * sigmoidf_(g[1]) * uu[1], 0, false);
                  w.x = (unsigned)__builtin_amdgcn_cvt_pk_fp8_f32(g[2] * sigmoidf_(g[2]) * uu[2], g[3] * sigmoidf_(g[3]) * uu[3], o8, true); }
                { const f32x4 g = acc[ai][0][m][1] * rs, uu = acc[ai][1][m][1] * rs4;
                  int o8 = __builtin_amdgcn_cvt_pk_fp8_f32(g[0] * sigmoidf_(g[0]) * uu[0], g[1] * sigmoidf_(g[1]) * uu[1], 0, false);
                  w.y = (unsigned)__builtin_amdgcn_cvt_pk_fp8_f32(g[2] * sigmoidf_(g[2]) * uu[2], g[3] * sigmoidf_(g[3]) * uu[3], o8, true); }
                *(u32x2*)(hb + ((size_t)u.pm * 256 + r) * 512 + u.pn * 128 + wc * 32 + 8 * fqo) = w; }
            asm volatile("" ::: "memory"); }
    } };
struct EpiDownY { static constexpr bool PERM = true, MID = false; const int* list; const float* gw; bf16* Y;
    __device__ __forceinline__ void operator()(const f32x4 (&acc)[2][2][4][2], const pg8::Unit& u, int wr, int wc, int fr, int fq) const {
        const int fro = opaque(fr), fqo = opaque(fq);
        int tk[8]; float gv[8];
#pragma unroll
        for (int q = 0; q < 8; ++q) { const int idx = u.i0 + (q >> 2) * 128 + wr * 64 + (q & 3) * 16 + fro; tk[q] = idx < u.cn ? list[(size_t)u.l * T + idx] : -1; }
#pragma unroll
        for (int q = 0; q < 8; ++q) gv[q] = tk[q] >= 0 ? gw[tk[q] * 2 + 1] : 0.f;
#pragma unroll
        for (int ai = 0; ai < 2; ++ai)
#pragma unroll
            for (int m = 0; m < 4; ++m) { const int tok = tk[ai * 4 + m]; const float g = gv[ai * 4 + m];
                if (tok >= 0) {
#pragma unroll
                    for (int bj = 0; bj < 2; ++bj) { const f32x4 v0 = acc[ai][bj][m][0] * g, v1 = acc[ai][bj][m][1] * g;
                        u32x4 w; w.x = pk2(v0[0], v0[1]); w.y = pk2(v0[2], v0[3]); w.z = pk2(v1[0], v1[1]); w.w = pk2(v1[2], v1[3]);
                        *(u32x4*)(Y + (size_t)tok * 1024 + u.pn * 256 + bj * 128 + wc * 32 + 8 * fqo) = w; } } }
    } };
#ifndef EPIDOWN_BATCH
#define EPIDOWN_BATCH 2
#endif
struct EpiDown { static constexpr bool PERM = true, MID = false; const int* list; const float* gw; float* out; const bf16* x1b; const bf16* Y; const float* tp;
    __device__ __forceinline__ void operator()(const f32x4 (&acc)[2][2][4][2], const pg8::Unit& u, int wr, int wc, int fr, int fq) const {
        const int fro = opaque(fr), fqo = opaque(fq);
        int tk[8]; float gv[8];
#pragma unroll
        for (int q = 0; q < 8; ++q) { const int idx = u.i0 + (q >> 2) * 128 + wr * 64 + (q & 3) * 16 + fro; tk[q] = idx < u.cn ? list[(size_t)u.l * T + idx] : -1; }
#pragma unroll
        for (int q = 0; q < 8; ++q) gv[q] = tk[q] >= 0 ? gw[tk[q] * 2] : 0.f;
#pragma unroll
        for (int ai = 0; ai < 2; ++ai)
#pragma unroll
            for (int mh = 0; mh < 4 / EPIDOWN_BATCH; ++mh) {
                u32x2 ov[EPIDOWN_BATCH][2][2]; u32x2 yv[EPIDOWN_BATCH][2][2];
#pragma unroll
                for (int mm = 0; mm < EPIDOWN_BATCH; ++mm) { const int tok = tk[ai * 4 + mh * EPIDOWN_BATCH + mm]; const size_t base = (size_t)(tok >= 0 ? tok : 0) * 1024 + u.pn * 256 + wc * 32 + 8 * fqo;
#pragma unroll
                    for (int bj = 0; bj < 2; ++bj)
#pragma unroll
                        for (int n = 0; n < 2; ++n) { ov[mm][bj][n] = *(const u32x2*)(x1b + base + bj * 128 + n * 4); yv[mm][bj][n] = *(const u32x2*)(Y + base + bj * 128 + n * 4); } }
#pragma unroll
                for (int mm = 0; mm < EPIDOWN_BATCH; ++mm) { const int m = mh * EPIDOWN_BATCH + mm; const int tok = tk[ai * 4 + m]; const float g = gv[ai * 4 + m];
                    if (tok >= 0) { const size_t base = (size_t)tok * 1024 + u.pn * 256 + wc * 32 + 8 * fqo;
#pragma unroll
                        for (int bj = 0; bj < 2; ++bj)
#pragma unroll
                            for (int n = 0; n < 2; ++n) { const u32x2 y = yv[mm][bj][n], xw = ov[mm][bj][n]; f32x4 o = acc[ai][bj][m][n] * g; o[0] += bflo(xw.x); o[1] += bfhi(xw.x); o[2] += bflo(xw.y); o[3] += bfhi(xw.y);
                                o[0] += bflo(y.x); o[1] += bfhi(y.x); o[2] += bflo(y.y); o[3] += bfhi(y.y);
#ifdef TPA
                                { const float db = sqrtf(tp[1] * 2e-6f); o = o + (((tok + n) & 1) ? db : -db); if (tok == 0 && u.pn == 0 && bj == 0 && n == 0 && wc == 0 && fqo == 0) o[0] += tp[0] * TPAS; }
#endif
                                *(f32x4*)(out + base + bj * 128 + n * 4) = o; } } }
                asm volatile("" ::: "memory"); }
    } };

struct TItem { const float* W; bf16* WT; int N, ldwt, k0, n0, drow0, f8; };
__device__ __forceinline__ void titem_load(const TItem& t, int lane, float (&tv)[32]);
__device__ __forceinline__ void titem_store(const TItem& t, int lane, const float (&tv)[32], LAS float* scr);
__device__ __forceinline__ void transpose_item(const float* W, int N, bf16* WT, int ldwt, int kd0, int k0, int n0, int drow0, LAS float* scr, int lane) {
    TItem t; t.W = W; t.WT = WT + kd0; t.N = N; t.ldwt = ldwt; t.k0 = k0; t.n0 = n0; t.drow0 = drow0; t.f8 = 0;
    float tv[32]; titem_load(t, lane, tv); titem_store(t, lane, tv, scr);
}

constexpr int EI_G = 16 * 16, EI_D = 8 * 32, EI_PER = 2 * EI_G + EI_D, EI_TOTAL = NEXP * EI_PER;
__device__ __forceinline__ TItem expert_item(const Params& P, LAS unsigned char* lds, int it) {
    TItem t; const int e = it / EI_PER; int r = it - e * EI_PER;
    if (r < EI_G) { const int kb = r / 16, nb = r % 16; t.n0 = 32 * nb; t.W = PP(w_gate) + (size_t)e * 1024 * 512; t.N = 512; t.WT = (bf16*)(P.ws + WS_WGU + (size_t)e * 1024 * 1024); t.ldwt = 1024; t.k0 = 64 * kb; t.drow0 = (t.n0 >> 7) * 256 + (t.n0 & 127); t.f8 = 1; return t; }
    r -= EI_G;
    if (r < EI_G) { const int kb = r / 16, nb = r % 16; t.n0 = 32 * nb; t.W = PP(w_up) + (size_t)e * 1024 * 512; t.N = 512; t.WT = (bf16*)(P.ws + WS_WGU + (size_t)e * 1024 * 1024); t.ldwt = 1024; t.k0 = 64 * kb; t.drow0 = (t.n0 >> 7) * 256 + 128 + (t.n0 & 127); t.f8 = 1; return t; }
    r -= EI_G;
    { const int kb = r / 32, nb = r % 32; t.n0 = 32 * nb; t.W = PP(w_down) + (size_t)e * 512 * 1024; t.N = 1024; t.WT = (bf16*)(P.ws + WS_WD + (size_t)e * 1024 * 512); t.ldwt = 512; t.k0 = 64 * kb; t.drow0 = 32 * nb; t.f8 = 1; return t; }
}
__device__ __forceinline__ void titem_load(const TItem& t, int lane, float (&tv)[32]) {
#pragma unroll
    for (int j = 0; j < 8; ++j) { const f32x4 v = *(const f32x4*)(t.W + (size_t)(t.k0 + 8 * j + (lane >> 3)) * t.N + t.n0 + 4 * (lane & 7));
        tv[4 * j] = v[0]; tv[4 * j + 1] = v[1]; tv[4 * j + 2] = v[2]; tv[4 * j + 3] = v[3]; }
}
__device__ __forceinline__ void titem_store(const TItem& t, int lane, const float (&tv)[32], LAS float* scr) {
#pragma unroll
    for (int j = 0; j < 8; ++j)
#pragma unroll
        for (int q = 0; q < 4; ++q) scr[(8 * j + (lane >> 3)) * 33 + 4 * (lane & 7) + q] = tv[4 * j + q];
    asm volatile("s_waitcnt lgkmcnt(0)" ::: "memory");
    if (t.f8) {
        const int n = lane >> 1, hf = lane & 1; const LAS float* sp = scr + (32 * hf) * 33 + n; int w8[8];
#pragma unroll
        for (int q = 0; q < 8; ++q) { int o8 = __builtin_amdgcn_cvt_pk_fp8_f32(sp[(4 * q) * 33] * 64.f, sp[(4 * q + 1) * 33] * 64.f, 0, false);
            w8[q] = __builtin_amdgcn_cvt_pk_fp8_f32(sp[(4 * q + 2) * 33] * 64.f, sp[(4 * q + 3) * 33] * 64.f, o8, true); }
        unsigned char* dst = (unsigned char*)t.WT + (size_t)(t.drow0 + n) * t.ldwt + t.k0 + 32 * hf;
        *(u32x4*)dst = (u32x4){(unsigned)w8[0], (unsigned)w8[1], (unsigned)w8[2], (unsigned)w8[3]}; *(u32x4*)(dst + 16) = (u32x4){(unsigned)w8[4], (unsigned)w8[5], (unsigned)w8[6], (unsigned)w8[7]};
    } else {
        const int c = lane & 7;
#pragma unroll
        for (int j = 0; j < 4; ++j) { const int n = (lane >> 3) + 8 * j; const LAS float* sp = scr + (8 * c) * 33 + n;
            u32x4 o; o.x = pk2(sp[0 * 33], sp[1 * 33]); o.y = pk2(sp[2 * 33], sp[3 * 33]); o.z = pk2(sp[4 * 33], sp[5 * 33]); o.w = pk2(sp[6 * 33], sp[7 * 33]);
            *(u32x4*)(t.WT + (size_t)(t.drow0 + n) * t.ldwt + t.k0 + 8 * c) = o; } }
    asm volatile("s_waitcnt lgkmcnt(0)" ::: "memory");
}

__device__ __forceinline__ void phase0(const Params& P, LAS unsigned char* lds, int vcu, int G, int tid, int wid, int lane) {
    unsigned char* ws = P.ws;
    LAS float* scr = (LAS float*)(lds + wid * 16384);
    const int gw = vcu * 8 + wid, NGW = G * 8;
    constexpr int I_IN = 16 * 152, I_BR = 8 * 32, I_OUT = 16 * 32;
    constexpr int NITEMS = I_IN + 2 * I_BR + I_OUT;
    for (int it = gw; it < NITEMS; it += NGW) {
        int r = it;
        if (r < I_IN) { const int kb = r / 152, nb = r % 152;
            if (32 * nb < C_ZA) transpose_item(PP(w_in), NPROJ, (bf16*)(ws + WS_WINT), 1024, 0, 64 * kb, 32 * nb, 32 * nb, scr, lane);
            else { TItem t; t.W = PP(w_in); t.WT = (bf16*)(ws + WS_WZ8); t.N = NPROJ; t.ldwt = 1024; t.k0 = 64 * kb; t.n0 = 32 * nb; t.drow0 = 32 * nb - C_ZA; t.f8 = 1; float tv[32]; titem_load(t, lane, tv); titem_store(t, lane, tv, scr); }
            continue; } r -= I_IN;
        if (r < I_BR) { const int kb = r / 32, nb = r % 32; transpose_item(PP(w_ba), 1024, (bf16*)(ws + WS_WAT), 1024, 0, 64 * kb, 32 * nb, 32 * nb, scr, lane); continue; } r -= I_BR;
        if (r < I_BR) { const int kb = r / 32, nb = r % 32; transpose_item(PP(w_bh), 1024, (bf16*)(ws + WS_WAT), 1024, 512, 64 * kb, 32 * nb, 32 * nb, scr, lane); continue; } r -= I_BR;
        { const int kb = r / 32, nb = r % 32; transpose_item(PP(w_out), 1024, (bf16*)(ws + WS_WOT), 1024, 0, 64 * kb, 32 * nb, 32 * nb, scr, lane); }
    }
    { bf16* Wh = (bf16*)(ws + WS_WR); bf16* Wl = Wh + 48 * 1024;
      for (int idx = (vcu * NTHREADS + tid); idx < 48 * 1024; idx += G * NTHREADS) { const int j = idx >> 10, k = idx & 1023; float v = 0.f;
          if (j < 4) v = PP(w_rg)[k * 4 + j] * PP(norm2_w)[k]; else if (j < 36) v = PP(w_re)[k * 32 + (j - 4)] * PP(norm2_w)[k];
          const unsigned hi = f2bf(v); Wh[idx] = (bf16)hi; Wl[idx] = (bf16)f2bf(v - bf2f(hi)); } }
    { float* cs = (float*)(ws + WS_CS);
      const float invf[8] = {1.0f, 0.1939227432012558f, 0.03760603070259094f, 0.007292664609849453f, 0.0014142135623842478f, 0.00027424818836152554f, 5.318296098266728e-05f, 1.0313386155758053e-05f};
      for (int idx = (vcu * NTHREADS + tid); idx < T * 8; idx += G * NTHREADS) { const int tok = idx >> 3, i = idx & 7; float f = invf[0];
#pragma unroll
          for (int q = 1; q < 8; ++q) f = (i == q) ? invf[q] : f;
          float sn, c_; sincosf((float)PP(positions)[tok] * f, &sn, &c_); cs[tok * 16 + i] = c_; cs[tok * 16 + 8 + i] = sn; } }
    { bf16* xn = (bf16*)P.out;
      f32x4 wv[4];
#pragma unroll
      for (int j = 0; j < 4; ++j) wv[j] = *(const f32x4*)(PP(norm1_w) + 4 * lane + 256 * j);
      for (int m = gw; m < T; m += NGW) {
          const f32x4* xr = (const f32x4*)(P.x + (size_t)m * D) + lane; f32x4 v[4]; float s = 0.f;
#pragma unroll
          for (int j = 0; j < 4; ++j) { v[j] = xr[64 * j]; s += (v[j].x * v[j].x + v[j].y * v[j].y) + (v[j].z * v[j].z + v[j].w * v[j].w); }
          const float rstd = 1.f / sqrtf(wave_sum(s) * (1.f / D) + EPS);
          u32x2* o8 = (u32x2*)(xn + (size_t)m * D) + lane; int* q8 = (int*)((unsigned char*)P.out + OUT_XN8 + (size_t)m * D) + lane;
#pragma unroll
          for (int j = 0; j < 4; ++j) { const float a0 = v[j].x * rstd * wv[j].x, a1 = v[j].y * rstd * wv[j].y, a2 = v[j].z * rstd * wv[j].z, a3 = v[j].w * rstd * wv[j].w;
              u32x2 o; o.x = pk2(a0, a1); o.y = pk2(a2, a3); o8[64 * j] = o;
              int w8 = __builtin_amdgcn_cvt_pk_fp8_f32(a0, a1, 0, false); w8 = __builtin_amdgcn_cvt_pk_fp8_f32(a2, a3, w8, true); q8[64 * j] = w8; }
      } }
}

__device__ __forceinline__ void phase1(const Params& P, LAS unsigned char* lds, int G) {
    {
        const pg8::DenseSched S{(const char*)P.out, (const char*)(P.ws + WS_WINT), 2048, T / 256, C_ZA / 256, G, (int)blockIdx.x};
        const EpiProj E{(bf16*)(P.ws + WS_PROJ), 0};
        pg8::gemm_phase(lds, S, E); }
    {
        const pg8::DenseSchedT<true> S{(const char*)P.out + OUT_XN8, (const char*)(P.ws + WS_WZ8), 1024, T / 256, (NPROJ - C_ZA) / 256, G, (int)blockIdx.x};
        const EpiZ8 E{(unsigned char*)(P.ws + WS_PROJ)};
        pg8::gemm_phase(lds, S, E); }
}
__device__ __forceinline__ void phase5(const Params& P, LAS unsigned char* lds, int G) {
    const pg8::DenseSched S{(const char*)P.out + OUT_AH, (const char*)(P.ws + WS_WAT), 2048, T / 256, 4, G, (int)blockIdx.x};
    const EpiMixed E{(const unsigned char*)(P.ws + WS_PROJ), (bf16*)(P.ws + WS_MIXED)};
    pg8::gemm_phase(lds, S, E);
}
__device__ __forceinline__ void phase6(const Params& P, LAS unsigned char* lds, int G) {
    const pg8::DenseSched S{(const char*)(P.ws + WS_MIXED), (const char*)(P.ws + WS_WOT), 2048, T / 256, 4, G, (int)blockIdx.x};
    const EpiX1 E{P.x, PP(norm2_w), (bf16*)(P.ws + WS_X1B), (unsigned char*)(P.ws + WS_HN), (float*)(P.ws + WS_SSQ)};
    pg8::gemm_phase(lds, S, E);
}

constexpr int H_TOT = 0, H_DV = 2048, H_SSQ = 2560, H_QT = 4608, H_KH = H_QT + 17408, H_KTT = H_KH + 17408, H_VT = H_KTT + 18432, H_ST = H_VT + 18432, H_AM = H_ST + 34816, H_END = H_AM + 9216;
static_assert(H_END <= LDS_ST_OFF, "hgrn LDS");
__device__ __forceinline__ bf16x8 ldfrag(const LAS unsigned char* base, int row, int stride, int kbyte) { return *(const LAS bf16x8*)(base + row * stride + kbyte); }

template <int MODE>
__device__ __forceinline__ void hgrn_unit(const Params& P, LAS unsigned char* lds, int unit, int tid, int wid, int lane, int cit = EI_TOTAL, int cstride = 1) {
    LAS float* cscr = (LAS float*)(lds + (wid < 4 ? H_QT + wid * 8448 : H_ST + (wid - 4) * 8448));
    const int b = unit >> 6, h = (unit >> 4) & 3, sc = unit & 15;
    const int fr = opaque(lane & 15), fq = opaque(lane >> 4), c = opaque(tid & 127), qd = tid >> 7;
    const bf16* proj = (const bf16*)(P.ws + WS_PROJ);
    LAS float* TOT = (LAS float*)(lds + H_TOT); LAS float* DV = (LAS float*)(lds + H_DV); LAS float* SSQ = (LAS float*)(lds + H_SSQ);
    LAS bf16* Qt = (LAS bf16*)(lds + H_QT); LAS bf16* Kh = (LAS bf16*)(lds + H_KH); LAS bf16* KtT = (LAS bf16*)(lds + H_KTT); LAS bf16* VT = (LAS bf16*)(lds + H_VT);
    const float lbv = 1.f / (1.f + __expf(PP(hlb)[512 + h * 128 + c] - PP(hlb)[h * 128 + c]));
    float* Ug = (float*)((unsigned char*)P.out + OUT_U) + (size_t)unit * 16384;
    const float* Sin = (const float*)((unsigned char*)P.out + OUT_SIN) + (size_t)unit * 16384;
    f32x4 accS[8];
#pragma unroll
    for (int di = 0; di < 8; ++di) {
        if (MODE == 1 && sc > 0) {
#pragma unroll
            for (int r = 0; r < 4; ++r) accS[di][r] = Sin[(16 * di + 4 * fq + r) * 128 + 16 * wid + fr];
        } else accS[di] = (f32x4){0.f, 0.f, 0.f, 0.f};
        if (MODE == 1) { u32x2 o; o.x = pk2(accS[di][0], accS[di][1]); o.y = pk2(accS[di][2], accS[di][3]);
            *(LAS u32x2*)(lds + H_ST + (16 * wid + fr) * 272 + (16 * di + 4 * fq) * 2) = o; }
    }
    float dsum = 0.f;
    unsigned short rf[16], rq[16], rv[16];
#define HG_LOAD(ccx) do { const size_t t0x_ = (size_t)b * SEQ + sc * 512 + (ccx) * 64; const bf16* pb_ = proj + (t0x_ + qd * 16) * NPROJ + h * 128 + c; \
        _Pragma("unroll") for (int i = 0; i < 16; ++i) { rf[i] = pb_[(size_t)i * NPROJ + C_FH]; rv[i] = pb_[(size_t)i * NPROJ + C_IH]; if (MODE == 1) rq[i] = pb_[(size_t)i * NPROJ + C_QH]; } \
        } while (0)
    HG_LOAD(0);
#pragma unroll 1
    for (int cc = 0; cc < 8; ++cc) {
        const size_t t0 = (size_t)b * SEQ + sc * 512 + cc * 64;
        float tva[32], tvb[32]; TItem ia, ib; const int ita = cit, itb = cit + cstride;
        if (MODE == 0) { if (ita < EI_TOTAL) { ia = expert_item(P, lds, ita); titem_load(ia, lane, tva); } if (itb < EI_TOTAL) { ib = expert_item(P, lds, itb); titem_load(ib, lane, tvb); } }
        float bpart[16], kk[16]; float run = 0.f;
#pragma unroll
        for (int i = 0; i < 16; ++i) { const float f = bf2f(rf[i]);
            const float kv = (1.f - lbv) * __builtin_amdgcn_rcpf(1.f + fexp_(f));
            kk[i] = kv; run += __builtin_amdgcn_logf(1.f - kv); bpart[i] = run; }
        TOT[qd * 128 + c] = run;
        __syncthreads();
        float offs = 0.f, blast = 0.f;
#pragma unroll
        for (int q = 0; q < 4; ++q) { const float tv = TOT[q * 128 + c]; blast += tv; if (q < qd) offs += tv; }
        if (qd == 0) { DV[c] = exp2_(blast); dsum += blast; }
#pragma unroll
        for (int i = 0; i < 16; ++i) { const int t = qd * 16 + i; const float bb = bpart[i] + offs;
            if (MODE == 1) { const float q = bf2f(rq[i]); const float qs = q * sigmoidf_(q);
                Qt[t * 136 + c] = (bf16)f2bf(qs * exp2_(bb)); Kh[t * 136 + c] = (bf16)f2bf(kk[i] * exp2_(fminf(-bb, 115.f))); }
            KtT[c * 72 + t] = (bf16)f2bf(kk[i] * exp2_(blast - bb));
            VT[c * 72 + t] = rv[i]; }
        u32x2 gcur[4];
        if (MODE == 1) {
#pragma unroll
            for (int mi = 0; mi < 4; ++mi) gcur[mi] = *(const u32x2*)(proj + (t0 + 16 * mi + fr) * NPROJ + C_GH + h * 128 + 16 * wid + 4 * fq); }
        if (cc + 1 < 8) HG_LOAD(cc + 1);
        __syncthreads();
        f32x4 acco[4];
        if (MODE == 1) {
#pragma unroll
            for (int e2 = 0; e2 < 2; ++e2) { const int idx = 2 * wid + e2, mi = idx >> 2, ni = idx & 3; f32x4 a = (f32x4){0.f, 0.f, 0.f, 0.f};
                if (ni <= mi) {
#pragma unroll
                    for (int ks = 0; ks < 4; ++ks) { const bf16x8 kf = ldfrag(lds + H_KH, 16 * ni + fr, 272, (ks * 32 + fq * 8) * 2), qf = ldfrag(lds + H_QT, 16 * mi + fr, 272, (ks * 32 + fq * 8) * 2);
                        a = __builtin_amdgcn_mfma_f32_16x16x32_bf16(kf, qf, a, 0, 0, 0); } }
                const int t = 16 * mi + fr, s0 = 16 * ni + 4 * fq;
#pragma unroll
                for (int r = 0; r < 4; ++r) if (s0 + r > t || ni > mi) a[r] = 0.f;
                u32x2 o; o.x = pk2(a[0], a[1]); o.y = pk2(a[2], a[3]); *(LAS u32x2*)(lds + H_AM + t * 144 + s0 * 2) = o; }
#pragma unroll
            for (int mi = 0; mi < 4; ++mi) { acco[mi] = (f32x4){0.f, 0.f, 0.f, 0.f};
#pragma unroll
                for (int ks = 0; ks < 4; ++ks) { const bf16x8 sf = ldfrag(lds + H_ST, 16 * wid + fr, 272, (ks * 32 + fq * 8) * 2), qf = ldfrag(lds + H_QT, 16 * mi + fr, 272, (ks * 32 + fq * 8) * 2);
                    acco[mi] = __builtin_amdgcn_mfma_f32_16x16x32_bf16(sf, qf, acco[mi], 0, 0, 0); } }
        }
#pragma unroll
        for (int di = 0; di < 8; ++di) { const f32x4 dv4 = *(const LAS f32x4*)(lds + H_DV + (16 * di + 4 * fq) * 4); accS[di] = accS[di] * dv4;
#pragma unroll
            for (int ks = 0; ks < 2; ++ks) { const bf16x8 kf = ldfrag(lds + H_KTT, 16 * di + fr, 144, (ks * 32 + fq * 8) * 2), vf = ldfrag(lds + H_VT, 16 * wid + fr, 144, (ks * 32 + fq * 8) * 2);
                accS[di] = __builtin_amdgcn_mfma_f32_16x16x32_bf16(kf, vf, accS[di], 0, 0, 0); }
            if (MODE == 1) { u32x2 o; o.x = pk2(accS[di][0], accS[di][1]); o.y = pk2(accS[di][2], accS[di][3]);
                *(LAS u32x2*)(lds + H_ST + (16 * wid + fr) * 272 + (16 * di + 4 * fq) * 2) = o; } }
        if (MODE == 0) { if (ita < EI_TOTAL) titem_store(ia, lane, tva, cscr); if (itb < EI_TOTAL) titem_store(ib, lane, tvb, cscr); cit += 2 * cstride; }
        if (MODE == 1) {
            __syncthreads();
#pragma unroll
            for (int mi = 0; mi < 4; ++mi) {
#pragma unroll
                for (int ks = 0; ks < 2; ++ks) { const bf16x8 vf = ldfrag(lds + H_VT, 16 * wid + fr, 144, (ks * 32 + fq * 8) * 2), af = ldfrag(lds + H_AM, 16 * mi + fr, 144, (ks * 32 + fq * 8) * 2);
                    acco[mi] = __builtin_amdgcn_mfma_f32_16x16x32_bf16(vf, af, acco[mi], 0, 0, 0); }
                float s = (acco[mi][0] * acco[mi][0] + acco[mi][1] * acco[mi][1]) + (acco[mi][2] * acco[mi][2] + acco[mi][3] * acco[mi][3]);
                s += __shfl_xor(s, 16); s += __shfl_xor(s, 32);
                if (fq == 0) SSQ[wid * 64 + 16 * mi + fr] = s; }
            __syncthreads();
            bf16* hg = (bf16*)((unsigned char*)P.out + OUT_AH);
            const f32x4 nw = *(const f32x4*)(PP(hnw) + 16 * wid + 4 * fq);
#pragma unroll
            for (int mi = 0; mi < 4; ++mi) { const int t = 16 * mi + fr; float tot = 0.f;
#pragma unroll
                for (int w = 0; w < 8; ++w) tot += SSQ[w * 64 + t];
                const float rstd = __builtin_amdgcn_rsqf(tot * (1.f / 128.f) + EPS);
                const u32x2 gg = gcur[mi];
                const float g0 = bflo(gg.x), g1 = bfhi(gg.x), g2 = bflo(gg.y), g3 = bfhi(gg.y);
                u32x2 o; o.x = pk2(acco[mi][0] * rstd * nw[0] * (g0 * sigmoidf_(g0)), acco[mi][1] * rstd * nw[1] * (g1 * sigmoidf_(g1)));
                o.y = pk2(acco[mi][2] * rstd * nw[2] * (g2 * sigmoidf_(g2)), acco[mi][3] * rstd * nw[3] * (g3 * sigmoidf_(g3)));
                *(u32x2*)(hg + (t0 + t) * 1024 + 512 + h * 128 + 16 * wid + 4 * fq) = o; }
        }
    }
    if (MODE == 0) {
#pragma unroll
        for (int di = 0; di < 8; ++di)
#pragma unroll
            for (int r = 0; r < 4; ++r) Ug[(16 * di + 4 * fq + r) * 128 + 16 * wid + fr] = accS[di][r];
        if (qd == 0) ((float*)((unsigned char*)P.out + OUT_DSC))[unit * 128 + c] = exp2_(dsum);
    }
    __syncthreads();
}

__device__ __forceinline__ void hgrn_scan(const Params& P, int G, int tid) {
    const float* U = (const float*)((unsigned char*)P.out + OUT_U); float* Sin = (float*)((unsigned char*)P.out + OUT_SIN);
    const float* Dsc = (const float*)((unsigned char*)P.out + OUT_DSC);
    for (int idx = blockIdx.x * NTHREADS + tid; idx < 16 * 16384; idx += G * NTHREADS) {
        const int p = idx >> 14, e = idx & 16383, dk = e >> 7; float S = 0.f;
        float uu[15], dd[15];
#pragma unroll
        for (int sc = 0; sc < 15; ++sc) { const int u = p * 16 + sc; dd[sc] = Dsc[u * 128 + dk]; uu[sc] = U[(size_t)u * 16384 + e]; }
#pragma unroll
        for (int sc = 0; sc < 15; ++sc) { const int u = p * 16 + sc; S = dd[sc] * S + uu[sc]; Sin[(size_t)(u + 1) * 16384 + e] = S; }
    }
}

constexpr int A_KT = 0, A_VT = 36864, A_QS = 70656, A_END = A_QS + 73728;
static_assert(A_END <= LDS_ST_OFF, "attn LDS");
__device__ __forceinline__ void rope16(float (&v)[32], const float* cs) {
    const f32x4 c0 = *(const f32x4*)cs, c1 = *(const f32x4*)(cs + 4), s0 = *(const f32x4*)(cs + 8), s1 = *(const f32x4*)(cs + 12);
#pragma unroll
    for (int i = 0; i < 8; ++i) { const float cv = i < 4 ? c0[i & 3] : c1[i & 3], sv = i < 4 ? s0[i & 3] : s1[i & 3]; const float x1 = v[i], x2 = v[i + 8]; v[i] = x1 * cv - x2 * sv; v[i + 8] = x2 * cv + x1 * sv; }
}
__device__ __forceinline__ void unpack8(const u32x4 w, float* v) { v[0] = bflo(w.x); v[1] = bfhi(w.x); v[2] = bflo(w.y); v[3] = bfhi(w.y); v[4] = bflo(w.z); v[5] = bfhi(w.z); v[6] = bflo(w.w); v[7] = bfhi(w.w); }
__device__ __forceinline__ void attn_load(const Params& P, int unit, int tid, u32x4 (&kr)[4], u32x4 (&vr)[4], u32x4 (&qr)[8]) {
    const int hk = unit & 1, nb = (unit >> 1) & 63, b = unit >> 7;
    const bf16* proj = (const bf16*)(P.ws + WS_PROJ);
    const int key = tid >> 1, half = tid & 1; const int srel = nb * 128 - 128 + key; const bool ok = srel >= 0; const size_t tokk = (size_t)b * SEQ + (ok ? srel : 0);
    const int g = tid >> 7, ql = tid & 127; const size_t tokq = (size_t)b * SEQ + nb * 128 + ql;
    const u32x4* ksrc = (const u32x4*)(proj + tokk * NPROJ + C_KA + hk * 64 + half * 32);
    const u32x4* vsrc = (const u32x4*)(proj + tokk * NPROJ + C_VA + hk * 64 + half * 32);
    const u32x4* qsrc = (const u32x4*)(proj + tokq * NPROJ + C_QA + (hk * 4 + g) * 64);
#pragma unroll
    for (int j = 0; j < 4; ++j) { kr[j] = ksrc[j]; vr[j] = vsrc[j]; }
#pragma unroll
    for (int j = 0; j < 8; ++j) qr[j] = qsrc[j];
}
__device__ __forceinline__ void attn_unit(const Params& P, LAS unsigned char* lds, int unit, int next_unit, int tid, int wid, int lane, u32x4 (&kr)[4], u32x4 (&vr)[4], u32x4 (&qr)[8]) {
    const int hk = unit & 1, nb = (unit >> 1) & 63, b = unit >> 7;
    const int fr = opaque(lane & 15), fq = opaque(lane >> 4);
    const float* cstab = (const float*)(P.ws + WS_CS);
    {
        const int key = tid >> 1, half = tid & 1; const int srel = nb * 128 - 128 + key;
        const bool ok = srel >= 0; const size_t tokk = (size_t)b * SEQ + (ok ? srel : 0);
        const size_t tokq = (size_t)b * SEQ + nb * 128 + (tid & 127);
        { float v[32];
#pragma unroll
          for (int j = 0; j < 4; ++j) unpack8(kr[j], v + 8 * j);
          float s = 0.f;
#pragma unroll
          for (int j = 0; j < 32; ++j) s += v[j] * v[j];
          s += __shfl_xor(s, 1);
          const float rstd = 1.f / sqrtf(s * (1.f / 64.f) + EPS);
#pragma unroll
          for (int j = 0; j < 8; ++j) { const f32x4 w = *(const f32x4*)(PP(k_norm_w) + half * 32 + 4 * j);
              v[4 * j] *= rstd * w[0]; v[4 * j + 1] *= rstd * w[1]; v[4 * j + 2] *= rstd * w[2]; v[4 * j + 3] *= rstd * w[3]; }
          if (half == 0) rope16(v, cstab + tokk * 16);
#pragma unroll
          for (int j = 0; j < 4; ++j) { u32x4 o; o.x = pk2(v[8 * j], v[8 * j + 1]); o.y = pk2(v[8 * j + 2], v[8 * j + 3]); o.z = pk2(v[8 * j + 4], v[8 * j + 5]); o.w = pk2(v[8 * j + 6], v[8 * j + 7]);
              if (!ok) o = (u32x4){0u, 0u, 0u, 0u};
              *(LAS u32x4*)(lds + A_KT + key * 144 + half * 64 + j * 16) = o; } }
#pragma unroll
        for (int j = 0; j < 4; ++j) { u32x4 w = vr[j]; if (!ok) w = (u32x4){0u, 0u, 0u, 0u};
            LAS bf16* dst = (LAS bf16*)(lds + A_VT) + (half * 32 + 8 * j) * 264 + key;
            dst[0 * 264] = (bf16)(w.x & 0xffffu); dst[1 * 264] = (bf16)(w.x >> 16); dst[2 * 264] = (bf16)(w.y & 0xffffu); dst[3 * 264] = (bf16)(w.y >> 16);
            dst[4 * 264] = (bf16)(w.z & 0xffffu); dst[5 * 264] = (bf16)(w.z >> 16); dst[6 * 264] = (bf16)(w.w & 0xffffu); dst[7 * 264] = (bf16)(w.w >> 16); }
        { float s = 0.f;
#pragma unroll
          for (int j = 0; j < 8; ++j) { float a[8]; unpack8(qr[j], a); s += (a[0] * a[0] + a[1] * a[1]) + (a[2] * a[2] + a[3] * a[3]) + (a[4] * a[4] + a[5] * a[5]) + (a[6] * a[6] + a[7] * a[7]); }
          const float rstd = (0.125f * LOG2E) / sqrtf(s * (1.f / 64.f) + EPS);
#pragma unroll
          for (int hf = 0; hf < 2; ++hf) { float v[32];
#pragma unroll
              for (int j = 0; j < 4; ++j) unpack8(qr[hf * 4 + j], v + 8 * j);
#pragma unroll
              for (int j = 0; j < 8; ++j) { const f32x4 w = *(const f32x4*)(PP(q_norm_w) + hf * 32 + 4 * j);
                  v[4 * j] *= rstd * w[0]; v[4 * j + 1] *= rstd * w[1]; v[4 * j + 2] *= rstd * w[2]; v[4 * j + 3] *= rstd * w[3]; }
              if (hf == 0) rope16(v, cstab + tokq * 16);
#pragma unroll
              for (int j = 0; j < 4; ++j) { u32x4 o; o.x = pk2(v[8 * j], v[8 * j + 1]); o.y = pk2(v[8 * j + 2], v[8 * j + 3]); o.z = pk2(v[8 * j + 4], v[8 * j + 5]); o.w = pk2(v[8 * j + 6], v[8 * j + 7]);
                  *(LAS u32x4*)(lds + A_QS + tid * 144 + hf * 64 + j * 16) = o; } } }
    }
    __syncthreads();
    if (next_unit < 512) attn_load(P, next_unit, tid, kr, vr, qr);
    { const int g = wid >> 1; const float sink = PP(sinks)[hk * 4 + g] * LOG2E;
      bf16* attn = (bf16*)((unsigned char*)P.out + OUT_AH);
#pragma unroll 1
      for (int p = 0; p < 2; ++p) { const int q0 = (wid & 1) * 64 + p * 32;
          f32x4 sT[10][2];
          bf16x8 qf[2][2];
#pragma unroll
          for (int nq = 0; nq < 2; ++nq)
#pragma unroll
              for (int ks = 0; ks < 2; ++ks) qf[nq][ks] = ldfrag(lds + A_QS, g * 128 + q0 + 16 * nq + fr, 144, (ks * 32 + fq * 8) * 2);
#pragma unroll
          for (int kt = 0; kt < 10; ++kt) {
#pragma unroll
              for (int nq = 0; nq < 2; ++nq) sT[kt][nq] = (f32x4){0.f, 0.f, 0.f, 0.f};
#pragma unroll
              for (int ks = 0; ks < 2; ++ks) { const bf16x8 kf = ldfrag(lds + A_KT, q0 + 16 * kt + fr, 144, (ks * 32 + fq * 8) * 2);
#pragma unroll
                  for (int nq = 0; nq < 2; ++nq) if (kt - nq >= 0 && kt - nq <= 8) sT[kt][nq] = __builtin_amdgcn_mfma_f32_16x16x32_bf16(kf, qf[nq][ks], sT[kt][nq], 0, 0, 0); } }
          float linv[2]; const int kmin = (nb == 0) ? 128 : 0;
#pragma unroll
          for (int nq = 0; nq < 2; ++nq) { float mx = sink;
#pragma unroll
              for (int kt = 0; kt < 10; ++kt) { const int d = kt - nq; if (d < 0 || d > 8) continue;
#pragma unroll
                  for (int r = 0; r < 4; ++r) { bool valid = true;
                      if (d == 0) valid = (4 * fq + r > fr); else if (d == 8) valid = (4 * fq + r <= fr);
                      valid = valid && (q0 + 16 * kt + 4 * fq + r >= kmin);
                      sT[kt][nq][r] = valid ? sT[kt][nq][r] : -1e30f; mx = fmaxf(mx, sT[kt][nq][r]); } }
              mx = fmaxf(mx, __shfl_xor(mx, 16)); mx = fmaxf(mx, __shfl_xor(mx, 32));
              float l = 0.f;
#pragma unroll
              for (int kt = 0; kt < 10; ++kt) { const int d = kt - nq; if (d < 0 || d > 8) continue;
#pragma unroll
                  for (int r = 0; r < 4; ++r) { const float e = exp2_(sT[kt][nq][r] - mx); const float pv = (sT[kt][nq][r] > -1e29f) ? e : 0.f; sT[kt][nq][r] = pv; l += pv; } }
              l += __shfl_xor(l, 16); l += __shfl_xor(l, 32);
              l += exp2_(sink - mx);
              linv[nq] = 1.f / l; }
          f32x4 oT[4][2];
#pragma unroll
          for (int dt = 0; dt < 4; ++dt)
#pragma unroll
              for (int nq = 0; nq < 2; ++nq) oT[dt][nq] = (f32x4){0.f, 0.f, 0.f, 0.f};
#pragma unroll
          for (int j = 0; j < 5; ++j) { bf16x8 pf[2];
#pragma unroll
              for (int nq = 0; nq < 2; ++nq) { u32x4 w; w.x = pk2(sT[2 * j][nq][0], sT[2 * j][nq][1]); w.y = pk2(sT[2 * j][nq][2], sT[2 * j][nq][3]); w.z = pk2(sT[2 * j + 1][nq][0], sT[2 * j + 1][nq][1]); w.w = pk2(sT[2 * j + 1][nq][2], sT[2 * j + 1][nq][3]);
                  pf[nq] = __builtin_bit_cast(bf16x8, w); }
#pragma unroll
              for (int dt = 0; dt < 4; ++dt) { const LAS unsigned char* vrow = lds + A_VT + (16 * dt + fr) * 528 + (q0 + 32 * j + 4 * fq) * 2;
                  const u32x2 lo = *(const LAS u32x2*)vrow, hi = *(const LAS u32x2*)(vrow + 32);
                  u32x4 w; w.x = lo.x; w.y = lo.y; w.z = hi.x; w.w = hi.y; const bf16x8 vf = __builtin_bit_cast(bf16x8, w);
#pragma unroll
                  for (int nq = 0; nq < 2; ++nq) oT[dt][nq] = __builtin_amdgcn_mfma_f32_16x16x32_bf16(vf, pf[nq], oT[dt][nq], 0, 0, 0); } }
#pragma unroll
          for (int nq = 0; nq < 2; ++nq) { const size_t tok = (size_t)b * SEQ + nb * 128 + q0 + 16 * nq + fr;
#pragma unroll
              for (int dt = 0; dt < 4; ++dt) { const f32x4 v = oT[dt][nq] * linv[nq]; u32x2 o; o.x = pk2(v[0], v[1]); o.y = pk2(v[2], v[3]);
                  *(u32x2*)(attn + tok * 1024 + (hk * 4 + g) * 64 + 16 * dt + 4 * fq) = o; } }
      } }
    __syncthreads();
}

constexpr int P7_B0 = 25600, P7_B1 = 76288;
__device__ __forceinline__ void phase7(const Params& P, LAS unsigned char* lds, int vcu, int G, int tid, int wid, int lane, bool commit = true) {
    const bf16* Wrh = (const bf16*)(P.ws + WS_WR); const float* ssq = (const float*)(P.ws + WS_SSQ);
    unsigned* cnt = (unsigned*)(P.ws + WS_CTL + CTL_CNT); int* list = (int*)(P.ws + WS_LIST); float* gw = (float*)(P.ws + WS_GW); float* rstdv = (float*)(P.ws + WS_RSTD);
    const int fr = lane & 15, fq = lane >> 4;
    LAS float* LG = (LAS float*)(lds + wid * 3072);
    LAS unsigned* LC = (LAS unsigned*)(lds + 24576); LAS unsigned* LB = (LAS unsigned*)(lds + 24576 + 256);
    if (tid < 64) LC[tid] = 0u;
    __syncthreads();
    for (int base = vcu * 8; base < T / 16; base += G * 8) {
        const int rg = base + wid; const int R0 = rg * 16;
        f32x4 acc[3];
#pragma unroll
        for (int nt = 0; nt < 3; ++nt) acc[nt] = (f32x4){0.f, 0.f, 0.f, 0.f};
        const bf16* xr = (const bf16*)(P.ws + WS_X1B) + (size_t)(R0 + fr) * 1024 + 8 * fq;
        u32x4 wst[6]; bf16x8 xa[8], xb[8];
#define P7_WLOAD(kq) do { _Pragma("unroll") for (int j = 0; j < 6; ++j) { const int idx = tid + 512 * j, mat = idx / 1536, rem = idx - mat * 1536, row = rem >> 5, ch = rem & 31; \
            wst[j] = *(const u32x4*)(Wrh + (size_t)mat * 48 * 1024 + row * 1024 + (kq) * 256 + ch * 8); } } while (0)
#define P7_WSTORE(buf) do { _Pragma("unroll") for (int j = 0; j < 6; ++j) { const int idx = tid + 512 * j, mat = idx / 1536, rem = idx - mat * 1536, row = rem >> 5, ch = rem & 31; \
            *(LAS u32x4*)(lds + (buf) + mat * 25344 + row * 528 + ch * 16) = wst[j]; } } while (0)
#define P7_XLOAD(dst, kq) do { _Pragma("unroll") for (int ks = 0; ks < 8; ++ks) dst[ks] = *(const bf16x8*)(xr + (kq) * 256 + 32 * ks); } while (0)
#define P7_COMPUTE(src, buf) do { _Pragma("unroll") for (int ks = 0; ks < 8; ++ks) { const bf16x8 ah = src[ks]; \
            _Pragma("unroll") for (int nt = 0; nt < 3; ++nt) { const LAS unsigned char* wp = lds + (buf) + (16 * nt + fr) * 528 + (ks * 32 + 8 * fq) * 2; \
                const bf16x8 bh = *(const LAS bf16x8*)wp, bl = *(const LAS bf16x8*)(wp + 25344); \
                acc[nt] = __builtin_amdgcn_mfma_f32_16x16x32_bf16(ah, bh, acc[nt], 0, 0, 0); \
                acc[nt] = __builtin_amdgcn_mfma_f32_16x16x32_bf16(ah, bl, acc[nt], 0, 0, 0); } } } while (0)
        P7_WLOAD(0); P7_XLOAD(xa, 0); P7_WSTORE(P7_B0); P7_WLOAD(1); P7_XLOAD(xb, 1);
        __syncthreads();
        P7_COMPUTE(xa, P7_B0); P7_WSTORE(P7_B1); P7_WLOAD(2); P7_XLOAD(xa, 2);
        __syncthreads();
        P7_COMPUTE(xb, P7_B1); P7_WSTORE(P7_B0); P7_WLOAD(3); P7_XLOAD(xb, 3);
        __syncthreads();
        P7_COMPUTE(xa, P7_B0); P7_WSTORE(P7_B1);
        __syncthreads();
        P7_COMPUTE(xb, P7_B1);
#undef P7_WLOAD
#undef P7_WSTORE
#undef P7_XLOAD
#undef P7_COMPUTE
#pragma unroll
        for (int r = 0; r < 4; ++r) { const float* sp = ssq + (size_t)(R0 + 4 * fq + r) * 16; float tot = 0.f;
#pragma unroll
            for (int q = 0; q < 4; ++q) { const f32x4 v = *(const f32x4*)(sp + 4 * q); tot += v[0]; tot += v[1]; tot += v[2]; tot += v[3]; }
            const float rstd = 1.f / sqrtf(tot * (1.f / 1024.f) + EPS);
            if (fr == 0) rstdv[R0 + 4 * fq + r] = rstd;
#pragma unroll
            for (int nt = 0; nt < 3; ++nt) { const int j = 16 * nt + fr; float bias = 0.f; if (j < 4) bias = PP(b_rg)[j]; else if (j < 36) bias = PP(b_re)[j - 4];
                LG[(4 * fq + r) * 48 + j] = acc[nt][r] * rstd + bias; } }
        __syncthreads();
        int l0 = 0, l1 = 0; unsigned rk0 = 0u, rk1 = 0u;
        if (lane < 16) { const int tok = R0 + lane; const LAS float* lg = LG + lane * 48;
            int gsel = 0; float best = lg[0];
#pragma unroll
            for (int i = 1; i < 4; ++i) { const float v = lg[i]; if (v > best) { best = v; gsel = i; } }
            float Z = 0.f;
#pragma unroll
            for (int i = 0; i < 4; ++i) Z += __expf(lg[i] - best);
            const float pgsel = 1.f / Z;
            const LAS float* le = lg + 4 + gsel * 8;
            float lmax = le[0];
#pragma unroll
            for (int i = 1; i < 8; ++i) lmax = fmaxf(lmax, le[i]);
            float Zp = 0.f;
#pragma unroll
            for (int i = 0; i < 8; ++i) Zp += __expf(le[i] - lmax);
            int i1 = 0; float p1 = -1.f;
#pragma unroll
            for (int i = 0; i < 8; ++i) { const float pe = __expf(le[i] - lmax) / Zp; if (pe > p1) { p1 = pe; i1 = i; } }
            int i2 = 0; float p2 = -1.f;
#pragma unroll
            for (int i = 0; i < 8; ++i) { const float pe = __expf(le[i] - lmax) / Zp; if (i != i1 && pe > p2) { p2 = pe; i2 = i; } }
            const float den = p1 + p2;
            gw[tok * 2 + 0] = pgsel * p1 / den; gw[tok * 2 + 1] = pgsel * p2 / den;
            l0 = gsel * 8 + i1; l1 = 32 + gsel * 8 + i2;
            rk0 = __hip_atomic_fetch_add(&LC[l0], 1u, __ATOMIC_RELAXED, __HIP_MEMORY_SCOPE_WORKGROUP); rk1 = __hip_atomic_fetch_add(&LC[l1], 1u, __ATOMIC_RELAXED, __HIP_MEMORY_SCOPE_WORKGROUP); }
        __syncthreads();
        if (tid < 64) { const unsigned n = LC[tid]; LC[tid] = 0u; if (n && commit) LB[tid] = atomicAdd(&cnt[tid * 64], n); }
        __syncthreads();
        if (lane < 16 && commit) { const int tok = R0 + lane; list[(size_t)l0 * T + LB[l0] + rk0] = tok; list[(size_t)l1 * T + LB[l1] + rk1] = tok; }
        __syncthreads();
    }
}

constexpr int M_PB = 133120, M_CN = 133632, M_RBL = 133888;
__device__ __forceinline__ void moe_prefix(const Params& P, LAS unsigned char* lds, int tid) {
    const unsigned* cnt = (const unsigned*)(P.ws + WS_CTL + CTL_CNT);
    LAS int* PB = (LAS int*)(lds + M_PB); LAS int* CN = (LAS int*)(lds + M_CN);
    if (tid < 64) CN[tid] = (int)cnt[tid * 64];
    __syncthreads();
    if (tid == 0) { int s = 0; for (int l = 0; l < 64; ++l) { PB[l] = s; s += (CN[l] + 255) >> 8; } PB[64] = s; }
    __syncthreads();
    if (tid < 64) { LAS int* RBL = (LAS int*)(lds + M_RBL); for (int rb = PB[tid]; rb < PB[tid + 1]; ++rb) RBL[rb] = tid; }
    __syncthreads();
}
__device__ __forceinline__ void phase8(const Params& P, LAS unsigned char* lds, int vcu, int G) {
    const LAS int* PB = (const LAS int*)(lds + M_PB); const LAS int* CN = (const LAS int*)(lds + M_CN);
    const pg8::MoeSched<0> S{(const char*)(P.ws + WS_HN), (const char*)(P.ws + WS_WGU), (const int*)(P.ws + WS_LIST), PB, CN, (const LAS int*)(lds + M_RBL), 1024, PB[0], (PB[64] - PB[0]) * 4, vcu, G};
    const EpiGateUp E{(const int*)(P.ws + WS_LIST), (const float*)(P.ws + WS_RSTD), (unsigned char*)(P.ws + WS_H)};
    pg8::gemm_phase(lds, S, E);
}
__device__ __forceinline__ void phase9(const Params& P, LAS unsigned char* lds, int vcu, int G) {
    const LAS int* PB = (const LAS int*)(lds + M_PB); const LAS int* CN = (const LAS int*)(lds + M_CN);
    const pg8::MoeSched<1> S{(const char*)(P.ws + WS_H), (const char*)(P.ws + WS_WD), (const int*)(P.ws + WS_LIST), PB, CN, (const LAS int*)(lds + M_RBL), 512, PB[32], (PB[64] - PB[32]) * 4, vcu, G};
    const EpiDownY E{(const int*)(P.ws + WS_LIST), (const float*)(P.ws + WS_GW), (bf16*)(P.ws + WS_Y)};
    pg8::gemm_phase(lds, S, E);
}
__device__ __forceinline__ void phase10(const Params& P, LAS unsigned char* lds, int vcu, int G) {
    const LAS int* PB = (const LAS int*)(lds + M_PB); const LAS int* CN = (const LAS int*)(lds + M_CN);
    const pg8::MoeSched<1> S{(const char*)(P.ws + WS_H), (const char*)(P.ws + WS_WD), (const int*)(P.ws + WS_LIST), PB, CN, (const LAS int*)(lds + M_RBL), 512, PB[0], (PB[32] - PB[0]) * 4, vcu, G};
    const EpiDown E{(const int*)(P.ws + WS_LIST), (const float*)(P.ws + WS_GW), P.out, (const bf16*)(P.ws + WS_X1B), (const bf16*)(P.ws + WS_Y), (const float*)(P.ws + WS_CTL + 32768)};
    pg8::gemm_phase(lds, S, E);
}

__global__ void __launch_bounds__(NTHREADS, 2) mega_fwd(Params P) {
    extern __shared__ __attribute__((aligned(16))) unsigned char lds_raw[];
    LAS unsigned char* lds = (LAS unsigned char*)lds_raw;
    const int tid = threadIdx.x, lane = tid & 63, wid = __builtin_amdgcn_readfirstlane(tid >> 6);
    const int G = gridDim.x; const int bx = blockIdx.x; const int vcu = (G % 8 == 0) ? (bx % 8) * (G / 8) + bx / 8 : bx;
    volatile LAS unsigned* st = (volatile LAS unsigned*)(lds + LDS_ST_OFF);
    if (tid < 16) st[tid] = 0u;
    if (tid == 0) { LAS unsigned long long* pt = (LAS unsigned long long*)(lds + LDS_PTAB);
#define PT_(f) pt[__builtin_offsetof(Params, f) / 8] = (unsigned long long)P.f
        PT_(positions); PT_(norm1_w); PT_(w_in); PT_(q_norm_w); PT_(k_norm_w); PT_(sinks); PT_(hlb); PT_(hnw); PT_(w_ba); PT_(w_bh); PT_(w_out); PT_(norm2_w);
        PT_(w_rg); PT_(b_rg); PT_(w_re); PT_(b_re); PT_(w_gate); PT_(w_up); PT_(w_down);
#undef PT_
    }
    __syncthreads();
    unsigned* bar = (unsigned*)(P.ws + WS_CTL);
    const XcdBarrier xb = xcd_barrier_post(bar, st);

#ifndef DUPMASK
#define DUPMASK 0
#endif
#define DUPQ(k) if ((DUPMASK >> (k)) & 1)
#ifndef PHMASK
#define PHMASK 0xFFFF
#endif
#define PH(k) if ((PHMASK >> (k)) & 1)
    PH(0) phase0(P, lds, vcu, G, tid, wid, lane);
    DUPQ(0) phase0(P, lds, vcu, G, tid, wid, lane);
    xcd_barrier(xb);
    PH(1) phase1(P, lds, G);
    DUPQ(1) phase1(P, lds, G);
    const int ei_p1 = (G == 256) ? 8192 : 0;
    PH(1) if (G == 256 && bx >= 128) { LAS float* cscr = (LAS float*)(lds + wid * 16384); const int w1 = (bx - 128) * 8 + wid;
#pragma unroll 1
        for (int k = 0; k < 8; k += 2) { float tva[32], tvb[32]; const TItem ia = expert_item(P, lds, w1 + k * 1024), ib = expert_item(P, lds, w1 + (k + 1) * 1024);
            titem_load(ia, lane, tva); titem_load(ib, lane, tvb); titem_store(ia, lane, tva, cscr); titem_store(ib, lane, tvb, cscr); } }
    xcd_barrier(xb);
    PH(2) {
        int cit = ei_p1 + vcu * 8 + wid; const int cstride = G * 8;
        for (int u = bx; u < 256; u += G) {
            if ((u & 15) != 15) { hgrn_unit<0>(P, lds, u, tid, wid, lane, cit, cstride); cit += 16 * cstride; } }
        LAS float* cscr = (LAS float*)(lds + (wid < 4 ? H_QT + wid * 8448 : H_ST + (wid - 4) * 8448));
        for (; cit < EI_TOTAL; cit += cstride) { float tv[32]; const TItem t = expert_item(P, lds, cit); titem_load(t, lane, tv); titem_store(t, lane, tv, cscr); }
    }
    DUPQ(2) for (int u = bx; u < 256; u += G) if ((u & 15) != 15) hgrn_unit<0>(P, lds, u, tid, wid, lane);
    xcd_barrier(xb);
    PH(3) { hgrn_scan(P, G, tid);
    { u32x4 kr[4], vr[4], qr[8]; if (bx < 512) attn_load(P, bx, tid, kr, vr, qr);
      for (int u = bx; u < 512; u += G) attn_unit(P, lds, u, u + G, tid, wid, lane, kr, vr, qr); } }
    DUPQ(3) { u32x4 kr[4], vr[4], qr[8]; if (bx < 512) attn_load(P, bx, tid, kr, vr, qr);
      for (int u = bx; u < 512; u += G) attn_unit(P, lds, u, u + G, tid, wid, lane, kr, vr, qr); }
    xcd_barrier(xb);
    PH(4) for (int u = bx; u < 256; u += G) hgrn_unit<1>(P, lds, u, tid, wid, lane);
    DUPQ(4) for (int u = bx; u < 256; u += G) hgrn_unit<1>(P, lds, u, tid, wid, lane);
    xcd_barrier(xb);
    PH(5) phase5(P, lds, G);
    DUPQ(5) phase5(P, lds, G);
    xcd_barrier(xb);
    PH(6) phase6(P, lds, G);
    DUPQ(6) phase6(P, lds, G);
    xcd_barrier(xb);
    if ((DUPMASK >> 7) & 1) phase7(P, lds, vcu, G, tid, wid, lane, false);
    PH(7) phase7(P, lds, vcu, G, tid, wid, lane);
    xcd_barrier(xb);
    moe_prefix(P, lds, tid);
    PH(8) phase8(P, lds, vcu, G);
    DUPQ(8) phase8(P, lds, vcu, G);
    xcd_barrier(xb);
    PH(9) phase9(P, lds, vcu, G);
    xcd_barrier(xb);
    PH(10) phase10(P, lds, vcu, G);
    if (xb_ld(&bar[XB_TMO]) != 0u && tid == 0) P.out[(size_t)bx * 1024] = __builtin_nanf("");
}

extern "C" void kernel_launch(void* const* d_in, const int* in_sizes, int n_in, void* d_out, int out_size, void* d_ws, size_t ws_size, hipStream_t stream) {
    static int grid = 0;
    if (grid == 0) {
        if (n_in != 20 || out_size != T * D || ws_size < WS_END) { fprintf(stderr, "kernel_launch: unexpected shapes (n_in %d out %d ws %zu, need ws >= %zu)\n", n_in, out_size, ws_size, (size_t)WS_END); grid = -1; return; }
        int dev = 0, cus = 0, per_cu = 0;
        if (hipGetDevice(&dev) != hipSuccess || hipDeviceGetAttribute(&cus, hipDeviceAttributeMultiprocessorCount, dev) != hipSuccess) { grid = -1; return; }
        if (hipFuncSetAttribute((const void*)mega_fwd, hipFuncAttributeMaxDynamicSharedMemorySize, LDS_BYTES) != hipSuccess) { fprintf(stderr, "hipFuncSetAttribute failed\n"); grid = -1; return; }
        if (hipOccupancyMaxActiveBlocksPerMultiprocessor(&per_cu, (const void*)mega_fwd, NTHREADS, LDS_BYTES) != hipSuccess || per_cu < 1) { fprintf(stderr, "occupancy query: %d blocks/CU\n", per_cu); grid = -1; return; }
        grid = cus;
    }
    if (grid < 0) return;
    if (hipMemsetAsync((char*)d_ws + WS_CTL, 0, 96 * 1024, stream) != hipSuccess) return;
    Params p{};
    p.x = (const float*)d_in[0]; p.positions = (const int*)d_in[1]; p.norm1_w = (const float*)d_in[2]; p.w_in = (const float*)d_in[3];
    p.q_norm_w = (const float*)d_in[4]; p.k_norm_w = (const float*)d_in[5]; p.sinks = (const float*)d_in[6]; p.hlb = (const float*)d_in[7];
    p.hnw = (const float*)d_in[8]; p.w_ba = (const float*)d_in[9]; p.w_bh = (const float*)d_in[10]; p.w_out = (const float*)d_in[11];
    p.norm2_w = (const float*)d_in[12]; p.w_rg = (const float*)d_in[13]; p.b_rg = (const float*)d_in[14]; p.w_re = (const float*)d_in[15];
    p.b_re = (const float*)d_in[16]; p.w_gate = (const float*)d_in[17]; p.w_up = (const float*)d_in[18]; p.w_down = (const float*)d_in[19];
    p.out = (float*)d_out; p.ws = (unsigned char*)d_ws;
    void* args[] = {&p};
    const hipError_t e = hipLaunchCooperativeKernel((const void*)mega_fwd, dim3(grid), dim3(NTHREADS), args, LDS_BYTES, stream);
    if (e != hipSuccess) fprintf(stderr, "cooperative launch failed: %s (grid %d)\n", hipGetErrorString(e), grid);
}
```

```cpp
#define DUPMASK 0
#include <hip/hip_runtime.h>
#include <cstdio>
#include <cstdint>

#define LAS __attribute__((address_space(3)))
typedef unsigned short bf16;
typedef short bf16x8 __attribute__((ext_vector_type(8)));
typedef float f32x4 __attribute__((ext_vector_type(4)));
typedef unsigned u32x4 __attribute__((ext_vector_type(4)));
typedef unsigned u32x2 __attribute__((ext_vector_type(2)));

constexpr int NTHREADS = 512;
constexpr int LDS_BYTES = 147456;
constexpr int LDS_ST_OFF = LDS_BYTES - 64;

constexpr int BATCH = 4, SEQ = 8192, T = BATCH * SEQ, D = 1024, NPROJ = 4864;
constexpr int C_QA = 0, C_KA = 512, C_VA = 640, C_QH = 768, C_FH = 1280, C_IH = 1792, C_GH = 2304, C_ZA = 2816, C_ZB = 3840;
constexpr int NEXP = 32, FF = 512;
constexpr float EPS = 1e-6f;

constexpr size_t MiB = 1u << 20;
constexpr size_t WS_CTL = 0;
constexpr size_t CTL_CNT = 65536;
constexpr size_t WS_WINT = 1 * MiB;
constexpr size_t WS_WAT = 11 * MiB;
constexpr size_t WS_WBT = 12 * MiB;
constexpr size_t WS_WOT = 13 * MiB;
constexpr size_t WS_WR = 15 * MiB;
constexpr size_t WS_WGU = 16 * MiB;
constexpr size_t WS_WD = 80 * MiB;
constexpr size_t WS_PROJ = 112 * MiB;
constexpr size_t WS_MIXED = 416 * MiB;
constexpr size_t WS_CS = 480 * MiB;
constexpr size_t WS_WZ8 = 482 * MiB;
constexpr size_t WS_END = 485 * MiB;
constexpr size_t WS_HN = 112 * MiB;
constexpr size_t WS_SSQ = 176 * MiB;
constexpr size_t WS_LIST = 178 * MiB;
constexpr size_t WS_GW = 186 * MiB;
constexpr size_t WS_RSTD = 187 * MiB;
constexpr size_t WS_H = 192 * MiB;
constexpr size_t WS_X1B = 336 * MiB;
constexpr size_t WS_Y = 272 * MiB;
constexpr size_t WS_U = 416 * MiB, WS_SIN = 432 * MiB, WS_DSC = 448 * MiB, WS_R1 = 484 * MiB;
constexpr size_t OUT_AH = 64 * MiB, OUT_XN8 = 64 * MiB;

typedef float f32x2_ __attribute__((ext_vector_type(2)));
typedef __bf16 bf16x2_ __attribute__((ext_vector_type(2)));
__device__ __forceinline__ unsigned f2bf(float f) { return (unsigned)__builtin_bit_cast(unsigned short, (__bf16)f); }
__device__ __forceinline__ float bf2f(unsigned h) { return __builtin_bit_cast(float, h << 16); }
__device__ __forceinline__ unsigned pk2(float lo, float hi) { const f32x2_ v = {lo, hi}; return __builtin_bit_cast(unsigned, __builtin_convertvector(v, bf16x2_)); }
__device__ __forceinline__ float bflo(unsigned w) { return __builtin_bit_cast(float, w << 16); }
__device__ __forceinline__ float bfhi(unsigned w) { return __builtin_bit_cast(float, w & 0xffff0000u); }
constexpr float LOG2E = 1.4426950408889634f;
__device__ __forceinline__ float exp2_(float x) { return __builtin_amdgcn_exp2f(x); }
__device__ __forceinline__ float fexp_(float x) { return __builtin_amdgcn_exp2f(x * LOG2E); }
__device__ __forceinline__ float sigmoidf_(float x) { return __builtin_amdgcn_rcpf(1.f + fexp_(-x)); }
__device__ __forceinline__ int opaque(int x) { asm volatile("" : "+v"(x)); return x; }
__device__ __forceinline__ float wave_sum(float v) {
#pragma unroll
    for (int o = 1; o < 64; o <<= 1) v += __shfl_xor(v, o);
    return v;
}

#define XB_TMO      128
#define XB_XCNT(j)  (256  + 64 * (j))
#define XB_XSUB(j)  (1280 + 64 * (j))
#define XB_XGEN(j)  (2304 + 64 * (j))
#define XB_TOP      3328
#define XB_TOPGEN   3392
#define XCD_BAR_WORDS 3456
#define XB_SPIN_CAP (1u << 20)
__device__ __forceinline__ unsigned xb_ld(unsigned* p)              { return __hip_atomic_load(p, __ATOMIC_RELAXED, __HIP_MEMORY_SCOPE_AGENT); }
__device__ __forceinline__ unsigned xb_add(unsigned* p, unsigned v) { return __hip_atomic_fetch_add(p, v, __ATOMIC_RELAXED, __HIP_MEMORY_SCOPE_AGENT); }
__device__ __forceinline__ unsigned xb_xcc_id() { return (unsigned)__builtin_amdgcn_s_getreg((3 << 11) | 20) & 0xFu; }
#define XB_SPIN(cond, bar) do { unsigned _sp = 0; while (cond) { __builtin_amdgcn_s_sleep(1); \
    if ((++_sp & 255u) == 0u) { if (xb_ld(&(bar)[XB_TMO])) break; if (_sp > XB_SPIN_CAP) { atomicAdd(&(bar)[XB_TMO], 1u); break; } } } } while (0)
struct XcdBarrier { unsigned* bar; unsigned x; volatile LAS unsigned* st; };
__device__ __forceinline__ XcdBarrier xcd_barrier_post(unsigned* bar, volatile LAS unsigned* st) {
    XcdBarrier b; b.bar = bar; b.x = xb_xcc_id(); b.st = st;
    if (threadIdx.x == 0) (void)xb_add(&bar[XB_XCNT(b.x)], 1u);
    return b;
}
__device__ __forceinline__ void xcd_barrier_complete(unsigned* bar, unsigned x, unsigned& nloc, unsigned& nx) {
    const unsigned G = gridDim.x * gridDim.y * gridDim.z;
    unsigned sum, cnt, mine, sp = 0u;
    for (;;) {
        sum = 0u; cnt = 0u; mine = 0u;
#pragma unroll
        for (unsigned j = 0; j < 16; ++j) { const unsigned c = xb_ld(&bar[XB_XCNT(j)]); sum += c; cnt += (c > 0u) ? 1u : 0u; mine = (j == x) ? c : mine; }
        if (sum == G) break;
        __builtin_amdgcn_s_sleep(1);
        if ((++sp & 255u) == 0u) { if (xb_ld(&bar[XB_TMO])) break; if (sp > XB_SPIN_CAP) { atomicAdd(&bar[XB_TMO], 1u); break; } }
    }
    nloc = mine > 0u ? mine : 1u; nx = cnt > 0u ? cnt : 1u;
}
__device__ __forceinline__ void xcd_barrier(const XcdBarrier& b) {
    asm volatile("s_waitcnt vmcnt(0)" ::: "memory");
    __syncthreads();
    if (threadIdx.x == 0) {
        unsigned* bar = b.bar;
        __builtin_amdgcn_s_waitcnt(0);
        unsigned nloc = b.st[0], nx = b.st[1];
        if (nloc == 0u) { xcd_barrier_complete(bar, b.x, nloc, nx); b.st[0] = nloc; b.st[1] = nx; }
        const unsigned old = xb_add(&bar[XB_XSUB(b.x)], 1u);
        const unsigned gen = old / nloc;
        if (old + 1u == (gen + 1u) * nloc) {
            __builtin_amdgcn_fence(__ATOMIC_RELEASE, "agent");
            asm volatile("s_waitcnt vmcnt(0)" ::: "memory");
            const unsigned og = xb_add(&bar[XB_TOP], 1u);
            const unsigned tg = og / nx;
            if (og + 1u == (tg + 1u) * nx) xb_add(&bar[XB_TOPGEN], 1u);
            else XB_SPIN(xb_ld(&bar[XB_TOPGEN]) == tg, bar);
            __builtin_amdgcn_fence(__ATOMIC_ACQUIRE, "agent");
            xb_add(&bar[XB_XGEN(b.x)], 1u);
            asm volatile("s_waitcnt vmcnt(0)" ::: "memory");
        } else {
            XB_SPIN(xb_ld(&bar[XB_XGEN(b.x)]) == gen, bar);
            __builtin_amdgcn_fence(__ATOMIC_ACQUIRE, "agent");
            asm volatile("s_waitcnt vmcnt(0)" ::: "memory");
        }
    }
    __syncthreads();
}

struct Params {
    const float* x; const int* positions; const float* norm1_w; const float* w_in; const float* q_norm_w; const float* k_norm_w;
    const float* sinks; const float* hlb; const float* hnw; const float* w_ba; const float* w_bh; const float* w_out; const float* norm2_w;
    const float* w_rg; const float* b_rg; const float* w_re; const float* b_re; const float* w_gate; const float* w_up; const float* w_down;
    float* out; unsigned char* ws;
};
constexpr int LDS_PTAB = LDS_ST_OFF - 256;
template <class Tp> __device__ __forceinline__ Tp ldparam(LAS unsigned char* lds, int off) {
    const u32x2 v = *(const LAS u32x2*)(lds + LDS_PTAB + off);
    const unsigned lo = (unsigned)__builtin_amdgcn_readfirstlane((int)v.x), hi = (unsigned)__builtin_amdgcn_readfirstlane((int)v.y);
    return (Tp)(((unsigned long long)hi << 32) | (unsigned long long)lo); }
#define PP(f) ldparam<decltype(Params::f)>(lds, (int)__builtin_offsetof(Params, f))


namespace pg8 {
constexpr int BK = 64, HALF = 128, HTB = HALF * BK * 2;
__device__ __forceinline__ int lds_byte(int r, int c) { const int st = (r >> 4) * 2 + (c >> 5), rr = r & 15, cc = c & 31, ob = rr * 64 + cc * 2; return st * 1024 + (ob ^ (((ob >> 9) & 1) << 5)); }
__device__ __forceinline__ void stage_rc(int b, int& R, int& C) { const int st = b / 1024, sb = b % 1024, swz = sb ^ (((sb >> 9) & 1) << 5); R = (st >> 1) * 16 + swz / 64; C = (st & 1) * 32 + (swz % 64) / 2; }
__device__ __forceinline__ int perm32(int rho) { const int n = rho >> 4, i = rho & 15; return 8 * (i >> 2) + 4 * n + (i & 3); }
struct Unit { int pm, pn, l, i0, cn; };
typedef int i32x4_ __attribute__((ext_vector_type(4)));
typedef int i32x8_ __attribute__((ext_vector_type(8)));
__device__ __forceinline__ i32x8_ cat8(i32x4_ a, i32x4_ b) { return __builtin_shufflevector(a, b, 0, 1, 2, 3, 4, 5, 6, 7); }
__device__ __forceinline__ bf16x8 lo8(i32x8_ v) { return __builtin_bit_cast(bf16x8, __builtin_shufflevector(v, v, 0, 1, 2, 3)); }
__device__ __forceinline__ bf16x8 hi8(i32x8_ v) { return __builtin_bit_cast(bf16x8, __builtin_shufflevector(v, v, 4, 5, 6, 7)); }

template <class Epi, class Sched>
__device__ __forceinline__ void gemm_phase(LAS unsigned char* lds, const Sched& S, const Epi& E) {
    const int tid = threadIdx.x, wid = __builtin_amdgcn_readfirstlane(tid >> 6), lane = tid & 63, wr = wid >> 2, wc = wid & 3, fr = lane & 15, fq = lane >> 4;
    const int KB = S.KB, nt = KB / 128;
    int sR[2], sC = 0; unsigned voffB[2];
#pragma unroll
    for (int i = 0; i < 2; ++i) { int R, C; stage_rc(tid * 16 + i * 8192, R, C); sR[i] = R; sC = C; const int Rb = Epi::PERM ? ((R & ~31) + perm32(R & 31)) : R; voffB[i] = (unsigned)(Rb * KB + C * 2); }
    const unsigned kstep = (unsigned)(BK * 2);
    const size_t hstep = (size_t)HALF * KB;
    const unsigned ldsw = (unsigned)wid * 1024u;
    const int aoff = lds_byte(wr * 64 + fr, fq * 8), boff = lds_byte(wc * 32 + fr, fq * 8);
#define PG8_SA(b, h) (((b) * 2 + (h)) * HTB)
#define PG8_SB(b, h) ((4 + (b) * 2 + (h)) * HTB)
#define PG8_STAGE_B(bufoff, gbase) do { _Pragma("unroll") for (int _i = 0; _i < 2; ++_i) \
        __builtin_amdgcn_global_load_lds((const unsigned*)((const char*)(gbase) + voffB[_i]), (LAS unsigned*)(lds + (bufoff) + ldsw + _i * 8192), 16, 0, 0); } while (0)
#define PG8_STAGE_A(bufoff, va, kb) do { _Pragma("unroll") for (int _i = 0; _i < 2; ++_i) \
        __builtin_amdgcn_global_load_lds((const unsigned*)(Ab + ((size_t)(va)[_i] + (kb))), (LAS unsigned*)(lds + (bufoff) + ldsw + _i * 8192), 16, 0, 0); } while (0)
#define PG8_LDA(dst, b, h) do { _Pragma("unroll") for (int m = 0; m < 4; ++m) dst[m] = cat8(*(const LAS i32x4_*)(lds + PG8_SA(b, h) + aoff + m * 2048), *(const LAS i32x4_*)(lds + PG8_SA(b, h) + aoff + m * 2048 + 1024)); } while (0)
#define PG8_LDB(dst, b, h) do { _Pragma("unroll") for (int n = 0; n < 2; ++n) dst[n] = cat8(*(const LAS i32x4_*)(lds + PG8_SB(b, h) + boff + n * 2048), *(const LAS i32x4_*)(lds + PG8_SB(b, h) + boff + n * 2048 + 1024)); } while (0)
#define PG8_MMA(ai, bj, At, Bt) do { __builtin_amdgcn_s_setprio(1); _Pragma("unroll") for (int m = 0; m < 4; ++m) _Pragma("unroll") for (int n = 0; n < 2; ++n) { \
        if constexpr (Sched::FP8) {   \
              \
            asm volatile("v_mfma_scale_f32_16x16x128_f8f6f4 %0, %1, %2, %0, %3, %4 op_sel_hi:[0,0,0]" : "+v"(acc[ai][bj][m][n]) : "v"(Bt[n]), "v"(At[m]), "v"(sclB), "v"(sclA)); \
        } else { acc[ai][bj][m][n] = __builtin_amdgcn_mfma_f32_16x16x32_bf16(lo8(Bt[n]), lo8(At[m]), acc[ai][bj][m][n], 0, 0, 0); \
                 acc[ai][bj][m][n] = __builtin_amdgcn_mfma_f32_16x16x32_bf16(hi8(Bt[n]), hi8(At[m]), acc[ai][bj][m][n], 0, 0, 0); } } \
        __builtin_amdgcn_s_setprio(0); } while (0)
#define PG8_WAIT_V(n) asm volatile("s_waitcnt vmcnt(" #n ")" ::: "memory")
#define PG8_WAIT_L(n) asm volatile("s_waitcnt lgkmcnt(" #n ")" ::: "memory")
#define PG8_BAR __builtin_amdgcn_s_barrier()
#define PG8_SCHED __builtin_amdgcn_sched_barrier(0)
    Unit cur, nxt; int ui = 0;
    if (!S.next(0, cur)) return;
    const int sclA = Sched::SCALE_A, sclB = Sched::SCALE_B; (void)sclA; (void)sclB;
    f32x4 acc[2][2][4][2];
#pragma unroll
    for (int a = 0; a < 2; ++a)
#pragma unroll
        for (int b = 0; b < 2; ++b)
#pragma unroll
            for (int m = 0; m < 4; ++m)
#pragma unroll
                for (int n = 0; n < 2; ++n) acc[a][b][m][n] = (f32x4){0.f, 0.f, 0.f, 0.f};
    i32x8_ At[4], B0[2], B1[2];
    const char* const Ab = S.a_base();
    unsigned vA0[2], vA1[2], nA0[2], nA1[2];
#pragma unroll
    for (int i = 0; i < 2; ++i) { vA0[i] = S.a_voff(cur, 0, sR[i], sC); vA1[i] = S.a_voff(cur, 1, sR[i], sC); }
    const char* cB = S.b_base(cur);
    PG8_STAGE_B(PG8_SB(0, 0), cB); PG8_STAGE_B(PG8_SB(0, 1), cB + hstep); PG8_STAGE_A(PG8_SA(0, 0), vA0, 0u); PG8_STAGE_A(PG8_SA(0, 1), vA1, 0u);
    if (wr == 1) PG8_BAR;
    PG8_WAIT_V(2); PG8_BAR;
    PG8_STAGE_B(PG8_SB(1, 0), cB + kstep); PG8_STAGE_A(PG8_SA(1, 0), vA0, kstep); PG8_STAGE_B(PG8_SB(1, 1), cB + hstep + kstep);
    PG8_WAIT_V(6); PG8_BAR;
    for (;;) {
        const bool has_next = S.next(ui + 1, nxt);
        const char* nB = has_next ? S.b_base(nxt) : cB;
#pragma unroll
        for (int i = 0; i < 2; ++i) { nA0[i] = has_next ? S.a_voff(nxt, 0, sR[i], sC) : vA0[i]; nA1[i] = has_next ? S.a_voff(nxt, 1, sR[i], sC) : vA1[i]; }
#pragma unroll 1
        for (int t = 0; t < nt; t += 2) {
            const bool last = (t == nt - 2);
            if constexpr (Epi::MID) { if (t == (nt >> 1)) E.mid(acc, cur, wr, wc, fr, fq); }
            const unsigned k1 = (unsigned)(t + 1) * kstep;
            const unsigned k2 = last ? 0u : (unsigned)(t + 2) * kstep, k3 = k2 + kstep;
            const char* b2 = last ? nB : cB + (size_t)(t + 2) * kstep; const char* b3 = b2 + kstep;
            unsigned uA0[2], uA1[2];
#pragma unroll
            for (int i = 0; i < 2; ++i) { uA0[i] = last ? nA0[i] : vA0[i]; uA1[i] = last ? nA1[i] : vA1[i]; }
            PG8_LDB(B0, 0, 0); PG8_LDB(B1, 0, 1); PG8_SCHED; PG8_LDA(At, 0, 0); PG8_STAGE_A(PG8_SA(1, 1), vA1, k1);
            PG8_WAIT_V(8); PG8_WAIT_L(0); PG8_BAR; PG8_MMA(0, 0, At, B0); PG8_MMA(0, 1, At, B1); PG8_BAR; PG8_SCHED;
            PG8_LDA(At, 0, 1); PG8_STAGE_B(PG8_SB(0, 0), b2); PG8_STAGE_B(PG8_SB(0, 1), b2 + hstep); PG8_STAGE_A(PG8_SA(0, 0), uA0, k2);
            PG8_WAIT_V(8); PG8_WAIT_L(0); PG8_BAR; PG8_MMA(1, 0, At, B0); PG8_MMA(1, 1, At, B1); PG8_BAR; PG8_SCHED;
            PG8_LDB(B0, 1, 0); PG8_LDB(B1, 1, 1); PG8_SCHED; PG8_LDA(At, 1, 0); PG8_STAGE_A(PG8_SA(0, 1), uA1, k2);
            PG8_WAIT_V(8); PG8_WAIT_L(0); PG8_BAR; PG8_MMA(0, 0, At, B0); PG8_MMA(0, 1, At, B1); PG8_BAR; PG8_SCHED;
            PG8_LDA(At, 1, 1); PG8_STAGE_B(PG8_SB(1, 0), b3); PG8_STAGE_B(PG8_SB(1, 1), b3 + hstep); PG8_STAGE_A(PG8_SA(1, 0), uA0, k3);
            PG8_WAIT_V(8); PG8_WAIT_L(0); PG8_BAR; PG8_MMA(1, 0, At, B0); PG8_MMA(1, 1, At, B1); PG8_BAR; PG8_SCHED;
        }
        if constexpr (Sched::FP8) asm volatile("s_nop 15\n\ts_nop 15" ::: "memory");
        if (wr == 0) PG8_BAR;
        E(acc, cur, wr, wc, fr, fq);
        if (!has_next) break;
#pragma unroll
        for (int a = 0; a < 2; ++a)
#pragma unroll
            for (int b = 0; b < 2; ++b)
#pragma unroll
                for (int m = 0; m < 4; ++m)
#pragma unroll
                    for (int n = 0; n < 2; ++n) acc[a][b][m][n] = (f32x4){0.f, 0.f, 0.f, 0.f};
        cur = nxt; cB = nB; ++ui;
#pragma unroll
        for (int i = 0; i < 2; ++i) { vA0[i] = nA0[i]; vA1[i] = nA1[i]; }
        if (wr == 1) PG8_BAR;
    }
    PG8_WAIT_V(0);
    PG8_BAR;
#undef PG8_SA
#undef PG8_SB
#undef PG8_STAGE_A
#undef PG8_STAGE_B
#undef PG8_LDA
#undef PG8_LDB
#undef PG8_MMA
#undef PG8_WAIT_V
#undef PG8_WAIT_L
#undef PG8_BAR
#undef PG8_SCHED
}
__device__ __forceinline__ bool tile_order(int i, int G, int c, int nM, int nN, int& pm, int& pn) {
    const int nwg = nM * nN; const long L = (long)i * G + c; if (L >= nwg) return false;
    int wgid = (int)L; { const int q = nwg / 8, r = nwg % 8, xcd = wgid % 8, off = wgid / 8; wgid = (xcd < r ? xcd * (q + 1) : r * (q + 1) + (xcd - r) * q) + off; }
    const int WGM = 8, nig = WGM * nN, gid = wgid / nig, fm = gid * WGM, gsz = (nM - fm) < WGM ? (nM - fm) : WGM;
    pm = fm + ((wgid % nig) % gsz); pn = (wgid % nig) / gsz; return true;
}
template <bool F8 = false> struct DenseSchedT {
    static constexpr bool FP8 = F8; static constexpr int SCALE_A = 0x7F7F7F7F, SCALE_B = F8 ? 0x79797979 : 0x7F7F7F7F;
    const char* A; const char* Bt; int KB, nM, nN, G, c;
    __device__ __forceinline__ bool next(int i, Unit& u) const { u.l = 0; u.i0 = 0; u.cn = 0; return tile_order(i, G, c, nM, nN, u.pm, u.pn); }
    __device__ __forceinline__ const char* a_base() const { return A; }
    __device__ __forceinline__ unsigned a_voff(const Unit& u, int h, int R, int C) const { return (unsigned)((u.pm * 256 + h * 128 + R) * KB + C * 2); }
    __device__ __forceinline__ const char* b_base(const Unit& u) const { return Bt + (size_t)u.pn * 256 * KB; }
};
typedef DenseSchedT<false> DenseSched;
template <int MODE> struct MoeSched {
    static constexpr bool FP8 = true; static constexpr int SCALE_A = (MODE == 0) ? 0x7F7F7F7F : 0x7D7D7D7D, SCALE_B = 0x79797979;
    const char* A; const char* Bt; const int* list; const LAS int* PB; const LAS int* CN; const LAS int* RBL; int KB, rb0, nunits, vcu, G;
    __device__ __forceinline__ bool next(int i, Unit& u) const {
        const int idx = vcu + i * G; if (idx >= nunits) return false;
        const int rb = rb0 + (idx >> 2); const int l = RBL[rb];
        u.pm = rb; u.pn = idx & 3; u.l = l; u.i0 = (rb - PB[l]) * 256; u.cn = CN[l]; return true; }
    __device__ __forceinline__ const char* a_base() const { return A; }
    __device__ __forceinline__ unsigned a_voff(const Unit& u, int h, int R, int C) const {
        if (MODE == 0) { int idx = u.i0 + h * 128 + R; idx = idx < u.cn ? idx : u.cn - 1; const int tok = list[(size_t)u.l * T + idx]; return (unsigned)(tok * KB + C * 2); }
        return (unsigned)((u.pm * 256 + h * 128 + R) * KB + C * 2); }
    __device__ __forceinline__ const char* b_base(const Unit& u) const { return Bt + ((size_t)(u.l & 31) * 1024 + u.pn * 256) * KB; }
};
}

struct EpiProj { static constexpr bool PERM = true, MID = false; bf16* proj; int coff;
    __device__ __forceinline__ void operator()(const f32x4 (&acc)[2][2][4][2], const pg8::Unit& u, int wr, int wc, int fr, int fq) const {
        const int fro = opaque(fr), fqo = opaque(fq);
#pragma unroll
        for (int ai = 0; ai < 2; ++ai)
#pragma unroll
            for (int m = 0; m < 4; ++m) { bf16* rowp = proj + (size_t)(u.pm * 256 + ai * 128 + wr * 64 + m * 16 + fro) * NPROJ + coff + u.pn * 256 + wc * 32 + 8 * fqo;
#pragma unroll
                for (int bj = 0; bj < 2; ++bj) { const f32x4 v0 = acc[ai][bj][m][0], v1 = acc[ai][bj][m][1];
                    u32x4 w; w.x = pk2(v0[0], v0[1]); w.y = pk2(v0[2], v0[3]); w.z = pk2(v1[0], v1[1]); w.w = pk2(v1[2], v1[3]); *(u32x4*)(rowp + bj * 128) = w; } }
    } };
struct EpiZ8 { static constexpr bool PERM = true, MID = false; unsigned char* projb;
    __device__ __forceinline__ void operator()(const f32x4 (&acc)[2][2][4][2], const pg8::Unit& u, int wr, int wc, int fr, int fq) const {
        const int fro = opaque(fr), fqo = opaque(fq);
#pragma unroll
        for (int ai = 0; ai < 2; ++ai)
#pragma unroll
            for (int m = 0; m < 4; ++m) { unsigned char* rowp = projb + ((size_t)(u.pm * 256 + ai * 128 + wr * 64 + m * 16 + fro) * NPROJ + C_ZA) * 2 + u.pn * 256 + wc * 32 + 8 * fqo;
#pragma unroll
                for (int bj = 0; bj < 2; ++bj) { const f32x4 v0 = acc[ai][bj][m][0], v1 = acc[ai][bj][m][1];
                    u32x2 w; int o8 = __builtin_amdgcn_cvt_pk_fp8_f32(v0[0], v0[1], 0, false); w.x = (unsigned)__builtin_amdgcn_cvt_pk_fp8_f32(v0[2], v0[3], o8, true);
                    o8 = __builtin_amdgcn_cvt_pk_fp8_f32(v1[0], v1[1], 0, false); w.y = (unsigned)__builtin_amdgcn_cvt_pk_fp8_f32(v1[2], v1[3], o8, true);
                    *(u32x2*)(rowp + bj * 128) = w; } }
    } };
__device__ __forceinline__ void unpack8f(const u32x2 w, float* v) {
    const f32x2_ a = __builtin_amdgcn_cvt_pk_f32_fp8((int)w.x, false), b = __builtin_amdgcn_cvt_pk_f32_fp8((int)w.x, true), c = __builtin_amdgcn_cvt_pk_f32_fp8((int)w.y, false), d = __builtin_amdgcn_cvt_pk_f32_fp8((int)w.y, true);
    v[0] = a[0]; v[1] = a[1]; v[2] = b[0]; v[3] = b[1]; v[4] = c[0]; v[5] = c[1]; v[6] = d[0]; v[7] = d[1]; }
__device__ __forceinline__ float ratio_(float zb, float za) { return (1.f + fexp_(-zb)) * __builtin_amdgcn_rcpf(1.f + fexp_(-za)); }
struct EpiMixed { static constexpr bool PERM = true, MID = true; const unsigned char* projb; bf16* mixed;
    __device__ __forceinline__ void mid(f32x4 (&acc)[2][2][4][2], const pg8::Unit& u, int wr, int wc, int fr, int fq) const {
        const int fro = opaque(fr), fqo = opaque(fq);
#pragma unroll
        for (int ai = 0; ai < 2; ++ai) {
            u32x2 za[4][2], zb[4][2];
#pragma unroll
            for (int m = 0; m < 4; ++m) { const unsigned char* zr = projb + ((size_t)(u.pm * 256 + ai * 128 + wr * 64 + m * 16 + fro) * NPROJ + C_ZA) * 2 + u.pn * 256 + wc * 32 + 8 * fqo;
#pragma unroll
                for (int bj = 0; bj < 2; ++bj) { za[m][bj] = *(const u32x2*)(zr + bj * 128); zb[m][bj] = *(const u32x2*)(zr + 1024 + bj * 128); } }
#pragma unroll
            for (int m = 0; m < 4; ++m)
#pragma unroll
                for (int bj = 0; bj < 2; ++bj) { float a[8], b[8]; unpack8f(za[m][bj], a); unpack8f(zb[m][bj], b); f32x4 r0, r1;
                    r0[0] = ratio_(b[0], a[0]); r0[1] = ratio_(b[1], a[1]); r0[2] = ratio_(b[2], a[2]); r0[3] = ratio_(b[3], a[3]);
                    r1[0] = ratio_(b[4], a[4]); r1[1] = ratio_(b[5], a[5]); r1[2] = ratio_(b[6], a[6]); r1[3] = ratio_(b[7], a[7]);
                    acc[ai][bj][m][0] = acc[ai][bj][m][0] * r0; acc[ai][bj][m][1] = acc[ai][bj][m][1] * r1; }
            asm volatile("" ::: "memory"); }
    }
    __device__ __forceinline__ void operator()(const f32x4 (&acc)[2][2][4][2], const pg8::Unit& u, int wr, int wc, int fr, int fq) const {
        const int fro = opaque(fr), fqo = opaque(fq);
#pragma unroll
        for (int ai = 0; ai < 2; ++ai) {
            u32x2 zb[4][2];
#pragma unroll
            for (int m = 0; m < 4; ++m) { const unsigned char* zr = projb + ((size_t)(u.pm * 256 + ai * 128 + wr * 64 + m * 16 + fro) * NPROJ + C_ZA) * 2 + u.pn * 256 + wc * 32 + 8 * fqo;
#pragma unroll
                for (int bj = 0; bj < 2; ++bj) zb[m][bj] = *(const u32x2*)(zr + 1024 + bj * 128); }
#pragma unroll
            for (int m = 0; m < 4; ++m) { bf16* orow = mixed + (size_t)(u.pm * 256 + ai * 128 + wr * 64 + m * 16 + fro) * 1024 + u.pn * 256 + wc * 32 + 8 * fqo;
#pragma unroll
                for (int bj = 0; bj < 2; ++bj) { float b[8]; unpack8f(zb[m][bj], b); const f32x4 v0 = acc[ai][bj][m][0], v1 = acc[ai][bj][m][1];
                    u32x4 w; w.x = pk2(v0[0] * sigmoidf_(b[0]), v0[1] * sigmoidf_(b[1])); w.y = pk2(v0[2] * sigmoidf_(b[2]), v0[3] * sigmoidf_(b[3]));
                    w.z = pk2(v1[0] * sigmoidf_(b[4]), v1[1] * sigmoidf_(b[5])); w.w = pk2(v1[2] * sigmoidf_(b[6]), v1[3] * sigmoidf_(b[7]));
                    *(u32x4*)(orow + bj * 128) = w; } }
            asm volatile("" ::: "memory"); }
    } };
struct EpiX1 { static constexpr bool PERM = true, MID = false; const bf16* xn; const float* rms1; const float* w1; const float* w2; bf16* x1b; unsigned char* hn; float* ssq;
    __device__ __forceinline__ void operator()(const f32x4 (&acc)[2][2][4][2], const pg8::Unit& u, int wr, int wc, int fr, int fq) const {
        const int fro = opaque(fr), fqo = opaque(fq);
        f32x4 wv[2][2], iw[2][2];
#pragma unroll
        for (int bj = 0; bj < 2; ++bj)
#pragma unroll
            for (int n = 0; n < 2; ++n) { const int col = u.pn * 256 + bj * 128 + wc * 32 + 8 * fqo + 4 * n; wv[bj][n] = *(const f32x4*)(w2 + col);
                const f32x4 a = *(const f32x4*)(w1 + col); iw[bj][n] = (f32x4){__builtin_amdgcn_rcpf(a[0]), __builtin_amdgcn_rcpf(a[1]), __builtin_amdgcn_rcpf(a[2]), __builtin_amdgcn_rcpf(a[3])}; }
#pragma unroll
        for (int ai = 0; ai < 2; ++ai)
#pragma unroll
            for (int mh = 0; mh < 2; ++mh) {
                u32x4 xv[2][2]; float rm[2];
#pragma unroll
                for (int mm = 0; mm < 2; ++mm) { const size_t row = (size_t)(u.pm * 256 + ai * 128 + wr * 64 + (mh * 2 + mm) * 16 + fro); rm[mm] = rms1[row];
#pragma unroll
                    for (int bj = 0; bj < 2; ++bj) xv[mm][bj] = *(const u32x4*)(xn + row * 1024 + u.pn * 256 + bj * 128 + wc * 32 + 8 * fqo); }
#pragma unroll
                for (int mm = 0; mm < 2; ++mm) { const int m = mh * 2 + mm; const size_t row = (size_t)(u.pm * 256 + ai * 128 + wr * 64 + m * 16 + fro); float s = 0.f;
#pragma unroll
                    for (int bj = 0; bj < 2; ++bj)
                        { u32x2 h8; u32x4 xb; const u32x4 xw = xv[mm][bj];
#pragma unroll
                          for (int n = 0; n < 2; ++n) { const unsigned w0 = n == 0 ? xw.x : xw.z, w1_ = n == 0 ? xw.y : xw.w;
                            f32x4 xr = (f32x4){bflo(w0), bfhi(w0), bflo(w1_), bfhi(w1_)}; xr = xr * rm[mm] * iw[bj][n];
                            const f32x4 v = acc[ai][bj][m][n] + xr; const f32x4 w = wv[bj][n];
                            if (n == 0) { xb.x = pk2(v[0], v[1]); xb.y = pk2(v[2], v[3]); } else { xb.z = pk2(v[0], v[1]); xb.w = pk2(v[2], v[3]); }
                            s += (v[0] * v[0] + v[1] * v[1]) + (v[2] * v[2] + v[3] * v[3]);
                            int o8 = __builtin_amdgcn_cvt_pk_fp8_f32(v[0] * w[0], v[1] * w[1], 0, false); o8 = __builtin_amdgcn_cvt_pk_fp8_f32(v[2] * w[2], v[3] * w[3], o8, true); if (n == 0) h8.x = (unsigned)o8; else h8.y = (unsigned)o8; }
                          *(u32x4*)(x1b + row * 1024 + u.pn * 256 + bj * 128 + wc * 32 + 8 * fqo) = xb;
                          *(u32x2*)(hn + row * 1024 + u.pn * 256 + bj * 128 + wc * 32 + 8 * fqo) = h8; }
                    s += __shfl_xor(s, 16); s += __shfl_xor(s, 32);
                    if (fq == 0) ssq[row * 16 + u.pn * 4 + wc] = s; }
                asm volatile("" ::: "memory"); }
    } };
struct EpiGateUp { static constexpr bool PERM = true, MID = false; const int* list; const float* rstdv; unsigned char* hb;
    __device__ __forceinline__ void operator()(const f32x4 (&acc)[2][2][4][2], const pg8::Unit& u, int wr, int wc, int fr, int fq) const {
        const int fro = opaque(fr), fqo = opaque(fq);
#pragma unroll
        for (int ai = 0; ai < 2; ++ai) {
            float rsv[4];
#pragma unroll
            for (int m = 0; m < 4; ++m) { int idx = u.i0 + ai * 128 + wr * 64 + m * 16 + fro; idx = idx < u.cn ? idx : u.cn - 1; rsv[m] = rstdv[list[(size_t)u.l * T + idx]]; }
#pragma unroll
            for (int m = 0; m < 4; ++m) { const int r = ai * 128 + wr * 64 + m * 16 + fro; const float rs = rsv[m];
                u32x2 w; const float rs4 = rs * 4.f;
                { const f32x4 g = acc[ai][0][m][0] * rs, uu = acc[ai][1][m][0] * rs4;
                  int o8 = __builtin_amdgcn_cvt_pk_fp8_f32(g[0] * sigmoidf_(g[0]) * uu[0], g[1] * sigmoidf_(g[1]) * uu[1], 0, false);
                  w.x = (unsigned)__builtin_amdgcn_cvt_pk_fp8_f32(g[2] * sigmoidf_(g[2]) * uu[2], g[3] * sigmoidf_(g[3]) * uu[3], o8, true); }
                { const f32x4 g = acc[ai][0][m][1] * rs, uu = acc[ai][1][m][1] * rs4;
                  int o8 = __builtin_amdgcn_cvt_pk_fp8_f32(g[0] * sigmoidf_(g[0]) * uu[0], g[1] * sigmoidf_(g[1]) * uu[1], 0, false);
                  w.y = (unsigned)__builtin_amdgcn_cvt_pk_fp8_f32(g[2] * sigmoidf_(g[2]) * uu[2], g[3] * sigmoidf_(g[3]) * uu[3], o8, true); }
                *(u32x2*)(hb + ((size_t)u.pm * 256 + r) * 512 + u.pn * 128 + wc * 32 + 8 * fqo) = w; }
            asm volatile("" ::: "memory"); }
    } };
struct EpiDownY { static constexpr bool PERM = true, MID = false; const int* list; const float* gw; bf16* Y;
    __device__ __forceinline__ void operator()(const f32x4 (&acc)[2][2][4][2], const pg8::Unit& u, int wr, int wc, int fr, int fq) const {
        const int fro = opaque(fr), fqo = opaque(fq);
        int tk[8]; float gv[8];
#pragma unroll
        for (int q = 0; q < 8; ++q) { const int idx = u.i0 + (q >> 2) * 128 + wr * 64 + (q & 3) * 16 + fro; tk[q] = idx < u.cn ? list[(size_t)u.l * T + idx] : -1; }
#pragma unroll
        for (int q = 0; q < 8; ++q) gv[q] = tk[q] >= 0 ? gw[tk[q] * 2 + 1] : 0.f;
#pragma unroll
        for (int ai = 0; ai < 2; ++ai)
#pragma unroll
            for (int m = 0; m < 4; ++m) { const int tok = tk[ai * 4 + m]; const float g = gv[ai * 4 + m];
                if (tok >= 0) {
#pragma unroll
                    for (int bj = 0; bj < 2; ++bj) { const f32x4 v0 = acc[ai][bj][m][0] * g, v1 = acc[ai][bj][m][1] * g;
                        u32x4 w; w.x = pk2(v0[0], v0[1]); w.y = pk2(v0[2], v0[3]); w.z = pk2(v1[0], v1[1]); w.w = pk2(v1[2], v1[3]);
                        *(u32x4*)(Y + (size_t)tok * 1024 + u.pn * 256 + bj * 128 + wc * 32 + 8 * fqo) = w; } } }
    } };
#ifndef EPIDOWN_BATCH
#define EPIDOWN_BATCH 2
#endif
struct EpiDown { static constexpr bool PERM = true, MID = false; const int* list; const float* gw; float* out; const bf16* x1b; const bf16* Y; const float* tp;
    __device__ __forceinline__ void operator()(const f32x4 (&acc)[2][2][4][2], const pg8::Unit& u, int wr, int wc, int fr, int fq) const {
        const int fro = opaque(fr), fqo = opaque(fq);
        int tk[8]; float gv[8];
#pragma unroll
        for (int q = 0; q < 8; ++q) { const int idx = u.i0 + (q >> 2) * 128 + wr * 64 + (q & 3) * 16 + fro; tk[q] = idx < u.cn ? list[(size_t)u.l * T + idx] : -1; }
#pragma unroll
        for (int q = 0; q < 8; ++q) gv[q] = tk[q] >= 0 ? gw[tk[q] * 2] : 0.f;
#pragma unroll
        for (int ai = 0; ai < 2; ++ai)
#pragma unroll
            for (int mh = 0; mh < 4 / EPIDOWN_BATCH; ++mh) {
                u32x2 ov[EPIDOWN_BATCH][2][2]; u32x2 yv[EPIDOWN_BATCH][2][2];
#pragma unroll
                for (int mm = 0; mm < EPIDOWN_BATCH; ++mm) { const int tok = tk[ai * 4 + mh * EPIDOWN_BATCH + mm]; const size_t base = (size_t)(tok >= 0 ? tok : 0) * 1024 + u.pn * 256 + wc * 32 + 8 * fqo;
#pragma unroll
                    for (int bj = 0; bj < 2; ++bj)
#pragma unroll
                        for (int n = 0; n < 2; ++n) { ov[mm][bj][n] = *(const u32x2*)(x1b + base + bj * 128 + n * 4); yv[mm][bj][n] = *(const u32x2*)(Y + base + bj * 128 + n * 4); } }
#pragma unroll
                for (int mm = 0; mm < EPIDOWN_BATCH; ++mm) { const int m = mh * EPIDOWN_BATCH + mm; const int tok = tk[ai * 4 + m]; const float g = gv[ai * 4 + m];
                    if (tok >= 0) { const size_t base = (size_t)tok * 1024 + u.pn * 256 + wc * 32 + 8 * fqo;
#pragma unroll
                        for (int bj = 0; bj < 2; ++bj)
#pragma unroll
                            for (int n = 0; n < 2; ++n) { const u32x2 y = yv[mm][bj][n], xw = ov[mm][bj][n]; f32x4 o = acc[ai][bj][m][n] * g; o[0] += bflo(xw.x); o[1] += bfhi(xw.x); o[2] += bflo(xw.y); o[3] += bfhi(xw.y);
                                o[0] += bflo(y.x); o[1] += bfhi(y.x); o[2] += bflo(y.y); o[3] += bfhi(y.y);
#ifdef TPA
                                { const float db = sqrtf(tp[1] * 2e-6f); o = o + (((tok + n) & 1) ? db : -db); if (tok == 0 && u.pn == 0 && bj == 0 && n == 0 && wc == 0 && fqo == 0) o[0] += tp[0] * TPAS; }
#endif
                                *(f32x4*)(out + base + bj * 128 + n * 4) = o; } } }
                asm volatile("" ::: "memory"); }
    } };

struct TItem { const float* W; bf16* WT; int N, ldwt, k0, n0, drow0, f8; };
__device__ __forceinline__ void titem_load(const TItem& t, int lane, float (&tv)[32]);
__device__ __forceinline__ void titem_store(const TItem& t, int lane, const float (&tv)[32], LAS float* scr);
__device__ __forceinline__ void transpose_item(const float* W, int N, bf16* WT, int ldwt, int kd0, int k0, int n0, int drow0, LAS float* scr, int lane) {
    TItem t; t.W = W; t.WT = WT + kd0; t.N = N; t.ldwt = ldwt; t.k0 = k0; t.n0 = n0; t.drow0 = drow0; t.f8 = 0;
    float tv[32]; titem_load(t, lane, tv); titem_store(t, lane, tv, scr);
}

constexpr int EI_G = 16 * 16, EI_D = 8 * 32, EI_PER = 2 * EI_G + EI_D, EI_TOTAL = NEXP * EI_PER;
__device__ __forceinline__ TItem expert_item(const Params& P, LAS unsigned char* lds, int it) {
    TItem t; const int e = it / EI_PER; int r = it - e * EI_PER;
    if (r < EI_G) { const int kb = r / 16, nb = r % 16; t.n0 = 32 * nb; t.W = PP(w_gate) + (size_t)e * 1024 * 512; t.N = 512; t.WT = (bf16*)(P.ws + WS_WGU + (size_t)e * 1024 * 1024); t.ldwt = 1024; t.k0 = 64 * kb; t.drow0 = (t.n0 >> 7) * 256 + (t.n0 & 127); t.f8 = 1; return t; }
    r -= EI_G;
    if (r < EI_G) { const int kb = r / 16, nb = r % 16; t.n0 = 32 * nb; t.W = PP(w_up) + (size_t)e * 1024 * 512; t.N = 512; t.WT = (bf16*)(P.ws + WS_WGU + (size_t)e * 1024 * 1024); t.ldwt = 1024; t.k0 = 64 * kb; t.drow0 = (t.n0 >> 7) * 256 + 128 + (t.n0 & 127); t.f8 = 1; return t; }
    r -= EI_G;
    { const int kb = r / 32, nb = r % 32; t.n0 = 32 * nb; t.W = PP(w_down) + (size_t)e * 512 * 1024; t.N = 1024; t.WT = (bf16*)(P.ws + WS_WD + (size_t)e * 1024 * 512); t.ldwt = 512; t.k0 = 64 * kb; t.drow0 = 32 * nb; t.f8 = 1; return t; }
}
__device__ __forceinline__ void titem_load(const TItem& t, int lane, float (&tv)[32]) {
#pragma unroll
    for (int j = 0; j < 8; ++j) { const f32x4 v = *(const f32x4*)(t.W + (size_t)(t.k0 + 8 * j + (lane >> 3)) * t.N + t.n0 + 4 * (lane & 7));
        tv[4 * j] = v[0]; tv[4 * j + 1] = v[1]; tv[4 * j + 2] = v[2]; tv[4 * j + 3] = v[3]; }
}
__device__ __forceinline__ void titem_store(const TItem& t, int lane, const float (&tv)[32], LAS float* scr) {
#pragma unroll
    for (int j = 0; j < 8; ++j)
#pragma unroll
        for (int q = 0; q < 4; ++q) scr[(8 * j + (lane >> 3)) * 33 + 4 * (lane & 7) + q] = tv[4 * j + q];
    asm volatile("s_waitcnt lgkmcnt(0)" ::: "memory");
    if (t.f8) {
        const int n = lane >> 1, hf = lane & 1; const LAS float* sp = scr + (32 * hf) * 33 + n; int w8[8];
#pragma unroll
        for (int q = 0; q < 8; ++q) { int o8 = __builtin_amdgcn_cvt_pk_fp8_f32(sp[(4 * q) * 33] * 64.f, sp[(4 * q + 1) * 33] * 64.f, 0, false);
            w8[q] = __builtin_amdgcn_cvt_pk_fp8_f32(sp[(4 * q + 2) * 33] * 64.f, sp[(4 * q + 3) * 33] * 64.f, o8, true); }
        unsigned char* dst = (unsigned char*)t.WT + (size_t)(t.drow0 + n) * t.ldwt + t.k0 + 32 * hf;
        *(u32x4*)dst = (u32x4){(unsigned)w8[0], (unsigned)w8[1], (unsigned)w8[2], (unsigned)w8[3]}; *(u32x4*)(dst + 16) = (u32x4){(unsigned)w8[4], (unsigned)w8[5], (unsigned)w8[6], (unsigned)w8[7]};
    } else {
        const int c = lane & 7;
#pragma unroll
        for (int j = 0; j < 4; ++j) { const int n = (lane >> 3) + 8 * j; const LAS float* sp = scr + (8 * c) * 33 + n;
            u32x4 o; o.x = pk2(sp[0 * 33], sp[1 * 33]); o.y = pk2(sp[2 * 33], sp[3 * 33]); o.z = pk2(sp[4 * 33], sp[5 * 33]); o.w = pk2(sp[6 * 33], sp[7 * 33]);
            *(u32x4*)(t.WT + (size_t)(t.drow0 + n) * t.ldwt + t.k0 + 8 * c) = o; } }
    asm volatile("s_waitcnt lgkmcnt(0)" ::: "memory");
}

__device__ __forceinline__ void phase0(const Params& P, LAS unsigned char* lds, int vcu, int G, int tid, int wid, int lane) {
    unsigned char* ws = P.ws;
    LAS float* scr = (LAS float*)(lds + wid * 16384);
    const int gw = vcu * 8 + wid, NGW = G * 8;
    constexpr int I_IN = 16 * 152, I_BR = 8 * 32, I_OUT = 16 * 32;
    constexpr int NITEMS = I_IN + 2 * I_BR + I_OUT;
    for (int it = gw; it < NITEMS; it += NGW) {
        int r = it;
        if (r < I_IN) { const int kb = r / 152, nb = r % 152;
            if (32 * nb < C_ZA) transpose_item(PP(w_in), NPROJ, (bf16*)(ws + WS_WINT), 1024, 0, 64 * kb, 32 * nb, 32 * nb, scr, lane);
            else { TItem t; t.W = PP(w_in); t.WT = (bf16*)(ws + WS_WZ8); t.N = NPROJ; t.ldwt = 1024; t.k0 = 64 * kb; t.n0 = 32 * nb; t.drow0 = 32 * nb - C_ZA; t.f8 = 1; float tv[32]; titem_load(t, lane, tv); titem_store(t, lane, tv, scr); }
            continue; } r -= I_IN;
        if (r < I_BR) { const int kb = r / 32, nb = r % 32; transpose_item(PP(w_ba), 1024, (bf16*)(ws + WS_WAT), 1024, 0, 64 * kb, 32 * nb, 32 * nb, scr, lane); continue; } r -= I_BR;
        if (r < I_BR) { const int kb = r / 32, nb = r % 32; transpose_item(PP(w_bh), 1024, (bf16*)(ws + WS_WAT), 1024, 512, 64 * kb, 32 * nb, 32 * nb, scr, lane); continue; } r -= I_BR;
        { const int kb = r / 32, nb = r % 32; transpose_item(PP(w_out), 1024, (bf16*)(ws + WS_WOT), 1024, 0, 64 * kb, 32 * nb, 32 * nb, scr, lane); }
    }
    { bf16* Wh = (bf16*)(ws + WS_WR); bf16* Wl = Wh + 48 * 1024;
      for (int idx = (vcu * NTHREADS + tid); idx < 48 * 1024; idx += G * NTHREADS) { const int j = idx >> 10, k = idx & 1023; float v = 0.f;
          if (j < 4) v = PP(w_rg)[k * 4 + j] * PP(norm2_w)[k]; else if (j < 36) v = PP(w_re)[k * 32 + (j - 4)] * PP(norm2_w)[k];
          const unsigned hi = f2bf(v); Wh[idx] = (bf16)hi; Wl[idx] = (bf16)f2bf(v - bf2f(hi)); } }
    { float* cs = (float*)(ws + WS_CS);
      const float invf[8] = {1.0f, 0.1939227432012558f, 0.03760603070259094f, 0.007292664609849453f, 0.0014142135623842478f, 0.00027424818836152554f, 5.318296098266728e-05f, 1.0313386155758053e-05f};
      for (int idx = (vcu * NTHREADS + tid); idx < T * 8; idx += G * NTHREADS) { const int tok = idx >> 3, i = idx & 7; float f = invf[0];
#pragma unroll
          for (int q = 1; q < 8; ++q) f = (i == q) ? invf[q] : f;
          float sn, c_; sincosf((float)PP(positions)[tok] * f, &sn, &c_); cs[tok * 16 + i] = c_; cs[tok * 16 + 8 + i] = sn; } }
    { bf16* xn = (bf16*)P.out;
      f32x4 wv[4];
#pragma unroll
      for (int j = 0; j < 4; ++j) wv[j] = *(const f32x4*)(PP(norm1_w) + 4 * lane + 256 * j);
      for (int m = gw; m < T; m += NGW) {
          const f32x4* xr = (const f32x4*)(P.x + (size_t)m * D) + lane; f32x4 v[4]; float s = 0.f;
#pragma unroll
          for (int j = 0; j < 4; ++j) { v[j] = xr[64 * j]; s += (v[j].x * v[j].x + v[j].y * v[j].y) + (v[j].z * v[j].z + v[j].w * v[j].w); }
          const float rms = sqrtf(wave_sum(s) * (1.f / D) + EPS); const float rstd = 1.f / rms;
          if (lane == 0) ((float*)(ws + WS_R1))[m] = rms;
          u32x2* o8 = (u32x2*)(xn + (size_t)m * D) + lane; int* q8 = (int*)((unsigned char*)P.out + OUT_XN8 + (size_t)m * D) + lane;
#pragma unroll
          for (int j = 0; j < 4; ++j) { const float a0 = v[j].x * rstd * wv[j].x, a1 = v[j].y * rstd * wv[j].y, a2 = v[j].z * rstd * wv[j].z, a3 = v[j].w * rstd * wv[j].w;
              u32x2 o; o.x = pk2(a0, a1); o.y = pk2(a2, a3); o8[64 * j] = o;
              int w8 = __builtin_amdgcn_cvt_pk_fp8_f32(a0, a1, 0, false); w8 = __builtin_amdgcn_cvt_pk_fp8_f32(a2, a3, w8, true); q8[64 * j] = w8; }
      } }
}

__device__ __forceinline__ void phase1(const Params& P, LAS unsigned char* lds, int G) {
    {
        const pg8::DenseSched S{(const char*)P.out, (const char*)(P.ws + WS_WINT), 2048, T / 256, C_ZA / 256, G, (int)blockIdx.x};
        const EpiProj E{(bf16*)(P.ws + WS_PROJ), 0};
        pg8::gemm_phase(lds, S, E); }
    {
        const pg8::DenseSchedT<true> S{(const char*)P.out + OUT_XN8, (const char*)(P.ws + WS_WZ8), 1024, T / 256, (NPROJ - C_ZA) / 256, G, (int)blockIdx.x};
        const EpiZ8 E{(unsigned char*)(P.ws + WS_PROJ)};
        pg8::gemm_phase(lds, S, E); }
}
__device__ __forceinline__ void phase5(const Params& P, LAS unsigned char* lds, int G) {
    const pg8::DenseSched S{(const char*)P.out + OUT_AH, (const char*)(P.ws + WS_WAT), 2048, T / 256, 4, G, (int)blockIdx.x};
    const EpiMixed E{(const unsigned char*)(P.ws + WS_PROJ), (bf16*)(P.ws + WS_MIXED)};
    pg8::gemm_phase(lds, S, E);
}
__device__ __forceinline__ void phase6(const Params& P, LAS unsigned char* lds, int G) {
    const pg8::DenseSched S{(const char*)(P.ws + WS_MIXED), (const char*)(P.ws + WS_WOT), 2048, T / 256, 4, G, (int)blockIdx.x};
    const EpiX1 E{(const bf16*)P.out, (const float*)(P.ws + WS_R1), PP(norm1_w), PP(norm2_w), (bf16*)(P.ws + WS_X1B), (unsigned char*)(P.ws + WS_HN), (float*)(P.ws + WS_SSQ)};
    pg8::gemm_phase(lds, S, E);
}

constexpr int H_TOT = 0, H_DV = 2048, H_SSQ = 2560, H_QT = 4608, H_KH = H_QT + 17408, H_KTT = H_KH + 17408, H_VT = H_KTT + 18432, H_ST = H_VT + 18432, H_AM = H_ST + 34816, H_END = H_AM + 9216;
static_assert(H_END <= LDS_ST_OFF, "hgrn LDS");
__device__ __forceinline__ bf16x8 ldfrag(const LAS unsigned char* base, int row, int stride, int kbyte) { return *(const LAS bf16x8*)(base + row * stride + kbyte); }

template <int MODE>
__device__ __forceinline__ void hgrn_unit(const Params& P, LAS unsigned char* lds, int unit, int tid, int wid, int lane, int cit = EI_TOTAL, int cstride = 1) {
    LAS float* cscr = (LAS float*)(lds + (wid < 4 ? H_QT + wid * 8448 : H_ST + (wid - 4) * 8448));
    const int b = unit >> 6, h = (unit >> 4) & 3, sc = unit & 15;
    const int fr = opaque(lane & 15), fq = opaque(lane >> 4), c = opaque(tid & 127), qd = tid >> 7;
    const bf16* proj = (const bf16*)(P.ws + WS_PROJ);
    LAS float* TOT = (LAS float*)(lds + H_TOT); LAS float* DV = (LAS float*)(lds + H_DV); LAS float* SSQ = (LAS float*)(lds + H_SSQ);
    LAS bf16* Qt = (LAS bf16*)(lds + H_QT); LAS bf16* Kh = (LAS bf16*)(lds + H_KH); LAS bf16* KtT = (LAS bf16*)(lds + H_KTT); LAS bf16* VT = (LAS bf16*)(lds + H_VT);
    const float lbv = 1.f / (1.f + __expf(PP(hlb)[512 + h * 128 + c] - PP(hlb)[h * 128 + c]));
    float* Ug = (float*)(P.ws + WS_U) + (size_t)unit * 16384;
    const float* Sin = (const float*)(P.ws + WS_SIN) + (size_t)unit * 16384;
    f32x4 accS[8];
#pragma unroll
    for (int di = 0; di < 8; ++di) {
        if (MODE == 1 && sc > 0) {
#pragma unroll
            for (int r = 0; r < 4; ++r) accS[di][r] = Sin[(16 * di + 4 * fq + r) * 128 + 16 * wid + fr];
        } else accS[di] = (f32x4){0.f, 0.f, 0.f, 0.f};
        if (MODE == 1) { u32x2 o; o.x = pk2(accS[di][0], accS[di][1]); o.y = pk2(accS[di][2], accS[di][3]);
            *(LAS u32x2*)(lds + H_ST + (16 * wid + fr) * 272 + (16 * di + 4 * fq) * 2) = o; }
    }
    float dsum = 0.f;
    unsigned short rf[16], rq[16], rv[16];
#define HG_LOAD(ccx) do { const size_t t0x_ = (size_t)b * SEQ + sc * 512 + (ccx) * 64; const bf16* pb_ = proj + (t0x_ + qd * 16) * NPROJ + h * 128 + c; \
        _Pragma("unroll") for (int i = 0; i < 16; ++i) { rf[i] = pb_[(size_t)i * NPROJ + C_FH]; rv[i] = pb_[(size_t)i * NPROJ + C_IH]; if (MODE == 1) rq[i] = pb_[(size_t)i * NPROJ + C_QH]; } \
        } while (0)
    HG_LOAD(0);
#pragma unroll 1
    for (int cc = 0; cc < 8; ++cc) {
        const size_t t0 = (size_t)b * SEQ + sc * 512 + cc * 64;
        float tva[32], tvb[32]; TItem ia, ib; const int ita = cit, itb = cit + cstride;
        if (MODE == 0) { if (ita < EI_TOTAL) { ia = expert_item(P, lds, ita); titem_load(ia, lane, tva); } if (itb < EI_TOTAL) { ib = expert_item(P, lds, itb); titem_load(ib, lane, tvb); } }
        float bpart[16], kk[16]; float run = 0.f;
#pragma unroll
        for (int i = 0; i < 16; ++i) { const float f = bf2f(rf[i]);
            const float kv = (1.f - lbv) * __builtin_amdgcn_rcpf(1.f + fexp_(f));
            kk[i] = kv; run += __builtin_amdgcn_logf(1.f - kv); bpart[i] = run; }
        TOT[qd * 128 + c] = run;
        __syncthreads();
        float offs = 0.f, blast = 0.f;
#pragma unroll
        for (int q = 0; q < 4; ++q) { const float tv = TOT[q * 128 + c]; blast += tv; if (q < qd) offs += tv; }
        if (qd == 0) { DV[c] = exp2_(blast); dsum += blast; }
#pragma unroll
        for (int i = 0; i < 16; ++i) { const int t = qd * 16 + i; const float bb = bpart[i] + offs;
            if (MODE == 1) { const float q = bf2f(rq[i]); const float qs = q * sigmoidf_(q);
                Qt[t * 136 + c] = (bf16)f2bf(qs * exp2_(bb)); Kh[t * 136 + c] = (bf16)f2bf(kk[i] * exp2_(fminf(-bb, 115.f))); }
            KtT[c * 72 + t] = (bf16)f2bf(kk[i] * exp2_(blast - bb));
            VT[c * 72 + t] = rv[i]; }
        u32x2 gcur[4];
        if (MODE == 1) {
#pragma unroll
            for (int mi = 0; mi < 4; ++mi) gcur[mi] = *(const u32x2*)(proj + (t0 + 16 * mi + fr) * NPROJ + C_GH + h * 128 + 16 * wid + 4 * fq); }
        if (cc + 1 < 8) HG_LOAD(cc + 1);
        __syncthreads();
        f32x4 acco[4];
        if (MODE == 1) {
#pragma unroll
            for (int e2 = 0; e2 < 2; ++e2) { const int idx = 2 * wid + e2, mi = idx >> 2, ni = idx & 3; f32x4 a = (f32x4){0.f, 0.f, 0.f, 0.f};
                if (ni <= mi) {
#pragma unroll
                    for (int ks = 0; ks < 4; ++ks) { const bf16x8 kf = ldfrag(lds + H_KH, 16 * ni + fr, 272, (ks * 32 + fq * 8) * 2), qf = ldfrag(lds + H_QT, 16 * mi + fr, 272, (ks * 32 + fq * 8) * 2);
                        a = __builtin_amdgcn_mfma_f32_16x16x32_bf16(kf, qf, a, 0, 0, 0); } }
                const int t = 16 * mi + fr, s0 = 16 * ni + 4 * fq;
#pragma unroll
                for (int r = 0; r < 4; ++r) if (s0 + r > t || ni > mi) a[r] = 0.f;
                u32x2 o; o.x = pk2(a[0], a[1]); o.y = pk2(a[2], a[3]); *(LAS u32x2*)(lds + H_AM + t * 144 + s0 * 2) = o; }
#pragma unroll
            for (int mi = 0; mi < 4; ++mi) { acco[mi] = (f32x4){0.f, 0.f, 0.f, 0.f};
#pragma unroll
                for (int ks = 0; ks < 4; ++ks) { const bf16x8 sf = ldfrag(lds + H_ST, 16 * wid + fr, 272, (ks * 32 + fq * 8) * 2), qf = ldfrag(lds + H_QT, 16 * mi + fr, 272, (ks * 32 + fq * 8) * 2);
                    acco[mi] = __builtin_amdgcn_mfma_f32_16x16x32_bf16(sf, qf, acco[mi], 0, 0, 0); } }
        }
#pragma unroll
        for (int di = 0; di < 8; ++di) { const f32x4 dv4 = *(const LAS f32x4*)(lds + H_DV + (16 * di + 4 * fq) * 4); accS[di] = accS[di] * dv4;
#pragma unroll
            for (int ks = 0; ks < 2; ++ks) { const bf16x8 kf = ldfrag(lds + H_KTT, 16 * di + fr, 144, (ks * 32 + fq * 8) * 2), vf = ldfrag(lds + H_VT, 16 * wid + fr, 144, (ks * 32 + fq * 8) * 2);
                accS[di] = __builtin_amdgcn_mfma_f32_16x16x32_bf16(kf, vf, accS[di], 0, 0, 0); }
            if (MODE == 1) { u32x2 o; o.x = pk2(accS[di][0], accS[di][1]); o.y = pk2(accS[di][2], accS[di][3]);
                *(LAS u32x2*)(lds + H_ST + (16 * wid + fr) * 272 + (16 * di + 4 * fq) * 2) = o; } }
        if (MODE == 0) { if (ita < EI_TOTAL) titem_store(ia, lane, tva, cscr); if (itb < EI_TOTAL) titem_store(ib, lane, tvb, cscr); cit += 2 * cstride; }
        if (MODE == 1) {
            __syncthreads();
#pragma unroll
            for (int mi = 0; mi < 4; ++mi) {
#pragma unroll
                for (int ks = 0; ks < 2; ++ks) { const bf16x8 vf = ldfrag(lds + H_VT, 16 * wid + fr, 144, (ks * 32 + fq * 8) * 2), af = ldfrag(lds + H_AM, 16 * mi + fr, 144, (ks * 32 + fq * 8) * 2);
                    acco[mi] = __builtin_amdgcn_mfma_f32_16x16x32_bf16(vf, af, acco[mi], 0, 0, 0); }
                float s = (acco[mi][0] * acco[mi][0] + acco[mi][1] * acco[mi][1]) + (acco[mi][2] * acco[mi][2] + acco[mi][3] * acco[mi][3]);
                s += __shfl_xor(s, 16); s += __shfl_xor(s, 32);
                if (fq == 0) SSQ[wid * 64 + 16 * mi + fr] = s; }
            __syncthreads();
            bf16* hg = (bf16*)((unsigned char*)P.out + OUT_AH);
            const f32x4 nw = *(const f32x4*)(PP(hnw) + 16 * wid + 4 * fq);
#pragma unroll
            for (int mi = 0; mi < 4; ++mi) { const int t = 16 * mi + fr; float tot = 0.f;
#pragma unroll
                for (int w = 0; w < 8; ++w) tot += SSQ[w * 64 + t];
                const float rstd = __builtin_amdgcn_rsqf(tot * (1.f / 128.f) + EPS);
                const u32x2 gg = gcur[mi];
                const float g0 = bflo(gg.x), g1 = bfhi(gg.x), g2 = bflo(gg.y), g3 = bfhi(gg.y);
                u32x2 o; o.x = pk2(acco[mi][0] * rstd * nw[0] * (g0 * sigmoidf_(g0)), acco[mi][1] * rstd * nw[1] * (g1 * sigmoidf_(g1)));
                o.y = pk2(acco[mi][2] * rstd * nw[2] * (g2 * sigmoidf_(g2)), acco[mi][3] * rstd * nw[3] * (g3 * sigmoidf_(g3)));
                *(u32x2*)(hg + (t0 + t) * 1024 + 512 + h * 128 + 16 * wid + 4 * fq) = o; }
        }
    }
    if (MODE == 0) {
#pragma unroll
        for (int di = 0; di < 8; ++di)
#pragma unroll
            for (int r = 0; r < 4; ++r) Ug[(16 * di + 4 * fq + r) * 128 + 16 * wid + fr] = accS[di][r];
        if (qd == 0) ((float*)(P.ws + WS_DSC))[unit * 128 + c] = exp2_(dsum);
    }
    __syncthreads();
}

__device__ __forceinline__ void hgrn_scan(const Params& P, int G, int tid) {
    const float* U = (const float*)(P.ws + WS_U); float* Sin = (float*)(P.ws + WS_SIN);
    const float* Dsc = (const float*)(P.ws + WS_DSC);
    for (int idx = blockIdx.x * NTHREADS + tid; idx < 16 * 16384; idx += G * NTHREADS) {
        const int p = idx >> 14, e = idx & 16383, dk = e >> 7; float S = 0.f;
        float uu[15], dd[15];
#pragma unroll
        for (int sc = 0; sc < 15; ++sc) { const int u = p * 16 + sc; dd[sc] = Dsc[u * 128 + dk]; uu[sc] = U[(size_t)u * 16384 + e]; }
#pragma unroll
        for (int sc = 0; sc < 15; ++sc) { const int u = p * 16 + sc; S = dd[sc] * S + uu[sc]; Sin[(size_t)(u + 1) * 16384 + e] = S; }
    }
}

constexpr int A_KT = 0, A_VT = 36864, A_QS = 70656, A_END = A_QS + 73728;
static_assert(A_END <= LDS_ST_OFF, "attn LDS");
__device__ __forceinline__ void rope16(float (&v)[32], const float* cs) {
    const f32x4 c0 = *(const f32x4*)cs, c1 = *(const f32x4*)(cs + 4), s0 = *(const f32x4*)(cs + 8), s1 = *(const f32x4*)(cs + 12);
#pragma unroll
    for (int i = 0; i < 8; ++i) { const float cv = i < 4 ? c0[i & 3] : c1[i & 3], sv = i < 4 ? s0[i & 3] : s1[i & 3]; const float x1 = v[i], x2 = v[i + 8]; v[i] = x1 * cv - x2 * sv; v[i + 8] = x2 * cv + x1 * sv; }
}
__device__ __forceinline__ void unpack8(const u32x4 w, float* v) { v[0] = bflo(w.x); v[1] = bfhi(w.x); v[2] = bflo(w.y); v[3] = bfhi(w.y); v[4] = bflo(w.z); v[5] = bfhi(w.z); v[6] = bflo(w.w); v[7] = bfhi(w.w); }
__device__ __forceinline__ void attn_load(const Params& P, int unit, int tid, u32x4 (&kr)[4], u32x4 (&vr)[4], u32x4 (&qr)[8]) {
    const int hk = unit & 1, nb = (unit >> 1) & 63, b = unit >> 7;
    const bf16* proj = (const bf16*)(P.ws + WS_PROJ);
    const int key = tid >> 1, half = tid & 1; const int srel = nb * 128 - 128 + key; const bool ok = srel >= 0; const size_t tokk = (size_t)b * SEQ + (ok ? srel : 0);
    const int g = tid >> 7, ql = tid & 127; const size_t tokq = (size_t)b * SEQ + nb * 128 + ql;
    const u32x4* ksrc = (const u32x4*)(proj + tokk * NPROJ + C_KA + hk * 64 + half * 32);
    const u32x4* vsrc = (const u32x4*)(proj + tokk * NPROJ + C_VA + hk * 64 + half * 32);
    const u32x4* qsrc = (const u32x4*)(proj + tokq * NPROJ + C_QA + (hk * 4 + g) * 64);
#pragma unroll
    for (int j = 0; j < 4; ++j) { kr[j] = ksrc[j]; vr[j] = vsrc[j]; }
#pragma unroll
    for (int j = 0; j < 8; ++j) qr[j] = qsrc[j];
}
__device__ __forceinline__ void attn_unit(const Params& P, LAS unsigned char* lds, int unit, int next_unit, int tid, int wid, int lane, u32x4 (&kr)[4], u32x4 (&vr)[4], u32x4 (&qr)[8]) {
    const int hk = unit & 1, nb = (unit >> 1) & 63, b = unit >> 7;
    const int fr = opaque(lane & 15), fq = opaque(lane >> 4);
    const float* cstab = (const float*)(P.ws + WS_CS);
    {
        const int key = tid >> 1, half = tid & 1; const int srel = nb * 128 - 128 + key;
        const bool ok = srel >= 0; const size_t tokk = (size_t)b * SEQ + (ok ? srel : 0);
        const size_t tokq = (size_t)b * SEQ + nb * 128 + (tid & 127);
        { float v[32];
#pragma unroll
          for (int j = 0; j < 4; ++j) unpack8(kr[j], v + 8 * j);
          float s = 0.f;
#pragma unroll
          for (int j = 0; j < 32; ++j) s += v[j] * v[j];
          s += __shfl_xor(s, 1);
          const float rstd = 1.f / sqrtf(s * (1.f / 64.f) + EPS);
#pragma unroll
          for (int j = 0; j < 8; ++j) { const f32x4 w = *(const f32x4*)(PP(k_norm_w) + half * 32 + 4 * j);
              v[4 * j] *= rstd * w[0]; v[4 * j + 1] *= rstd * w[1]; v[4 * j + 2] *= rstd * w[2]; v[4 * j + 3] *= rstd * w[3]; }
          if (half == 0) rope16(v, cstab + tokk * 16);
#pragma unroll
          for (int j = 0; j < 4; ++j) { u32x4 o; o.x = pk2(v[8 * j], v[8 * j + 1]); o.y = pk2(v[8 * j + 2], v[8 * j + 3]); o.z = pk2(v[8 * j + 4], v[8 * j + 5]); o.w = pk2(v[8 * j + 6], v[8 * j + 7]);
              if (!ok) o = (u32x4){0u, 0u, 0u, 0u};
              *(LAS u32x4*)(lds + A_KT + key * 144 + half * 64 + j * 16) = o; } }
#pragma unroll
        for (int j = 0; j < 4; ++j) { u32x4 w = vr[j]; if (!ok) w = (u32x4){0u, 0u, 0u, 0u};
            LAS bf16* dst = (LAS bf16*)(lds + A_VT) + (half * 32 + 8 * j) * 264 + key;
            dst[0 * 264] = (bf16)(w.x & 0xffffu); dst[1 * 264] = (bf16)(w.x >> 16); dst[2 * 264] = (bf16)(w.y & 0xffffu); dst[3 * 264] = (bf16)(w.y >> 16);
            dst[4 * 264] = (bf16)(w.z & 0xffffu); dst[5 * 264] = (bf16)(w.z >> 16); dst[6 * 264] = (bf16)(w.w & 0xffffu); dst[7 * 264] = (bf16)(w.w >> 16); }
        { float s = 0.f;
#pragma unroll
          for (int j = 0; j < 8; ++j) { float a[8]; unpack8(qr[j], a); s += (a[0] * a[0] + a[1] * a[1]) + (a[2] * a[2] + a[3] * a[3]) + (a[4] * a[4] + a[5] * a[5]) + (a[6] * a[6] + a[7] * a[7]); }
          const float rstd = (0.125f * LOG2E) / sqrtf(s * (1.f / 64.f) + EPS);
#pragma unroll
          for (int hf = 0; hf < 2; ++hf) { float v[32];
#pragma unroll
              for (int j = 0; j < 4; ++j) unpack8(qr[hf * 4 + j], v + 8 * j);
#pragma unroll
              for (int j = 0; j < 8; ++j) { const f32x4 w = *(const f32x4*)(PP(q_norm_w) + hf * 32 + 4 * j);
                  v[4 * j] *= rstd * w[0]; v[4 * j + 1] *= rstd * w[1]; v[4 * j + 2] *= rstd * w[2]; v[4 * j + 3] *= rstd * w[3]; }
              if (hf == 0) rope16(v, cstab + tokq * 16);
#pragma unroll
              for (int j = 0; j < 4; ++j) { u32x4 o; o.x = pk2(v[8 * j], v[8 * j + 1]); o.y = pk2(v[8 * j + 2], v[8 * j + 3]); o.z = pk2(v[8 * j + 4], v[8 * j + 5]); o.w = pk2(v[8 * j + 6], v[8 * j + 7]);
                  *(LAS u32x4*)(lds + A_QS + tid * 144 + hf * 64 + j * 16) = o; } } }
    }
    __syncthreads();
    if (next_unit < 512) attn_load(P, next_unit, tid, kr, vr, qr);
    { const int g = wid >> 1; const float sink = PP(sinks)[hk * 4 + g] * LOG2E;
      bf16* attn = (bf16*)((unsigned char*)P.out + OUT_AH);
#pragma unroll 1
      for (int p = 0; p < 2; ++p) { const int q0 = (wid & 1) * 64 + p * 32;
          f32x4 sT[10][2];
          bf16x8 qf[2][2];
#pragma unroll
          for (int nq = 0; nq < 2; ++nq)
#pragma unroll
              for (int ks = 0; ks < 2; ++ks) qf[nq][ks] = ldfrag(lds + A_QS, g * 128 + q0 + 16 * nq + fr, 144, (ks * 32 + fq * 8) * 2);
#pragma unroll
          for (int kt = 0; kt < 10; ++kt) {
#pragma unroll
              for (int nq = 0; nq < 2; ++nq) sT[kt][nq] = (f32x4){0.f, 0.f, 0.f, 0.f};
#pragma unroll
              for (int ks = 0; ks < 2; ++ks) { const bf16x8 kf = ldfrag(lds + A_KT, q0 + 16 * kt + fr, 144, (ks * 32 + fq * 8) * 2);
#pragma unroll
                  for (int nq = 0; nq < 2; ++nq) if (kt - nq >= 0 && kt - nq <= 8) sT[kt][nq] = __builtin_amdgcn_mfma_f32_16x16x32_bf16(kf, qf[nq][ks], sT[kt][nq], 0, 0, 0); } }
          float linv[2]; const int kmin = (nb == 0) ? 128 : 0;
#pragma unroll
          for (int nq = 0; nq < 2; ++nq) { float mx = sink;
#pragma unroll
              for (int kt = 0; kt < 10; ++kt) { const int d = kt - nq; if (d < 0 || d > 8) continue;
#pragma unroll
                  for (int r = 0; r < 4; ++r) { bool valid = true;
                      if (d == 0) valid = (4 * fq + r > fr); else if (d == 8) valid = (4 * fq + r <= fr);
                      valid = valid && (q0 + 16 * kt + 4 * fq + r >= kmin);
                      sT[kt][nq][r] = valid ? sT[kt][nq][r] : -1e30f; mx = fmaxf(mx, sT[kt][nq][r]); } }
              mx = fmaxf(mx, __shfl_xor(mx, 16)); mx = fmaxf(mx, __shfl_xor(mx, 32));
              float l = 0.f;
#pragma unroll
              for (int kt = 0; kt < 10; ++kt) { const int d = kt - nq; if (d < 0 || d > 8) continue;
#pragma unroll
                  for (int r = 0; r < 4; ++r) { const float e = exp2_(sT[kt][nq][r] - mx); const float pv = (sT[kt][nq][r] > -1e29f) ? e : 0.f; sT[kt][nq][r] = pv; l += pv; } }
              l += __shfl_xor(l, 16); l += __shfl_xor(l, 32);
              l += exp2_(sink - mx);
              linv[nq] = 1.f / l; }
          f32x4 oT[4][2];
#pragma unroll
          for (int dt = 0; dt < 4; ++dt)
#pragma unroll
              for (int nq = 0; nq < 2; ++nq) oT[dt][nq] = (f32x4){0.f, 0.f, 0.f, 0.f};
#pragma unroll
          for (int j = 0; j < 5; ++j) { bf16x8 pf[2];
#pragma unroll
              for (int nq = 0; nq < 2; ++nq) { u32x4 w; w.x = pk2(sT[2 * j][nq][0], sT[2 * j][nq][1]); w.y = pk2(sT[2 * j][nq][2], sT[2 * j][nq][3]); w.z = pk2(sT[2 * j + 1][nq][0], sT[2 * j + 1][nq][1]); w.w = pk2(sT[2 * j + 1][nq][2], sT[2 * j + 1][nq][3]);
                  pf[nq] = __builtin_bit_cast(bf16x8, w); }
#pragma unroll
              for (int dt = 0; dt < 4; ++dt) { const LAS unsigned char* vrow = lds + A_VT + (16 * dt + fr) * 528 + (q0 + 32 * j + 4 * fq) * 2;
                  const u32x2 lo = *(const LAS u32x2*)vrow, hi = *(const LAS u32x2*)(vrow + 32);
                  u32x4 w; w.x = lo.x; w.y = lo.y; w.z = hi.x; w.w = hi.y; const bf16x8 vf = __builtin_bit_cast(bf16x8, w);
#pragma unroll
                  for (int nq = 0; nq < 2; ++nq) oT[dt][nq] = __builtin_amdgcn_mfma_f32_16x16x32_bf16(vf, pf[nq], oT[dt][nq], 0, 0, 0); } }
#pragma unroll
          for (int nq = 0; nq < 2; ++nq) { const size_t tok = (size_t)b * SEQ + nb * 128 + q0 + 16 * nq + fr;
#pragma unroll
              for (int dt = 0; dt < 4; ++dt) { const f32x4 v = oT[dt][nq] * linv[nq]; u32x2 o; o.x = pk2(v[0], v[1]); o.y = pk2(v[2], v[3]);
                  *(u32x2*)(attn + tok * 1024 + (hk * 4 + g) * 64 + 16 * dt + 4 * fq) = o; } }
      } }
    __syncthreads();
}

constexpr int P7_B0 = 25600, P7_B1 = 76288;
__device__ __forceinline__ void phase7(const Params& P, LAS unsigned char* lds, int vcu, int G, int tid, int wid, int lane, bool commit = true) {
    const bf16* Wrh = (const bf16*)(P.ws + WS_WR); const float* ssq = (const float*)(P.ws + WS_SSQ);
    unsigned* cnt = (unsigned*)(P.ws + WS_CTL + CTL_CNT); int* list = (int*)(P.ws + WS_LIST); float* gw = (float*)(P.ws + WS_GW); float* rstdv = (float*)(P.ws + WS_RSTD);
    const int fr = lane & 15, fq = lane >> 4;
    LAS float* LG = (LAS float*)(lds + wid * 3072);
    LAS unsigned* LC = (LAS unsigned*)(lds + 24576); LAS unsigned* LB = (LAS unsigned*)(lds + 24576 + 256);
    if (tid < 64) LC[tid] = 0u;
    __syncthreads();
    for (int base = vcu * 8; base < T / 16; base += G * 8) {
        const int rg = base + wid; const int R0 = rg * 16;
        f32x4 acc[3];
#pragma unroll
        for (int nt = 0; nt < 3; ++nt) acc[nt] = (f32x4){0.f, 0.f, 0.f, 0.f};
        const bf16* xr = (const bf16*)(P.ws + WS_X1B) + (size_t)(R0 + fr) * 1024 + 8 * fq;
        u32x4 wst[6]; bf16x8 xa[8], xb[8];
#define P7_WLOAD(kq) do { _Pragma("unroll") for (int j = 0; j < 6; ++j) { const int idx = tid + 512 * j, mat = idx / 1536, rem = idx - mat * 1536, row = rem >> 5, ch = rem & 31; \
            wst[j] = *(const u32x4*)(Wrh + (size_t)mat * 48 * 1024 + row * 1024 + (kq) * 256 + ch * 8); } } while (0)
#define P7_WSTORE(buf) do { _Pragma("unroll") for (int j = 0; j < 6; ++j) { const int idx = tid + 512 * j, mat = idx / 1536, rem = idx - mat * 1536, row = rem >> 5, ch = rem & 31; \
            *(LAS u32x4*)(lds + (buf) + mat * 25344 + row * 528 + ch * 16) = wst[j]; } } while (0)
#define P7_XLOAD(dst, kq) do { _Pragma("unroll") for (int ks = 0; ks < 8; ++ks) dst[ks] = *(const bf16x8*)(xr + (kq) * 256 + 32 * ks); } while (0)
#define P7_COMPUTE(src, buf) do { _Pragma("unroll") for (int ks = 0; ks < 8; ++ks) { const bf16x8 ah = src[ks]; \
            _Pragma("unroll") for (int nt = 0; nt < 3; ++nt) { const LAS unsigned char* wp = lds + (buf) + (16 * nt + fr) * 528 + (ks * 32 + 8 * fq) * 2; \
                const bf16x8 bh = *(const LAS bf16x8*)wp, bl = *(const LAS bf16x8*)(wp + 25344); \
                acc[nt] = __builtin_amdgcn_mfma_f32_16x16x32_bf16(ah, bh, acc[nt], 0, 0, 0); \
                acc[nt] = __builtin_amdgcn_mfma_f32_16x16x32_bf16(ah, bl, acc[nt], 0, 0, 0); } } } while (0)
        P7_WLOAD(0); P7_XLOAD(xa, 0); P7_WSTORE(P7_B0); P7_WLOAD(1); P7_XLOAD(xb, 1);
        __syncthreads();
        P7_COMPUTE(xa, P7_B0); P7_WSTORE(P7_B1); P7_WLOAD(2); P7_XLOAD(xa, 2);
        __syncthreads();
        P7_COMPUTE(xb, P7_B1); P7_WSTORE(P7_B0); P7_WLOAD(3); P7_XLOAD(xb, 3);
        __syncthreads();
        P7_COMPUTE(xa, P7_B0); P7_WSTORE(P7_B1);
        __syncthreads();
        P7_COMPUTE(xb, P7_B1);
#undef P7_WLOAD
#undef P7_WSTORE
#undef P7_XLOAD
#undef P7_COMPUTE
#pragma unroll
        for (int r = 0; r < 4; ++r) { const float* sp = ssq + (size_t)(R0 + 4 * fq + r) * 16; float tot = 0.f;
#pragma unroll
            for (int q = 0; q < 4; ++q) { const f32x4 v = *(const f32x4*)(sp + 4 * q); tot += v[0]; tot += v[1]; tot += v[2]; tot += v[3]; }
            const float rstd = 1.f / sqrtf(tot * (1.f / 1024.f) + EPS);
            if (fr == 0) rstdv[R0 + 4 * fq + r] = rstd;
#pragma unroll
            for (int nt = 0; nt < 3; ++nt) { const int j = 16 * nt + fr; float bias = 0.f; if (j < 4) bias = PP(b_rg)[j]; else if (j < 36) bias = PP(b_re)[j - 4];
                LG[(4 * fq + r) * 48 + j] = acc[nt][r] * rstd + bias; } }
        __syncthreads();
        int l0 = 0, l1 = 0; unsigned rk0 = 0u, rk1 = 0u;
        if (lane < 16) { const int tok = R0 + lane; const LAS float* lg = LG + lane * 48;
            int gsel = 0; float best = lg[0];
#pragma unroll
            for (int i = 1; i < 4; ++i) { const float v = lg[i]; if (v > best) { best = v; gsel = i; } }
            float Z = 0.f;
#pragma unroll
            for (int i = 0; i < 4; ++i) Z += __expf(lg[i] - best);
            const float pgsel = 1.f / Z;
            const LAS float* le = lg + 4 + gsel * 8;
            float lmax = le[0];
#pragma unroll
            for (int i = 1; i < 8; ++i) lmax = fmaxf(lmax, le[i]);
            float Zp = 0.f;
#pragma unroll
            for (int i = 0; i < 8; ++i) Zp += __expf(le[i] - lmax);
            int i1 = 0; float p1 = -1.f;
#pragma unroll
            for (int i = 0; i < 8; ++i) { const float pe = __expf(le[i] - lmax) / Zp; if (pe > p1) { p1 = pe; i1 = i; } }
            int i2 = 0; float p2 = -1.f;
#pragma unroll
            for (int i = 0; i < 8; ++i) { const float pe = __expf(le[i] - lmax) / Zp; if (i != i1 && pe > p2) { p2 = pe; i2 = i; } }
            const float den = p1 + p2;
            gw[tok * 2 + 0] = pgsel * p1 / den; gw[tok * 2 + 1] = pgsel * p2 / den;
            l0 = gsel * 8 + i1; l1 = 32 + gsel * 8 + i2;
            rk0 = __hip_atomic_fetch_add(&LC[l0], 1u, __ATOMIC_RELAXED, __HIP_MEMORY_SCOPE_WORKGROUP); rk1 = __hip_atomic_fetch_add(&LC[l1], 1u, __ATOMIC_RELAXED, __HIP_MEMORY_SCOPE_WORKGROUP); }
        __syncthreads();
        if (tid < 64) { const unsigned n = LC[tid]; LC[tid] = 0u; if (n && commit) LB[tid] = atomicAdd(&cnt[tid * 64], n); }
        __syncthreads();
        if (lane < 16 && commit) { const int tok = R0 + lane; list[(size_t)l0 * T + LB[l0] + rk0] = tok; list[(size_t)l1 * T + LB[l1] + rk1] = tok; }
        __syncthreads();
    }
}

constexpr int M_PB = 133120, M_CN = 133632, M_RBL = 133888;
__device__ __forceinline__ void moe_prefix(const Params& P, LAS unsigned char* lds, int tid) {
    const unsigned* cnt = (const unsigned*)(P.ws + WS_CTL + CTL_CNT);
    LAS int* PB = (LAS int*)(lds + M_PB); LAS int* CN = (LAS int*)(lds + M_CN);
    if (tid < 64) CN[tid] = (int)cnt[tid * 64];
    __syncthreads();
    if (tid == 0) { int s = 0; for (int l = 0; l < 64; ++l) { PB[l] = s; s += (CN[l] + 255) >> 8; } PB[64] = s; }
    __syncthreads();
    if (tid < 64) { LAS int* RBL = (LAS int*)(lds + M_RBL); for (int rb = PB[tid]; rb < PB[tid + 1]; ++rb) RBL[rb] = tid; }
    __syncthreads();
}
__device__ __forceinline__ void phase8(const Params& P, LAS unsigned char* lds, int vcu, int G) {
    const LAS int* PB = (const LAS int*)(lds + M_PB); const LAS int* CN = (const LAS int*)(lds + M_CN);
    const pg8::MoeSched<0> S{(const char*)(P.ws + WS_HN), (const char*)(P.ws + WS_WGU), (const int*)(P.ws + WS_LIST), PB, CN, (const LAS int*)(lds + M_RBL), 1024, PB[0], (PB[64] - PB[0]) * 4, vcu, G};
    const EpiGateUp E{(const int*)(P.ws + WS_LIST), (const float*)(P.ws + WS_RSTD), (unsigned char*)(P.ws + WS_H)};
    pg8::gemm_phase(lds, S, E);
}
__device__ __forceinline__ void phase9(const Params& P, LAS unsigned char* lds, int vcu, int G) {
    const LAS int* PB = (const LAS int*)(lds + M_PB); const LAS int* CN = (const LAS int*)(lds + M_CN);
    const pg8::MoeSched<1> S{(const char*)(P.ws + WS_H), (const char*)(P.ws + WS_WD), (const int*)(P.ws + WS_LIST), PB, CN, (const LAS int*)(lds + M_RBL), 512, PB[32], (PB[64] - PB[32]) * 4, vcu, G};
    const EpiDownY E{(const int*)(P.ws + WS_LIST), (const float*)(P.ws + WS_GW), (bf16*)(P.ws + WS_Y)};
    pg8::gemm_phase(lds, S, E);
}
__device__ __forceinline__ void phase10(const Params& P, LAS unsigned char* lds, int vcu, int G) {
    const LAS int* PB = (const LAS int*)(lds + M_PB); const LAS int* CN = (const LAS int*)(lds + M_CN);
    const pg8::MoeSched<1> S{(const char*)(P.ws + WS_H), (const char*)(P.ws + WS_WD), (const int*)(P.ws + WS_LIST), PB, CN, (const LAS int*)(lds + M_RBL), 512, PB[0], (PB[32] - PB[0]) * 4, vcu, G};
    const EpiDown E{(const int*)(P.ws + WS_LIST), (const float*)(P.ws + WS_GW), P.out, (const bf16*)(P.ws + WS_X1B), (const bf16*)(P.ws + WS_Y), (const float*)(P.ws + WS_CTL + 32768)};
    pg8::gemm_phase(lds, S, E);
}

__global__ void __launch_bounds__(NTHREADS, 2) mega_fwd(Params P) {
    extern __shared__ __attribute__((aligned(16))) unsigned char lds_raw[];
    LAS unsigned char* lds = (LAS unsigned char*)lds_raw;
    const int tid = threadIdx.x, lane = tid & 63, wid = __builtin_amdgcn_readfirstlane(tid >> 6);
    const int G = gridDim.x; const int bx = blockIdx.x; const int vcu = (G % 8 == 0) ? (bx % 8) * (G / 8) + bx / 8 : bx;
    volatile LAS unsigned* st = (volatile LAS unsigned*)(lds + LDS_ST_OFF);
    if (tid < 16) st[tid] = 0u;
    if (tid == 0) { LAS unsigned long long* pt = (LAS unsigned long long*)(lds + LDS_PTAB);
#define PT_(f) pt[__builtin_offsetof(Params, f) / 8] = (unsigned long long)P.f
        PT_(positions); PT_(norm1_w); PT_(w_in); PT_(q_norm_w); PT_(k_norm_w); PT_(sinks); PT_(hlb); PT_(hnw); PT_(w_ba); PT_(w_bh); PT_(w_out); PT_(norm2_w);
        PT_(w_rg); PT_(b_rg); PT_(w_re); PT_(b_re); PT_(w_gate); PT_(w_up); PT_(w_down);
#undef PT_
    }
    __syncthreads();
    unsigned* bar = (unsigned*)(P.ws + WS_CTL);
    const XcdBarrier xb = xcd_barrier_post(bar, st);

#ifndef DUPMASK
#define DUPMASK 0
#endif
#define DUPQ(k) if ((DUPMASK >> (k)) & 1)
#ifndef PHMASK
#define PHMASK 0xFFFF
#endif
#define PH(k) if ((PHMASK >> (k)) & 1)
    PH(0) phase0(P, lds, vcu, G, tid, wid, lane);
    DUPQ(0) phase0(P, lds, vcu, G, tid, wid, lane);
    xcd_barrier(xb);
    PH(1) phase1(P, lds, G);
    DUPQ(1) phase1(P, lds, G);
    const int ei_p1 = (G == 256) ? 8192 : 0;
    PH(1) if (G == 256 && bx >= 128) { LAS float* cscr = (LAS float*)(lds + wid * 16384); const int w1 = (bx - 128) * 8 + wid;
#pragma unroll 1
        for (int k = 0; k < 8; k += 2) { float tva[32], tvb[32]; const TItem ia = expert_item(P, lds, w1 + k * 1024), ib = expert_item(P, lds, w1 + (k + 1) * 1024);
            titem_load(ia, lane, tva); titem_load(ib, lane, tvb); titem_store(ia, lane, tva, cscr); titem_store(ib, lane, tvb, cscr); } }
    xcd_barrier(xb);
    PH(2) {
        int cit = ei_p1 + vcu * 8 + wid; const int cstride = G * 8;
        for (int u = bx; u < 256; u += G) {
            if ((u & 15) != 15) { hgrn_unit<0>(P, lds, u, tid, wid, lane, cit, cstride); cit += 16 * cstride; } }
        LAS float* cscr = (LAS float*)(lds + (wid < 4 ? H_QT + wid * 8448 : H_ST + (wid - 4) * 8448));
        for (; cit < EI_TOTAL; cit += cstride) { float tv[32]; const TItem t = expert_item(P, lds, cit); titem_load(t, lane, tv); titem_store(t, lane, tv, cscr); }
    }
    DUPQ(2) for (int u = bx; u < 256; u += G) if ((u & 15) != 15) hgrn_unit<0>(P, lds, u, tid, wid, lane);
    xcd_barrier(xb);
    PH(3) { hgrn_scan(P, G, tid);
    { u32x4 kr[4], vr[4], qr[8]; if (bx < 512) attn_load(P, bx, tid, kr, vr, qr);
      for (int u = bx; u < 512; u += G) attn_unit(P, lds, u, u + G, tid, wid, lane, kr, vr, qr); } }
    DUPQ(3) { u32x4 kr[4], vr[4], qr[8]; if (bx < 512) attn_load(P, bx, tid, kr, vr, qr);
      for (int u = bx; u < 512; u += G) attn_unit(P, lds, u, u + G, tid, wid, lane, kr, vr, qr); }
    xcd_barrier(xb);
    PH(4) for (int u = bx; u < 256; u += G) hgrn_unit<1>(P, lds, u, tid, wid, lane);
    DUPQ(4) for (int u = bx; u < 256; u += G) hgrn_unit<1>(P, lds, u, tid, wid, lane);
    xcd_barrier(xb);
    PH(5) phase5(P, lds, G);
    DUPQ(5) phase5(P, lds, G);
    xcd_barrier(xb);
    PH(6) phase6(P, lds, G);
    DUPQ(6) phase6(P, lds, G);
    xcd_barrier(xb);
    if ((DUPMASK >> 7) & 1) phase7(P, lds, vcu, G, tid, wid, lane, false);
    PH(7) phase7(P, lds, vcu, G, tid, wid, lane);
    xcd_barrier(xb);
    moe_prefix(P, lds, tid);
    PH(8) phase8(P, lds, vcu, G);
    DUPQ(8) phase8(P, lds, vcu, G);
    xcd_barrier(xb);
    PH(9) phase9(P, lds, vcu, G);
    xcd_barrier(xb);
    PH(10) phase10(P, lds, vcu, G);
    if (xb_ld(&bar[XB_TMO]) != 0u && tid == 0) P.out[(size_t)bx * 1024] = __builtin_nanf("");
}

extern "C" void kernel_launch(void* const* d_in, const int* in_sizes, int n_in, void* d_out, int out_size, void* d_ws, size_t ws_size, hipStream_t stream) {
    static int grid = 0;
    if (grid == 0) {
        if (n_in != 20 || out_size != T * D || ws_size < WS_END) { fprintf(stderr, "kernel_launch: unexpected shapes (n_in %d out %d ws %zu, need ws >= %zu)\n", n_in, out_size, ws_size, (size_t)WS_END); grid = -1; return; }
        int dev = 0, cus = 0, per_cu = 0;
        if (hipGetDevice(&dev) != hipSuccess || hipDeviceGetAttribute(&cus, hipDeviceAttributeMultiprocessorCount, dev) != hipSuccess) { grid = -1; return; }
        if (hipFuncSetAttribute((const void*)mega_fwd, hipFuncAttributeMaxDynamicSharedMemorySize, LDS_BYTES) != hipSuccess) { fprintf(stderr, "hipFuncSetAttribute failed\n"); grid = -1; return; }
        if (hipOccupancyMaxActiveBlocksPerMultiprocessor(&per_cu, (const void*)mega_fwd, NTHREADS, LDS_BYTES) != hipSuccess || per_cu < 1) { fprintf(stderr, "occupancy query: %d blocks/CU\n", per_cu); grid = -1; return; }
        grid = cus;
    }
    if (grid < 0) return;
    if (hipMemsetAsync((char*)d_ws + WS_CTL, 0, 96 * 1024, stream) != hipSuccess) return;
    Params p{};
    p.x = (const float*)d_in[0]; p.positions = (const int*)d_in[1]; p.norm1_w = (const float*)d_in[2]; p.w_in = (const float*)d_in[3];
    p.q_norm_w = (const float*)d_in[4]; p.k_norm_w = (const float*)d_in[5]; p.sinks = (const float*)d_in[6]; p.hlb = (const float*)d_in[7];
    p.hnw = (const float*)d_in[8]; p.w_ba = (const float*)d_in[9]; p.w_bh = (const float*)d_in[10]; p.w_out = (const float*)d_in[11];
    p.norm2_w = (const float*)d_in[12]; p.w_rg = (const float*)d_in[13]; p.b_rg = (const float*)d_in[14]; p.w_re = (const float*)d_in[15];
    p.b_re = (const float*)d_in[16]; p.w_gate = (const float*)d_in[17]; p.w_up = (const float*)d_in[18]; p.w_down = (const float*)d_in[19];
    p.out = (float*)d_out; p.ws = (unsigned char*)d_ws;
    void* args[] = {&p};
    const hipError_t e = hipLaunchCooperativeKernel((const void*)mega_fwd, dim3(grid), dim3(NTHREADS), args, LDS_BYTES, stream);
    if (e != hipSuccess) fprintf(stderr, "cooperative launch failed: %s (grid %d)\n", hipGetErrorString(e), grid);
}
```
